# Optimizing an MI355X kernel written in HIP

```python
import jax, jax.numpy as jnp
from jax import lax
import numpy as np

D_MODEL = 2048
BATCH = 2
SEQ = 4096
DEPTH = 4

CHUNK = 64
PLE_DIM = 256
EPS = 1e-6
MLA_HEADS = 16
Q_LORA = 512
KV_LORA = 512
QK_NOPE = 128
QK_ROPE = 64
V_DIM = 128
QK_DIM = QK_NOPE + QK_ROPE
ROPE_THETA = 10000.0
Q_BLOCK = 128
SSM_EXPAND = 2
D_INNER = SSM_EXPAND * D_MODEL
SSM_HEADDIM = 64
SSM_HEADS = D_INNER // SSM_HEADDIM
SSM_GROUPS = 8
SSM_STATE = 128
HEADS_PER_GROUP = SSM_HEADS // SSM_GROUPS
CONV_WIDTH = 4
CONV_DIM = D_INNER + 2 * SSM_GROUPS * SSM_STATE
SSD_CHUNK = CHUNK
D_FF = 4 * D_MODEL
N_BRANCH = 2
SPLIT_POINTS = (
    Q_LORA,
    Q_LORA + KV_LORA,
    Q_LORA + KV_LORA + QK_ROPE,
    Q_LORA + KV_LORA + QK_ROPE + D_INNER,
    Q_LORA + KV_LORA + QK_ROPE + D_INNER + CONV_DIM,
    Q_LORA + KV_LORA + QK_ROPE + D_INNER + CONV_DIM + SSM_HEADS,
)
D_IN_PROJ = Q_LORA + KV_LORA + QK_ROPE + D_INNER + CONV_DIM + SSM_HEADS + N_BRANCH * D_MODEL

kernel_name = 'hybrid_mla_ssd_parallel_gated_trunk'


def rms_norm(x, w):
    xf = x.astype(jnp.float32)
    y = xf * lax.rsqrt(jnp.mean(xf * xf, axis=-1, keepdims=True) + EPS)
    return (y * w.astype(jnp.float32)).astype(x.dtype)


def rope_tables(positions):
    inv_freq = 1.0 / (ROPE_THETA ** (jnp.arange(0, QK_ROPE, 2, dtype=jnp.float32) / QK_ROPE))
    ang = positions.astype(jnp.float32)[..., None] * inv_freq
    return jnp.cos(ang), jnp.sin(ang)


def apply_rope(x, cos, sin):
    xf = x.astype(jnp.float32)
    x1, x2 = jnp.split(xf, 2, axis=-1)
    c = cos[:, :, None, :]
    s = sin[:, :, None, :]
    return jnp.concatenate([x1 * c - x2 * s, x1 * s + x2 * c], axis=-1).astype(x.dtype)


def chunk_causal_attention(q, k, v):
    B, S, H, Dh = q.shape
    n_blk = S // Q_BLOCK
    scale = Dh ** -0.5
    qb = q.reshape(B, n_blk, Q_BLOCK, H, Dh).transpose(1, 0, 3, 2, 4)
    kh = k.transpose(0, 2, 1, 3)
    vh = v.transpose(0, 2, 1, 3)
    key_chunk = jnp.arange(S) // CHUNK

    def one_block(args):
        q_blk, blk = args
        s = jnp.einsum('bhqd,bhkd->bhqk', q_blk, kh, preferred_element_type=jnp.float32) * scale
        q_chunk = (blk * Q_BLOCK + jnp.arange(Q_BLOCK)) // CHUNK
        mask = key_chunk[None, :] <= q_chunk[:, None]
        s = jnp.where(mask, s, -jnp.inf)
        pr = jax.nn.softmax(s, axis=-1)
        return jnp.einsum('bhqk,bhkd->bhqd', pr.astype(vh.dtype), vh)

    o = lax.map(one_block, (qb, jnp.arange(n_blk)))
    return o.transpose(1, 0, 3, 2, 4).reshape(B, S, H, V_DIM)


def mla_branch(c_q, c_kv, k_r, cos, sin, q_a_norm_w, w_uq, kv_a_norm_w, w_ukv, q_norm_w, k_norm_w):
    B, S, _ = c_q.shape
    q = (rms_norm(c_q, q_a_norm_w) @ w_uq).reshape(B, S, MLA_HEADS, QK_DIM)
    kv = (rms_norm(c_kv, kv_a_norm_w) @ w_ukv).reshape(B, S, MLA_HEADS, QK_NOPE + V_DIM)
    k_nope, v = kv[..., :QK_NOPE], kv[..., QK_NOPE:]
    k_rope = jnp.broadcast_to(k_r[:, :, None, :], (B, S, MLA_HEADS, QK_ROPE))
    k = jnp.concatenate([k_nope, k_rope], axis=-1)
    q = rms_norm(q, q_norm_w)
    k = rms_norm(k, k_norm_w)
    q = jnp.concatenate([q[..., :QK_NOPE], apply_rope(q[..., QK_NOPE:], cos, sin)], axis=-1)
    k = jnp.concatenate([k[..., :QK_NOPE], apply_rope(k[..., QK_NOPE:], cos, sin)], axis=-1)
    o = chunk_causal_attention(q, k, v)
    return o.reshape(B, S, MLA_HEADS * V_DIM)


def causal_depthwise_conv(x, w, b):
    S = x.shape[1]
    xp = jnp.pad(x, ((0, 0), (CONV_WIDTH - 1, 0), (0, 0)))
    y = xp[:, 0:S] * w[0]
    for tap in range(1, CONV_WIDTH):
        y = y + xp[:, tap:tap + S] * w[tap]
    return y + b


def ssd_branch(xbc_raw, z, dt_raw, conv_w, conv_b, dt_bias, a_log, d_skip, ssm_norm_w):
    B, S, _ = z.shape
    G, R, P, N, T = SSM_GROUPS, HEADS_PER_GROUP, SSM_HEADDIM, SSM_STATE, SSD_CHUNK
    nc = S // T
    xbc = jax.nn.silu(causal_depthwise_conv(xbc_raw, conv_w, conv_b)).astype(jnp.float32)
    x5 = xbc[..., :D_INNER].reshape(B, nc, T, G, R, P)
    Bm = xbc[..., D_INNER:D_INNER + G * N].reshape(B, nc, T, G, N)
    Cm = xbc[..., D_INNER + G * N:].reshape(B, nc, T, G, N)
    dt = jax.nn.softplus(dt_raw.astype(jnp.float32) + dt_bias.astype(jnp.float32))
    A = -jnp.exp(a_log.astype(jnp.float32))
    dt5 = dt.reshape(B, nc, T, G, R)
    a_cum = jnp.cumsum((dt * A).reshape(B, nc, T, G, R), axis=2)
    seg = a_cum[:, :, :, None] - a_cum[:, :, None]
    tri = jnp.tril(jnp.ones((T, T), dtype=bool))
    decay = jnp.exp(jnp.where(tri[:, :, None, None], seg, -jnp.inf))
    cb = jnp.einsum('bctgn,bcsgn->bctsg', Cm, Bm)
    m = cb[..., None] * decay * dt5[:, :, None]
    y_diag = jnp.einsum('bctsgr,bcsgrp->bctgrp', m, x5)
    decay_to_end = jnp.exp(a_cum[:, :, -1:] - a_cum)
    states = jnp.einsum('bcsgn,bcsgr,bcsgrp->bcgrpn', Bm, decay_to_end * dt5, x5)
    chunk_decay = jnp.exp(a_cum[:, :, -1])

    def step(h, inp):
        st, dec = inp
        return h * dec[..., None, None] + st, h

    h0 = jnp.zeros((B, G, R, P, N), jnp.float32)
    _, prev = lax.scan(step, h0, (jnp.moveaxis(states, 1, 0), jnp.moveaxis(chunk_decay, 1, 0)))
    prev = jnp.moveaxis(prev, 0, 1)
    y_off = jnp.einsum('bctgn,bcgrpn,bctgr->bctgrp', Cm, prev, jnp.exp(a_cum))
    y = y_diag + y_off + d_skip.astype(jnp.float32).reshape(G, R)[..., None] * x5
    y = y.reshape(B, S, D_INNER) * jax.nn.silu(z.astype(jnp.float32))
    yg = y.reshape(B, S, G, D_INNER // G)
    yg = yg * lax.rsqrt(jnp.mean(yg * yg, axis=-1, keepdims=True) + EPS)
    y = yg.reshape(B, S, D_INNER) * ssm_norm_w.astype(jnp.float32)
    return y.astype(z.dtype)


def setup_inputs(seed: int = 0) -> dict:
    key = jax.random.key(seed)
    ks = jax.random.split(key, 32)
    f32 = jnp.float32

    def nrm(k, shape, fan_in):
        return jax.random.normal(k, shape, f32) * (fan_in ** -0.5)

    def gain(k, dim):
        return 1.0 + 0.02 * jax.random.normal(k, (DEPTH, dim), f32)

    x = jax.random.normal(ks[0], (BATCH, SEQ, D_MODEL), f32)
    p = jax.random.normal(ks[1], (DEPTH, BATCH, SEQ, PLE_DIM), f32)
    start = jax.random.randint(ks[2], (BATCH, 1), 0, 16384, dtype=jnp.int32)
    positions = (start + jnp.arange(SEQ, dtype=jnp.int32)[None, :]).astype(jnp.int32)
    dt_init = jnp.exp(jax.random.uniform(ks[15], (DEPTH, SSM_HEADS), f32, np.log(1e-3), np.log(1e-1)))
    dt_bias = dt_init + jnp.log(-jnp.expm1(-dt_init))
    a_log = jnp.log(jax.random.uniform(ks[16], (DEPTH, SSM_HEADS), f32, 1.0, 16.0))
    return {
        'x': x,
        'p': p,
        'positions': positions,
        'norm_mix_w': gain(ks[3], D_MODEL),
        'w_in': nrm(ks[4], (DEPTH, D_MODEL, D_IN_PROJ), D_MODEL),
        'q_a_norm_w': gain(ks[5], Q_LORA),
        'w_uq': nrm(ks[6], (DEPTH, Q_LORA, MLA_HEADS * QK_DIM), Q_LORA),
        'kv_a_norm_w': gain(ks[7], KV_LORA),
        'w_ukv': nrm(ks[8], (DEPTH, KV_LORA, MLA_HEADS * (QK_NOPE + V_DIM)), KV_LORA),
        'q_norm_w': gain(ks[9], QK_DIM),
        'k_norm_w': gain(ks[10], QK_DIM),
        'w_o_mla': nrm(ks[11], (DEPTH, MLA_HEADS * V_DIM, D_MODEL), MLA_HEADS * V_DIM),
        'conv_w': nrm(ks[12], (DEPTH, CONV_WIDTH, CONV_DIM), CONV_WIDTH),
        'conv_b': 0.01 * jax.random.normal(ks[13], (DEPTH, CONV_DIM), f32),
        'dt_bias': dt_bias,
        'a_log': a_log,
        'd_skip': 1.0 + 0.1 * jax.random.normal(ks[17], (DEPTH, SSM_HEADS), f32),
        'ssm_norm_w': gain(ks[18], D_INNER),
        'w_o_ssm': nrm(ks[19], (DEPTH, D_INNER, D_MODEL), D_INNER),
        'w_out': nrm(ks[20], (DEPTH, D_MODEL, D_MODEL), D_MODEL),
        'norm_mlp_w': gain(ks[21], D_MODEL),
        'w_up': nrm(ks[22], (DEPTH, D_MODEL, D_FF), D_MODEL),
        'w_down': nrm(ks[23], (DEPTH, D_FF, D_MODEL), D_FF),
        'ple_norm_w': gain(ks[24], D_MODEL),
        'w_ple_gate': nrm(ks[25], (DEPTH, D_MODEL, D_MODEL), D_MODEL),
        'w_ple': nrm(ks[26], (DEPTH, PLE_DIM, D_MODEL), PLE_DIM),
    }


def reference(x, p, positions, norm_mix_w, w_in, q_a_norm_w, w_uq, kv_a_norm_w, w_ukv,
              q_norm_w, k_norm_w, w_o_mla, conv_w, conv_b, dt_bias, a_log, d_skip,
              ssm_norm_w, w_o_ssm, w_out, norm_mlp_w, w_up, w_down, ple_norm_w,
              w_ple_gate, w_ple):
    B, S, _ = x.shape
    cos, sin = rope_tables(positions)
    for i in range(DEPTH):
        h = rms_norm(x, norm_mix_w[i])
        proj = h @ w_in[i]
        c_q, c_kv, k_r, z, xbc, dt_raw, gate_logits = jnp.split(proj, SPLIT_POINTS, axis=-1)
        y_a = mla_branch(c_q, c_kv, k_r, cos, sin, q_a_norm_w[i], w_uq[i], kv_a_norm_w[i],
                         w_ukv[i], q_norm_w[i], k_norm_w[i]) @ w_o_mla[i]
        y_b = ssd_branch(xbc, z, dt_raw, conv_w[i], conv_b[i], dt_bias[i], a_log[i],
                         d_skip[i], ssm_norm_w[i]) @ w_o_ssm[i]
        g = jax.nn.sigmoid(gate_logits.astype(jnp.float32)).reshape(B, S, N_BRANCH, D_MODEL)
        merged = (g[:, :, 0] * y_a + g[:, :, 1] * y_b).astype(x.dtype)
        x = x + (merged @ w_out[i]).astype(x.dtype)
        h2 = rms_norm(x, norm_mlp_w[i])
        x = x + (jnp.square(jax.nn.relu(h2 @ w_up[i])) @ w_down[i]).astype(x.dtype)
        ple_gate = jax.nn.sigmoid((rms_norm(x, ple_norm_w[i]) @ w_ple_gate[i]).astype(jnp.float32))
        x = x + ((p[i] @ w_ple[i]) * ple_gate).astype(x.dtype)
    return x
```

```cpp
#include <hip/hip_runtime.h>
#include <cstdio>
#include <cstdint>

#ifndef MK_ONE_LAUNCH
#define MK_ONE_LAUNCH 0
#endif
#ifndef FAST_GEMM
#define FAST_GEMM 0
#endif

constexpr int NB = 2, SEQ = 4096, M = NB * SEQ, DM = 2048, DEPTH = 4, PLE = 256;
constexpr float EPS = 1e-6f;
constexpr int NH = 16, QL = 512, KVL = 512, NOPE = 128, ROPE = 64, VD = 128, QK = 192;
constexpr int DI = 4096, HD = 64, SH = 64, SG = 8, SN = 128, HPG = 8, CW = 4, CONVD = 6144, TC = 64, NCH = SEQ / TC;
constexpr int DFF = 8192;
constexpr int DIN = 15488;
constexpr int DINP = 15616;
constexpr int PC_CQ = 0, PC_CKV = 512, PC_Z = 1024, PC_XBC = 5120, PC_G = 11264, PC_KR = 15360, PC_DT = 15424, PC_PAD = 15488;
constexpr int NWAVES = 8, NTHR = 512;

typedef unsigned short bf16;
typedef unsigned u32x4 __attribute__((ext_vector_type(4)));
typedef unsigned u32x2 __attribute__((ext_vector_type(2)));
typedef float f32x4 __attribute__((ext_vector_type(4)));
typedef float f32x2 __attribute__((ext_vector_type(2)));
typedef short bf16x8 __attribute__((ext_vector_type(8)));
#define GAS __attribute__((address_space(1)))
#define LAS __attribute__((address_space(3)))
typedef GAS unsigned gu32;
#define RLX_AGENT __ATOMIC_RELAXED, __HIP_MEMORY_SCOPE_AGENT
#define LDS_WAIT() asm volatile("s_waitcnt lgkmcnt(0)" ::: "memory")
#define VM_WAIT() asm volatile("s_waitcnt vmcnt(0)" ::: "memory")

constexpr size_t MiB = 1u << 20;
constexpr size_t WS_CTL = 0, CTL_ZERO_BYTES = 2 * MiB;
constexpr int CW_TMO = 0, CW_CODE = 1, CW_BAR = 4096;
typedef unsigned long long u64;
constexpr int CW_SSQX = 16384;
constexpr int CW_SSQC = CW_SSQX + 2 * DEPTH * 3 * M;
static_assert((size_t)(CW_SSQC + 2 * DEPTH * 2 * M) * 4 <= CTL_ZERO_BYTES, "ctl");
constexpr size_t WL_IN = 0, WL_UQ = 61 * MiB, WL_UKV = 64 * MiB, WL_OM = 68 * MiB, WL_OS = 76 * MiB, WL_OUT = 92 * MiB, WL_UP = 100 * MiB, WL_DN = 132 * MiB, WL_PG = 164 * MiB, WL_PL = 172 * MiB, WL_BYTES = 173 * MiB;
static_assert((size_t)DINP * DM * 2 == 61 * MiB, "w_in copy");
constexpr size_t WS_W = 2 * MiB;
constexpr size_t WS_ACT = WS_W + DEPTH * WL_BYTES;
constexpr size_t WS_XB = WS_ACT;
constexpr size_t WS_XB1 = WS_XB + 32 * MiB, WS_XB2 = WS_XB1 + 32 * MiB;
constexpr size_t WS_PROJ = WS_XB2 + 32 * MiB;
constexpr size_t WS_U = WS_PROJ;
constexpr size_t WS_MISC = WS_PROJ + 244 * MiB;
constexpr size_t WS_QRAW = WS_MISC + 4 * MiB;
constexpr size_t WS_KVRAW = WS_QRAW + 48 * MiB;
constexpr size_t WS_KF = WS_KVRAW + 64 * MiB;
constexpr size_t WS_AO = WS_KF + 48 * MiB;
constexpr size_t WS_XC = WS_AO + 32 * MiB;
constexpr size_t WS_DTS = WS_XC + 96 * MiB;
constexpr size_t WS_CDEC = WS_DTS + 2 * MiB;
constexpr size_t WS_ST = WS_CDEC + 1 * MiB;
constexpr size_t WS_YPRE = WS_ST + 256 * MiB;
constexpr size_t WS_Y = WS_YPRE + 128 * MiB;
constexpr size_t WS_TMPF = WS_Y + 64 * MiB;
constexpr size_t WS_MERGED = WS_TMPF + 64 * MiB;
constexpr size_t WS_PE = WS_MERGED + 32 * MiB;
constexpr size_t WS_PB = WS_PE + 32 * MiB;
constexpr size_t WS_COS = WS_PB + 16 * MiB;
constexpr size_t WS_SIN = WS_COS + 1 * MiB;
constexpr size_t WS_END = WS_SIN + 1 * MiB;
static_assert(WS_END <= 1936 * MiB, "d_ws budget (4 x the largest input)");

constexpr int RING_OFF = 0, RING_BYTES = 131072;
constexpr int LDSCTL_OFF = RING_BYTES, MISC_OFF = LDSCTL_OFF + 320;
constexpr int EXTRA_OFF = LDSCTL_OFF + 512, LDS_BYTES = 147456, EXTRA_BYTES = LDS_BYTES - EXTRA_OFF;

__device__ __forceinline__ unsigned f2bf(float f) { unsigned u = __builtin_bit_cast(unsigned, f); return (u + 0x7fffu + ((u >> 16) & 1u)) >> 16; }
__device__ __forceinline__ float bf2f(unsigned h) { return __builtin_bit_cast(float, h << 16); }
typedef __bf16 bf16x2_t __attribute__((ext_vector_type(2)));
__device__ __forceinline__ unsigned pk2(float lo, float hi) { const f32x2 v = {lo, hi}; const bf16x2_t b = __builtin_convertvector(v, bf16x2_t); return __builtin_bit_cast(unsigned, b); }
__device__ __forceinline__ u32x4 pack8(const float (&v)[8]) { u32x4 w; w.x = pk2(v[0], v[1]); w.y = pk2(v[2], v[3]); w.z = pk2(v[4], v[5]); w.w = pk2(v[6], v[7]); return w; }
__device__ __forceinline__ void unpack8(u32x4 w, float (&v)[8]) {
    v[0] = bf2f(w.x & 0xffffu); v[1] = bf2f(w.x >> 16); v[2] = bf2f(w.y & 0xffffu); v[3] = bf2f(w.y >> 16);
    v[4] = bf2f(w.z & 0xffffu); v[5] = bf2f(w.z >> 16); v[6] = bf2f(w.w & 0xffffu); v[7] = bf2f(w.w >> 16); }
__device__ __forceinline__ float wave_sum(float v) {
#pragma unroll
    for (int o = 1; o < 64; o <<= 1) v += __shfl_xor(v, o);
    return v;
}
__device__ __forceinline__ float wave_max(float v) {
#pragma unroll
    for (int o = 1; o < 64; o <<= 1) v = fmaxf(v, __shfl_xor(v, o));
    return v;
}
__device__ __forceinline__ float sigmoidf_(float x) { return 1.f / (1.f + __expf(-x)); }
__device__ __forceinline__ float siluf_(float x) { return x / (1.f + __expf(-x)); }

#define XB_TMO      128
#define XB_XCNT(j)  (256  + 64 * (j))
#define XB_XSUB(j)  (1280 + 64 * (j))
#define XB_XGEN(j)  (2304 + 64 * (j))
#define XB_TOP      3328
#define XB_TOPGEN   3392
#define XCD_BAR_WORDS 3456
#define XB_SPIN_CAP (1u << 18)
__device__ __forceinline__ unsigned xb_ld(unsigned* p)              { return __hip_atomic_load(p, __ATOMIC_RELAXED, __HIP_MEMORY_SCOPE_AGENT); }
__device__ __forceinline__ unsigned xb_add(unsigned* p, unsigned v) { return __hip_atomic_fetch_add(p, v, __ATOMIC_RELAXED, __HIP_MEMORY_SCOPE_AGENT); }
__device__ __forceinline__ unsigned xb_xcc_id() { return (unsigned)__builtin_amdgcn_s_getreg((3 << 11) | 20) & 0xFu; }
#define XB_SPIN(cond, bar) do { unsigned _sp = 0; while (cond) { __builtin_amdgcn_s_sleep(1); \
    if ((++_sp & 255u) == 0u) { if (xb_ld(&(bar)[XB_TMO])) break; if (_sp > XB_SPIN_CAP) { atomicAdd(&(bar)[XB_TMO], 1u); break; } } } } while (0)
struct XcdBarrier { unsigned* bar; unsigned x; volatile LAS unsigned* st; };
__device__ __forceinline__ XcdBarrier xcd_barrier_post(unsigned* bar, volatile LAS unsigned* st) {
    XcdBarrier b; b.bar = bar; b.x = xb_xcc_id(); b.st = st;
    if (threadIdx.x == 0) (void)xb_add(&bar[XB_XCNT(b.x)], 1u);
    return b;
}
__device__ __forceinline__ void xcd_barrier_complete(unsigned* bar, unsigned x, unsigned& nloc, unsigned& nx) {
    const unsigned G = gridDim.x * gridDim.y * gridDim.z;
    unsigned sum, cnt, mine, sp = 0u;
    for (;;) {
        sum = 0u; cnt = 0u; mine = 0u;
#pragma unroll
        for (unsigned j = 0; j < 16; ++j) { const unsigned c = xb_ld(&bar[XB_XCNT(j)]); sum += c; cnt += (c > 0u) ? 1u : 0u; mine = (j == x) ? c : mine; }
        if (sum == G) break;
        __builtin_amdgcn_s_sleep(1);
        if ((++sp & 255u) == 0u) { if (xb_ld(&bar[XB_TMO])) break; if (sp > XB_SPIN_CAP) { atomicAdd(&bar[XB_TMO], 1u); break; } }
    }
    nloc = mine > 0u ? mine : 1u; nx = cnt > 0u ? cnt : 1u;
}
__device__ __forceinline__ void xcd_barrier(const XcdBarrier& b) {
    asm volatile("s_waitcnt vmcnt(0)" ::: "memory");
    __syncthreads();
    if (threadIdx.x == 0) {
        unsigned* bar = b.bar;
        __builtin_amdgcn_s_waitcnt(0);
        unsigned nloc = b.st[0], nx = b.st[1];
        if (nloc == 0u) { xcd_barrier_complete(bar, b.x, nloc, nx); b.st[0] = nloc; b.st[1] = nx; }
        const unsigned old = xb_add(&bar[XB_XSUB(b.x)], 1u);
        const unsigned gen = old / nloc;
        if (old + 1u == (gen + 1u) * nloc) {
            __builtin_amdgcn_fence(__ATOMIC_RELEASE, "agent");
            asm volatile("s_waitcnt vmcnt(0)" ::: "memory");
            const unsigned og = xb_add(&bar[XB_TOP], 1u);
            const unsigned tg = og / nx;
            if (og + 1u == (tg + 1u) * nx) xb_add(&bar[XB_TOPGEN], 1u);
            else XB_SPIN(xb_ld(&bar[XB_TOPGEN]) == tg, bar);
            __builtin_amdgcn_fence(__ATOMIC_ACQUIRE, "agent");
            xb_add(&bar[XB_XGEN(b.x)], 1u);
            asm volatile("s_waitcnt vmcnt(0)" ::: "memory");
        } else {
            XB_SPIN(xb_ld(&bar[XB_XGEN(b.x)]) == gen, bar);
            __builtin_amdgcn_fence(__ATOMIC_ACQUIRE, "agent");
            asm volatile("s_waitcnt vmcnt(0)" ::: "memory");
        }
    }
    __syncthreads();
}

namespace pg8 {
typedef unsigned short bf16_t;
constexpr int BM = 256, BK = 64, HALF = 128, HTB = HALF * BK * 2, STAGE_BYTES = 8 * HTB, NXCD = 8, WGM = 8;
__host__ __device__ __forceinline__ int lds_byte(int r, int c) { const int st = (r >> 4) * 2 + (c >> 5), rr = r & 15, cc = c & 31, ob = rr * 64 + cc * 2; return st * 1024 + (ob ^ (((ob >> 9) & 1) << 5)); }
__host__ __device__ __forceinline__ void stage_rc(int b, int& R, int& C) { const int st = b / 1024, sb = b % 1024, swz = sb ^ (((sb >> 9) & 1) << 5); R = (st >> 1) * 16 + swz / 64; C = (st & 1) * 32 + (swz % 64) / 2; }
__host__ __device__ __forceinline__ int perm32(int rho) { const int n = rho >> 4, i = rho & 15; return 8 * (i >> 2) + 4 * n + (i & 3); }
struct Unit { int pm, pn; };
struct Gemm { const bf16_t* A; const bf16_t* Bt; int M, N, K, lda; };
struct StaticOrder {
    int nM, nN, nwg, G, c;
    __host__ __device__ void init(int M_, int N_, int G_, int c_) { nM = M_ / BM; nN = N_ / BM; nwg = nM * nN; G = G_; c = c_; }
    __host__ __device__ bool next(int i, Unit& u) const {
        const long L = (long)i * G + c; if (L >= nwg) return false;
        int wgid = (int)L; { const int q = nwg / NXCD, r = nwg % NXCD, xcd = wgid % NXCD, off = wgid / NXCD; wgid = (xcd < r ? xcd * (q + 1) : r * (q + 1) + (xcd - r) * q) + off; }
        const int nig = WGM * nN, gid = wgid / nig, fm = gid * WGM, gsz = (nM - fm) < WGM ? (nM - fm) : WGM;
        u.pm = fm + ((wgid % nig) % gsz); u.pn = (wgid % nig) / gsz; return true;
    }
    __device__ __forceinline__ void a_ready(const Unit&) const {}
    __device__ __forceinline__ void done(const Unit&) const {}
};

template <class Epi, class Sched>
__device__ __forceinline__ void gemm_phase(LAS unsigned char* lds, const Gemm g, const Sched& S, const Epi& E) {
    const int tid = threadIdx.x, wid = __builtin_amdgcn_readfirstlane(tid >> 6), lane = tid & 63, wr = wid >> 2, wc = wid & 3, fr = lane & 15, fq = lane >> 4;
    const int K = g.K, nt = K / BK, lda = g.lda;
    unsigned voffA[2], voffB[2];
#pragma unroll
    for (int i = 0; i < 2; ++i) { int R, C; stage_rc(tid * 16 + i * 8192, R, C); const int Rb = (R & ~31) + perm32(R & 31);
        voffA[i] = (unsigned)(R * lda + C) * 2u; voffB[i] = (unsigned)(Rb * K + C) * 2u; }
    const size_t kstep = (size_t)(BK * 2);
    const size_t hstepA = (size_t)HALF * lda * 2, hstepB = (size_t)HALF * K * 2;
    const size_t tstepA = 2 * hstepA, tstepB = 2 * hstepB;
    const unsigned ldsw = (unsigned)wid * 1024u;
    const int aoff = lds_byte(wr * 64 + fr, fq * 8), boff = lds_byte(wc * 32 + fr, fq * 8);
#define PG8_SA(b, h) (((b) * 2 + (h)) * HTB)
#define PG8_SB(b, h) ((4 + (b) * 2 + (h)) * HTB)
#define PG8_STAGE(bufoff, gbase, voff) do { _Pragma("unroll") for (int _i = 0; _i < 2; ++_i) \
        __builtin_amdgcn_global_load_lds((const unsigned*)((const char*)(gbase) + (voff)[_i]), (LAS unsigned*)(lds + (bufoff) + ldsw + _i * 8192), 16, 0, 0); } while (0)
#define PG8_LDA(dst, b, h) do { _Pragma("unroll") for (int m = 0; m < 4; ++m) _Pragma("unroll") for (int k = 0; k < 2; ++k) dst[m][k] = *(const LAS bf16x8*)(lds + PG8_SA(b, h) + aoff + m * 2048 + k * 1024); } while (0)
#define PG8_LDB(dst, b, h) do { _Pragma("unroll") for (int n = 0; n < 2; ++n) _Pragma("unroll") for (int k = 0; k < 2; ++k) dst[n][k] = *(const LAS bf16x8*)(lds + PG8_SB(b, h) + boff + n * 2048 + k * 1024); } while (0)
#define PG8_MMA(ai, bj, At, Bt) do { __builtin_amdgcn_s_setprio(1); _Pragma("unroll") for (int m = 0; m < 4; ++m) _Pragma("unroll") for (int n = 0; n < 2; ++n) _Pragma("unroll") for (int k = 0; k < 2; ++k) \
        acc[ai][bj][m][n] = __builtin_amdgcn_mfma_f32_16x16x32_bf16(Bt[n][k], At[m][k], acc[ai][bj][m][n], 0, 0, 0); __builtin_amdgcn_s_setprio(0); } while (0)
#define PG8_WAIT_V(n) asm volatile("s_waitcnt vmcnt(" #n ")" ::: "memory")
#define PG8_WAIT_L(n) asm volatile("s_waitcnt lgkmcnt(" #n ")" ::: "memory")
#define PG8_BAR __builtin_amdgcn_s_barrier()
#define PG8_SCHED __builtin_amdgcn_sched_barrier(0)
    Unit cur, nxt; int ui = 0;
    if (!S.next(0, cur)) return;
    f32x4 acc[2][2][4][2];
#pragma unroll
    for (int a = 0; a < 2; ++a)
#pragma unroll
        for (int b = 0; b < 2; ++b)
#pragma unroll
            for (int m = 0; m < 4; ++m)
#pragma unroll
                for (int n = 0; n < 2; ++n) acc[a][b][m][n] = (f32x4){0.f, 0.f, 0.f, 0.f};
    bf16x8 At[4][2], B0[2][2], B1[2][2];
    const char* cA = (const char*)g.A + (size_t)cur.pm * tstepA; const char* cB = (const char*)g.Bt + (size_t)cur.pn * tstepB;
    S.a_ready(cur);
    PG8_STAGE(PG8_SB(0, 0), cB, voffB); PG8_STAGE(PG8_SB(0, 1), cB + hstepB, voffB); PG8_STAGE(PG8_SA(0, 0), cA, voffA); PG8_STAGE(PG8_SA(0, 1), cA + hstepA, voffA);
    if (wr == 1) PG8_BAR;
    PG8_WAIT_V(2); PG8_BAR;
    PG8_STAGE(PG8_SB(1, 0), cB + kstep, voffB); PG8_STAGE(PG8_SA(1, 0), cA + kstep, voffA); PG8_STAGE(PG8_SB(1, 1), cB + hstepB + kstep, voffB);
    PG8_WAIT_V(6); PG8_BAR;
    for (;;) {
        const bool has_next = S.next(ui + 1, nxt);
        const char* nA = has_next ? (const char*)g.A + (size_t)nxt.pm * tstepA : cA; const char* nB = has_next ? (const char*)g.Bt + (size_t)nxt.pn * tstepB : cB;
        for (int t = 0; t < nt; t += 2) {
            const bool last = (t == nt - 2);
            const char* a1 = cA + (size_t)(t + 1) * kstep;
            const char* a2 = last ? nA : cA + (size_t)(t + 2) * kstep; const char* b2 = last ? nB : cB + (size_t)(t + 2) * kstep;
            const char* a3 = a2 + kstep; const char* b3 = b2 + kstep;
            if (last && has_next) S.a_ready(nxt);
            PG8_LDB(B0, 0, 0); PG8_LDB(B1, 0, 1); PG8_SCHED; PG8_LDA(At, 0, 0); PG8_STAGE(PG8_SA(1, 1), a1 + hstepA, voffA);
            PG8_WAIT_V(8); PG8_WAIT_L(0); PG8_BAR; PG8_MMA(0, 0, At, B0); PG8_MMA(0, 1, At, B1); PG8_BAR; PG8_SCHED;
            PG8_LDA(At, 0, 1); PG8_STAGE(PG8_SB(0, 0), b2, voffB); PG8_STAGE(PG8_SB(0, 1), b2 + hstepB, voffB); PG8_STAGE(PG8_SA(0, 0), a2, voffA);
            PG8_WAIT_V(8); PG8_WAIT_L(0); PG8_BAR; PG8_MMA(1, 0, At, B0); PG8_MMA(1, 1, At, B1); PG8_BAR; PG8_SCHED;
            PG8_LDB(B0, 1, 0); PG8_LDB(B1, 1, 1); PG8_SCHED; PG8_LDA(At, 1, 0); PG8_STAGE(PG8_SA(0, 1), a2 + hstepA, voffA);
            PG8_WAIT_V(8); PG8_WAIT_L(0); PG8_BAR; PG8_MMA(0, 0, At, B0); PG8_MMA(0, 1, At, B1); PG8_BAR; PG8_SCHED;
            PG8_LDA(At, 1, 1); PG8_STAGE(PG8_SB(1, 0), b3, voffB); PG8_STAGE(PG8_SB(1, 1), b3 + hstepB, voffB); PG8_STAGE(PG8_SA(1, 0), a3, voffA);
            PG8_WAIT_V(8); PG8_WAIT_L(0); PG8_BAR; PG8_MMA(1, 0, At, B0); PG8_MMA(1, 1, At, B1); PG8_BAR; PG8_SCHED;
        }
        if (wr == 0) PG8_BAR;
        {
            const int row0 = cur.pm * BM + wr * 64 + fr, col00 = cur.pn * BM + wc * 32 + 8 * fq;
#pragma unroll
            for (int ai = 0; ai < 2; ++ai)
#pragma unroll
                for (int m = 0; m < 4; ++m)
#pragma unroll
                    for (int bj = 0; bj < 2; ++bj) {
                        const float v[8] = {acc[ai][bj][m][0][0], acc[ai][bj][m][0][1], acc[ai][bj][m][0][2], acc[ai][bj][m][0][3], acc[ai][bj][m][1][0], acc[ai][bj][m][1][1], acc[ai][bj][m][1][2], acc[ai][bj][m][1][3]};
                        E(row0 + ai * HALF + m * 16, col00 + bj * HALF, v);
                    }
        }
        S.done(cur);
        if (!has_next) break;
#pragma unroll
        for (int a = 0; a < 2; ++a)
#pragma unroll
            for (int b = 0; b < 2; ++b)
#pragma unroll
                for (int m = 0; m < 4; ++m)
#pragma unroll
                    for (int n = 0; n < 2; ++n) acc[a][b][m][n] = (f32x4){0.f, 0.f, 0.f, 0.f};
        cur = nxt; cA = nA; cB = nB; ++ui;
        if (wr == 1) PG8_BAR;
    }
    PG8_WAIT_V(0);
    PG8_BAR;
#undef PG8_SA
#undef PG8_SB
#undef PG8_STAGE
#undef PG8_LDA
#undef PG8_LDB
#undef PG8_MMA
#undef PG8_WAIT_V
#undef PG8_WAIT_L
#undef PG8_BAR
#undef PG8_SCHED
}

template <class Epi>
__device__ __forceinline__ void gemm_simple(const Gemm g, const Epi& E, int G, int wg) {
    const int tid = threadIdx.x, wid = tid >> 6, lane = tid & 63, fr = lane & 15, fq = lane >> 4;
    const int nbn = g.N / 32, nblk = (g.M / 16) * nbn;
    for (int it = wg * NWAVES + wid; it < nblk; it += G * NWAVES) {
        const int m0 = (it / nbn) * 16, n0 = (it % nbn) * 32;
        f32x4 acc0 = {0.f, 0.f, 0.f, 0.f}, acc1 = {0.f, 0.f, 0.f, 0.f};
        const bf16_t* ap = g.A + (size_t)(m0 + fr) * g.lda + 8 * fq;
        const bf16_t* bp0 = g.Bt + (size_t)(n0 + perm32(fr)) * g.K + 8 * fq;
        const bf16_t* bp1 = g.Bt + (size_t)(n0 + perm32(16 + fr)) * g.K + 8 * fq;
        for (int k0 = 0; k0 < g.K; k0 += 32) {
            const bf16x8 a = *(const bf16x8*)(ap + k0), b0 = *(const bf16x8*)(bp0 + k0), b1 = *(const bf16x8*)(bp1 + k0);
            acc0 = __builtin_amdgcn_mfma_f32_16x16x32_bf16(b0, a, acc0, 0, 0, 0);
            acc1 = __builtin_amdgcn_mfma_f32_16x16x32_bf16(b1, a, acc1, 0, 0, 0);
        }
        const float v[8] = {acc0[0], acc0[1], acc0[2], acc0[3], acc1[0], acc1[1], acc1[2], acc1[3]};
        E(m0 + fr, n0 + 8 * fq, v);
    }
}
}

template <class Epi>
__device__ __forceinline__ void run_gemm(LAS unsigned char* lds, const pg8::Gemm g, const Epi& E, int G, int wg) {
#if FAST_GEMM
    pg8::StaticOrder S; S.init(g.M, g.N, G, wg);
    pg8::gemm_phase<Epi, pg8::StaticOrder>(lds, g, S, E);
#else
    pg8::gemm_simple<Epi>(g, E, G, wg);
#endif
}

constexpr float SSQ_SCALE = 16777216.f, SSQ_INV = 1.f / 16777216.f;
__device__ __forceinline__ void ssq_add(u64* dst, int row, const float (&v)[8]) {
    float s = 0.f;
#pragma unroll
    for (int j = 0; j < 8; ++j) s += v[j] * v[j];
    s += __shfl_xor(s, 16); s += __shfl_xor(s, 32);
    if ((threadIdx.x & 63) < 16) atomicAdd(dst + row, (u64)(s * SSQ_SCALE));
}
__device__ __forceinline__ float ld_ssq(const u64* p) { return (float)__hip_atomic_load(p, __ATOMIC_RELAXED, __HIP_MEMORY_SCOPE_AGENT) * SSQ_INV; }
__device__ __forceinline__ void st_f32x8(float* p, const float (&v)[8]) { *(f32x4*)p = (f32x4){v[0], v[1], v[2], v[3]}; *(f32x4*)(p + 4) = (f32x4){v[4], v[5], v[6], v[7]}; }
__device__ __forceinline__ void ld_f32x8(const float* p, float (&v)[8]) { const f32x4 a = *(const f32x4*)p, b = *(const f32x4*)(p + 4); v[0] = a.x; v[1] = a.y; v[2] = a.z; v[3] = a.w; v[4] = b.x; v[5] = b.y; v[6] = b.z; v[7] = b.w; }
__device__ __forceinline__ void ld_bf16x8(const bf16* p, float (&v)[8]) { unpack8(*(const u32x4*)p, v); }

struct EpiInProj {
    const u64* ssq; u64* ssqc; bf16* proj; float* misc;
    __device__ __forceinline__ void operator()(int row, int col0, const float (&a)[8]) const {
        const float rs = rsqrtf(ld_ssq(ssq + row) * (1.f / DM) + EPS);
        float v[8];
#pragma unroll
        for (int j = 0; j < 8; ++j) v[j] = a[j] * rs;
        const int tile = col0 >> 8;
        if (tile == 60) { const int c = col0 - PC_KR; if (c < 128) st_f32x8(misc + (size_t)row * 128 + c, v); return; }
        if (tile >= 44) {
#pragma unroll
            for (int j = 0; j < 8; ++j) v[j] = sigmoidf_(v[j]);
        }
        *(u32x4*)(proj + (size_t)row * DINP + col0) = pack8(v);
        if (tile < 4) ssq_add(ssqc + (size_t)(tile >> 1) * M, row, v);
    }
};
struct EpiScaleBf16 {
    const u64* ssq; float inv_n; bf16* O; int ldo;
    __device__ __forceinline__ void operator()(int row, int col0, const float (&a)[8]) const {
        const float rs = ssq ? rsqrtf(ld_ssq(ssq + row) * inv_n + EPS) : 1.f;
        float v[8];
#pragma unroll
        for (int j = 0; j < 8; ++j) v[j] = a[j] * rs;
        *(u32x4*)(O + (size_t)row * ldo + col0) = pack8(v);
    }
};
struct EpiGateF32 {
    const bf16* proj; float* T;
    __device__ __forceinline__ void operator()(int row, int col0, const float (&a)[8]) const {
        float g[8], v[8]; ld_bf16x8(proj + (size_t)row * DINP + PC_G + col0, g);
#pragma unroll
        for (int j = 0; j < 8; ++j) v[j] = a[j] * g[j];
        st_f32x8(T + (size_t)row * DM + col0, v);
    }
};
struct EpiMerge {
    const bf16* proj; const float* T; bf16* O;
    __device__ __forceinline__ void operator()(int row, int col0, const float (&a)[8]) const {
        float g[8], t[8], v[8]; ld_bf16x8(proj + (size_t)row * DINP + PC_G + DM + col0, g); ld_f32x8(T + (size_t)row * DM + col0, t);
#pragma unroll
        for (int j = 0; j < 8; ++j) v[j] = t[j] + a[j] * g[j];
        *(u32x4*)(O + (size_t)row * DM + col0) = pack8(v);
    }
};
struct EpiResid {
    float* X; bf16* XB; u64* ssq_next;
    __device__ __forceinline__ void operator()(int row, int col0, const float (&a)[8]) const {
        float x[8]; ld_f32x8(X + (size_t)row * DM + col0, x);
#pragma unroll
        for (int j = 0; j < 8; ++j) x[j] += a[j];
        st_f32x8(X + (size_t)row * DM + col0, x);
        *(u32x4*)(XB + (size_t)row * DM + col0) = pack8(x);
        if (ssq_next) ssq_add(ssq_next, row, x);
    }
};
struct EpiUp {
    const u64* ssq; bf16* U;
    __device__ __forceinline__ void operator()(int row, int col0, const float (&a)[8]) const {
        const float rs = rsqrtf(ld_ssq(ssq + row) * (1.f / DM) + EPS);
        float v[8];
#pragma unroll
        for (int j = 0; j < 8; ++j) { const float r = fmaxf(a[j] * rs, 0.f); v[j] = r * r; }
        *(u32x4*)(U + (size_t)row * DFF + col0) = pack8(v);
    }
};
struct EpiPleGate {
    const u64* ssq; const bf16* PE; float* X; bf16* XB; u64* ssq_next;
    __device__ __forceinline__ void operator()(int row, int col0, const float (&a)[8]) const {
        const float rs = rsqrtf(ld_ssq(ssq + row) * (1.f / DM) + EPS);
        float x[8], pe[8]; ld_f32x8(X + (size_t)row * DM + col0, x); ld_bf16x8(PE + (size_t)row * DM + col0, pe);
#pragma unroll
        for (int j = 0; j < 8; ++j) { float d = pe[j] * sigmoidf_(a[j] * rs);
#if defined(DBG_VAR) && DBG_VAR == 1
            d = pe[j];
#elif defined(DBG_VAR) && DBG_VAR == 2
            d = sigmoidf_(a[j] * rs);
#elif defined(DBG_VAR) && DBG_VAR == 4
            d = pe[j] - x[j];
#elif defined(DBG_VAR) && (DBG_VAR == 5 || DBG_VAR == 6)
            d = (col0 < 256 && (DBG_VAR == 5 || row < 2048)) ? (bf2f(((const bf16*)PE)[(size_t)row * 256 + col0 + j]) - x[j]) : 0.f;
#elif defined(DBG_VAR) && DBG_VAR == 3
            d = a[j] * 0.01f;
#endif
#ifdef DBG_SANITIZE
            if (!(fabsf(d) < 1e4f)) d = 0.f;
#endif
            x[j] += d; }
        st_f32x8(X + (size_t)row * DM + col0, x);
        *(u32x4*)(XB + (size_t)row * DM + col0) = pack8(x);
        if (ssq_next) ssq_add(ssq_next, row, x);
    }
};

__device__ __forceinline__ void transpose_item(const float* W, int K, int Nsrc, int nsrc0, const float* gain, bf16* WT, int ndst0, int k0, LAS float* scr, int lane) {
#pragma unroll 8
    for (int i = 0; i < 32; ++i) { const int kk = 2 * i + (lane >> 5);
        float w = 0.f; if (nsrc0 >= 0) { w = W[(size_t)(k0 + kk) * Nsrc + nsrc0 + (lane & 31)]; if (gain) w *= gain[k0 + kk]; }
        scr[kk * 33 + (lane & 31)] = w; }
    LDS_WAIT(); asm volatile("" ::: "memory");
    const int c = lane & 7;
#pragma unroll
    for (int j = 0; j < 4; ++j) { const int n = (lane >> 3) + 8 * j; const LAS float* s = scr + (8 * c) * 33 + n;
        u32x4 o; o.x = pk2(s[0 * 33], s[1 * 33]); o.y = pk2(s[2 * 33], s[3 * 33]); o.z = pk2(s[4 * 33], s[5 * 33]); o.w = pk2(s[6 * 33], s[7 * 33]);
        *(u32x4*)(WT + (size_t)(ndst0 + n) * K + k0 + 8 * c) = o; }
    LDS_WAIT(); asm volatile("" ::: "memory");
}
__host__ __device__ __forceinline__ int inproj_src_col(int n) {
    if (n < PC_Z) return n;
    if (n < PC_G) return n + 64;
    if (n < PC_KR) return n + 128;
    if (n < PC_DT) return n - PC_KR + 1024;
    if (n < PC_PAD) return n - PC_DT + 11328;
    return -1;
}
struct In { const float* p[26]; };
constexpr int I_IN = (DM / 64) * (DINP / 32), I_UQ = (QL / 64) * (NH * QK / 32), I_UKV = (KVL / 64) * (NH * 256 / 32), I_OM = (DM / 64) * (DM / 32), I_OS = (DI / 64) * (DM / 32),
              I_OUT = I_OM, I_UP = (DM / 64) * (DFF / 32), I_DN = (DFF / 64) * (DM / 32), I_PG = I_OM, I_PL = (PLE / 64) * (DM / 32),
              I_LAYER = I_IN + I_UQ + I_UKV + I_OM + I_OS + I_OUT + I_UP + I_DN + I_PG + I_PL;
__device__ __forceinline__ void prologue_weights(const In& in, unsigned char* ws, LAS unsigned char* lds, int G, int wg) {
    const int wave = threadIdx.x >> 6, lane = threadIdx.x & 63;
    LAS float* scr = (LAS float*)(lds + RING_OFF + wave * 16384);
    for (int it = wg * NWAVES + wave; it < DEPTH * I_LAYER; it += G * NWAVES) {
        const int l = it / I_LAYER; int r = it % I_LAYER;
        unsigned char* wl = ws + WS_W + (size_t)l * WL_BYTES;
        if (r < I_IN) { const int nblk = DINP / 32, kb = r / nblk, nb = r % nblk;
            transpose_item(in.p[4] + (size_t)l * DM * DIN, DM, DIN, inproj_src_col(32 * nb), in.p[3] + l * DM, (bf16*)(wl + WL_IN), 32 * nb, 64 * kb, scr, lane); continue; } r -= I_IN;
        if (r < I_UQ) { const int nblk = NH * QK / 32, kb = r / nblk, nb = r % nblk;
            transpose_item(in.p[6] + (size_t)l * QL * NH * QK, QL, NH * QK, 32 * nb, in.p[5] + l * QL, (bf16*)(wl + WL_UQ), 32 * nb, 64 * kb, scr, lane); continue; } r -= I_UQ;
        if (r < I_UKV) { const int nblk = NH * 256 / 32, kb = r / nblk, nb = r % nblk;
            transpose_item(in.p[8] + (size_t)l * KVL * NH * 256, KVL, NH * 256, 32 * nb, in.p[7] + l * KVL, (bf16*)(wl + WL_UKV), 32 * nb, 64 * kb, scr, lane); continue; } r -= I_UKV;
        if (r < I_OM) { const int nblk = DM / 32, kb = r / nblk, nb = r % nblk;
            transpose_item(in.p[11] + (size_t)l * DM * DM, DM, DM, 32 * nb, nullptr, (bf16*)(wl + WL_OM), 32 * nb, 64 * kb, scr, lane); continue; } r -= I_OM;
        if (r < I_OS) { const int nblk = DM / 32, kb = r / nblk, nb = r % nblk;
            transpose_item(in.p[18] + (size_t)l * DI * DM, DI, DM, 32 * nb, in.p[17] + l * DI, (bf16*)(wl + WL_OS), 32 * nb, 64 * kb, scr, lane); continue; } r -= I_OS;
        if (r < I_OUT) { const int nblk = DM / 32, kb = r / nblk, nb = r % nblk;
            transpose_item(in.p[19] + (size_t)l * DM * DM, DM, DM, 32 * nb, nullptr, (bf16*)(wl + WL_OUT), 32 * nb, 64 * kb, scr, lane); continue; } r -= I_OUT;
        if (r < I_UP) { const int nblk = DFF / 32, kb = r / nblk, nb = r % nblk;
            transpose_item(in.p[21] + (size_t)l * DM * DFF, DM, DFF, 32 * nb, in.p[20] + l * DM, (bf16*)(wl + WL_UP), 32 * nb, 64 * kb, scr, lane); continue; } r -= I_UP;
        if (r < I_DN) { const int nblk = DM / 32, kb = r / nblk, nb = r % nblk;
            transpose_item(in.p[22] + (size_t)l * DFF * DM, DFF, DM, 32 * nb, nullptr, (bf16*)(wl + WL_DN), 32 * nb, 64 * kb, scr, lane); continue; } r -= I_DN;
        if (r < I_PG) { const int nblk = DM / 32, kb = r / nblk, nb = r % nblk;
            transpose_item(in.p[24] + (size_t)l * DM * DM, DM, DM, 32 * nb, in.p[23] + l * DM, (bf16*)(wl + WL_PG), 32 * nb, 64 * kb, scr, lane); continue; } r -= I_PG;
        { const int nblk = DM / 32, kb = r / nblk, nb = r % nblk;
            transpose_item(in.p[25] + (size_t)l * PLE * DM, PLE, DM, 32 * nb, nullptr, (bf16*)(wl + WL_PL), 32 * nb, 64 * kb, scr, lane); }
    }
}
__device__ __forceinline__ void prologue_rows(const In& in, float* out, unsigned char* ws, int G, int wg) {
    const int wave = threadIdx.x >> 6, lane = threadIdx.x & 63, gw = wg * NWAVES + wave, NGW = G * NWAVES;
    const float* x = in.p[0]; bf16* XB = (bf16*)(ws + WS_XB); u64* ssq0 = (u64*)((unsigned*)(ws + WS_CTL) + CW_SSQX);
    for (int m = gw; m < M; m += NGW) {
        float s = 0.f;
#pragma unroll
        for (int j = 0; j < 8; ++j) { const f32x4 v = *(const f32x4*)(x + (size_t)m * DM + j * 256 + lane * 4);
            *(f32x4*)(out + (size_t)m * DM + j * 256 + lane * 4) = v; s += v.x * v.x + v.y * v.y + v.z * v.z + v.w * v.w;
            u32x2 o; o.x = pk2(v.x, v.y); o.y = pk2(v.z, v.w); *(u32x2*)(XB + (size_t)m * DM + j * 256 + lane * 4) = o; }
        s = wave_sum(s); if (lane == 0) ssq0[m] = (u64)(s * SSQ_SCALE);
    }
    {
        u64* z0 = (u64*)((unsigned*)(ws + WS_CTL) + CW_SSQX) + M; const int nz = (DEPTH * 3 - 1) * M + DEPTH * 2 * M;
        for (int i = wg * NTHR + threadIdx.x; i < nz; i += G * NTHR) z0[i] = 0ull;
    }
    const float* p = in.p[1]; bf16* PB = (bf16*)(ws + WS_PB);
    for (size_t i = (size_t)wg * NTHR + threadIdx.x; i < (size_t)DEPTH * M * PLE / 8; i += (size_t)G * NTHR) { float v[8]; ld_f32x8(p + i * 8, v); *(u32x4*)(PB + i * 8) = pack8(v); }
    const int* pos = (const int*)in.p[2]; float* COS = (float*)(ws + WS_COS); float* SIN = (float*)(ws + WS_SIN);
    for (int i = wg * NTHR + threadIdx.x; i < M * 32; i += G * NTHR) { const int m = i >> 5, k = i & 31;
        const float invf = 1.0f / (float)pow(10000.0, (double)k / 32.0);
        const float ang = (float)pos[m] * invf;
        COS[i] = (float)cos((double)ang); SIN[i] = (float)sin((double)ang); }
}

__device__ __forceinline__ void phase_kfin(const bf16* KVRAW, const float* MISC, const float* kw, const float* COS, const float* SIN, bf16* KF, int G, int wg) {
    const int wave = threadIdx.x >> 6, lane = threadIdx.x & 63;
    const float w0 = kw[lane], w1 = kw[64 + lane], w2 = kw[128 + lane];
    for (int it = wg * NWAVES + wave; it < M * NH; it += G * NWAVES) {
        const int m = it >> 4, h = it & 15;
        const float a0 = bf2f(KVRAW[(size_t)m * 4096 + h * 256 + lane]), a1 = bf2f(KVRAW[(size_t)m * 4096 + h * 256 + 64 + lane]), a2 = MISC[(size_t)m * 128 + lane];
        const float ss = wave_sum(a0 * a0 + a1 * a1 + a2 * a2), rs = rsqrtf(ss * (1.f / QK) + EPS);
        const float t2 = a2 * rs * w2, o2 = __shfl_xor(t2, 32);
        const float c = COS[m * 32 + (lane & 31)], s = SIN[m * 32 + (lane & 31)];
        const float r2 = lane < 32 ? (t2 * c - o2 * s) : (o2 * s + t2 * c);
        bf16* o = KF + (size_t)m * (NH * QK) + h * QK;
        o[lane] = (bf16)f2bf(a0 * rs * w0); o[64 + lane] = (bf16)f2bf(a1 * rs * w1); o[128 + lane] = (bf16)f2bf(r2);
    }
}
__device__ __forceinline__ void phase_ssdpre(const bf16* PROJ, const float* MISC, const float* cw, const float* cb, const float* dtb, bf16* XC, float* DTS, int G, int wg) {
    for (int i = wg * NTHR + threadIdx.x; i < M * (CONVD / 8); i += G * NTHR) {
        const int m = i / (CONVD / 8), c0 = (i % (CONVD / 8)) * 8, t = m % SEQ;
        float acc[8]; ld_f32x8(cb + c0, acc);
#pragma unroll
        for (int j = 0; j < CW; ++j) { const int tt = t - (CW - 1) + j;
            if (tt >= 0) { float xv[8], wv[8]; ld_bf16x8(PROJ + (size_t)(m - (CW - 1) + j) * DINP + PC_XBC + c0, xv); ld_f32x8(cw + j * CONVD + c0, wv);
#pragma unroll
                for (int e = 0; e < 8; ++e) acc[e] += xv[e] * wv[e]; } }
#pragma unroll
        for (int e = 0; e < 8; ++e) acc[e] = siluf_(acc[e]);
        *(u32x4*)(XC + (size_t)m * CONVD + c0) = pack8(acc);
    }
    for (int i = wg * NTHR + threadIdx.x; i < M * SH; i += G * NTHR) { const int m = i >> 6, h = i & 63;
        const float x = MISC[(size_t)m * 128 + 64 + h] + dtb[h]; DTS[i] = x > 20.f ? x : log1pf(__expf(x)); }
}
__device__ __forceinline__ void phase_ssdnorm(const float* YPRE, const bf16* PROJ, bf16* Y, int G, int wg) {
    const int wave = threadIdx.x >> 6, lane = threadIdx.x & 63;
    for (int it = wg * NWAVES + wave; it < M * SG; it += G * NWAVES) {
        const int m = it >> 3, g = it & 7, c0 = g * 512 + lane * 8;
        float y[8], z[8]; ld_f32x8(YPRE + (size_t)m * DI + c0, y); ld_bf16x8(PROJ + (size_t)m * DINP + PC_Z + c0, z);
        float s = 0.f;
#pragma unroll
        for (int e = 0; e < 8; ++e) { y[e] *= siluf_(z[e]); s += y[e] * y[e]; }
        const float rs = rsqrtf(wave_sum(s) * (1.f / 512.f) + EPS);
#pragma unroll
        for (int e = 0; e < 8; ++e) y[e] *= rs;
        *(u32x4*)(Y + (size_t)m * DI + c0) = pack8(y);
    }
}

__device__ __forceinline__ void phase_attn_simple(const bf16* QRAW, const bf16* KF, const bf16* KVRAW, const float* qw, const float* COS, const float* SIN, bf16* AO, LAS unsigned char* lds, int G, int wg) {
    const int wave = threadIdx.x >> 6, lane = threadIdx.x & 63;
    LAS float* sc = (LAS float*)(lds + RING_OFF + wave * 16384);
    LAS float* qs = (LAS float*)(lds + EXTRA_OFF + wave * 768);
    const float w0 = qw[lane], w1 = qw[64 + lane], w2 = qw[128 + lane];
    for (int it = wg * NWAVES + wave; it < NB * NH * SEQ; it += G * NWAVES) {
        const int t = it % SEQ, bh = it / SEQ, h = bh % NH, b = bh / NH, m = b * SEQ + t;
        const bf16* qp = QRAW + (size_t)m * (NH * QK) + h * QK;
        const float a0 = bf2f(qp[lane]), a1 = bf2f(qp[64 + lane]), a2 = bf2f(qp[128 + lane]);
        const float ss = wave_sum(a0 * a0 + a1 * a1 + a2 * a2), rs = rsqrtf(ss * (1.f / QK) + EPS);
        const float t2 = a2 * rs * w2, o2 = __shfl_xor(t2, 32);
        const float c = COS[m * 32 + (lane & 31)], s = SIN[m * 32 + (lane & 31)];
        const float r2 = lane < 32 ? (t2 * c - o2 * s) : (o2 * s + t2 * c);
        const float scale = 0.07216878364870322f;
        qs[lane] = a0 * rs * w0 * scale; qs[64 + lane] = a1 * rs * w1 * scale; qs[128 + lane] = r2 * scale;
        LDS_WAIT();
        const int nk = (t / TC + 1) * TC;
        float mx = -3.0e38f;
        for (int j = lane; j < nk; j += 64) {
            const bf16* kp = KF + (size_t)(b * SEQ + j) * (NH * QK) + h * QK;
            float acc = 0.f;
#pragma unroll 4
            for (int d = 0; d < QK; d += 8) { float kv[8]; ld_bf16x8(kp + d, kv);
#pragma unroll
                for (int e = 0; e < 8; ++e) acc += qs[d + e] * kv[e]; }
            sc[j] = acc; mx = fmaxf(mx, acc);
        }
        mx = wave_max(mx);
        LDS_WAIT();
        float l = 0.f;
        for (int j = lane; j < nk; j += 64) { const float p = __expf(sc[j] - mx); sc[j] = p; l += p; }
        l = wave_sum(l);
        LDS_WAIT();
        float o0 = 0.f, o1 = 0.f;
        const bf16* vp = KVRAW + (size_t)(b * SEQ) * 4096 + h * 256 + 128;
#pragma unroll 8
        for (int j = 0; j < nk; ++j) { const float p = sc[j]; o0 += p * bf2f(vp[(size_t)j * 4096 + lane]); o1 += p * bf2f(vp[(size_t)j * 4096 + 64 + lane]); }
        const float il = 1.f / l;
        AO[(size_t)m * DM + h * VD + lane] = (bf16)f2bf(o0 * il); AO[(size_t)m * DM + h * VD + 64 + lane] = (bf16)f2bf(o1 * il);
        LDS_WAIT();
    }
}
__device__ __forceinline__ float wave_scan(float v, int lane) {
#pragma unroll
    for (int o = 1; o < 64; o <<= 1) { const float n = __shfl_up(v, o); if (lane >= o) v += n; }
    return v;
}
__device__ __forceinline__ void phase_ssd_states(const bf16* XC, const float* DTS, const float* a_log, float* ST, float* CDEC, LAS unsigned char* lds, int G, int wg) {
    LAS float* wsh = (LAS float*)(lds + RING_OFF);
    const int tid = threadIdx.x;
    for (int it = wg; it < NB * NCH * SH; it += G) {
        const int h = it % SH, bc = it / SH, m0 = bc * TC, g = h / HPG;
        __syncthreads();
        if (tid < 64) { const float A = -__expf(a_log[h]), dt = DTS[(size_t)(m0 + tid) * SH + h];
            const float ac = wave_scan(dt * A, tid), last = __shfl(ac, 63);
            wsh[tid] = __expf(last - ac) * dt; if (tid == 63) CDEC[bc * SH + h] = __expf(last); }
        __syncthreads();
        const int p = tid >> 3, n0 = (tid & 7) * 16;
        float acc[16];
#pragma unroll
        for (int e = 0; e < 16; ++e) acc[e] = 0.f;
        for (int s = 0; s < TC; ++s) {
            const float xw = bf2f(XC[(size_t)(m0 + s) * CONVD + h * HD + p]) * wsh[s];
            float b0[8], b1[8]; ld_bf16x8(XC + (size_t)(m0 + s) * CONVD + DI + g * SN + n0, b0); ld_bf16x8(XC + (size_t)(m0 + s) * CONVD + DI + g * SN + n0 + 8, b1);
#pragma unroll
            for (int e = 0; e < 8; ++e) { acc[e] += xw * b0[e]; acc[8 + e] += xw * b1[e]; }
        }
        float* o = ST + (((size_t)bc * SH + h) * HD + p) * SN + n0;
#pragma unroll
        for (int e = 0; e < 16; e += 4) *(f32x4*)(o + e) = (f32x4){acc[e], acc[e + 1], acc[e + 2], acc[e + 3]};
    }
}
__device__ __forceinline__ void phase_ssd_scan(float* ST, const float* CDEC, int G, int wg) {
    constexpr int PER_B = SH * HD * SN;
    for (int e = wg * NTHR + threadIdx.x; e < NB * PER_B; e += G * NTHR) {
        const int b = e / PER_B, r = e % PER_B, h = r / (HD * SN);
        float state = 0.f;
        for (int c = 0; c < NCH; ++c) { const size_t idx = (size_t)(b * NCH + c) * PER_B + r; const float tmp = ST[idx]; ST[idx] = state; state = state * CDEC[(b * NCH + c) * SH + h] + tmp; }
    }
}
__device__ __forceinline__ void phase_ssd_out(const bf16* XC, const float* DTS, const float* a_log, const float* dskip, const float* ST, float* YPRE, LAS unsigned char* lds, int G, int wg) {
    LAS float* Mm = (LAS float*)(lds + RING_OFF);
    LAS float* acs = (LAS float*)(lds + RING_OFF + 20480);
    LAS float* dts = acs + 64;
    const int tid = threadIdx.x;
    for (int it = wg; it < NB * NCH * SH; it += G) {
        const int h = it % SH, bc = it / SH, m0 = bc * TC, g = h / HPG;
        __syncthreads();
        if (tid < 64) { const float A = -__expf(a_log[h]), dt = DTS[(size_t)(m0 + tid) * SH + h]; acs[tid] = wave_scan(dt * A, tid); dts[tid] = dt; }
        __syncthreads();
        for (int i = 0; i < 8; ++i) { const int e = tid + NTHR * i, t = e >> 6, s = e & 63;
            float v = 0.f;
            if (s <= t) { const bf16* cp = XC + (size_t)(m0 + t) * CONVD + DI + SG * SN + g * SN; const bf16* bp = XC + (size_t)(m0 + s) * CONVD + DI + g * SN;
                float dot = 0.f;
#pragma unroll 4
                for (int n = 0; n < SN; n += 8) { float cv[8], bv[8]; ld_bf16x8(cp + n, cv); ld_bf16x8(bp + n, bv);
#pragma unroll
                    for (int q = 0; q < 8; ++q) dot += cv[q] * bv[q]; }
                v = dot * __expf(acs[t] - acs[s]) * dts[s]; }
            Mm[t * 65 + s] = v; }
        __syncthreads();
        const int t = tid >> 3, p0 = (tid & 7) * 8;
        float y[8];
#pragma unroll
        for (int j = 0; j < 8; ++j) y[j] = 0.f;
        for (int s = 0; s < TC; ++s) { float xv[8]; ld_bf16x8(XC + (size_t)(m0 + s) * CONVD + h * HD + p0, xv); const float mv = Mm[t * 65 + s];
#pragma unroll
            for (int j = 0; j < 8; ++j) y[j] += mv * xv[j]; }
        const float ea = __expf(acs[t]), dk = dskip[h];
        const bf16* cp = XC + (size_t)(m0 + t) * CONVD + DI + SG * SN + g * SN;
        float xt[8]; ld_bf16x8(XC + (size_t)(m0 + t) * CONVD + h * HD + p0, xt);
#pragma unroll
        for (int j = 0; j < 8; ++j) { const float* pp = ST + (((size_t)bc * SH + h) * HD + p0 + j) * SN;
            float dot = 0.f;
#pragma unroll 4
            for (int n = 0; n < SN; n += 8) { float cv[8], pv[8]; ld_bf16x8(cp + n, cv); ld_f32x8(pp + n, pv);
#pragma unroll
                for (int q = 0; q < 8; ++q) dot += cv[q] * pv[q]; }
            y[j] += ea * dot + dk * xt[j]; }
        st_f32x8(YPRE + (size_t)(m0 + t) * DI + h * HD + p0, y);
    }
}

constexpr int PPL = 14, NPH = 1 + DEPTH * PPL;
struct Args { const float* in[26]; float* out; unsigned char* ws; int ph_lo, ph_hi; };
__global__ void __launch_bounds__(NTHR, 2) fwd(Args args) {
    extern __shared__ __attribute__((aligned(16))) unsigned char lds_[];
    LAS unsigned char* lds = (LAS unsigned char*)lds_;
    const int tid = threadIdx.x, G = gridDim.x, wg = blockIdx.x;
    for (int u = tid; u < (LDS_BYTES - LDSCTL_OFF) / 4; u += NTHR) ((LAS unsigned*)(lds + LDSCTL_OFF))[u] = 0u;
    __syncthreads();
    unsigned char* ws = args.ws;
    unsigned* ctl = (unsigned*)(ws + WS_CTL);
    const int lo = args.ph_lo, hi = args.ph_hi;
    XcdBarrier bar; bar.bar = ctl + CW_BAR; bar.x = 0; bar.st = (volatile LAS unsigned*)(lds + MISC_OFF) + 8;
    if (hi - lo > 1) bar = xcd_barrier_post(ctl + CW_BAR, (volatile LAS unsigned*)(lds + MISC_OFF) + 8);
    In in;
#pragma unroll
    for (int i = 0; i < 26; ++i) in.p[i] = args.in[i];
    float* X = args.out;
    u64* SSQX = (u64*)(ctl + CW_SSQX); u64* SSQC = (u64*)(ctl + CW_SSQC);
    bf16* XB0 = (bf16*)(ws + WS_XB); bf16* XB1 = (bf16*)(ws + WS_XB1); bf16* XB2 = (bf16*)(ws + WS_XB2);
    bf16* PROJ = (bf16*)(ws + WS_PROJ); bf16* U = (bf16*)(ws + WS_U); float* MISC = (float*)(ws + WS_MISC);
    bf16* QRAW = (bf16*)(ws + WS_QRAW); bf16* KVRAW = (bf16*)(ws + WS_KVRAW); bf16* KF = (bf16*)(ws + WS_KF); bf16* AO = (bf16*)(ws + WS_AO);
    bf16* XC = (bf16*)(ws + WS_XC); float* DTS = (float*)(ws + WS_DTS); float* CDEC = (float*)(ws + WS_CDEC); float* ST = (float*)(ws + WS_ST);
    float* YPRE = (float*)(ws + WS_YPRE); bf16* Y = (bf16*)(ws + WS_Y); float* TMPF = (float*)(ws + WS_TMPF); bf16* MERGED = (bf16*)(ws + WS_MERGED);
    bf16* PE = (bf16*)(ws + WS_PE); bf16* PB = (bf16*)(ws + WS_PB); float* COS = (float*)(ws + WS_COS); float* SIN = (float*)(ws + WS_SIN);

    int ph = 0;
#define PHASE(...) do { if (lo <= ph && ph < hi) { __VA_ARGS__; if (ph + 1 < hi) xcd_barrier(bar); } ++ph; } while (0)

    PHASE({ prologue_weights(in, ws, lds, G, wg); prologue_rows(in, X, ws, G, wg); });

    for (int l = 0; l < DEPTH; ++l) {
        const unsigned char* wl = ws + WS_W + (size_t)l * WL_BYTES;
        u64* ssq0 = SSQX + (size_t)(l * 3 + 0) * M; u64* ssq1 = SSQX + (size_t)(l * 3 + 1) * M; u64* ssq2 = SSQX + (size_t)(l * 3 + 2) * M;
        u64* ssqn = (l + 1 < DEPTH) ? SSQX + (size_t)((l + 1) * 3) * M : nullptr;
        u64* ssqc = SSQC + (size_t)l * 2 * M;
        PHASE({ pg8::Gemm g{XB0, (const bf16*)(wl + WL_IN), M, DINP, DM, DM}; EpiInProj E{ssq0, ssqc, PROJ, MISC}; run_gemm(lds, g, E, G, wg); });
        PHASE({ { pg8::Gemm g{PROJ + PC_CQ, (const bf16*)(wl + WL_UQ), M, NH * QK, QL, DINP}; EpiScaleBf16 E{ssqc, 1.f / QL, QRAW, NH * QK}; run_gemm(lds, g, E, G, wg); }
                { pg8::Gemm g{PROJ + PC_CKV, (const bf16*)(wl + WL_UKV), M, NH * 256, KVL, DINP}; EpiScaleBf16 E{ssqc + M, 1.f / KVL, KVRAW, NH * 256}; run_gemm(lds, g, E, G, wg); }
                { pg8::Gemm g{PB + (size_t)l * M * PLE, (const bf16*)(wl + WL_PL), M, DM, PLE, PLE}; EpiScaleBf16 E{nullptr, 0.f, PE, DM}; run_gemm(lds, g, E, G, wg); } });
        PHASE({ phase_kfin(KVRAW, MISC, in.p[10] + l * QK, COS, SIN, KF, G, wg);
                phase_ssdpre(PROJ, MISC, in.p[12] + (size_t)l * CW * CONVD, in.p[13] + (size_t)l * CONVD, in.p[14] + l * SH, XC, DTS, G, wg); });
        PHASE({ phase_attn_simple(QRAW, KF, KVRAW, in.p[9] + l * QK, COS, SIN, AO, lds, G, wg); });
        PHASE({ phase_ssd_states(XC, DTS, in.p[15] + l * SH, ST, CDEC, lds, G, wg); });
        PHASE({ phase_ssd_scan(ST, CDEC, G, wg); });
        PHASE({ phase_ssd_out(XC, DTS, in.p[15] + l * SH, in.p[16] + l * SH, ST, YPRE, lds, G, wg); });
        PHASE({ phase_ssdnorm(YPRE, PROJ, Y, G, wg); });
        PHASE({ pg8::Gemm g{AO, (const bf16*)(wl + WL_OM), M, DM, DM, DM}; EpiGateF32 E{PROJ, TMPF}; run_gemm(lds, g, E, G, wg); });
        PHASE({ pg8::Gemm g{Y, (const bf16*)(wl + WL_OS), M, DM, DI, DI}; EpiMerge E{PROJ, TMPF, MERGED}; run_gemm(lds, g, E, G, wg); });
        PHASE({ pg8::Gemm g{MERGED, (const bf16*)(wl + WL_OUT), M, DM, DM, DM}; EpiResid E{X, XB1, ssq1}; run_gemm(lds, g, E, G, wg); });
        PHASE({ pg8::Gemm g{XB1, (const bf16*)(wl + WL_UP), M, DFF, DM, DM}; EpiUp E{ssq1, U}; run_gemm(lds, g, E, G, wg); });
        PHASE({ pg8::Gemm g{U, (const bf16*)(wl + WL_DN), M, DM, DFF, DFF}; EpiResid E{X, XB2, ssq2}; run_gemm(lds, g, E, G, wg); });
        PHASE({ pg8::Gemm g{XB2, (const bf16*)(wl + WL_PG), M, DM, DM, DM};
#if defined(DBG_VAR) && DBG_VAR == 5
            EpiPleGate E{ssq2, PB, X, XB0, ssqn};
#elif defined(DBG_VAR) && DBG_VAR == 6
            EpiPleGate E{ssq2, (const bf16*)(wl + WL_PL), X, XB0, ssqn};
#else
            EpiPleGate E{ssq2, PE, X, XB0, ssqn};
#endif
 run_gemm(lds, g, E, G, wg); });
    }
#undef PHASE
}

extern "C" void kernel_launch(void* const* d_in, const int* in_sizes, int n_in, void* d_out, int out_size, void* d_ws, size_t ws_size, hipStream_t stream) {
    static int grid = 0;
    if (grid == 0) {
        if (n_in != 26 || out_size != M * DM || ws_size < WS_END) { fprintf(stderr, "kernel_launch: built for 26 inputs, out %d floats, >= %zu bytes of workspace; got n_in %d out %d ws %zu\n", M * DM, (size_t)WS_END, n_in, out_size, ws_size); grid = -1; return; }
        int dev = 0, cus = 0;
        if (hipGetDevice(&dev) != hipSuccess || hipDeviceGetAttribute(&cus, hipDeviceAttributeMultiprocessorCount, dev) != hipSuccess) { grid = -1; return; }
        if (hipFuncSetAttribute((const void*)fwd, hipFuncAttributeMaxDynamicSharedMemorySize, LDS_BYTES) != hipSuccess) { fprintf(stderr, "kernel_launch: hipFuncSetAttribute failed\n"); grid = -1; return; }
        int per_cu = 0;
        if (hipOccupancyMaxActiveBlocksPerMultiprocessor(&per_cu, (const void*)fwd, NTHR, LDS_BYTES) != hipSuccess || per_cu < 1) fprintf(stderr, "kernel_launch: occupancy query says %d\n", per_cu);
        (void)hipGetLastError();
        grid = cus;
    }
    if (grid < 0) return;
    if (hipMemsetAsync((char*)d_ws + WS_CTL, 0, CTL_ZERO_BYTES, stream) != hipSuccess) return;
    Args a{};
    for (int i = 0; i < 26; ++i) a.in[i] = (const float*)d_in[i];
    a.out = (float*)d_out; a.ws = (unsigned char*)d_ws;
#if MK_ONE_LAUNCH
    a.ph_lo = 0; a.ph_hi = NPH;
    hipLaunchKernelGGL(fwd, dim3(grid), dim3(NTHR), LDS_BYTES, stream, a);
#else
#ifndef STOP_PH
#define STOP_PH NPH
#endif
    for (int ph = 0; ph < STOP_PH; ++ph) {
#ifdef SKIP_LO
        if (ph >= SKIP_LO && ph < SKIP_HI) continue;
#endif
        a.ph_lo = ph; a.ph_hi = ph + 1; hipLaunchKernelGGL(fwd, dim3(grid), dim3(NTHR), LDS_BYTES, stream, a); }
#endif
    const hipError_t le = hipPeekAtLastError();
    if (le != hipSuccess) fprintf(stderr, "kernel_launch: launch failed: %s\n", hipGetErrorName(le));
}
```

```cpp
#define FAST_GEMM 1
#include <hip/hip_runtime.h>
#include <cstdio>
#include <cstdint>

#ifndef MK_ONE_LAUNCH
#define MK_ONE_LAUNCH 0
#endif
#ifndef FAST_GEMM
#define FAST_GEMM 0
#endif

constexpr int NB = 2, SEQ = 4096, M = NB * SEQ, DM = 2048, DEPTH = 4, PLE = 256;
constexpr float EPS = 1e-6f;
constexpr int NH = 16, QL = 512, KVL = 512, NOPE = 128, ROPE = 64, VD = 128, QK = 192;
constexpr int DI = 4096, HD = 64, SH = 64, SG = 8, SN = 128, HPG = 8, CW = 4, CONVD = 6144, TC = 64, NCH = SEQ / TC;
constexpr int DFF = 8192;
constexpr int DIN = 15488;
constexpr int DINP = 15616;
constexpr int PC_CQ = 0, PC_CKV = 512, PC_Z = 1024, PC_XBC = 5120, PC_G = 11264, PC_KR = 15360, PC_DT = 15424, PC_PAD = 15488;
constexpr int NWAVES = 8, NTHR = 512;

typedef unsigned short bf16;
typedef unsigned u32x4 __attribute__((ext_vector_type(4)));
typedef unsigned u32x2 __attribute__((ext_vector_type(2)));
typedef float f32x4 __attribute__((ext_vector_type(4)));
typedef float f32x2 __attribute__((ext_vector_type(2)));
typedef short bf16x8 __attribute__((ext_vector_type(8)));
#define GAS __attribute__((address_space(1)))
#define LAS __attribute__((address_space(3)))
typedef GAS unsigned gu32;
#define RLX_AGENT __ATOMIC_RELAXED, __HIP_MEMORY_SCOPE_AGENT
#define LDS_WAIT() asm volatile("s_waitcnt lgkmcnt(0)" ::: "memory")
#define VM_WAIT() asm volatile("s_waitcnt vmcnt(0)" ::: "memory")

constexpr size_t MiB = 1u << 20;
constexpr size_t WS_CTL = 0, CTL_ZERO_BYTES = 2 * MiB;
constexpr int CW_TMO = 0, CW_CODE = 1, CW_BAR = 4096;
typedef unsigned long long u64;
constexpr int CW_SSQX = 16384;
constexpr int CW_SSQC = CW_SSQX + 2 * DEPTH * 3 * M;
static_assert((size_t)(CW_SSQC + 2 * DEPTH * 2 * M) * 4 <= CTL_ZERO_BYTES, "ctl");
constexpr size_t WL_IN = 0, WL_UQ = 61 * MiB, WL_UKV = 64 * MiB, WL_OM = 68 * MiB, WL_OS = 76 * MiB, WL_OUT = 92 * MiB, WL_UP = 100 * MiB, WL_DN = 132 * MiB, WL_PG = 164 * MiB, WL_PL = 172 * MiB, WL_BYTES = 173 * MiB;
static_assert((size_t)DINP * DM * 2 == 61 * MiB, "w_in copy");
constexpr size_t WS_W = 2 * MiB;
constexpr size_t WS_ACT = WS_W + DEPTH * WL_BYTES;
constexpr size_t WS_XB = WS_ACT;
constexpr size_t WS_XB1 = WS_XB + 32 * MiB, WS_XB2 = WS_XB1 + 32 * MiB;
constexpr size_t WS_PROJ = WS_XB2 + 32 * MiB;
constexpr size_t WS_U = WS_PROJ;
constexpr size_t WS_MISC = WS_PROJ + 244 * MiB;
constexpr size_t WS_QRAW = WS_MISC + 4 * MiB;
constexpr size_t WS_KVRAW = WS_QRAW + 48 * MiB;
constexpr size_t WS_KF = WS_KVRAW + 64 * MiB;
constexpr size_t WS_AO = WS_KF + 48 * MiB;
constexpr size_t WS_XC = WS_AO + 32 * MiB;
constexpr size_t WS_DTS = WS_XC + 96 * MiB;
constexpr size_t WS_CDEC = WS_DTS + 2 * MiB;
constexpr size_t WS_ST = WS_CDEC + 1 * MiB;
constexpr size_t WS_YPRE = WS_ST + 256 * MiB;
constexpr size_t WS_Y = WS_YPRE + 128 * MiB;
constexpr size_t WS_TMPF = WS_Y + 64 * MiB;
constexpr size_t WS_MERGED = WS_TMPF + 64 * MiB;
constexpr size_t WS_PE = WS_MERGED + 32 * MiB;
constexpr size_t WS_PB = WS_PE + 32 * MiB;
constexpr size_t WS_COS = WS_PB + 16 * MiB;
constexpr size_t WS_SIN = WS_COS + 1 * MiB;
constexpr size_t WS_END = WS_SIN + 1 * MiB;
static_assert(WS_END <= 1936 * MiB, "d_ws budget (4 x the largest input)");

constexpr int RING_OFF = 0, RING_BYTES = 131072;
constexpr int LDSCTL_OFF = RING_BYTES, MISC_OFF = LDSCTL_OFF + 320;
constexpr int EXTRA_OFF = LDSCTL_OFF + 512, LDS_BYTES = 147456, EXTRA_BYTES = LDS_BYTES - EXTRA_OFF;

__device__ __forceinline__ unsigned f2bf(float f) { unsigned u = __builtin_bit_cast(unsigned, f); return (u + 0x7fffu + ((u >> 16) & 1u)) >> 16; }
__device__ __forceinline__ float bf2f(unsigned h) { return __builtin_bit_cast(float, h << 16); }
typedef __bf16 bf16x2_t __attribute__((ext_vector_type(2)));
__device__ __forceinline__ unsigned pk2(float lo, float hi) { const f32x2 v = {lo, hi}; const bf16x2_t b = __builtin_convertvector(v, bf16x2_t); return __builtin_bit_cast(unsigned, b); }
__device__ __forceinline__ u32x4 pack8(const float (&v)[8]) { u32x4 w; w.x = pk2(v[0], v[1]); w.y = pk2(v[2], v[3]); w.z = pk2(v[4], v[5]); w.w = pk2(v[6], v[7]); return w; }
__device__ __forceinline__ void unpack8(u32x4 w, float (&v)[8]) {
    v[0] = bf2f(w.x & 0xffffu); v[1] = bf2f(w.x >> 16); v[2] = bf2f(w.y & 0xffffu); v[3] = bf2f(w.y >> 16);
    v[4] = bf2f(w.z & 0xffffu); v[5] = bf2f(w.z >> 16); v[6] = bf2f(w.w & 0xffffu); v[7] = bf2f(w.w >> 16); }
__device__ __forceinline__ float wave_sum(float v) {
#pragma unroll
    for (int o = 1; o < 64; o <<= 1) v += __shfl_xor(v, o);
    return v;
}
__device__ __forceinline__ float wave_max(float v) {
#pragma unroll
    for (int o = 1; o < 64; o <<= 1) v = fmaxf(v, __shfl_xor(v, o));
    return v;
}
__device__ __forceinline__ int otid() { int t = threadIdx.x; asm volatile("" : "+v"(t)); return t; }
__device__ __forceinline__ float sigmoidf_(float x) { return 1.f / (1.f + __expf(-x)); }
__device__ __forceinline__ float siluf_(float x) { return x / (1.f + __expf(-x)); }

#define XB_TMO      128
#define XB_XCNT(j)  (256  + 64 * (j))
#define XB_XSUB(j)  (1280 + 64 * (j))
#define XB_XGEN(j)  (2304 + 64 * (j))
#define XB_TOP      3328
#define XB_TOPGEN   3392
#define XCD_BAR_WORDS 3456
#define XB_SPIN_CAP (1u << 18)
__device__ __forceinline__ unsigned xb_ld(unsigned* p)              { return __hip_atomic_load(p, __ATOMIC_RELAXED, __HIP_MEMORY_SCOPE_AGENT); }
__device__ __forceinline__ unsigned xb_add(unsigned* p, unsigned v) { return __hip_atomic_fetch_add(p, v, __ATOMIC_RELAXED, __HIP_MEMORY_SCOPE_AGENT); }
__device__ __forceinline__ unsigned xb_xcc_id() { return (unsigned)__builtin_amdgcn_s_getreg((3 << 11) | 20) & 0xFu; }
#define XB_SPIN(cond, bar) do { unsigned _sp = 0; while (cond) { __builtin_amdgcn_s_sleep(1); \
    if ((++_sp & 255u) == 0u) { if (xb_ld(&(bar)[XB_TMO])) break; if (_sp > XB_SPIN_CAP) { atomicAdd(&(bar)[XB_TMO], 1u); break; } } } } while (0)
struct XcdBarrier { unsigned* bar; unsigned x; volatile LAS unsigned* st; };
__device__ __forceinline__ XcdBarrier xcd_barrier_post(unsigned* bar, volatile LAS unsigned* st) {
    XcdBarrier b; b.bar = bar; b.x = xb_xcc_id(); b.st = st;
    if (threadIdx.x == 0) (void)xb_add(&bar[XB_XCNT(b.x)], 1u);
    return b;
}
__device__ __forceinline__ void xcd_barrier_complete(unsigned* bar, unsigned x, unsigned& nloc, unsigned& nx) {
    const unsigned G = gridDim.x * gridDim.y * gridDim.z;
    unsigned sum, cnt, mine, sp = 0u;
    for (;;) {
        sum = 0u; cnt = 0u; mine = 0u;
#pragma unroll
        for (unsigned j = 0; j < 16; ++j) { const unsigned c = xb_ld(&bar[XB_XCNT(j)]); sum += c; cnt += (c > 0u) ? 1u : 0u; mine = (j == x) ? c : mine; }
        if (sum == G) break;
        __builtin_amdgcn_s_sleep(1);
        if ((++sp & 255u) == 0u) { if (xb_ld(&bar[XB_TMO])) break; if (sp > XB_SPIN_CAP) { atomicAdd(&bar[XB_TMO], 1u); break; } }
    }
    nloc = mine > 0u ? mine : 1u; nx = cnt > 0u ? cnt : 1u;
}
__device__ __forceinline__ void xcd_barrier(const XcdBarrier& b) {
    asm volatile("s_waitcnt vmcnt(0)" ::: "memory");
    __syncthreads();
    if (threadIdx.x == 0) {
        unsigned* bar = b.bar;
        __builtin_amdgcn_s_waitcnt(0);
        unsigned nloc = b.st[0], nx = b.st[1];
        if (nloc == 0u) { xcd_barrier_complete(bar, b.x, nloc, nx); b.st[0] = nloc; b.st[1] = nx; }
        const unsigned old = xb_add(&bar[XB_XSUB(b.x)], 1u);
        const unsigned gen = old / nloc;
        if (old + 1u == (gen + 1u) * nloc) {
            __builtin_amdgcn_fence(__ATOMIC_RELEASE, "agent");
            asm volatile("s_waitcnt vmcnt(0)" ::: "memory");
            const unsigned og = xb_add(&bar[XB_TOP], 1u);
            const unsigned tg = og / nx;
            if (og + 1u == (tg + 1u) * nx) xb_add(&bar[XB_TOPGEN], 1u);
            else XB_SPIN(xb_ld(&bar[XB_TOPGEN]) == tg, bar);
            __builtin_amdgcn_fence(__ATOMIC_ACQUIRE, "agent");
            xb_add(&bar[XB_XGEN(b.x)], 1u);
            asm volatile("s_waitcnt vmcnt(0)" ::: "memory");
        } else {
            XB_SPIN(xb_ld(&bar[XB_XGEN(b.x)]) == gen, bar);
            __builtin_amdgcn_fence(__ATOMIC_ACQUIRE, "agent");
            asm volatile("s_waitcnt vmcnt(0)" ::: "memory");
        }
    }
    __syncthreads();
}

namespace pg8 {
typedef unsigned short bf16_t;
constexpr int BM = 256, BK = 64, HALF = 128, HTB = HALF * BK * 2, STAGE_BYTES = 8 * HTB, NXCD = 8, WGM = 8;
__host__ __device__ __forceinline__ int lds_byte(int r, int c) { const int st = (r >> 4) * 2 + (c >> 5), rr = r & 15, cc = c & 31, ob = rr * 64 + cc * 2; return st * 1024 + (ob ^ (((ob >> 9) & 1) << 5)); }
__host__ __device__ __forceinline__ void stage_rc(int b, int& R, int& C) { const int st = b / 1024, sb = b % 1024, swz = sb ^ (((sb >> 9) & 1) << 5); R = (st >> 1) * 16 + swz / 64; C = (st & 1) * 32 + (swz % 64) / 2; }
__host__ __device__ __forceinline__ int perm32(int rho) { const int n = rho >> 4, i = rho & 15; return 8 * (i >> 2) + 4 * n + (i & 3); }
struct Unit { int pm, pn; };
struct Gemm { const bf16_t* A; const bf16_t* Bt; int M, N, K, lda; };
struct StaticOrder {
    int nM, nN, nwg, G, c;
    __host__ __device__ void init(int M_, int N_, int G_, int c_) { nM = M_ / BM; nN = N_ / BM; nwg = nM * nN; G = G_; c = c_; }
    __host__ __device__ bool next(int i, Unit& u) const {
        const long L = (long)i * G + c; if (L >= nwg) return false;
        int wgid = (int)L; { const int q = nwg / NXCD, r = nwg % NXCD, xcd = wgid % NXCD, off = wgid / NXCD; wgid = (xcd < r ? xcd * (q + 1) : r * (q + 1) + (xcd - r) * q) + off; }
        const int nig = WGM * nN, gid = wgid / nig, fm = gid * WGM, gsz = (nM - fm) < WGM ? (nM - fm) : WGM;
        u.pm = fm + ((wgid % nig) % gsz); u.pn = (wgid % nig) / gsz; return true;
    }
    __device__ __forceinline__ void a_ready(const Unit&) const {}
    __device__ __forceinline__ void done(const Unit&) const {}
};

template <class Epi, class Sched>
__device__ __forceinline__ void gemm_phase(LAS unsigned char* lds, const Gemm g, const Sched& S, const Epi& E) {
    const int tid = otid(), wid = __builtin_amdgcn_readfirstlane(tid >> 6), lane = tid & 63, wr = wid >> 2, wc = wid & 3, fr = lane & 15, fq = lane >> 4;
    const int K = g.K, nt = K / BK, lda = g.lda;
    unsigned voffA[2], voffB[2];
#pragma unroll
    for (int i = 0; i < 2; ++i) { int R, C; stage_rc(tid * 16 + i * 8192, R, C); const int Rb = (R & ~31) + perm32(R & 31);
        voffA[i] = (unsigned)(R * lda + C) * 2u; voffB[i] = (unsigned)(Rb * K + C) * 2u; }
    const size_t kstep = (size_t)(BK * 2);
    const size_t hstepA = (size_t)HALF * lda * 2, hstepB = (size_t)HALF * K * 2;
    const size_t tstepA = 2 * hstepA, tstepB = 2 * hstepB;
    const unsigned ldsw = (unsigned)wid * 1024u;
    const int aoff = lds_byte(wr * 64 + fr, fq * 8), boff = lds_byte(wc * 32 + fr, fq * 8);
#define PG8_SA(b, h) (((b) * 2 + (h)) * HTB)
#define PG8_SB(b, h) ((4 + (b) * 2 + (h)) * HTB)
#define PG8_STAGE(bufoff, gbase, voff) do { _Pragma("unroll") for (int _i = 0; _i < 2; ++_i) \
        __builtin_amdgcn_global_load_lds((const unsigned*)((const char*)(gbase) + (voff)[_i]), (LAS unsigned*)(lds + (bufoff) + ldsw + _i * 8192), 16, 0, 0); } while (0)
#define PG8_LDA(dst, b, h) do { _Pragma("unroll") for (int m = 0; m < 4; ++m) _Pragma("unroll") for (int k = 0; k < 2; ++k) dst[m][k] = *(const LAS bf16x8*)(lds + PG8_SA(b, h) + aoff + m * 2048 + k * 1024); } while (0)
#define PG8_LDB(dst, b, h) do { _Pragma("unroll") for (int n = 0; n < 2; ++n) _Pragma("unroll") for (int k = 0; k < 2; ++k) dst[n][k] = *(const LAS bf16x8*)(lds + PG8_SB(b, h) + boff + n * 2048 + k * 1024); } while (0)
#define PG8_MMA(ai, bj, At, Bt) do { __builtin_amdgcn_s_setprio(1); _Pragma("unroll") for (int m = 0; m < 4; ++m) _Pragma("unroll") for (int n = 0; n < 2; ++n) _Pragma("unroll") for (int k = 0; k < 2; ++k) \
        acc[ai][bj][m][n] = __builtin_amdgcn_mfma_f32_16x16x32_bf16(Bt[n][k], At[m][k], acc[ai][bj][m][n], 0, 0, 0); __builtin_amdgcn_s_setprio(0); } while (0)
#define PG8_WAIT_V(n) asm volatile("s_waitcnt vmcnt(" #n ")" ::: "memory")
#define PG8_WAIT_L(n) asm volatile("s_waitcnt lgkmcnt(" #n ")" ::: "memory")
#define PG8_BAR __builtin_amdgcn_s_barrier()
#define PG8_SCHED __builtin_amdgcn_sched_barrier(0)
    Unit cur, nxt; int ui = 0;
    if (!S.next(0, cur)) return;
    f32x4 acc[2][2][4][2];
#pragma unroll
    for (int a = 0; a < 2; ++a)
#pragma unroll
        for (int b = 0; b < 2; ++b)
#pragma unroll
            for (int m = 0; m < 4; ++m)
#pragma unroll
                for (int n = 0; n < 2; ++n) acc[a][b][m][n] = (f32x4){0.f, 0.f, 0.f, 0.f};
    bf16x8 At[4][2], B0[2][2], B1[2][2];
    const char* cA = (const char*)g.A + (size_t)cur.pm * tstepA; const char* cB = (const char*)g.Bt + (size_t)cur.pn * tstepB;
    S.a_ready(cur);
    PG8_STAGE(PG8_SB(0, 0), cB, voffB); PG8_STAGE(PG8_SB(0, 1), cB + hstepB, voffB); PG8_STAGE(PG8_SA(0, 0), cA, voffA); PG8_STAGE(PG8_SA(0, 1), cA + hstepA, voffA);
    if (wr == 1) PG8_BAR;
    PG8_WAIT_V(2); PG8_BAR;
    PG8_STAGE(PG8_SB(1, 0), cB + kstep, voffB); PG8_STAGE(PG8_SA(1, 0), cA + kstep, voffA); PG8_STAGE(PG8_SB(1, 1), cB + hstepB + kstep, voffB);
    PG8_WAIT_V(6); PG8_BAR;
    for (;;) {
        const bool has_next = S.next(ui + 1, nxt);
        const char* nA = has_next ? (const char*)g.A + (size_t)nxt.pm * tstepA : cA; const char* nB = has_next ? (const char*)g.Bt + (size_t)nxt.pn * tstepB : cB;
        for (int t = 0; t < nt; t += 2) {
            const bool last = (t == nt - 2);
            const char* a1 = cA + (size_t)(t + 1) * kstep;
            const char* a2 = last ? nA : cA + (size_t)(t + 2) * kstep; const char* b2 = last ? nB : cB + (size_t)(t + 2) * kstep;
            const char* a3 = a2 + kstep; const char* b3 = b2 + kstep;
            if (last && has_next) S.a_ready(nxt);
            PG8_LDB(B0, 0, 0); PG8_LDB(B1, 0, 1); PG8_SCHED; PG8_LDA(At, 0, 0); PG8_STAGE(PG8_SA(1, 1), a1 + hstepA, voffA);
            PG8_WAIT_V(8); PG8_WAIT_L(0); PG8_BAR; PG8_MMA(0, 0, At, B0); PG8_MMA(0, 1, At, B1); PG8_BAR; PG8_SCHED;
            PG8_LDA(At, 0, 1); PG8_STAGE(PG8_SB(0, 0), b2, voffB); PG8_STAGE(PG8_SB(0, 1), b2 + hstepB, voffB); PG8_STAGE(PG8_SA(0, 0), a2, voffA);
            PG8_WAIT_V(8); PG8_WAIT_L(0); PG8_BAR; PG8_MMA(1, 0, At, B0); PG8_MMA(1, 1, At, B1); PG8_BAR; PG8_SCHED;
            PG8_LDB(B0, 1, 0); PG8_LDB(B1, 1, 1); PG8_SCHED; PG8_LDA(At, 1, 0); PG8_STAGE(PG8_SA(0, 1), a2 + hstepA, voffA);
            PG8_WAIT_V(8); PG8_WAIT_L(0); PG8_BAR; PG8_MMA(0, 0, At, B0); PG8_MMA(0, 1, At, B1); PG8_BAR; PG8_SCHED;
            PG8_LDA(At, 1, 1); PG8_STAGE(PG8_SB(1, 0), b3, voffB); PG8_STAGE(PG8_SB(1, 1), b3 + hstepB, voffB); PG8_STAGE(PG8_SA(1, 0), a3, voffA);
            PG8_WAIT_V(8); PG8_WAIT_L(0); PG8_BAR; PG8_MMA(1, 0, At, B0); PG8_MMA(1, 1, At, B1); PG8_BAR; PG8_SCHED;
        }
        if (wr == 0) PG8_BAR;
        {
            const int row0 = cur.pm * BM + wr * 64 + fr, col00 = cur.pn * BM + wc * 32 + 8 * fq;
            typename Epi::Regs RA[2], RB[2];
#define PG8_EL(R, gi) do { const int _r = row0 + ((gi) >> 2) * HALF + ((gi) & 3) * 16; E.load(_r, col00, R[0]); E.load(_r, col00 + HALF, R[1]); } while (0)
#define PG8_EA(R, gi) do { const int _r = row0 + ((gi) >> 2) * HALF + ((gi) & 3) * 16; _Pragma("unroll") for (int bj = 0; bj < 2; ++bj) { \
                const f32x4 _p = acc[(gi) >> 2][bj][(gi) & 3][0], _q = acc[(gi) >> 2][bj][(gi) & 3][1]; const float _v[8] = {_p[0], _p[1], _p[2], _p[3], _q[0], _q[1], _q[2], _q[3]}; \
                E.apply(_r, col00 + bj * HALF, _v, R[bj]); } } while (0)
            PG8_EL(RA, 0);
#pragma unroll
            for (int gi = 0; gi < 8; gi += 2) {
                PG8_EL(RB, gi + 1); PG8_SCHED; PG8_EA(RA, gi); PG8_SCHED;
                if (gi + 2 < 8) PG8_EL(RA, gi + 2);
                PG8_SCHED; PG8_EA(RB, gi + 1); PG8_SCHED;
            }
#undef PG8_EL
#undef PG8_EA
        }
        S.done(cur);
        if (!has_next) break;
#pragma unroll
        for (int a = 0; a < 2; ++a)
#pragma unroll
            for (int b = 0; b < 2; ++b)
#pragma unroll
                for (int m = 0; m < 4; ++m)
#pragma unroll
                    for (int n = 0; n < 2; ++n) acc[a][b][m][n] = (f32x4){0.f, 0.f, 0.f, 0.f};
        cur = nxt; cA = nA; cB = nB; ++ui;
        if (wr == 1) PG8_BAR;
    }
    PG8_WAIT_V(0);
    PG8_BAR;
#undef PG8_SA
#undef PG8_SB
#undef PG8_STAGE
#undef PG8_LDA
#undef PG8_LDB
#undef PG8_MMA
#undef PG8_WAIT_V
#undef PG8_WAIT_L
#undef PG8_BAR
#undef PG8_SCHED
}

template <class Epi>
__device__ __forceinline__ void gemm_simple(const Gemm g, const Epi& E, int G, int wg) {
    const int tid = otid(), wid = tid >> 6, lane = tid & 63, fr = lane & 15, fq = lane >> 4;
    const int nbn = g.N / 32, nblk = (g.M / 16) * nbn;
    for (int it = wg * NWAVES + wid; it < nblk; it += G * NWAVES) {
        const int m0 = (it / nbn) * 16, n0 = (it % nbn) * 32;
        f32x4 acc0 = {0.f, 0.f, 0.f, 0.f}, acc1 = {0.f, 0.f, 0.f, 0.f};
        const bf16_t* ap = g.A + (size_t)(m0 + fr) * g.lda + 8 * fq;
        const bf16_t* bp0 = g.Bt + (size_t)(n0 + perm32(fr)) * g.K + 8 * fq;
        const bf16_t* bp1 = g.Bt + (size_t)(n0 + perm32(16 + fr)) * g.K + 8 * fq;
        for (int k0 = 0; k0 < g.K; k0 += 32) {
            const bf16x8 a = *(const bf16x8*)(ap + k0), b0 = *(const bf16x8*)(bp0 + k0), b1 = *(const bf16x8*)(bp1 + k0);
            acc0 = __builtin_amdgcn_mfma_f32_16x16x32_bf16(b0, a, acc0, 0, 0, 0);
            acc1 = __builtin_amdgcn_mfma_f32_16x16x32_bf16(b1, a, acc1, 0, 0, 0);
        }
        const float v[8] = {acc0[0], acc0[1], acc0[2], acc0[3], acc1[0], acc1[1], acc1[2], acc1[3]};
        typename Epi::Regs rg; E.load(m0 + fr, n0 + 8 * fq, rg); E.apply(m0 + fr, n0 + 8 * fq, v, rg);
    }
}
}

template <class Epi>
__device__ __forceinline__ void run_gemm(LAS unsigned char* lds, const pg8::Gemm g, const Epi& E, int G, int wg) {
#if FAST_GEMM
    pg8::StaticOrder S; S.init(g.M, g.N, G, wg);
    pg8::gemm_phase<Epi, pg8::StaticOrder>(lds, g, S, E);
#else
    pg8::gemm_simple<Epi>(g, E, G, wg);
#endif
}

constexpr float SSQ_SCALE = 16777216.f, SSQ_INV = 1.f / 16777216.f;
__device__ __forceinline__ void ssq_add(u64* dst, int row, const float (&v)[8]) {
    float s = 0.f;
#pragma unroll
    for (int j = 0; j < 8; ++j) s += v[j] * v[j];
    s += __shfl_xor(s, 16); s += __shfl_xor(s, 32);
    if ((otid() & 63) < 16) atomicAdd(dst + row, (u64)(s * SSQ_SCALE));
}
__device__ __forceinline__ float ld_ssq(const u64* p) { return (float)__hip_atomic_load(p, __ATOMIC_RELAXED, __HIP_MEMORY_SCOPE_AGENT) * SSQ_INV; }
__device__ __forceinline__ void st_f32x8(float* p, const float (&v)[8]) { *(f32x4*)p = (f32x4){v[0], v[1], v[2], v[3]}; *(f32x4*)(p + 4) = (f32x4){v[4], v[5], v[6], v[7]}; }
__device__ __forceinline__ void ld_f32x8(const float* p, float (&v)[8]) { const f32x4 a = *(const f32x4*)p, b = *(const f32x4*)(p + 4); v[0] = a.x; v[1] = a.y; v[2] = a.z; v[3] = a.w; v[4] = b.x; v[5] = b.y; v[6] = b.z; v[7] = b.w; }
__device__ __forceinline__ void ld_bf16x8(const bf16* p, float (&v)[8]) { unpack8(*(const u32x4*)p, v); }

struct EpiInProj {
    const u64* ssq; u64* ssqc; bf16* proj; float* misc;
    struct Regs { float rs; };
    __device__ __forceinline__ void load(int row, int col0, Regs& r) const { r.rs = rsqrtf(ld_ssq(ssq + row) * (1.f / DM) + EPS); }
    __device__ __forceinline__ void apply(int row, int col0, const float (&a)[8], const Regs& r) const {
        float v[8];
#pragma unroll
        for (int j = 0; j < 8; ++j) v[j] = a[j] * r.rs;
        const int tile = col0 >> 8;
        if (tile == 60) { const int c = col0 - PC_KR; if (c < 128) st_f32x8(misc + (size_t)row * 128 + c, v); return; }
        if (tile >= 44) {
#pragma unroll
            for (int j = 0; j < 8; ++j) v[j] = sigmoidf_(v[j]);
        }
        *(u32x4*)(proj + (size_t)row * DINP + col0) = pack8(v);
        if (tile < 4) ssq_add(ssqc + (size_t)(tile >> 1) * M, row, v);
    }
};
struct EpiScaleBf16 {
    const u64* ssq; float inv_n; bf16* O; int ldo;
    struct Regs { float rs; };
    __device__ __forceinline__ void load(int row, int col0, Regs& r) const { r.rs = ssq ? rsqrtf(ld_ssq(ssq + row) * inv_n + EPS) : 1.f; }
    __device__ __forceinline__ void apply(int row, int col0, const float (&a)[8], const Regs& r) const {
        float v[8];
#pragma unroll
        for (int j = 0; j < 8; ++j) v[j] = a[j] * r.rs;
        *(u32x4*)(O + (size_t)row * ldo + col0) = pack8(v);
    }
};
struct EpiGateF32 {
    const bf16* proj; float* T;
    struct Regs { u32x4 g; };
    __device__ __forceinline__ void load(int row, int col0, Regs& r) const { r.g = *(const u32x4*)(proj + (size_t)row * DINP + PC_G + col0); }
    __device__ __forceinline__ void apply(int row, int col0, const float (&a)[8], const Regs& r) const {
        float g[8], v[8]; unpack8(r.g, g);
#pragma unroll
        for (int j = 0; j < 8; ++j) v[j] = a[j] * g[j];
        st_f32x8(T + (size_t)row * DM + col0, v);
    }
};
struct EpiMerge {
    const bf16* proj; const float* T; bf16* O;
    struct Regs { u32x4 g; f32x4 t0, t1; };
    __device__ __forceinline__ void load(int row, int col0, Regs& r) const { r.g = *(const u32x4*)(proj + (size_t)row * DINP + PC_G + DM + col0);
        r.t0 = *(const f32x4*)(T + (size_t)row * DM + col0); r.t1 = *(const f32x4*)(T + (size_t)row * DM + col0 + 4); }
    __device__ __forceinline__ void apply(int row, int col0, const float (&a)[8], const Regs& r) const {
        float g[8], v[8]; unpack8(r.g, g);
        const float t[8] = {r.t0.x, r.t0.y, r.t0.z, r.t0.w, r.t1.x, r.t1.y, r.t1.z, r.t1.w};
#pragma unroll
        for (int j = 0; j < 8; ++j) v[j] = t[j] + a[j] * g[j];
        *(u32x4*)(O + (size_t)row * DM + col0) = pack8(v);
    }
};
struct EpiResid {
    float* X; bf16* XB; u64* ssq_next;
    struct Regs { f32x4 x0, x1; };
    __device__ __forceinline__ void load(int row, int col0, Regs& r) const { r.x0 = *(const f32x4*)(X + (size_t)row * DM + col0); r.x1 = *(const f32x4*)(X + (size_t)row * DM + col0 + 4); }
    __device__ __forceinline__ void apply(int row, int col0, const float (&a)[8], const Regs& r) const {
        float x[8] = {r.x0.x, r.x0.y, r.x0.z, r.x0.w, r.x1.x, r.x1.y, r.x1.z, r.x1.w};
#pragma unroll
        for (int j = 0; j < 8; ++j) x[j] += a[j];
        st_f32x8(X + (size_t)row * DM + col0, x);
        *(u32x4*)(XB + (size_t)row * DM + col0) = pack8(x);
        if (ssq_next) ssq_add(ssq_next, row, x);
    }
};
struct EpiUp {
    const u64* ssq; bf16* U;
    struct Regs { float rs; };
    __device__ __forceinline__ void load(int row, int col0, Regs& r) const { r.rs = rsqrtf(ld_ssq(ssq + row) * (1.f / DM) + EPS); }
    __device__ __forceinline__ void apply(int row, int col0, const float (&a)[8], const Regs& r) const {
        float v[8];
#pragma unroll
        for (int j = 0; j < 8; ++j) { const float t = fmaxf(a[j] * r.rs, 0.f); v[j] = t * t; }
        *(u32x4*)(U + (size_t)row * DFF + col0) = pack8(v);
    }
};
struct EpiPleGate {
    const u64* ssq; const bf16* PE; float* X; bf16* XB; u64* ssq_next;
    struct Regs { float rs; f32x4 x0, x1; u32x4 pe; };
    __device__ __forceinline__ void load(int row, int col0, Regs& r) const { r.rs = rsqrtf(ld_ssq(ssq + row) * (1.f / DM) + EPS);
        r.x0 = *(const f32x4*)(X + (size_t)row * DM + col0); r.x1 = *(const f32x4*)(X + (size_t)row * DM + col0 + 4); r.pe = *(const u32x4*)(PE + (size_t)row * DM + col0); }
    __device__ __forceinline__ void apply(int row, int col0, const float (&a)[8], const Regs& r) const {
        float x[8] = {r.x0.x, r.x0.y, r.x0.z, r.x0.w, r.x1.x, r.x1.y, r.x1.z, r.x1.w}, pe[8]; unpack8(r.pe, pe);
#pragma unroll
        for (int j = 0; j < 8; ++j) x[j] += pe[j] * sigmoidf_(a[j] * r.rs);
        st_f32x8(X + (size_t)row * DM + col0, x);
        *(u32x4*)(XB + (size_t)row * DM + col0) = pack8(x);
        if (ssq_next) ssq_add(ssq_next, row, x);
    }
};

__device__ __forceinline__ void transpose_item(const float* W, int K, int Nsrc, int nsrc0, const float* gain, bf16* WT, int ndst0, int k0, LAS float* scr, int lane) {
#pragma unroll 8
    for (int i = 0; i < 32; ++i) { const int kk = 2 * i + (lane >> 5);
        float w = 0.f; if (nsrc0 >= 0) { w = W[(size_t)(k0 + kk) * Nsrc + nsrc0 + (lane & 31)]; if (gain) w *= gain[k0 + kk]; }
        scr[kk * 33 + (lane & 31)] = w; }
    LDS_WAIT(); asm volatile("" ::: "memory");
    const int c = lane & 7;
#pragma unroll
    for (int j = 0; j < 4; ++j) { const int n = (lane >> 3) + 8 * j; const LAS float* s = scr + (8 * c) * 33 + n;
        u32x4 o; o.x = pk2(s[0 * 33], s[1 * 33]); o.y = pk2(s[2 * 33], s[3 * 33]); o.z = pk2(s[4 * 33], s[5 * 33]); o.w = pk2(s[6 * 33], s[7 * 33]);
        *(u32x4*)(WT + (size_t)(ndst0 + n) * K + k0 + 8 * c) = o; }
    LDS_WAIT(); asm volatile("" ::: "memory");
}
__host__ __device__ __forceinline__ int inproj_src_col(int n) {
    if (n < PC_Z) return n;
    if (n < PC_G) return n + 64;
    if (n < PC_KR) return n + 128;
    if (n < PC_DT) return n - PC_KR + 1024;
    if (n < PC_PAD) return n - PC_DT + 11328;
    return -1;
}
constexpr int I_IN = (DM / 64) * (DINP / 32), I_UQ = (QL / 64) * (NH * QK / 32), I_UKV = (KVL / 64) * (NH * 256 / 32), I_OM = (DM / 64) * (DM / 32), I_OS = (DI / 64) * (DM / 32),
              I_OUT = I_OM, I_UP = (DM / 64) * (DFF / 32), I_DN = (DFF / 64) * (DM / 32), I_PG = I_OM, I_PL = (PLE / 64) * (DM / 32),
              I_LAYER = I_IN + I_UQ + I_UKV + I_OM + I_OS + I_OUT + I_UP + I_DN + I_PG + I_PL;
__device__ __forceinline__ void prologue_weights(const float* const (&inp)[26], unsigned char* ws, LAS unsigned char* lds, int G, int wg) {
    const int wave = otid() >> 6, lane = otid() & 63;
    LAS float* scr = (LAS float*)(lds + RING_OFF + wave * 16384);
    for (int it = wg * NWAVES + wave; it < DEPTH * I_LAYER; it += G * NWAVES) {
        const int l = it / I_LAYER; int r = it % I_LAYER;
        unsigned char* wl = ws + WS_W + (size_t)l * WL_BYTES;
        if (r < I_IN) { const int nblk = DINP / 32, kb = r / nblk, nb = r % nblk;
            transpose_item(inp[4] + (size_t)l * DM * DIN, DM, DIN, inproj_src_col(32 * nb), inp[3] + l * DM, (bf16*)(wl + WL_IN), 32 * nb, 64 * kb, scr, lane); continue; } r -= I_IN;
        if (r < I_UQ) { const int nblk = NH * QK / 32, kb = r / nblk, nb = r % nblk;
            transpose_item(inp[6] + (size_t)l * QL * NH * QK, QL, NH * QK, 32 * nb, inp[5] + l * QL, (bf16*)(wl + WL_UQ), 32 * nb, 64 * kb, scr, lane); continue; } r -= I_UQ;
        if (r < I_UKV) { const int nblk = NH * 256 / 32, kb = r / nblk, nb = r % nblk;
            transpose_item(inp[8] + (size_t)l * KVL * NH * 256, KVL, NH * 256, 32 * nb, inp[7] + l * KVL, (bf16*)(wl + WL_UKV), 32 * nb, 64 * kb, scr, lane); continue; } r -= I_UKV;
        if (r < I_OM) { const int nblk = DM / 32, kb = r / nblk, nb = r % nblk;
            transpose_item(inp[11] + (size_t)l * DM * DM, DM, DM, 32 * nb, nullptr, (bf16*)(wl + WL_OM), 32 * nb, 64 * kb, scr, lane); continue; } r -= I_OM;
        if (r < I_OS) { const int nblk = DM / 32, kb = r / nblk, nb = r % nblk;
            transpose_item(inp[18] + (size_t)l * DI * DM, DI, DM, 32 * nb, inp[17] + l * DI, (bf16*)(wl + WL_OS), 32 * nb, 64 * kb, scr, lane); continue; } r -= I_OS;
        if (r < I_OUT) { const int nblk = DM / 32, kb = r / nblk, nb = r % nblk;
            transpose_item(inp[19] + (size_t)l * DM * DM, DM, DM, 32 * nb, nullptr, (bf16*)(wl + WL_OUT), 32 * nb, 64 * kb, scr, lane); continue; } r -= I_OUT;
        if (r < I_UP) { const int nblk = DFF / 32, kb = r / nblk, nb = r % nblk;
            transpose_item(inp[21] + (size_t)l * DM * DFF, DM, DFF, 32 * nb, inp[20] + l * DM, (bf16*)(wl + WL_UP), 32 * nb, 64 * kb, scr, lane); continue; } r -= I_UP;
        if (r < I_DN) { const int nblk = DM / 32, kb = r / nblk, nb = r % nblk;
            transpose_item(inp[22] + (size_t)l * DFF * DM, DFF, DM, 32 * nb, nullptr, (bf16*)(wl + WL_DN), 32 * nb, 64 * kb, scr, lane); continue; } r -= I_DN;
        if (r < I_PG) { const int nblk = DM / 32, kb = r / nblk, nb = r % nblk;
            transpose_item(inp[24] + (size_t)l * DM * DM, DM, DM, 32 * nb, inp[23] + l * DM, (bf16*)(wl + WL_PG), 32 * nb, 64 * kb, scr, lane); continue; } r -= I_PG;
        { const int nblk = DM / 32, kb = r / nblk, nb = r % nblk;
            transpose_item(inp[25] + (size_t)l * PLE * DM, PLE, DM, 32 * nb, nullptr, (bf16*)(wl + WL_PL), 32 * nb, 64 * kb, scr, lane); }
    }
}
__device__ __forceinline__ void prologue_rows(const float* const (&inp)[26], float* out, unsigned char* ws, int G, int wg) {
    const int wave = otid() >> 6, lane = otid() & 63, gw = wg * NWAVES + wave, NGW = G * NWAVES;
    const float* x = inp[0]; bf16* XB = (bf16*)(ws + WS_XB); u64* ssq0 = (u64*)((unsigned*)(ws + WS_CTL) + CW_SSQX);
    for (int m = gw; m < M; m += NGW) {
        float s = 0.f;
#pragma unroll
        for (int j = 0; j < 8; ++j) { const f32x4 v = *(const f32x4*)(x + (size_t)m * DM + j * 256 + lane * 4);
            *(f32x4*)(out + (size_t)m * DM + j * 256 + lane * 4) = v; s += v.x * v.x + v.y * v.y + v.z * v.z + v.w * v.w;
            u32x2 o; o.x = pk2(v.x, v.y); o.y = pk2(v.z, v.w); *(u32x2*)(XB + (size_t)m * DM + j * 256 + lane * 4) = o; }
        s = wave_sum(s); if (lane == 0) ssq0[m] = (u64)(s * SSQ_SCALE);
    }
    {
        u64* z0 = (u64*)((unsigned*)(ws + WS_CTL) + CW_SSQX) + M; const int nz = (DEPTH * 3 - 1) * M + DEPTH * 2 * M;
        for (int i = wg * NTHR + otid(); i < nz; i += G * NTHR) z0[i] = 0ull;
    }
    const float* p = inp[1]; bf16* PB = (bf16*)(ws + WS_PB);
    for (size_t i = (size_t)wg * NTHR + otid(); i < (size_t)DEPTH * M * PLE / 8; i += (size_t)G * NTHR) { float v[8]; ld_f32x8(p + i * 8, v); *(u32x4*)(PB + i * 8) = pack8(v); }
    const int* pos = (const int*)inp[2]; float* COS = (float*)(ws + WS_COS); float* SIN = (float*)(ws + WS_SIN);
    for (int i = wg * NTHR + otid(); i < M * 32; i += G * NTHR) { const int m = i >> 5, k = i & 31;
        const float invf = 1.0f / (float)pow(10000.0, (double)k / 32.0);
        const float ang = (float)pos[m] * invf;
        COS[i] = (float)cos((double)ang); SIN[i] = (float)sin((double)ang); }
}

__device__ __forceinline__ void phase_kfin(const bf16* KVRAW, const float* MISC, const float* kw, const float* COS, const float* SIN, bf16* KF, int G, int wg) {
    const int wave = otid() >> 6, lane = otid() & 63;
    const float w0 = kw[lane], w1 = kw[64 + lane], w2 = kw[128 + lane];
    for (int it = wg * NWAVES + wave; it < M * NH; it += G * NWAVES) {
        const int m = it >> 4, h = it & 15;
        const float a0 = bf2f(KVRAW[(size_t)m * 4096 + h * 256 + lane]), a1 = bf2f(KVRAW[(size_t)m * 4096 + h * 256 + 64 + lane]), a2 = MISC[(size_t)m * 128 + lane];
        const float ss = wave_sum(a0 * a0 + a1 * a1 + a2 * a2), rs = rsqrtf(ss * (1.f / QK) + EPS);
        const float t2 = a2 * rs * w2, o2 = __shfl_xor(t2, 32);
        const float c = COS[m * 32 + (lane & 31)], s = SIN[m * 32 + (lane & 31)];
        const float r2 = lane < 32 ? (t2 * c - o2 * s) : (o2 * s + t2 * c);
        bf16* o = KF + (size_t)m * (NH * QK) + h * QK;
        o[lane] = (bf16)f2bf(a0 * rs * w0); o[64 + lane] = (bf16)f2bf(a1 * rs * w1); o[128 + lane] = (bf16)f2bf(r2);
    }
}
__device__ __forceinline__ void phase_ssdpre(const bf16* PROJ, const float* MISC, const float* cw, const float* cb, const float* dtb, bf16* XC, float* DTS, int G, int wg) {
    for (int i = wg * NTHR + otid(); i < M * (CONVD / 8); i += G * NTHR) {
        const int m = i / (CONVD / 8), c0 = (i % (CONVD / 8)) * 8, t = m % SEQ;
        float acc[8]; ld_f32x8(cb + c0, acc);
#pragma unroll
        for (int j = 0; j < CW; ++j) { const int tt = t - (CW - 1) + j;
            if (tt >= 0) { float xv[8], wv[8]; ld_bf16x8(PROJ + (size_t)(m - (CW - 1) + j) * DINP + PC_XBC + c0, xv); ld_f32x8(cw + j * CONVD + c0, wv);
#pragma unroll
                for (int e = 0; e < 8; ++e) acc[e] += xv[e] * wv[e]; } }
#pragma unroll
        for (int e = 0; e < 8; ++e) acc[e] = siluf_(acc[e]);
        *(u32x4*)(XC + (size_t)m * CONVD + c0) = pack8(acc);
    }
    for (int i = wg * NTHR + otid(); i < M * SH; i += G * NTHR) { const int m = i >> 6, h = i & 63;
        const float x = MISC[(size_t)m * 128 + 64 + h] + dtb[h]; DTS[i] = x > 20.f ? x : log1pf(__expf(x)); }
}
__device__ __forceinline__ void phase_ssdnorm(const float* YPRE, const bf16* PROJ, bf16* Y, int G, int wg) {
    const int wave = otid() >> 6, lane = otid() & 63;
    for (int it = wg * NWAVES + wave; it < M * SG; it += G * NWAVES) {
        const int m = it >> 3, g = it & 7, c0 = g * 512 + lane * 8;
        float y[8], z[8]; ld_f32x8(YPRE + (size_t)m * DI + c0, y); ld_bf16x8(PROJ + (size_t)m * DINP + PC_Z + c0, z);
        float s = 0.f;
#pragma unroll
        for (int e = 0; e < 8; ++e) { y[e] *= siluf_(z[e]); s += y[e] * y[e]; }
        const float rs = rsqrtf(wave_sum(s) * (1.f / 512.f) + EPS);
#pragma unroll
        for (int e = 0; e < 8; ++e) y[e] *= rs;
        *(u32x4*)(Y + (size_t)m * DI + c0) = pack8(y);
    }
}

__device__ __forceinline__ void phase_attn_simple(const bf16* QRAW, const bf16* KF, const bf16* KVRAW, const float* qw, const float* COS, const float* SIN, bf16* AO, LAS unsigned char* lds, int G, int wg) {
    const int wave = otid() >> 6, lane = otid() & 63;
    LAS float* sc = (LAS float*)(lds + RING_OFF + wave * 16384);
    LAS float* qs = (LAS float*)(lds + EXTRA_OFF + wave * 768);
    const float w0 = qw[lane], w1 = qw[64 + lane], w2 = qw[128 + lane];
    for (int it = wg * NWAVES + wave; it < NB * NH * SEQ; it += G * NWAVES) {
        const int t = it % SEQ, bh = it / SEQ, h = bh % NH, b = bh / NH, m = b * SEQ + t;
        const bf16* qp = QRAW + (size_t)m * (NH * QK) + h * QK;
        const float a0 = bf2f(qp[lane]), a1 = bf2f(qp[64 + lane]), a2 = bf2f(qp[128 + lane]);
        const float ss = wave_sum(a0 * a0 + a1 * a1 + a2 * a2), rs = rsqrtf(ss * (1.f / QK) + EPS);
        const float t2 = a2 * rs * w2, o2 = __shfl_xor(t2, 32);
        const float c = COS[m * 32 + (lane & 31)], s = SIN[m * 32 + (lane & 31)];
        const float r2 = lane < 32 ? (t2 * c - o2 * s) : (o2 * s + t2 * c);
        const float scale = 0.07216878364870322f;
        qs[lane] = a0 * rs * w0 * scale; qs[64 + lane] = a1 * rs * w1 * scale; qs[128 + lane] = r2 * scale;
        LDS_WAIT();
        const int nk = (t / TC + 1) * TC;
        float mx = -3.0e38f;
        for (int j = lane; j < nk; j += 64) {
            const bf16* kp = KF + (size_t)(b * SEQ + j) * (NH * QK) + h * QK;
            float acc = 0.f;
#pragma unroll 4
            for (int d = 0; d < QK; d += 8) { float kv[8]; ld_bf16x8(kp + d, kv);
#pragma unroll
                for (int e = 0; e < 8; ++e) acc += qs[d + e] * kv[e]; }
            sc[j] = acc; mx = fmaxf(mx, acc);
        }
        mx = wave_max(mx);
        LDS_WAIT();
        float l = 0.f;
        for (int j = lane; j < nk; j += 64) { const float p = __expf(sc[j] - mx); sc[j] = p; l += p; }
        l = wave_sum(l);
        LDS_WAIT();
        float o0 = 0.f, o1 = 0.f;
        const bf16* vp = KVRAW + (size_t)(b * SEQ) * 4096 + h * 256 + 128;
#pragma unroll 8
        for (int j = 0; j < nk; ++j) { const float p = sc[j]; o0 += p * bf2f(vp[(size_t)j * 4096 + lane]); o1 += p * bf2f(vp[(size_t)j * 4096 + 64 + lane]); }
        const float il = 1.f / l;
        AO[(size_t)m * DM + h * VD + lane] = (bf16)f2bf(o0 * il); AO[(size_t)m * DM + h * VD + 64 + lane] = (bf16)f2bf(o1 * il);
        LDS_WAIT();
    }
}
__device__ __forceinline__ float wave_scan(float v, int lane) {
#pragma unroll
    for (int o = 1; o < 64; o <<= 1) { const float n = __shfl_up(v, o); if (lane >= o) v += n; }
    return v;
}
__device__ __forceinline__ void phase_ssd_states(const bf16* XC, const float* DTS, const float* a_log, float* ST, float* CDEC, LAS unsigned char* lds, int G, int wg) {
    LAS float* wsh = (LAS float*)(lds + RING_OFF);
    const int tid = otid();
    for (int it = wg; it < NB * NCH * SH; it += G) {
        const int h = it % SH, bc = it / SH, m0 = bc * TC, g = h / HPG;
        __syncthreads();
        if (tid < 64) { const float A = -__expf(a_log[h]), dt = DTS[(size_t)(m0 + tid) * SH + h];
            const float ac = wave_scan(dt * A, tid), last = __shfl(ac, 63);
            wsh[tid] = __expf(last - ac) * dt; if (tid == 63) CDEC[bc * SH + h] = __expf(last); }
        __syncthreads();
        const int p = tid >> 3, n0 = (tid & 7) * 16;
        float acc[16];
#pragma unroll
        for (int e = 0; e < 16; ++e) acc[e] = 0.f;
        for (int s = 0; s < TC; ++s) {
            const float xw = bf2f(XC[(size_t)(m0 + s) * CONVD + h * HD + p]) * wsh[s];
            float b0[8], b1[8]; ld_bf16x8(XC + (size_t)(m0 + s) * CONVD + DI + g * SN + n0, b0); ld_bf16x8(XC + (size_t)(m0 + s) * CONVD + DI + g * SN + n0 + 8, b1);
#pragma unroll
            for (int e = 0; e < 8; ++e) { acc[e] += xw * b0[e]; acc[8 + e] += xw * b1[e]; }
        }
        float* o = ST + (((size_t)bc * SH + h) * HD + p) * SN + n0;
#pragma unroll
        for (int e = 0; e < 16; e += 4) *(f32x4*)(o + e) = (f32x4){acc[e], acc[e + 1], acc[e + 2], acc[e + 3]};
    }
}
__device__ __forceinline__ void phase_ssd_scan(float* ST, const float* CDEC, int G, int wg) {
    constexpr int PER_B = SH * HD * SN;
    for (int e = wg * NTHR + otid(); e < NB * PER_B; e += G * NTHR) {
        const int b = e / PER_B, r = e % PER_B, h = r / (HD * SN);
        float state = 0.f;
        for (int c = 0; c < NCH; ++c) { const size_t idx = (size_t)(b * NCH + c) * PER_B + r; const float tmp = ST[idx]; ST[idx] = state; state = state * CDEC[(b * NCH + c) * SH + h] + tmp; }
    }
}
__device__ __forceinline__ void phase_ssd_out(const bf16* XC, const float* DTS, const float* a_log, const float* dskip, const float* ST, float* YPRE, LAS unsigned char* lds, int G, int wg) {
    LAS float* Mm = (LAS float*)(lds + RING_OFF);
    LAS float* acs = (LAS float*)(lds + RING_OFF + 20480);
    LAS float* dts = acs + 64;
    const int tid = otid();
    for (int it = wg; it < NB * NCH * SH; it += G) {
        const int h = it % SH, bc = it / SH, m0 = bc * TC, g = h / HPG;
        __syncthreads();
        if (tid < 64) { const float A = -__expf(a_log[h]), dt = DTS[(size_t)(m0 + tid) * SH + h]; acs[tid] = wave_scan(dt * A, tid); dts[tid] = dt; }
        __syncthreads();
        for (int i = 0; i < 8; ++i) { const int e = tid + NTHR * i, t = e >> 6, s = e & 63;
            float v = 0.f;
            if (s <= t) { const bf16* cp = XC + (size_t)(m0 + t) * CONVD + DI + SG * SN + g * SN; const bf16* bp = XC + (size_t)(m0 + s) * CONVD + DI + g * SN;
                float dot = 0.f;
#pragma unroll 4
                for (int n = 0; n < SN; n += 8) { float cv[8], bv[8]; ld_bf16x8(cp + n, cv); ld_bf16x8(bp + n, bv);
#pragma unroll
                    for (int q = 0; q < 8; ++q) dot += cv[q] * bv[q]; }
                v = dot * __expf(acs[t] - acs[s]) * dts[s]; }
            Mm[t * 65 + s] = v; }
        __syncthreads();
        const int t = tid >> 3, p0 = (tid & 7) * 8;
        float y[8];
#pragma unroll
        for (int j = 0; j < 8; ++j) y[j] = 0.f;
        for (int s = 0; s < TC; ++s) { float xv[8]; ld_bf16x8(XC + (size_t)(m0 + s) * CONVD + h * HD + p0, xv); const float mv = Mm[t * 65 + s];
#pragma unroll
            for (int j = 0; j < 8; ++j) y[j] += mv * xv[j]; }
        const float ea = __expf(acs[t]), dk = dskip[h];
        const bf16* cp = XC + (size_t)(m0 + t) * CONVD + DI + SG * SN + g * SN;
        float xt[8]; ld_bf16x8(XC + (size_t)(m0 + t) * CONVD + h * HD + p0, xt);
#pragma unroll
        for (int j = 0; j < 8; ++j) { const float* pp = ST + (((size_t)bc * SH + h) * HD + p0 + j) * SN;
            float dot = 0.f;
#pragma unroll 4
            for (int n = 0; n < SN; n += 8) { float cv[8], pv[8]; ld_bf16x8(cp + n, cv); ld_f32x8(pp + n, pv);
#pragma unroll
                for (int q = 0; q < 8; ++q) dot += cv[q] * pv[q]; }
            y[j] += ea * dot + dk * xt[j]; }
        st_f32x8(YPRE + (size_t)(m0 + t) * DI + h * HD + p0, y);
    }
}

constexpr int PPL = 14, NPH = 1 + DEPTH * PPL;
struct Args { const float* in[26]; float* out; unsigned char* ws; int ph_lo, ph_hi; };
__global__ void __launch_bounds__(NTHR, 2) fwd(Args args) {
    extern __shared__ __attribute__((aligned(16))) unsigned char lds_[];
    LAS unsigned char* lds = (LAS unsigned char*)lds_;
    const int tid = threadIdx.x, G = gridDim.x, wg = blockIdx.x;
    for (int u = tid; u < (LDS_BYTES - LDSCTL_OFF) / 4; u += NTHR) ((LAS unsigned*)(lds + LDSCTL_OFF))[u] = 0u;
    __syncthreads();
    unsigned char* const ws0 = args.ws;
    unsigned* const ctl0 = (unsigned*)(ws0 + WS_CTL);
    const int lo = args.ph_lo, hi = args.ph_hi;
    XcdBarrier bar; bar.bar = ctl0 + CW_BAR; bar.x = 0; bar.st = (volatile LAS unsigned*)(lds + MISC_OFF) + 8;
    if (hi - lo > 1) bar = xcd_barrier_post(ctl0 + CW_BAR, (volatile LAS unsigned*)(lds + MISC_OFF) + 8);
#define INP(i) (args.in[i])
#define WSP(T, off) ((T*)(ws + (off)))
#define X (args.out)
#define SSQX ((u64*)(ctl + CW_SSQX))
#define SSQC ((u64*)(ctl + CW_SSQC))
#define XB0 WSP(bf16, WS_XB)
#define XB1 WSP(bf16, WS_XB1)
#define XB2 WSP(bf16, WS_XB2)
#define PROJ WSP(bf16, WS_PROJ)
#define U WSP(bf16, WS_U)
#define MISC WSP(float, WS_MISC)
#define QRAW WSP(bf16, WS_QRAW)
#define KVRAW WSP(bf16, WS_KVRAW)
#define KF WSP(bf16, WS_KF)
#define AO WSP(bf16, WS_AO)
#define XC WSP(bf16, WS_XC)
#define DTS WSP(float, WS_DTS)
#define CDEC WSP(float, WS_CDEC)
#define ST WSP(float, WS_ST)
#define YPRE WSP(float, WS_YPRE)
#define Y WSP(bf16, WS_Y)
#define TMPF WSP(float, WS_TMPF)
#define MERGED WSP(bf16, WS_MERGED)
#define PE WSP(bf16, WS_PE)
#define PB WSP(bf16, WS_PB)
#define COS WSP(float, WS_COS)
#define SIN WSP(float, WS_SIN)
    int ph = 0;
#define PHASE(...) do { if (lo <= ph && ph < hi) { { unsigned char* ws = ws0; asm volatile("" : "+s"(ws)); unsigned* ctl = (unsigned*)(ws + WS_CTL); __VA_ARGS__; } if (ph + 1 < hi) xcd_barrier(bar); } ++ph; } while (0)

    PHASE({ prologue_weights(args.in, ws, lds, G, wg); prologue_rows(args.in, X, ws, G, wg); });

#pragma unroll 1
    for (int l = 0; l < DEPTH; ++l) {
#define wl (ws + WS_W + (size_t)l * WL_BYTES)
#define ssq0 (SSQX + (size_t)(l * 3 + 0) * M)
#define ssq1 (SSQX + (size_t)(l * 3 + 1) * M)
#define ssq2 (SSQX + (size_t)(l * 3 + 2) * M)
#define ssqn ((l + 1 < DEPTH) ? SSQX + (size_t)((l + 1) * 3) * M : (u64*)nullptr)
#define ssqc (SSQC + (size_t)l * 2 * M)
        PHASE({ pg8::Gemm g{XB0, (const bf16*)(wl + WL_IN), M, DINP, DM, DM}; EpiInProj E{ssq0, ssqc, PROJ, MISC}; run_gemm(lds, g, E, G, wg); });
        PHASE({ { pg8::Gemm g{PROJ + PC_CQ, (const bf16*)(wl + WL_UQ), M, NH * QK, QL, DINP}; EpiScaleBf16 E{ssqc, 1.f / QL, QRAW, NH * QK}; run_gemm(lds, g, E, G, wg); }
                { pg8::Gemm g{PROJ + PC_CKV, (const bf16*)(wl + WL_UKV), M, NH * 256, KVL, DINP}; EpiScaleBf16 E{ssqc + M, 1.f / KVL, KVRAW, NH * 256}; run_gemm(lds, g, E, G, wg); }
                { pg8::Gemm g{PB + (size_t)l * M * PLE, (const bf16*)(wl + WL_PL), M, DM, PLE, PLE}; EpiScaleBf16 E{nullptr, 0.f, PE, DM}; run_gemm(lds, g, E, G, wg); } });
        PHASE({ phase_kfin(KVRAW, MISC, INP(10) + l * QK, COS, SIN, KF, G, wg);
                phase_ssdpre(PROJ, MISC, INP(12) + (size_t)l * CW * CONVD, INP(13) + (size_t)l * CONVD, INP(14) + l * SH, XC, DTS, G, wg); });
        PHASE({ phase_attn_simple(QRAW, KF, KVRAW, INP(9) + l * QK, COS, SIN, AO, lds, G, wg); });
        PHASE({ phase_ssd_states(XC, DTS, INP(15) + l * SH, ST, CDEC, lds, G, wg); });
        PHASE({ phase_ssd_scan(ST, CDEC, G, wg); });
        PHASE({ phase_ssd_out(XC, DTS, INP(15) + l * SH, INP(16) + l * SH, ST, YPRE, lds, G, wg); });
        PHASE({ phase_ssdnorm(YPRE, PROJ, Y, G, wg); });
        PHASE({ pg8::Gemm g{AO, (const bf16*)(wl + WL_OM), M, DM, DM, DM}; EpiGateF32 E{PROJ, TMPF}; run_gemm(lds, g, E, G, wg); });
        PHASE({ pg8::Gemm g{Y, (const bf16*)(wl + WL_OS), M, DM, DI, DI}; EpiMerge E{PROJ, TMPF, MERGED}; run_gemm(lds, g, E, G, wg); });
        PHASE({ pg8::Gemm g{MERGED, (const bf16*)(wl + WL_OUT), M, DM, DM, DM}; EpiResid E{X, XB1, ssq1}; run_gemm(lds, g, E, G, wg); });
        PHASE({ pg8::Gemm g{XB1, (const bf16*)(wl + WL_UP), M, DFF, DM, DM}; EpiUp E{ssq1, U}; run_gemm(lds, g, E, G, wg); });
        PHASE({ pg8::Gemm g{U, (const bf16*)(wl + WL_DN), M, DM, DFF, DFF}; EpiResid E{X, XB2, ssq2}; run_gemm(lds, g, E, G, wg); });
        PHASE({ pg8::Gemm g{XB2, (const bf16*)(wl + WL_PG), M, DM, DM, DM};  EpiPleGate E{ssq2, PE, X, XB0, ssqn}; run_gemm(lds, g, E, G, wg); });
    }
#undef PHASE
}

extern "C" void kernel_launch(void* const* d_in, const int* in_sizes, int n_in, void* d_out, int out_size, void* d_ws, size_t ws_size, hipStream_t stream) {
    static int grid = 0;
    if (grid == 0) {
        if (n_in != 26 || out_size != M * DM || ws_size < WS_END) { fprintf(stderr, "kernel_launch: built for 26 inputs, out %d floats, >= %zu bytes of workspace; got n_in %d out %d ws %zu\n", M * DM, (size_t)WS_END, n_in, out_size, ws_size); grid = -1; return; }
        int dev = 0, cus = 0;
        if (hipGetDevice(&dev) != hipSuccess || hipDeviceGetAttribute(&cus, hipDeviceAttributeMultiprocessorCount, dev) != hipSuccess) { grid = -1; return; }
        if (hipFuncSetAttribute((const void*)fwd, hipFuncAttributeMaxDynamicSharedMemorySize, LDS_BYTES) != hipSuccess) { fprintf(stderr, "kernel_launch: hipFuncSetAttribute failed\n"); grid = -1; return; }
        int per_cu = 0;
        if (hipOccupancyMaxActiveBlocksPerMultiprocessor(&per_cu, (const void*)fwd, NTHR, LDS_BYTES) != hipSuccess || per_cu < 1) fprintf(stderr, "kernel_launch: occupancy query says %d\n", per_cu);
        (void)hipGetLastError();
        grid = cus;
    }
    if (grid < 0) return;
    if (hipMemsetAsync((char*)d_ws + WS_CTL, 0, CTL_ZERO_BYTES, stream) != hipSuccess) return;
    Args a{};
    for (int i = 0; i < 26; ++i) a.in[i] = (const float*)d_in[i];
    a.out = (float*)d_out; a.ws = (unsigned char*)d_ws;
#if MK_ONE_LAUNCH
    a.ph_lo = 0; a.ph_hi = NPH;
    hipLaunchKernelGGL(fwd, dim3(grid), dim3(NTHR), LDS_BYTES, stream, a);
#else
#ifndef STOP_PH
#define STOP_PH NPH
#endif
    for (int ph = 0; ph < STOP_PH; ++ph) {
#ifdef SKIP_LO
        if (ph >= SKIP_LO && ph < SKIP_HI) continue;
#endif
        a.ph_lo = ph; a.ph_hi = ph + 1; hipLaunchKernelGGL(fwd, dim3(grid), dim3(NTHR), LDS_BYTES, stream, a); }
#endif
    const hipError_t le = hipPeekAtLastError();
    if (le != hipSuccess) fprintf(stderr, "kernel_launch: launch failed: %s\n", hipGetErrorName(le));
}
```

```cpp
#define FAST_GEMM 1
#define MK_ONE_LAUNCH 1
#include <hip/hip_runtime.h>
#include <cstdio>
#include <cstdint>

#ifndef MK_ONE_LAUNCH
#define MK_ONE_LAUNCH 0
#endif
#ifndef FAST_GEMM
#define FAST_GEMM 0
#endif

constexpr int NB = 2, SEQ = 4096, M = NB * SEQ, DM = 2048, DEPTH = 4, PLE = 256;
constexpr float EPS = 1e-6f;
constexpr int NH = 16, QL = 512, KVL = 512, NOPE = 128, ROPE = 64, VD = 128, QK = 192;
constexpr int DI = 4096, HD = 64, SH = 64, SG = 8, SN = 128, HPG = 8, CW = 4, CONVD = 6144, TC = 64, NCH = SEQ / TC;
constexpr int DFF = 8192;
constexpr int DIN = 15488;
constexpr int DINP = 15616;
constexpr int PC_CQ = 0, PC_CKV = 512, PC_Z = 1024, PC_XBC = 5120, PC_G = 11264, PC_KR = 15360, PC_DT = 15424, PC_PAD = 15488;
constexpr int NWAVES = 8, NTHR = 512;

typedef unsigned short bf16;
typedef unsigned u32x4 __attribute__((ext_vector_type(4)));
typedef unsigned u32x2 __attribute__((ext_vector_type(2)));
typedef float f32x4 __attribute__((ext_vector_type(4)));
typedef float f32x2 __attribute__((ext_vector_type(2)));
typedef short bf16x8 __attribute__((ext_vector_type(8)));
#define GAS __attribute__((address_space(1)))
#define LAS __attribute__((address_space(3)))
typedef GAS unsigned gu32;
#define RLX_AGENT __ATOMIC_RELAXED, __HIP_MEMORY_SCOPE_AGENT
#define LDS_WAIT() asm volatile("s_waitcnt lgkmcnt(0)" ::: "memory")
#define VM_WAIT() asm volatile("s_waitcnt vmcnt(0)" ::: "memory")

constexpr size_t MiB = 1u << 20;
constexpr size_t WS_CTL = 0, CTL_ZERO_BYTES = 2 * MiB;
constexpr int CW_TMO = 0, CW_CODE = 1, CW_BAR = 4096;
typedef unsigned long long u64;
constexpr int CW_SSQX = 16384;
constexpr int CW_SSQC = CW_SSQX + 2 * DEPTH * 3 * M;
static_assert((size_t)(CW_SSQC + 2 * DEPTH * 2 * M) * 4 <= CTL_ZERO_BYTES, "ctl");
constexpr size_t WL_IN = 0, WL_UQ = 61 * MiB, WL_UKV = 64 * MiB, WL_OM = 68 * MiB, WL_OS = 76 * MiB, WL_OUT = 92 * MiB, WL_UP = 100 * MiB, WL_DN = 132 * MiB, WL_PG = 164 * MiB, WL_PL = 172 * MiB, WL_BYTES = 173 * MiB;
static_assert((size_t)DINP * DM * 2 == 61 * MiB, "w_in copy");
constexpr size_t WS_W = 2 * MiB;
constexpr size_t WS_ACT = WS_W + DEPTH * WL_BYTES;
constexpr size_t WS_XB = WS_ACT;
constexpr size_t WS_XB1 = WS_XB + 32 * MiB, WS_XB2 = WS_XB1 + 32 * MiB;
constexpr size_t WS_PROJ = WS_XB2 + 32 * MiB;
constexpr size_t WS_U = WS_PROJ;
constexpr size_t WS_MISC = WS_PROJ + 244 * MiB;
constexpr size_t WS_QRAW = WS_MISC + 4 * MiB;
constexpr size_t WS_KVRAW = WS_QRAW + 48 * MiB;
constexpr size_t WS_KF = WS_KVRAW + 64 * MiB;
constexpr size_t WS_AO = WS_KF + 48 * MiB;
constexpr size_t WS_XC = WS_AO + 32 * MiB;
constexpr size_t WS_DTS = WS_XC + 96 * MiB;
constexpr size_t WS_CDEC = WS_DTS + 2 * MiB;
constexpr size_t WS_ST = WS_CDEC + 1 * MiB;
constexpr size_t WS_YPRE = WS_ST + 256 * MiB;
constexpr size_t WS_Y = WS_YPRE + 128 * MiB;
constexpr size_t WS_TMPF = WS_Y + 64 * MiB;
constexpr size_t WS_MERGED = WS_TMPF + 64 * MiB;
constexpr size_t WS_PE = WS_MERGED + 32 * MiB;
constexpr size_t WS_PB = WS_PE + 32 * MiB;
constexpr size_t WS_COS = WS_PB + 16 * MiB;
constexpr size_t WS_SIN = WS_COS + 1 * MiB;
constexpr size_t WS_END = WS_SIN + 1 * MiB;
static_assert(WS_END <= 1936 * MiB, "d_ws budget (4 x the largest input)");

constexpr int RING_OFF = 0, RING_BYTES = 131072;
constexpr int LDSCTL_OFF = RING_BYTES, MISC_OFF = LDSCTL_OFF + 320;
constexpr int EXTRA_OFF = LDSCTL_OFF + 512, LDS_BYTES = 147456, EXTRA_BYTES = LDS_BYTES - EXTRA_OFF;

__device__ __forceinline__ unsigned f2bf(float f) { unsigned u = __builtin_bit_cast(unsigned, f); return (u + 0x7fffu + ((u >> 16) & 1u)) >> 16; }
__device__ __forceinline__ float bf2f(unsigned h) { return __builtin_bit_cast(float, h << 16); }
typedef __bf16 bf16x2_t __attribute__((ext_vector_type(2)));
__device__ __forceinline__ unsigned pk2(float lo, float hi) { const f32x2 v = {lo, hi}; const bf16x2_t b = __builtin_convertvector(v, bf16x2_t); return __builtin_bit_cast(unsigned, b); }
__device__ __forceinline__ u32x4 pack8(const float (&v)[8]) { u32x4 w; w.x = pk2(v[0], v[1]); w.y = pk2(v[2], v[3]); w.z = pk2(v[4], v[5]); w.w = pk2(v[6], v[7]); return w; }
__device__ __forceinline__ void unpack8(u32x4 w, float (&v)[8]) {
    v[0] = bf2f(w.x & 0xffffu); v[1] = bf2f(w.x >> 16); v[2] = bf2f(w.y & 0xffffu); v[3] = bf2f(w.y >> 16);
    v[4] = bf2f(w.z & 0xffffu); v[5] = bf2f(w.z >> 16); v[6] = bf2f(w.w & 0xffffu); v[7] = bf2f(w.w >> 16); }
__device__ __forceinline__ float wave_sum(float v) {
#pragma unroll
    for (int o = 1; o < 64; o <<= 1) v += __shfl_xor(v, o);
    return v;
}
__device__ __forceinline__ float wave_max(float v) {
#pragma unroll
    for (int o = 1; o < 64; o <<= 1) v = fmaxf(v, __shfl_xor(v, o));
    return v;
}
__device__ __forceinline__ int otid() { int t = threadIdx.x; asm volatile("" : "+v"(t)); return t; }
__device__ __forceinline__ float sigmoidf_(float x) { return 1.f / (1.f + __expf(-x)); }
__device__ __forceinline__ float siluf_(float x) { return x / (1.f + __expf(-x)); }

#define XB_TMO      128
#define XB_XCNT(j)  (256  + 64 * (j))
#define XB_XSUB(j)  (1280 + 64 * (j))
#define XB_XGEN(j)  (2304 + 64 * (j))
#define XB_TOP      3328
#define XB_TOPGEN   3392
#define XCD_BAR_WORDS 3456
#define XB_SPIN_CAP (1u << 18)
__device__ __forceinline__ unsigned xb_ld(unsigned* p)              { return __hip_atomic_load(p, __ATOMIC_RELAXED, __HIP_MEMORY_SCOPE_AGENT); }
__device__ __forceinline__ unsigned xb_add(unsigned* p, unsigned v) { return __hip_atomic_fetch_add(p, v, __ATOMIC_RELAXED, __HIP_MEMORY_SCOPE_AGENT); }
__device__ __forceinline__ unsigned xb_xcc_id() { return (unsigned)__builtin_amdgcn_s_getreg((3 << 11) | 20) & 0xFu; }
#define XB_SPIN(cond, bar) do { unsigned _sp = 0; while (cond) { __builtin_amdgcn_s_sleep(1); \
    if ((++_sp & 255u) == 0u) { if (xb_ld(&(bar)[XB_TMO])) break; if (_sp > XB_SPIN_CAP) { atomicAdd(&(bar)[XB_TMO], 1u); break; } } } } while (0)
struct XcdBarrier { unsigned* bar; unsigned x; volatile LAS unsigned* st; };
__device__ __forceinline__ XcdBarrier xcd_barrier_post(unsigned* bar, volatile LAS unsigned* st) {
    XcdBarrier b; b.bar = bar; b.x = xb_xcc_id(); b.st = st;
    if (threadIdx.x == 0) (void)xb_add(&bar[XB_XCNT(b.x)], 1u);
    return b;
}
__device__ __forceinline__ void xcd_barrier_complete(unsigned* bar, unsigned x, unsigned& nloc, unsigned& nx) {
    const unsigned G = gridDim.x * gridDim.y * gridDim.z;
    unsigned sum, cnt, mine, sp = 0u;
    for (;;) {
        sum = 0u; cnt = 0u; mine = 0u;
#pragma unroll
        for (unsigned j = 0; j < 16; ++j) { const unsigned c = xb_ld(&bar[XB_XCNT(j)]); sum += c; cnt += (c > 0u) ? 1u : 0u; mine = (j == x) ? c : mine; }
        if (sum == G) break;
        __builtin_amdgcn_s_sleep(1);
        if ((++sp & 255u) == 0u) { if (xb_ld(&bar[XB_TMO])) break; if (sp > XB_SPIN_CAP) { atomicAdd(&bar[XB_TMO], 1u); break; } }
    }
    nloc = mine > 0u ? mine : 1u; nx = cnt > 0u ? cnt : 1u;
}
__device__ __forceinline__ void xcd_barrier(const XcdBarrier& b) {
    asm volatile("s_waitcnt vmcnt(0)" ::: "memory");
    __syncthreads();
    if (threadIdx.x == 0) {
        unsigned* bar = b.bar;
        __builtin_amdgcn_s_waitcnt(0);
        unsigned nloc = b.st[0], nx = b.st[1];
        if (nloc == 0u) { xcd_barrier_complete(bar, b.x, nloc, nx); b.st[0] = nloc; b.st[1] = nx; }
        const unsigned old = xb_add(&bar[XB_XSUB(b.x)], 1u);
        const unsigned gen = old / nloc;
        if (old + 1u == (gen + 1u) * nloc) {
            __builtin_amdgcn_fence(__ATOMIC_RELEASE, "agent");
            asm volatile("s_waitcnt vmcnt(0)" ::: "memory");
            const unsigned og = xb_add(&bar[XB_TOP], 1u);
            const unsigned tg = og / nx;
            if (og + 1u == (tg + 1u) * nx) xb_add(&bar[XB_TOPGEN], 1u);
            else XB_SPIN(xb_ld(&bar[XB_TOPGEN]) == tg, bar);
            __builtin_amdgcn_fence(__ATOMIC_ACQUIRE, "agent");
            xb_add(&bar[XB_XGEN(b.x)], 1u);
            asm volatile("s_waitcnt vmcnt(0)" ::: "memory");
        } else {
            XB_SPIN(xb_ld(&bar[XB_XGEN(b.x)]) == gen, bar);
            __builtin_amdgcn_fence(__ATOMIC_ACQUIRE, "agent");
            asm volatile("s_waitcnt vmcnt(0)" ::: "memory");
        }
    }
    __syncthreads();
}

namespace pg8 {
typedef unsigned short bf16_t;
constexpr int BM = 256, BK = 64, HALF = 128, HTB = HALF * BK * 2, STAGE_BYTES = 8 * HTB, NXCD = 8, WGM = 8;
__host__ __device__ __forceinline__ int lds_byte(int r, int c) { const int st = (r >> 4) * 2 + (c >> 5), rr = r & 15, cc = c & 31, ob = rr * 64 + cc * 2; return st * 1024 + (ob ^ (((ob >> 9) & 1) << 5)); }
__host__ __device__ __forceinline__ void stage_rc(int b, int& R, int& C) { const int st = b / 1024, sb = b % 1024, swz = sb ^ (((sb >> 9) & 1) << 5); R = (st >> 1) * 16 + swz / 64; C = (st & 1) * 32 + (swz % 64) / 2; }
__host__ __device__ __forceinline__ int perm32(int rho) { const int n = rho >> 4, i = rho & 15; return 8 * (i >> 2) + 4 * n + (i & 3); }
struct Unit { int pm, pn; };
struct Gemm { const bf16_t* A; const bf16_t* Bt; int M, N, K, lda; };
struct StaticOrder {
    int nM, nN, nwg, G, c;
    __host__ __device__ void init(int M_, int N_, int G_, int c_) { nM = M_ / BM; nN = N_ / BM; nwg = nM * nN; G = G_; c = c_; }
    __host__ __device__ bool next(int i, Unit& u) const {
        const long L = (long)i * G + c; if (L >= nwg) return false;
        int wgid = (int)L; { const int q = nwg / NXCD, r = nwg % NXCD, xcd = wgid % NXCD, off = wgid / NXCD; wgid = (xcd < r ? xcd * (q + 1) : r * (q + 1) + (xcd - r) * q) + off; }
        const int nig = WGM * nN, gid = wgid / nig, fm = gid * WGM, gsz = (nM - fm) < WGM ? (nM - fm) : WGM;
        u.pm = fm + ((wgid % nig) % gsz); u.pn = (wgid % nig) / gsz; return true;
    }
    __device__ __forceinline__ void a_ready(const Unit&) const {}
    __device__ __forceinline__ void done(const Unit&) const {}
};

template <class Epi, class Sched>
__device__ __forceinline__ void gemm_phase(LAS unsigned char* lds, const Gemm g, const Sched& S, const Epi& E) {
    const int tid = otid(), wid = __builtin_amdgcn_readfirstlane(tid >> 6), lane = tid & 63, wr = wid >> 2, wc = wid & 3, fr = lane & 15, fq = lane >> 4;
    const int K = g.K, nt = K / BK, lda = g.lda;
    unsigned voffA[2], voffB[2];
#pragma unroll
    for (int i = 0; i < 2; ++i) { int R, C; stage_rc(tid * 16 + i * 8192, R, C); const int Rb = (R & ~31) + perm32(R & 31);
        voffA[i] = (unsigned)(R * lda + C) * 2u; voffB[i] = (unsigned)(Rb * K + C) * 2u; }
    const size_t kstep = (size_t)(BK * 2);
    const size_t hstepA = (size_t)HALF * lda * 2, hstepB = (size_t)HALF * K * 2;
    const size_t tstepA = 2 * hstepA, tstepB = 2 * hstepB;
    const unsigned ldsw = (unsigned)wid * 1024u;
    const int aoff = lds_byte(wr * 64 + fr, fq * 8), boff = lds_byte(wc * 32 + fr, fq * 8);
#define PG8_SA(b, h) (((b) * 2 + (h)) * HTB)
#define PG8_SB(b, h) ((4 + (b) * 2 + (h)) * HTB)
#define PG8_STAGE(bufoff, gbase, voff) do { _Pragma("unroll") for (int _i = 0; _i < 2; ++_i) \
        __builtin_amdgcn_global_load_lds((const unsigned*)((const char*)(gbase) + (voff)[_i]), (LAS unsigned*)(lds + (bufoff) + ldsw + _i * 8192), 16, 0, 0); } while (0)
#define PG8_LDA(dst, b, h) do { _Pragma("unroll") for (int m = 0; m < 4; ++m) _Pragma("unroll") for (int k = 0; k < 2; ++k) dst[m][k] = *(const LAS bf16x8*)(lds + PG8_SA(b, h) + aoff + m * 2048 + k * 1024); } while (0)
#define PG8_LDB(dst, b, h) do { _Pragma("unroll") for (int n = 0; n < 2; ++n) _Pragma("unroll") for (int k = 0; k < 2; ++k) dst[n][k] = *(const LAS bf16x8*)(lds + PG8_SB(b, h) + boff + n * 2048 + k * 1024); } while (0)
#define PG8_MMA(ai, bj, At, Bt) do { __builtin_amdgcn_s_setprio(1); _Pragma("unroll") for (int m = 0; m < 4; ++m) _Pragma("unroll") for (int n = 0; n < 2; ++n) _Pragma("unroll") for (int k = 0; k < 2; ++k) \
        acc[ai][bj][m][n] = __builtin_amdgcn_mfma_f32_16x16x32_bf16(Bt[n][k], At[m][k], acc[ai][bj][m][n], 0, 0, 0); __builtin_amdgcn_s_setprio(0); } while (0)
#define PG8_WAIT_V(n) asm volatile("s_waitcnt vmcnt(" #n ")" ::: "memory")
#define PG8_WAIT_L(n) asm volatile("s_waitcnt lgkmcnt(" #n ")" ::: "memory")
#define PG8_BAR __builtin_amdgcn_s_barrier()
#define PG8_SCHED __builtin_amdgcn_sched_barrier(0)
    Unit cur, nxt; int ui = 0;
    if (!S.next(0, cur)) return;
    f32x4 acc[2][2][4][2];
#pragma unroll
    for (int a = 0; a < 2; ++a)
#pragma unroll
        for (int b = 0; b < 2; ++b)
#pragma unroll
            for (int m = 0; m < 4; ++m)
#pragma unroll
                for (int n = 0; n < 2; ++n) acc[a][b][m][n] = (f32x4){0.f, 0.f, 0.f, 0.f};
    bf16x8 At[4][2], B0[2][2], B1[2][2];
    const char* cA = (const char*)g.A + (size_t)cur.pm * tstepA; const char* cB = (const char*)g.Bt + (size_t)cur.pn * tstepB;
    S.a_ready(cur);
    PG8_STAGE(PG8_SB(0, 0), cB, voffB); PG8_STAGE(PG8_SB(0, 1), cB + hstepB, voffB); PG8_STAGE(PG8_SA(0, 0), cA, voffA); PG8_STAGE(PG8_SA(0, 1), cA + hstepA, voffA);
    if (wr == 1) PG8_BAR;
    PG8_WAIT_V(2); PG8_BAR;
    PG8_STAGE(PG8_SB(1, 0), cB + kstep, voffB); PG8_STAGE(PG8_SA(1, 0), cA + kstep, voffA); PG8_STAGE(PG8_SB(1, 1), cB + hstepB + kstep, voffB);
    PG8_WAIT_V(6); PG8_BAR;
    for (;;) {
        const bool has_next = S.next(ui + 1, nxt);
        const char* nA = has_next ? (const char*)g.A + (size_t)nxt.pm * tstepA : cA; const char* nB = has_next ? (const char*)g.Bt + (size_t)nxt.pn * tstepB : cB;
        for (int t = 0; t < nt; t += 2) {
            const bool last = (t == nt - 2);
            const char* a1 = cA + (size_t)(t + 1) * kstep;
            const char* a2 = last ? nA : cA + (size_t)(t + 2) * kstep; const char* b2 = last ? nB : cB + (size_t)(t + 2) * kstep;
            const char* a3 = a2 + kstep; const char* b3 = b2 + kstep;
            if (last && has_next) S.a_ready(nxt);
            PG8_LDB(B0, 0, 0); PG8_LDB(B1, 0, 1); PG8_SCHED; PG8_LDA(At, 0, 0); PG8_STAGE(PG8_SA(1, 1), a1 + hstepA, voffA);
            PG8_WAIT_V(8); PG8_WAIT_L(0); PG8_BAR; PG8_MMA(0, 0, At, B0); PG8_MMA(0, 1, At, B1); PG8_BAR; PG8_SCHED;
            PG8_LDA(At, 0, 1); PG8_STAGE(PG8_SB(0, 0), b2, voffB); PG8_STAGE(PG8_SB(0, 1), b2 + hstepB, voffB); PG8_STAGE(PG8_SA(0, 0), a2, voffA);
            PG8_WAIT_V(8); PG8_WAIT_L(0); PG8_BAR; PG8_MMA(1, 0, At, B0); PG8_MMA(1, 1, At, B1); PG8_BAR; PG8_SCHED;
            PG8_LDB(B0, 1, 0); PG8_LDB(B1, 1, 1); PG8_SCHED; PG8_LDA(At, 1, 0); PG8_STAGE(PG8_SA(0, 1), a2 + hstepA, voffA);
            PG8_WAIT_V(8); PG8_WAIT_L(0); PG8_BAR; PG8_MMA(0, 0, At, B0); PG8_MMA(0, 1, At, B1); PG8_BAR; PG8_SCHED;
            PG8_LDA(At, 1, 1); PG8_STAGE(PG8_SB(1, 0), b3, voffB); PG8_STAGE(PG8_SB(1, 1), b3 + hstepB, voffB); PG8_STAGE(PG8_SA(1, 0), a3, voffA);
            PG8_WAIT_V(8); PG8_WAIT_L(0); PG8_BAR; PG8_MMA(1, 0, At, B0); PG8_MMA(1, 1, At, B1); PG8_BAR; PG8_SCHED;
        }
        if (wr == 0) PG8_BAR;
        {
            const int row0 = cur.pm * BM + wr * 64 + fr, col00 = cur.pn * BM + wc * 32 + 8 * fq;
            typename Epi::Regs RA[2], RB[2];
#define PG8_EL(R, gi) do { const int _r = row0 + ((gi) >> 2) * HALF + ((gi) & 3) * 16; E.load(_r, col00, R[0]); E.load(_r, col00 + HALF, R[1]); } while (0)
#define PG8_EA(R, gi) do { const int _r = row0 + ((gi) >> 2) * HALF + ((gi) & 3) * 16; _Pragma("unroll") for (int bj = 0; bj < 2; ++bj) { \
                const f32x4 _p = acc[(gi) >> 2][bj][(gi) & 3][0], _q = acc[(gi) >> 2][bj][(gi) & 3][1]; const float _v[8] = {_p[0], _p[1], _p[2], _p[3], _q[0], _q[1], _q[2], _q[3]}; \
                E.apply(_r, col00 + bj * HALF, _v, R[bj]); } } while (0)
            PG8_EL(RA, 0);
#pragma unroll
            for (int gi = 0; gi < 8; gi += 2) {
                PG8_EL(RB, gi + 1); PG8_SCHED; PG8_EA(RA, gi); PG8_SCHED;
                if (gi + 2 < 8) PG8_EL(RA, gi + 2);
                PG8_SCHED; PG8_EA(RB, gi + 1); PG8_SCHED;
            }
#undef PG8_EL
#undef PG8_EA
        }
        S.done(cur);
        if (!has_next) break;
#pragma unroll
        for (int a = 0; a < 2; ++a)
#pragma unroll
            for (int b = 0; b < 2; ++b)
#pragma unroll
                for (int m = 0; m < 4; ++m)
#pragma unroll
                    for (int n = 0; n < 2; ++n) acc[a][b][m][n] = (f32x4){0.f, 0.f, 0.f, 0.f};
        cur = nxt; cA = nA; cB = nB; ++ui;
        if (wr == 1) PG8_BAR;
    }
    PG8_WAIT_V(0);
    PG8_BAR;
#undef PG8_SA
#undef PG8_SB
#undef PG8_STAGE
#undef PG8_LDA
#undef PG8_LDB
#undef PG8_MMA
#undef PG8_WAIT_V
#undef PG8_WAIT_L
#undef PG8_BAR
#undef PG8_SCHED
}

template <class Epi>
__device__ __forceinline__ void gemm_simple(const Gemm g, const Epi& E, int G, int wg) {
    const int tid = otid(), wid = tid >> 6, lane = tid & 63, fr = lane & 15, fq = lane >> 4;
    const int nbn = g.N / 32, nblk = (g.M / 16) * nbn;
    for (int it = wg * NWAVES + wid; it < nblk; it += G * NWAVES) {
        const int m0 = (it / nbn) * 16, n0 = (it % nbn) * 32;
        f32x4 acc0 = {0.f, 0.f, 0.f, 0.f}, acc1 = {0.f, 0.f, 0.f, 0.f};
        const bf16_t* ap = g.A + (size_t)(m0 + fr) * g.lda + 8 * fq;
        const bf16_t* bp0 = g.Bt + (size_t)(n0 + perm32(fr)) * g.K + 8 * fq;
        const bf16_t* bp1 = g.Bt + (size_t)(n0 + perm32(16 + fr)) * g.K + 8 * fq;
        for (int k0 = 0; k0 < g.K; k0 += 32) {
            const bf16x8 a = *(const bf16x8*)(ap + k0), b0 = *(const bf16x8*)(bp0 + k0), b1 = *(const bf16x8*)(bp1 + k0);
            acc0 = __builtin_amdgcn_mfma_f32_16x16x32_bf16(b0, a, acc0, 0, 0, 0);
            acc1 = __builtin_amdgcn_mfma_f32_16x16x32_bf16(b1, a, acc1, 0, 0, 0);
        }
        const float v[8] = {acc0[0], acc0[1], acc0[2], acc0[3], acc1[0], acc1[1], acc1[2], acc1[3]};
        typename Epi::Regs rg; E.load(m0 + fr, n0 + 8 * fq, rg); E.apply(m0 + fr, n0 + 8 * fq, v, rg);
    }
}
}

#ifndef GEMM_REPEAT
#define GEMM_REPEAT 1
#endif
template <class Epi>
__device__ __forceinline__ void run_gemm(LAS unsigned char* lds, const pg8::Gemm g, const Epi& E, int G, int wg, int rep = 1) {
#if FAST_GEMM
    if (rep < 0) { pg8::gemm_simple<Epi>(g, E, G, wg); return; }
    for (int rr = 0; rr < rep; ++rr) { pg8::StaticOrder S; S.init(g.M, g.N, G, wg); pg8::gemm_phase<Epi, pg8::StaticOrder>(lds, g, S, E); }
#else
    pg8::gemm_simple<Epi>(g, E, G, wg);
#endif
}

constexpr float SSQ_SCALE = 16777216.f, SSQ_INV = 1.f / 16777216.f;
__device__ __forceinline__ void ssq_add(u64* dst, int row, const float (&v)[8]) {
    float s = 0.f;
#pragma unroll
    for (int j = 0; j < 8; ++j) s += v[j] * v[j];
    s += __shfl_xor(s, 16); s += __shfl_xor(s, 32);
    if ((otid() & 63) < 16) atomicAdd(dst + row, (u64)(s * SSQ_SCALE));
}
__device__ __forceinline__ float ld_ssq(const u64* p) { return (float)__hip_atomic_load(p, __ATOMIC_RELAXED, __HIP_MEMORY_SCOPE_AGENT) * SSQ_INV; }
__device__ __forceinline__ void st_f32x8(float* p, const float (&v)[8]) { *(f32x4*)p = (f32x4){v[0], v[1], v[2], v[3]}; *(f32x4*)(p + 4) = (f32x4){v[4], v[5], v[6], v[7]}; }
__device__ __forceinline__ void ld_f32x8(const float* p, float (&v)[8]) { const f32x4 a = *(const f32x4*)p, b = *(const f32x4*)(p + 4); v[0] = a.x; v[1] = a.y; v[2] = a.z; v[3] = a.w; v[4] = b.x; v[5] = b.y; v[6] = b.z; v[7] = b.w; }
__device__ __forceinline__ void ld_bf16x8(const bf16* p, float (&v)[8]) { unpack8(*(const u32x4*)p, v); }

struct EpiInProj {
    const u64* ssq; u64* ssqc; bf16* proj; float* misc;
    struct Regs { float rs; };
    __device__ __forceinline__ void load(int row, int col0, Regs& r) const { r.rs = rsqrtf(ld_ssq(ssq + row) * (1.f / DM) + EPS); }
    __device__ __forceinline__ void apply(int row, int col0, const float (&a)[8], const Regs& r) const {
        float v[8];
#pragma unroll
        for (int j = 0; j < 8; ++j) v[j] = a[j] * r.rs;
        const int tile = col0 >> 8;
        if (tile == 60) { const int c = col0 - PC_KR; if (c < 128) st_f32x8(misc + (size_t)row * 128 + c, v); return; }
        if (tile >= 44) {
#pragma unroll
            for (int j = 0; j < 8; ++j) v[j] = sigmoidf_(v[j]);
        }
        *(u32x4*)(proj + (size_t)row * DINP + col0) = pack8(v);
        if (tile < 4) ssq_add(ssqc + (size_t)(tile >> 1) * M, row, v);
    }
};
struct EpiScaleBf16 {
    const u64* ssq; float inv_n; bf16* O; int ldo;
    struct Regs { float rs; };
    __device__ __forceinline__ void load(int row, int col0, Regs& r) const { r.rs = ssq ? rsqrtf(ld_ssq(ssq + row) * inv_n + EPS) : 1.f; }
    __device__ __forceinline__ void apply(int row, int col0, const float (&a)[8], const Regs& r) const {
        float v[8];
#pragma unroll
        for (int j = 0; j < 8; ++j) v[j] = a[j] * r.rs;
        *(u32x4*)(O + (size_t)row * ldo + col0) = pack8(v);
    }
};
struct EpiGateF32 {
    const bf16* proj; float* T;
    struct Regs { u32x4 g; };
    __device__ __forceinline__ void load(int row, int col0, Regs& r) const { r.g = *(const u32x4*)(proj + (size_t)row * DINP + PC_G + col0); }
    __device__ __forceinline__ void apply(int row, int col0, const float (&a)[8], const Regs& r) const {
        float g[8], v[8]; unpack8(r.g, g);
#pragma unroll
        for (int j = 0; j < 8; ++j) v[j] = a[j] * g[j];
        st_f32x8(T + (size_t)row * DM + col0, v);
    }
};
struct EpiMerge {
    const bf16* proj; const float* T; bf16* O;
    struct Regs { u32x4 g; f32x4 t0, t1; };
    __device__ __forceinline__ void load(int row, int col0, Regs& r) const { r.g = *(const u32x4*)(proj + (size_t)row * DINP + PC_G + DM + col0);
        r.t0 = *(const f32x4*)(T + (size_t)row * DM + col0); r.t1 = *(const f32x4*)(T + (size_t)row * DM + col0 + 4); }
    __device__ __forceinline__ void apply(int row, int col0, const float (&a)[8], const Regs& r) const {
        float g[8], v[8]; unpack8(r.g, g);
        const float t[8] = {r.t0.x, r.t0.y, r.t0.z, r.t0.w, r.t1.x, r.t1.y, r.t1.z, r.t1.w};
#pragma unroll
        for (int j = 0; j < 8; ++j) v[j] = t[j] + a[j] * g[j];
        *(u32x4*)(O + (size_t)row * DM + col0) = pack8(v);
    }
};
struct EpiResid {
    float* X; bf16* XB; u64* ssq_next;
    struct Regs { f32x4 x0, x1; };
    __device__ __forceinline__ void load(int row, int col0, Regs& r) const { r.x0 = *(const f32x4*)(X + (size_t)row * DM + col0); r.x1 = *(const f32x4*)(X + (size_t)row * DM + col0 + 4); }
    __device__ __forceinline__ void apply(int row, int col0, const float (&a)[8], const Regs& r) const {
        float x[8] = {r.x0.x, r.x0.y, r.x0.z, r.x0.w, r.x1.x, r.x1.y, r.x1.z, r.x1.w};
#pragma unroll
        for (int j = 0; j < 8; ++j) x[j] += a[j];
        st_f32x8(X + (size_t)row * DM + col0, x);
        *(u32x4*)(XB + (size_t)row * DM + col0) = pack8(x);
        if (ssq_next) ssq_add(ssq_next, row, x);
    }
};
struct EpiUp {
    const u64* ssq; bf16* U;
    struct Regs { float rs; };
    __device__ __forceinline__ void load(int row, int col0, Regs& r) const { r.rs = rsqrtf(ld_ssq(ssq + row) * (1.f / DM) + EPS); }
    __device__ __forceinline__ void apply(int row, int col0, const float (&a)[8], const Regs& r) const {
        float v[8];
#pragma unroll
        for (int j = 0; j < 8; ++j) { const float t = fmaxf(a[j] * r.rs, 0.f); v[j] = t * t; }
        *(u32x4*)(U + (size_t)row * DFF + col0) = pack8(v);
    }
};
struct EpiPleGate {
    const u64* ssq; const bf16* PE; float* X; bf16* XB; u64* ssq_next;
    struct Regs { float rs; f32x4 x0, x1; u32x4 pe; };
    __device__ __forceinline__ void load(int row, int col0, Regs& r) const { r.rs = rsqrtf(ld_ssq(ssq + row) * (1.f / DM) + EPS);
        r.x0 = *(const f32x4*)(X + (size_t)row * DM + col0); r.x1 = *(const f32x4*)(X + (size_t)row * DM + col0 + 4); r.pe = *(const u32x4*)(PE + (size_t)row * DM + col0); }
    __device__ __forceinline__ void apply(int row, int col0, const float (&a)[8], const Regs& r) const {
        float x[8] = {r.x0.x, r.x0.y, r.x0.z, r.x0.w, r.x1.x, r.x1.y, r.x1.z, r.x1.w}, pe[8]; unpack8(r.pe, pe);
#pragma unroll
        for (int j = 0; j < 8; ++j) x[j] += pe[j] * sigmoidf_(a[j] * r.rs);
        st_f32x8(X + (size_t)row * DM + col0, x);
        *(u32x4*)(XB + (size_t)row * DM + col0) = pack8(x);
        if (ssq_next) ssq_add(ssq_next, row, x);
    }
};

__device__ __forceinline__ void transpose_item(const float* W, int K, int Nsrc, int nsrc0, const float* gain, bf16* WT, int ndst0, int k0, LAS float* scr, int lane) {
#pragma unroll 8
    for (int i = 0; i < 32; ++i) { const int kk = 2 * i + (lane >> 5);
        float w = 0.f; if (nsrc0 >= 0) { w = W[(size_t)(k0 + kk) * Nsrc + nsrc0 + (lane & 31)]; if (gain) w *= gain[k0 + kk]; }
        scr[kk * 33 + (lane & 31)] = w; }
    LDS_WAIT(); asm volatile("" ::: "memory");
    const int c = lane & 7;
#pragma unroll
    for (int j = 0; j < 4; ++j) { const int n = (lane >> 3) + 8 * j; const LAS float* s = scr + (8 * c) * 33 + n;
        u32x4 o; o.x = pk2(s[0 * 33], s[1 * 33]); o.y = pk2(s[2 * 33], s[3 * 33]); o.z = pk2(s[4 * 33], s[5 * 33]); o.w = pk2(s[6 * 33], s[7 * 33]);
        *(u32x4*)(WT + (size_t)(ndst0 + n) * K + k0 + 8 * c) = o; }
    LDS_WAIT(); asm volatile("" ::: "memory");
}
__host__ __device__ __forceinline__ int inproj_src_col(int n) {
    if (n < PC_Z) return n;
    if (n < PC_G) return n + 64;
    if (n < PC_KR) return n + 128;
    if (n < PC_DT) return n - PC_KR + 1024;
    if (n < PC_PAD) return n - PC_DT + 11328;
    return -1;
}
constexpr int I_IN = (DM / 64) * (DINP / 32), I_UQ = (QL / 64) * (NH * QK / 32), I_UKV = (KVL / 64) * (NH * 256 / 32), I_OM = (DM / 64) * (DM / 32), I_OS = (DI / 64) * (DM / 32),
              I_OUT = I_OM, I_UP = (DM / 64) * (DFF / 32), I_DN = (DFF / 64) * (DM / 32), I_PG = I_OM, I_PL = (PLE / 64) * (DM / 32),
              I_LAYER = I_IN + I_UQ + I_UKV + I_OM + I_OS + I_OUT + I_UP + I_DN + I_PG + I_PL;
__device__ __forceinline__ void prologue_weights(const float* const (&inp)[26], unsigned char* ws, LAS unsigned char* lds, int G, int wg) {
    const int wave = otid() >> 6, lane = otid() & 63;
    LAS float* scr = (LAS float*)(lds + RING_OFF + wave * 16384);
    for (int it = wg * NWAVES + wave; it < DEPTH * I_LAYER; it += G * NWAVES) {
        const int l = it / I_LAYER; int r = it % I_LAYER;
        unsigned char* wl = ws + WS_W + (size_t)l * WL_BYTES;
        if (r < I_IN) { const int nblk = DINP / 32, kb = r / nblk, nb = r % nblk;
            transpose_item(inp[4] + (size_t)l * DM * DIN, DM, DIN, inproj_src_col(32 * nb), inp[3] + l * DM, (bf16*)(wl + WL_IN), 32 * nb, 64 * kb, scr, lane); continue; } r -= I_IN;
        if (r < I_UQ) { const int nblk = NH * QK / 32, kb = r / nblk, nb = r % nblk;
            transpose_item(inp[6] + (size_t)l * QL * NH * QK, QL, NH * QK, 32 * nb, inp[5] + l * QL, (bf16*)(wl + WL_UQ), 32 * nb, 64 * kb, scr, lane); continue; } r -= I_UQ;
        if (r < I_UKV) { const int nblk = NH * 256 / 32, kb = r / nblk, nb = r % nblk;
            transpose_item(inp[8] + (size_t)l * KVL * NH * 256, KVL, NH * 256, 32 * nb, inp[7] + l * KVL, (bf16*)(wl + WL_UKV), 32 * nb, 64 * kb, scr, lane); continue; } r -= I_UKV;
        if (r < I_OM) { const int nblk = DM / 32, kb = r / nblk, nb = r % nblk;
            transpose_item(inp[11] + (size_t)l * DM * DM, DM, DM, 32 * nb, nullptr, (bf16*)(wl + WL_OM), 32 * nb, 64 * kb, scr, lane); continue; } r -= I_OM;
        if (r < I_OS) { const int nblk = DM / 32, kb = r / nblk, nb = r % nblk;
            transpose_item(inp[18] + (size_t)l * DI * DM, DI, DM, 32 * nb, inp[17] + l * DI, (bf16*)(wl + WL_OS), 32 * nb, 64 * kb, scr, lane); continue; } r -= I_OS;
        if (r < I_OUT) { const int nblk = DM / 32, kb = r / nblk, nb = r % nblk;
            transpose_item(inp[19] + (size_t)l * DM * DM, DM, DM, 32 * nb, nullptr, (bf16*)(wl + WL_OUT), 32 * nb, 64 * kb, scr, lane); continue; } r -= I_OUT;
        if (r < I_UP) { const int nblk = DFF / 32, kb = r / nblk, nb = r % nblk;
            transpose_item(inp[21] + (size_t)l * DM * DFF, DM, DFF, 32 * nb, inp[20] + l * DM, (bf16*)(wl + WL_UP), 32 * nb, 64 * kb, scr, lane); continue; } r -= I_UP;
        if (r < I_DN) { const int nblk = DM / 32, kb = r / nblk, nb = r % nblk;
            transpose_item(inp[22] + (size_t)l * DFF * DM, DFF, DM, 32 * nb, nullptr, (bf16*)(wl + WL_DN), 32 * nb, 64 * kb, scr, lane); continue; } r -= I_DN;
        if (r < I_PG) { const int nblk = DM / 32, kb = r / nblk, nb = r % nblk;
            transpose_item(inp[24] + (size_t)l * DM * DM, DM, DM, 32 * nb, inp[23] + l * DM, (bf16*)(wl + WL_PG), 32 * nb, 64 * kb, scr, lane); continue; } r -= I_PG;
        { const int nblk = DM / 32, kb = r / nblk, nb = r % nblk;
            transpose_item(inp[25] + (size_t)l * PLE * DM, PLE, DM, 32 * nb, nullptr, (bf16*)(wl + WL_PL), 32 * nb, 64 * kb, scr, lane); }
    }
}
__device__ __forceinline__ void prologue_rows(const float* const (&inp)[26], float* out, unsigned char* ws, int G, int wg) {
    const int wave = otid() >> 6, lane = otid() & 63, gw = wg * NWAVES + wave, NGW = G * NWAVES;
    const float* x = inp[0]; bf16* XB = (bf16*)(ws + WS_XB); u64* ssq0 = (u64*)((unsigned*)(ws + WS_CTL) + CW_SSQX);
    for (int m = gw; m < M; m += NGW) {
        float s = 0.f;
#pragma unroll
        for (int j = 0; j < 8; ++j) { const f32x4 v = *(const f32x4*)(x + (size_t)m * DM + j * 256 + lane * 4);
            *(f32x4*)(out + (size_t)m * DM + j * 256 + lane * 4) = v; s += v.x * v.x + v.y * v.y + v.z * v.z + v.w * v.w;
            u32x2 o; o.x = pk2(v.x, v.y); o.y = pk2(v.z, v.w); *(u32x2*)(XB + (size_t)m * DM + j * 256 + lane * 4) = o; }
        s = wave_sum(s); if (lane == 0) ssq0[m] = (u64)(s * SSQ_SCALE);
    }
    {
        u64* z0 = (u64*)((unsigned*)(ws + WS_CTL) + CW_SSQX) + M; const int nz = (DEPTH * 3 - 1) * M + DEPTH * 2 * M;
        for (int i = wg * NTHR + otid(); i < nz; i += G * NTHR) z0[i] = 0ull;
    }
    const float* p = inp[1]; bf16* PB = (bf16*)(ws + WS_PB);
    for (size_t i = (size_t)wg * NTHR + otid(); i < (size_t)DEPTH * M * PLE / 8; i += (size_t)G * NTHR) { float v[8]; ld_f32x8(p + i * 8, v); *(u32x4*)(PB + i * 8) = pack8(v); }
    const int* pos = (const int*)inp[2]; float* COS = (float*)(ws + WS_COS); float* SIN = (float*)(ws + WS_SIN);
    for (int i = wg * NTHR + otid(); i < M * 32; i += G * NTHR) { const int m = i >> 5, k = i & 31;
        const float invf = 1.0f / (float)pow(10000.0, (double)k / 32.0);
        const float ang = (float)pos[m] * invf;
        COS[i] = (float)cos((double)ang); SIN[i] = (float)sin((double)ang); }
}

__device__ __forceinline__ void phase_kfin(const bf16* KVRAW, const float* MISC, const float* kw, const float* COS, const float* SIN, bf16* KF, int G, int wg) {
    const int wave = otid() >> 6, lane = otid() & 63;
    const float w0 = kw[lane], w1 = kw[64 + lane], w2 = kw[128 + lane];
    for (int it = wg * NWAVES + wave; it < M * NH; it += G * NWAVES) {
        const int m = it >> 4, h = it & 15;
        const float a0 = bf2f(KVRAW[(size_t)m * 4096 + h * 256 + lane]), a1 = bf2f(KVRAW[(size_t)m * 4096 + h * 256 + 64 + lane]), a2 = MISC[(size_t)m * 128 + lane];
        const float ss = wave_sum(a0 * a0 + a1 * a1 + a2 * a2), rs = rsqrtf(ss * (1.f / QK) + EPS);
        const float t2 = a2 * rs * w2, o2 = __shfl_xor(t2, 32);
        const float c = COS[m * 32 + (lane & 31)], s = SIN[m * 32 + (lane & 31)];
        const float r2 = lane < 32 ? (t2 * c - o2 * s) : (o2 * s + t2 * c);
        bf16* o = KF + (size_t)m * (NH * QK) + h * QK;
        o[lane] = (bf16)f2bf(a0 * rs * w0); o[64 + lane] = (bf16)f2bf(a1 * rs * w1); o[128 + lane] = (bf16)f2bf(r2);
    }
}
__device__ __forceinline__ void phase_ssdpre(const bf16* PROJ, const float* MISC, const float* cw, const float* cb, const float* dtb, bf16* XC, float* DTS, int G, int wg) {
    for (int i = wg * NTHR + otid(); i < M * (CONVD / 8); i += G * NTHR) {
        const int m = i / (CONVD / 8), c0 = (i % (CONVD / 8)) * 8, t = m % SEQ;
        float acc[8]; ld_f32x8(cb + c0, acc);
#pragma unroll
        for (int j = 0; j < CW; ++j) { const int tt = t - (CW - 1) + j;
            if (tt >= 0) { float xv[8], wv[8]; ld_bf16x8(PROJ + (size_t)(m - (CW - 1) + j) * DINP + PC_XBC + c0, xv); ld_f32x8(cw + j * CONVD + c0, wv);
#pragma unroll
                for (int e = 0; e < 8; ++e) acc[e] += xv[e] * wv[e]; } }
#pragma unroll
        for (int e = 0; e < 8; ++e) acc[e] = siluf_(acc[e]);
        *(u32x4*)(XC + (size_t)m * CONVD + c0) = pack8(acc);
    }
    for (int i = wg * NTHR + otid(); i < M * SH; i += G * NTHR) { const int m = i >> 6, h = i & 63;
        const float x = MISC[(size_t)m * 128 + 64 + h] + dtb[h]; DTS[i] = x > 20.f ? x : log1pf(__expf(x)); }
}
__device__ __forceinline__ void phase_ssdnorm(const float* YPRE, const bf16* PROJ, bf16* Y, int G, int wg) {
    const int wave = otid() >> 6, lane = otid() & 63;
    for (int it = wg * NWAVES + wave; it < M * SG; it += G * NWAVES) {
        const int m = it >> 3, g = it & 7, c0 = g * 512 + lane * 8;
        float y[8], z[8]; ld_f32x8(YPRE + (size_t)m * DI + c0, y); ld_bf16x8(PROJ + (size_t)m * DINP + PC_Z + c0, z);
        float s = 0.f;
#pragma unroll
        for (int e = 0; e < 8; ++e) { y[e] *= siluf_(z[e]); s += y[e] * y[e]; }
        const float rs = rsqrtf(wave_sum(s) * (1.f / 512.f) + EPS);
#pragma unroll
        for (int e = 0; e < 8; ++e) y[e] *= rs;
        *(u32x4*)(Y + (size_t)m * DI + c0) = pack8(y);
    }
}

__device__ __forceinline__ void phase_attn_simple(const bf16* QRAW, const bf16* KF, const bf16* KVRAW, const float* qw, const float* COS, const float* SIN, bf16* AO, LAS unsigned char* lds, int G, int wg) {
    const int wave = otid() >> 6, lane = otid() & 63;
    LAS float* sc = (LAS float*)(lds + RING_OFF + wave * 16384);
    LAS float* qs = (LAS float*)(lds + EXTRA_OFF + wave * 768);
    const float w0 = qw[lane], w1 = qw[64 + lane], w2 = qw[128 + lane];
    for (int it = wg * NWAVES + wave; it < NB * NH * SEQ; it += G * NWAVES) {
        const int t = it % SEQ, bh = it / SEQ, h = bh % NH, b = bh / NH, m = b * SEQ + t;
        const bf16* qp = QRAW + (size_t)m * (NH * QK) + h * QK;
        const float a0 = bf2f(qp[lane]), a1 = bf2f(qp[64 + lane]), a2 = bf2f(qp[128 + lane]);
        const float ss = wave_sum(a0 * a0 + a1 * a1 + a2 * a2), rs = rsqrtf(ss * (1.f / QK) + EPS);
        const float t2 = a2 * rs * w2, o2 = __shfl_xor(t2, 32);
        const float c = COS[m * 32 + (lane & 31)], s = SIN[m * 32 + (lane & 31)];
        const float r2 = lane < 32 ? (t2 * c - o2 * s) : (o2 * s + t2 * c);
        const float scale = 0.07216878364870322f;
        qs[lane] = a0 * rs * w0 * scale; qs[64 + lane] = a1 * rs * w1 * scale; qs[128 + lane] = r2 * scale;
        LDS_WAIT();
        const int nk = (t / TC + 1) * TC;
        float mx = -3.0e38f;
        for (int j = lane; j < nk; j += 64) {
            const bf16* kp = KF + (size_t)(b * SEQ + j) * (NH * QK) + h * QK;
            float acc = 0.f;
#pragma unroll 4
            for (int d = 0; d < QK; d += 8) { float kv[8]; ld_bf16x8(kp + d, kv);
#pragma unroll
                for (int e = 0; e < 8; ++e) acc += qs[d + e] * kv[e]; }
            sc[j] = acc; mx = fmaxf(mx, acc);
        }
        mx = wave_max(mx);
        LDS_WAIT();
        float l = 0.f;
        for (int j = lane; j < nk; j += 64) { const float p = __expf(sc[j] - mx); sc[j] = p; l += p; }
        l = wave_sum(l);
        LDS_WAIT();
        float o0 = 0.f, o1 = 0.f;
        const bf16* vp = KVRAW + (size_t)(b * SEQ) * 4096 + h * 256 + 128;
#pragma unroll 8
        for (int j = 0; j < nk; ++j) { const float p = sc[j]; o0 += p * bf2f(vp[(size_t)j * 4096 + lane]); o1 += p * bf2f(vp[(size_t)j * 4096 + 64 + lane]); }
        const float il = 1.f / l;
        AO[(size_t)m * DM + h * VD + lane] = (bf16)f2bf(o0 * il); AO[(size_t)m * DM + h * VD + 64 + lane] = (bf16)f2bf(o1 * il);
        LDS_WAIT();
    }
}
__device__ __forceinline__ float wave_scan(float v, int lane) {
#pragma unroll
    for (int o = 1; o < 64; o <<= 1) { const float n = __shfl_up(v, o); if (lane >= o) v += n; }
    return v;
}
__device__ __forceinline__ void phase_ssd_states(const bf16* XC, const float* DTS, const float* a_log, float* ST, float* CDEC, LAS unsigned char* lds, int G, int wg) {
    LAS float* wsh = (LAS float*)(lds + RING_OFF);
    const int tid = otid();
    for (int it = wg; it < NB * NCH * SH; it += G) {
        const int h = it % SH, bc = it / SH, m0 = bc * TC, g = h / HPG;
        __syncthreads();
        if (tid < 64) { const float A = -__expf(a_log[h]), dt = DTS[(size_t)(m0 + tid) * SH + h];
            const float ac = wave_scan(dt * A, tid), last = __shfl(ac, 63);
            wsh[tid] = __expf(last - ac) * dt; if (tid == 63) CDEC[bc * SH + h] = __expf(last); }
        __syncthreads();
        const int p = tid >> 3, n0 = (tid & 7) * 16;
        float acc[16];
#pragma unroll
        for (int e = 0; e < 16; ++e) acc[e] = 0.f;
        for (int s = 0; s < TC; ++s) {
            const float xw = bf2f(XC[(size_t)(m0 + s) * CONVD + h * HD + p]) * wsh[s];
            float b0[8], b1[8]; ld_bf16x8(XC + (size_t)(m0 + s) * CONVD + DI + g * SN + n0, b0); ld_bf16x8(XC + (size_t)(m0 + s) * CONVD + DI + g * SN + n0 + 8, b1);
#pragma unroll
            for (int e = 0; e < 8; ++e) { acc[e] += xw * b0[e]; acc[8 + e] += xw * b1[e]; }
        }
        float* o = ST + (((size_t)bc * SH + h) * HD + p) * SN + n0;
#pragma unroll
        for (int e = 0; e < 16; e += 4) *(f32x4*)(o + e) = (f32x4){acc[e], acc[e + 1], acc[e + 2], acc[e + 3]};
    }
}
__device__ __forceinline__ void phase_ssd_scan(float* ST, const float* CDEC, int G, int wg) {
    constexpr int PER_B = SH * HD * SN;
    for (int e = wg * NTHR + otid(); e < NB * PER_B; e += G * NTHR) {
        const int b = e / PER_B, r = e % PER_B, h = r / (HD * SN);
        float state = 0.f;
        for (int c = 0; c < NCH; ++c) { const size_t idx = (size_t)(b * NCH + c) * PER_B + r; const float tmp = ST[idx]; ST[idx] = state; state = state * CDEC[(b * NCH + c) * SH + h] + tmp; }
    }
}
__device__ __forceinline__ void phase_ssd_out(const bf16* XC, const float* DTS, const float* a_log, const float* dskip, const float* ST, float* YPRE, LAS unsigned char* lds, int G, int wg) {
    LAS float* Mm = (LAS float*)(lds + RING_OFF);
    LAS float* acs = (LAS float*)(lds + RING_OFF + 20480);
    LAS float* dts = acs + 64;
    const int tid = otid();
    for (int it = wg; it < NB * NCH * SH; it += G) {
        const int h = it % SH, bc = it / SH, m0 = bc * TC, g = h / HPG;
        __syncthreads();
        if (tid < 64) { const float A = -__expf(a_log[h]), dt = DTS[(size_t)(m0 + tid) * SH + h]; acs[tid] = wave_scan(dt * A, tid); dts[tid] = dt; }
        __syncthreads();
        for (int i = 0; i < 8; ++i) { const int e = tid + NTHR * i, t = e >> 6, s = e & 63;
            float v = 0.f;
            if (s <= t) { const bf16* cp = XC + (size_t)(m0 + t) * CONVD + DI + SG * SN + g * SN; const bf16* bp = XC + (size_t)(m0 + s) * CONVD + DI + g * SN;
                float dot = 0.f;
#pragma unroll 4
                for (int n = 0; n < SN; n += 8) { float cv[8], bv[8]; ld_bf16x8(cp + n, cv); ld_bf16x8(bp + n, bv);
#pragma unroll
                    for (int q = 0; q < 8; ++q) dot += cv[q] * bv[q]; }
                v = dot * __expf(acs[t] - acs[s]) * dts[s]; }
            Mm[t * 65 + s] = v; }
        __syncthreads();
        const int t = tid >> 3, p0 = (tid & 7) * 8;
        float y[8];
#pragma unroll
        for (int j = 0; j < 8; ++j) y[j] = 0.f;
        for (int s = 0; s < TC; ++s) { float xv[8]; ld_bf16x8(XC + (size_t)(m0 + s) * CONVD + h * HD + p0, xv); const float mv = Mm[t * 65 + s];
#pragma unroll
            for (int j = 0; j < 8; ++j) y[j] += mv * xv[j]; }
        const float ea = __expf(acs[t]), dk = dskip[h];
        const bf16* cp = XC + (size_t)(m0 + t) * CONVD + DI + SG * SN + g * SN;
        float xt[8]; ld_bf16x8(XC + (size_t)(m0 + t) * CONVD + h * HD + p0, xt);
#pragma unroll
        for (int j = 0; j < 8; ++j) { const float* pp = ST + (((size_t)bc * SH + h) * HD + p0 + j) * SN;
            float dot = 0.f;
#pragma unroll 4
            for (int n = 0; n < SN; n += 8) { float cv[8], pv[8]; ld_bf16x8(cp + n, cv); ld_f32x8(pp + n, pv);
#pragma unroll
                for (int q = 0; q < 8; ++q) dot += cv[q] * pv[q]; }
            y[j] += ea * dot + dk * xt[j]; }
        st_f32x8(YPRE + (size_t)(m0 + t) * DI + h * HD + p0, y);
    }
}

#ifndef ATTN_REPEAT
#define ATTN_REPEAT 1
#endif
#ifndef SLOW4
#define SLOW4 1
#endif
constexpr int PPL = 14, NPH = 1 + DEPTH * PPL;
struct Args { const float* in[26]; float* out; unsigned char* ws; int ph_lo, ph_hi; };
__global__ void __launch_bounds__(NTHR, 2) fwd(Args args) {
    extern __shared__ __attribute__((aligned(16))) unsigned char lds_[];
    LAS unsigned char* lds = (LAS unsigned char*)lds_;
    const int tid = threadIdx.x, G = gridDim.x, wg = blockIdx.x;
    for (int u = tid; u < (LDS_BYTES - LDSCTL_OFF) / 4; u += NTHR) ((LAS unsigned*)(lds + LDSCTL_OFF))[u] = 0u;
    __syncthreads();
    unsigned char* const ws0 = args.ws;
    unsigned* const ctl0 = (unsigned*)(ws0 + WS_CTL);
    const int lo = args.ph_lo, hi = args.ph_hi;
    XcdBarrier bar; bar.bar = ctl0 + CW_BAR; bar.x = 0; bar.st = (volatile LAS unsigned*)(lds + MISC_OFF) + 8;
    if (hi - lo > 1) bar = xcd_barrier_post(ctl0 + CW_BAR, (volatile LAS unsigned*)(lds + MISC_OFF) + 8);
#define INP(i) (args.in[i])
#define WSP(T, off) ((T*)(ws + (off)))
#define X (args.out)
#define SSQX ((u64*)(ctl + CW_SSQX))
#define SSQC ((u64*)(ctl + CW_SSQC))
#define XB0 WSP(bf16, WS_XB)
#define XB1 WSP(bf16, WS_XB1)
#define XB2 WSP(bf16, WS_XB2)
#define PROJ WSP(bf16, WS_PROJ)
#define U WSP(bf16, WS_U)
#define MISC WSP(float, WS_MISC)
#define QRAW WSP(bf16, WS_QRAW)
#define KVRAW WSP(bf16, WS_KVRAW)
#define KF WSP(bf16, WS_KF)
#define AO WSP(bf16, WS_AO)
#define XC WSP(bf16, WS_XC)
#define DTS WSP(float, WS_DTS)
#define CDEC WSP(float, WS_CDEC)
#define ST WSP(float, WS_ST)
#define YPRE WSP(float, WS_YPRE)
#define Y WSP(bf16, WS_Y)
#define TMPF WSP(float, WS_TMPF)
#define MERGED WSP(bf16, WS_MERGED)
#define PE WSP(bf16, WS_PE)
#define PB WSP(bf16, WS_PB)
#define COS WSP(float, WS_COS)
#define SIN WSP(float, WS_SIN)
    int ph = 0;
#define PHASE(...) do { if (lo <= ph && ph < hi) { { unsigned char* ws = ws0; asm volatile("" : "+s"(ws)); unsigned* ctl = (unsigned*)(ws + WS_CTL); __VA_ARGS__; } if (ph + 1 < hi) xcd_barrier(bar); } ++ph; } while (0)

    PHASE({ prologue_weights(args.in, ws, lds, G, wg); prologue_rows(args.in, X, ws, G, wg); });

#pragma unroll 1
    for (int l = 0; l < DEPTH; ++l) {
#define wl (ws + WS_W + (size_t)l * WL_BYTES)
#define ssq0 (SSQX + (size_t)(l * 3 + 0) * M)
#define ssq1 (SSQX + (size_t)(l * 3 + 1) * M)
#define ssq2 (SSQX + (size_t)(l * 3 + 2) * M)
#define ssqn ((l + 1 < DEPTH) ? SSQX + (size_t)((l + 1) * 3) * M : (u64*)nullptr)
#define ssqc (SSQC + (size_t)l * 2 * M)
        PHASE({ pg8::Gemm g{XB0, (const bf16*)(wl + WL_IN), M, DINP, DM, DM}; EpiInProj E{ssq0, ssqc, PROJ, MISC}; run_gemm(lds, g, E, G, wg, SLOW4); });
        PHASE({ { pg8::Gemm g{PROJ + PC_CQ, (const bf16*)(wl + WL_UQ), M, NH * QK, QL, DINP}; EpiScaleBf16 E{ssqc, 1.f / QL, QRAW, NH * QK}; run_gemm(lds, g, E, G, wg, GEMM_REPEAT); }
                { pg8::Gemm g{PROJ + PC_CKV, (const bf16*)(wl + WL_UKV), M, NH * 256, KVL, DINP}; EpiScaleBf16 E{ssqc + M, 1.f / KVL, KVRAW, NH * 256}; run_gemm(lds, g, E, G, wg, GEMM_REPEAT); }
                { pg8::Gemm g{PB + (size_t)l * M * PLE, (const bf16*)(wl + WL_PL), M, DM, PLE, PLE}; EpiScaleBf16 E{nullptr, 0.f, PE, DM}; run_gemm(lds, g, E, G, wg, GEMM_REPEAT); } });
        PHASE({ phase_kfin(KVRAW, MISC, INP(10) + l * QK, COS, SIN, KF, G, wg);
                phase_ssdpre(PROJ, MISC, INP(12) + (size_t)l * CW * CONVD, INP(13) + (size_t)l * CONVD, INP(14) + l * SH, XC, DTS, G, wg); });
        PHASE({ for (int rr = 0; rr < ATTN_REPEAT; ++rr) phase_attn_simple(QRAW, KF, KVRAW, INP(9) + l * QK, COS, SIN, AO, lds, G, wg); });
        PHASE({ phase_ssd_states(XC, DTS, INP(15) + l * SH, ST, CDEC, lds, G, wg); });
        PHASE({ phase_ssd_scan(ST, CDEC, G, wg); });
        PHASE({ phase_ssd_out(XC, DTS, INP(15) + l * SH, INP(16) + l * SH, ST, YPRE, lds, G, wg); });
        PHASE({ phase_ssdnorm(YPRE, PROJ, Y, G, wg); });
        PHASE({ pg8::Gemm g{AO, (const bf16*)(wl + WL_OM), M, DM, DM, DM}; EpiGateF32 E{PROJ, TMPF}; run_gemm(lds, g, E, G, wg, GEMM_REPEAT); });
        PHASE({ pg8::Gemm g{Y, (const bf16*)(wl + WL_OS), M, DM, DI, DI}; EpiMerge E{PROJ, TMPF, MERGED}; run_gemm(lds, g, E, G, wg, GEMM_REPEAT); });
        PHASE({ pg8::Gemm g{MERGED, (const bf16*)(wl + WL_OUT), M, DM, DM, DM}; EpiResid E{X, XB1, ssq1}; run_gemm(lds, g, E, G, wg, SLOW4); });
        PHASE({ pg8::Gemm g{XB1, (const bf16*)(wl + WL_UP), M, DFF, DM, DM}; EpiUp E{ssq1, U}; run_gemm(lds, g, E, G, wg, GEMM_REPEAT); });
        PHASE({ pg8::Gemm g{U, (const bf16*)(wl + WL_DN), M, DM, DFF, DFF}; EpiResid E{X, XB2, ssq2}; run_gemm(lds, g, E, G, wg, SLOW4); });
        PHASE({ pg8::Gemm g{XB2, (const bf16*)(wl + WL_PG), M, DM, DM, DM};  EpiPleGate E{ssq2, PE, X, XB0, ssqn}; run_gemm(lds, g, E, G, wg, SLOW4); });
    }
#undef PHASE
}

extern "C" void kernel_launch(void* const* d_in, const int* in_sizes, int n_in, void* d_out, int out_size, void* d_ws, size_t ws_size, hipStream_t stream) {
    static int grid = 0;
    if (grid == 0) {
        if (n_in != 26 || out_size != M * DM || ws_size < WS_END) { fprintf(stderr, "kernel_launch: built for 26 inputs, out %d floats, >= %zu bytes of workspace; got n_in %d out %d ws %zu\n", M * DM, (size_t)WS_END, n_in, out_size, ws_size); grid = -1; return; }
        int dev = 0, cus = 0;
        if (hipGetDevice(&dev) != hipSuccess || hipDeviceGetAttribute(&cus, hipDeviceAttributeMultiprocessorCount, dev) != hipSuccess) { grid = -1; return; }
        if (hipFuncSetAttribute((const void*)fwd, hipFuncAttributeMaxDynamicSharedMemorySize, LDS_BYTES) != hipSuccess) { fprintf(stderr, "kernel_launch: hipFuncSetAttribute failed\n"); grid = -1; return; }
        int per_cu = 0;
        if (hipOccupancyMaxActiveBlocksPerMultiprocessor(&per_cu, (const void*)fwd, NTHR, LDS_BYTES) != hipSuccess || per_cu < 1) fprintf(stderr, "kernel_launch: occupancy query says %d\n", per_cu);
        (void)hipGetLastError();
        grid = cus;
    }
    if (grid < 0) return;
    if (hipMemsetAsync((char*)d_ws + WS_CTL, 0, CTL_ZERO_BYTES, stream) != hipSuccess) return;
    Args a{};
    for (int i = 0; i < 26; ++i) a.in[i] = (const float*)d_in[i];
    a.out = (float*)d_out; a.ws = (unsigned char*)d_ws;
#if MK_ONE_LAUNCH
    a.ph_lo = 0; a.ph_hi = NPH;
    hipLaunchKernelGGL(fwd, dim3(grid), dim3(NTHR), LDS_BYTES, stream, a);
#else
#ifndef STOP_PH
#define STOP_PH NPH
#endif
    for (int ph = 0; ph < STOP_PH; ++ph) {
#ifdef SKIP_LO
        if (ph >= SKIP_LO && ph < SKIP_HI) continue;
#endif
        a.ph_lo = ph; a.ph_hi = ph + 1; hipLaunchKernelGGL(fwd, dim3(grid), dim3(NTHR), LDS_BYTES, stream, a); }
#endif
    const hipError_t le = hipPeekAtLastError();
    if (le != hipSuccess) fprintf(stderr, "kernel_launch: launch failed: %s\n", hipGetErrorName(le));
}
```

```cpp
#define FAST_GEMM 1
#define FAST_ATTN 1
#define MK_ONE_LAUNCH 1
#include <hip/hip_runtime.h>
#include <cstdio>
#include <cstdint>

#ifndef MK_ONE_LAUNCH
#define MK_ONE_LAUNCH 0
#endif
#ifndef FAST_ATTN
#define FAST_ATTN 0
#endif
#ifndef FAST_GEMM
#define FAST_GEMM 0
#endif

constexpr int NB = 2, SEQ = 4096, M = NB * SEQ, DM = 2048, DEPTH = 4, PLE = 256;
constexpr float EPS = 1e-6f;
constexpr int NH = 16, QL = 512, KVL = 512, NOPE = 128, ROPE = 64, VD = 128, QK = 192;
constexpr int DI = 4096, HD = 64, SH = 64, SG = 8, SN = 128, HPG = 8, CW = 4, CONVD = 6144, TC = 64, NCH = SEQ / TC;
constexpr int DFF = 8192;
constexpr int DIN = 15488;
constexpr int DINP = 15616;
constexpr int PC_CQ = 0, PC_CKV = 512, PC_Z = 1024, PC_XBC = 5120, PC_G = 11264, PC_KR = 15360, PC_DT = 15424, PC_PAD = 15488;
constexpr int NWAVES = 8, NTHR = 512;

typedef unsigned short bf16;
typedef unsigned u32x4 __attribute__((ext_vector_type(4)));
typedef unsigned u32x2 __attribute__((ext_vector_type(2)));
typedef float f32x4 __attribute__((ext_vector_type(4)));
typedef float f32x2 __attribute__((ext_vector_type(2)));
typedef short bf16x8 __attribute__((ext_vector_type(8)));
#define GAS __attribute__((address_space(1)))
#define LAS __attribute__((address_space(3)))
typedef GAS unsigned gu32;
#define RLX_AGENT __ATOMIC_RELAXED, __HIP_MEMORY_SCOPE_AGENT
#define LDS_WAIT() asm volatile("s_waitcnt lgkmcnt(0)" ::: "memory")
#define VM_WAIT() asm volatile("s_waitcnt vmcnt(0)" ::: "memory")

constexpr size_t MiB = 1u << 20;
constexpr size_t WS_CTL = 0, CTL_ZERO_BYTES = 2 * MiB;
constexpr int CW_TMO = 0, CW_CODE = 1, CW_BAR = 4096;
typedef unsigned long long u64;
constexpr int CW_SSQX = 16384;
constexpr int CW_SSQC = CW_SSQX + 2 * DEPTH * 3 * M;
static_assert((size_t)(CW_SSQC + 2 * DEPTH * 2 * M) * 4 <= CTL_ZERO_BYTES, "ctl");
constexpr size_t WL_IN = 0, WL_UQ = 61 * MiB, WL_UKV = 64 * MiB, WL_OM = 68 * MiB, WL_OS = 76 * MiB, WL_OUT = 92 * MiB, WL_UP = 100 * MiB, WL_DN = 132 * MiB, WL_PG = 164 * MiB, WL_PL = 172 * MiB, WL_BYTES = 173 * MiB;
static_assert((size_t)DINP * DM * 2 == 61 * MiB, "w_in copy");
constexpr size_t WS_W = 2 * MiB;
constexpr size_t WS_ACT = WS_W + DEPTH * WL_BYTES;
constexpr size_t WS_XB = WS_ACT;
constexpr size_t WS_XB1 = WS_XB + 32 * MiB, WS_XB2 = WS_XB1 + 32 * MiB;
constexpr size_t WS_PROJ = WS_XB2 + 32 * MiB;
constexpr size_t WS_U = WS_PROJ;
constexpr size_t WS_MISC = WS_PROJ + 244 * MiB;
constexpr size_t WS_QRAW = WS_MISC + 4 * MiB;
constexpr size_t WS_KVRAW = WS_QRAW + 48 * MiB;
constexpr size_t WS_KF = WS_KVRAW + 64 * MiB;
constexpr size_t WS_AO = WS_KF + 48 * MiB;
constexpr size_t WS_XC = WS_AO + 32 * MiB;
constexpr size_t WS_DTS = WS_XC + 96 * MiB;
constexpr size_t WS_CDEC = WS_DTS + 2 * MiB;
constexpr size_t WS_ST = WS_CDEC + 1 * MiB;
constexpr size_t WS_YPRE = WS_ST + 256 * MiB;
constexpr size_t WS_Y = WS_YPRE + 128 * MiB;
constexpr size_t WS_TMPF = WS_Y + 64 * MiB;
constexpr size_t WS_MERGED = WS_TMPF + 64 * MiB;
constexpr size_t WS_PE = WS_MERGED + 32 * MiB;
constexpr size_t WS_PB = WS_PE + 32 * MiB;
constexpr size_t WS_COS = WS_PB + 16 * MiB;
constexpr size_t WS_SIN = WS_COS + 1 * MiB;
constexpr size_t WS_END = WS_SIN + 1 * MiB;
static_assert(WS_END <= 1936 * MiB, "d_ws budget (4 x the largest input)");

constexpr int RING_OFF = 0, RING_BYTES = 131072;
constexpr int LDSCTL_OFF = RING_BYTES, MISC_OFF = LDSCTL_OFF + 320;
constexpr int EXTRA_OFF = LDSCTL_OFF + 512, LDS_BYTES = 147456, EXTRA_BYTES = LDS_BYTES - EXTRA_OFF;

__device__ __forceinline__ unsigned f2bf(float f) { unsigned u = __builtin_bit_cast(unsigned, f); return (u + 0x7fffu + ((u >> 16) & 1u)) >> 16; }
__device__ __forceinline__ float bf2f(unsigned h) { return __builtin_bit_cast(float, h << 16); }
typedef __bf16 bf16x2_t __attribute__((ext_vector_type(2)));
__device__ __forceinline__ unsigned pk2(float lo, float hi) { const f32x2 v = {lo, hi}; const bf16x2_t b = __builtin_convertvector(v, bf16x2_t); return __builtin_bit_cast(unsigned, b); }
__device__ __forceinline__ u32x4 pack8(const float (&v)[8]) { u32x4 w; w.x = pk2(v[0], v[1]); w.y = pk2(v[2], v[3]); w.z = pk2(v[4], v[5]); w.w = pk2(v[6], v[7]); return w; }
__device__ __forceinline__ void unpack8(u32x4 w, float (&v)[8]) {
    v[0] = bf2f(w.x & 0xffffu); v[1] = bf2f(w.x >> 16); v[2] = bf2f(w.y & 0xffffu); v[3] = bf2f(w.y >> 16);
    v[4] = bf2f(w.z & 0xffffu); v[5] = bf2f(w.z >> 16); v[6] = bf2f(w.w & 0xffffu); v[7] = bf2f(w.w >> 16); }
__device__ __forceinline__ float wave_sum(float v) {
#pragma unroll
    for (int o = 1; o < 64; o <<= 1) v += __shfl_xor(v, o);
    return v;
}
__device__ __forceinline__ float wave_max(float v) {
#pragma unroll
    for (int o = 1; o < 64; o <<= 1) v = fmaxf(v, __shfl_xor(v, o));
    return v;
}
__device__ __forceinline__ int otid() { int t = threadIdx.x; asm volatile("" : "+v"(t)); return t; }
__device__ __forceinline__ float sigmoidf_(float x) { return 1.f / (1.f + __expf(-x)); }
__device__ __forceinline__ float siluf_(float x) { return x / (1.f + __expf(-x)); }

#define XB_TMO      128
#define XB_XCNT(j)  (256  + 64 * (j))
#define XB_XSUB(j)  (1280 + 64 * (j))
#define XB_XGEN(j)  (2304 + 64 * (j))
#define XB_TOP      3328
#define XB_TOPGEN   3392
#define XCD_BAR_WORDS 3456
#define XB_SPIN_CAP (1u << 18)
__device__ __forceinline__ unsigned xb_ld(unsigned* p)              { return __hip_atomic_load(p, __ATOMIC_RELAXED, __HIP_MEMORY_SCOPE_AGENT); }
__device__ __forceinline__ unsigned xb_add(unsigned* p, unsigned v) { return __hip_atomic_fetch_add(p, v, __ATOMIC_RELAXED, __HIP_MEMORY_SCOPE_AGENT); }
__device__ __forceinline__ unsigned xb_xcc_id() { return (unsigned)__builtin_amdgcn_s_getreg((3 << 11) | 20) & 0xFu; }
#define XB_SPIN(cond, bar) do { unsigned _sp = 0; while (cond) { __builtin_amdgcn_s_sleep(1); \
    if ((++_sp & 255u) == 0u) { if (xb_ld(&(bar)[XB_TMO])) break; if (_sp > XB_SPIN_CAP) { atomicAdd(&(bar)[XB_TMO], 1u); break; } } } } while (0)
struct XcdBarrier { unsigned* bar; unsigned x; volatile LAS unsigned* st; };
__device__ __forceinline__ XcdBarrier xcd_barrier_post(unsigned* bar, volatile LAS unsigned* st) {
    XcdBarrier b; b.bar = bar; b.x = xb_xcc_id(); b.st = st;
    if (threadIdx.x == 0) (void)xb_add(&bar[XB_XCNT(b.x)], 1u);
    return b;
}
__device__ __forceinline__ void xcd_barrier_complete(unsigned* bar, unsigned x, unsigned& nloc, unsigned& nx) {
    const unsigned G = gridDim.x * gridDim.y * gridDim.z;
    unsigned sum, cnt, mine, sp = 0u;
    for (;;) {
        sum = 0u; cnt = 0u; mine = 0u;
#pragma unroll
        for (unsigned j = 0; j < 16; ++j) { const unsigned c = xb_ld(&bar[XB_XCNT(j)]); sum += c; cnt += (c > 0u) ? 1u : 0u; mine = (j == x) ? c : mine; }
        if (sum == G) break;
        __builtin_amdgcn_s_sleep(1);
        if ((++sp & 255u) == 0u) { if (xb_ld(&bar[XB_TMO])) break; if (sp > XB_SPIN_CAP) { atomicAdd(&bar[XB_TMO], 1u); break; } }
    }
    nloc = mine > 0u ? mine : 1u; nx = cnt > 0u ? cnt : 1u;
}
__device__ __forceinline__ void xcd_barrier(const XcdBarrier& b) {
    asm volatile("s_waitcnt vmcnt(0)" ::: "memory");
    __syncthreads();
    if (threadIdx.x == 0) {
        unsigned* bar = b.bar;
        __builtin_amdgcn_s_waitcnt(0);
        unsigned nloc = b.st[0], nx = b.st[1];
        if (nloc == 0u) { xcd_barrier_complete(bar, b.x, nloc, nx); b.st[0] = nloc; b.st[1] = nx; }
        const unsigned old = xb_add(&bar[XB_XSUB(b.x)], 1u);
        const unsigned gen = old / nloc;
        if (old + 1u == (gen + 1u) * nloc) {
            __builtin_amdgcn_fence(__ATOMIC_RELEASE, "agent");
            asm volatile("s_waitcnt vmcnt(0)" ::: "memory");
            const unsigned og = xb_add(&bar[XB_TOP], 1u);
            const unsigned tg = og / nx;
            if (og + 1u == (tg + 1u) * nx) xb_add(&bar[XB_TOPGEN], 1u);
            else XB_SPIN(xb_ld(&bar[XB_TOPGEN]) == tg, bar);
            __builtin_amdgcn_fence(__ATOMIC_ACQUIRE, "agent");
            xb_add(&bar[XB_XGEN(b.x)], 1u);
            asm volatile("s_waitcnt vmcnt(0)" ::: "memory");
        } else {
            XB_SPIN(xb_ld(&bar[XB_XGEN(b.x)]) == gen, bar);
            __builtin_amdgcn_fence(__ATOMIC_ACQUIRE, "agent");
            asm volatile("s_waitcnt vmcnt(0)" ::: "memory");
        }
    }
    __syncthreads();
}

namespace pg8 {
typedef unsigned short bf16_t;
constexpr int BM = 256, BK = 64, HALF = 128, HTB = HALF * BK * 2, STAGE_BYTES = 8 * HTB, NXCD = 8, WGM = 8;
__host__ __device__ __forceinline__ int lds_byte(int r, int c) { const int st = (r >> 4) * 2 + (c >> 5), rr = r & 15, cc = c & 31, ob = rr * 64 + cc * 2; return st * 1024 + (ob ^ (((ob >> 9) & 1) << 5)); }
__host__ __device__ __forceinline__ void stage_rc(int b, int& R, int& C) { const int st = b / 1024, sb = b % 1024, swz = sb ^ (((sb >> 9) & 1) << 5); R = (st >> 1) * 16 + swz / 64; C = (st & 1) * 32 + (swz % 64) / 2; }
__host__ __device__ __forceinline__ int perm32(int rho) { const int n = rho >> 4, i = rho & 15; return 8 * (i >> 2) + 4 * n + (i & 3); }
struct Unit { int pm, pn; };
struct Gemm { const bf16_t* A; const bf16_t* Bt; int M, N, K, lda; };
struct StaticOrder {
    int nM, nN, nwg, G, c;
    __host__ __device__ void init(int M_, int N_, int G_, int c_) { nM = M_ / BM; nN = N_ / BM; nwg = nM * nN; G = G_; c = c_; }
    __host__ __device__ bool next(int i, Unit& u) const {
        const long L = (long)i * G + c; if (L >= nwg) return false;
        int wgid = (int)L; { const int q = nwg / NXCD, r = nwg % NXCD, xcd = wgid % NXCD, off = wgid / NXCD; wgid = (xcd < r ? xcd * (q + 1) : r * (q + 1) + (xcd - r) * q) + off; }
        const int nig = WGM * nN, gid = wgid / nig, fm = gid * WGM, gsz = (nM - fm) < WGM ? (nM - fm) : WGM;
        u.pm = fm + ((wgid % nig) % gsz); u.pn = (wgid % nig) / gsz; return true;
    }
    __device__ __forceinline__ void a_ready(const Unit&) const {}
    __device__ __forceinline__ void done(const Unit&) const {}
};

template <class Epi, class Sched>
__device__ __forceinline__ void gemm_phase(LAS unsigned char* lds, const Gemm g, const Sched& S, const Epi& E) {
    const int tid = otid(), wid = __builtin_amdgcn_readfirstlane(tid >> 6), lane = tid & 63, wr = wid >> 2, wc = wid & 3, fr = lane & 15, fq = lane >> 4;
    const int K = g.K, nt = K / BK, lda = g.lda;
    unsigned voffA[2], voffB[2];
#pragma unroll
    for (int i = 0; i < 2; ++i) { int R, C; stage_rc(tid * 16 + i * 8192, R, C); const int Rb = (R & ~31) + perm32(R & 31);
        voffA[i] = (unsigned)(R * lda + C) * 2u; voffB[i] = (unsigned)(Rb * K + C) * 2u; }
    const size_t kstep = (size_t)(BK * 2);
    const size_t hstepA = (size_t)HALF * lda * 2, hstepB = (size_t)HALF * K * 2;
    const size_t tstepA = 2 * hstepA, tstepB = 2 * hstepB;
    const unsigned ldsw = (unsigned)wid * 1024u;
    const int aoff = lds_byte(wr * 64 + fr, fq * 8), boff = lds_byte(wc * 32 + fr, fq * 8);
#define PG8_SA(b, h) (((b) * 2 + (h)) * HTB)
#define PG8_SB(b, h) ((4 + (b) * 2 + (h)) * HTB)
#define PG8_STAGE(bufoff, gbase, voff) do { _Pragma("unroll") for (int _i = 0; _i < 2; ++_i) \
        __builtin_amdgcn_global_load_lds((const unsigned*)((const char*)(gbase) + (voff)[_i]), (LAS unsigned*)(lds + (bufoff) + ldsw + _i * 8192), 16, 0, 0); } while (0)
#define PG8_LDA(dst, b, h) do { _Pragma("unroll") for (int m = 0; m < 4; ++m) _Pragma("unroll") for (int k = 0; k < 2; ++k) dst[m][k] = *(const LAS bf16x8*)(lds + PG8_SA(b, h) + aoff + m * 2048 + k * 1024); } while (0)
#define PG8_LDB(dst, b, h) do { _Pragma("unroll") for (int n = 0; n < 2; ++n) _Pragma("unroll") for (int k = 0; k < 2; ++k) dst[n][k] = *(const LAS bf16x8*)(lds + PG8_SB(b, h) + boff + n * 2048 + k * 1024); } while (0)
#define PG8_MMA(ai, bj, At, Bt) do { __builtin_amdgcn_s_setprio(1); _Pragma("unroll") for (int m = 0; m < 4; ++m) _Pragma("unroll") for (int n = 0; n < 2; ++n) _Pragma("unroll") for (int k = 0; k < 2; ++k) \
        acc[ai][bj][m][n] = __builtin_amdgcn_mfma_f32_16x16x32_bf16(Bt[n][k], At[m][k], acc[ai][bj][m][n], 0, 0, 0); __builtin_amdgcn_s_setprio(0); } while (0)
#define PG8_WAIT_V(n) asm volatile("s_waitcnt vmcnt(" #n ")" ::: "memory")
#define PG8_WAIT_L(n) asm volatile("s_waitcnt lgkmcnt(" #n ")" ::: "memory")
#define PG8_BAR __builtin_amdgcn_s_barrier()
#define PG8_SCHED __builtin_amdgcn_sched_barrier(0)
    Unit cur, nxt; int ui = 0;
    if (!S.next(0, cur)) return;
    f32x4 acc[2][2][4][2];
#pragma unroll
    for (int a = 0; a < 2; ++a)
#pragma unroll
        for (int b = 0; b < 2; ++b)
#pragma unroll
            for (int m = 0; m < 4; ++m)
#pragma unroll
                for (int n = 0; n < 2; ++n) acc[a][b][m][n] = (f32x4){0.f, 0.f, 0.f, 0.f};
    bf16x8 At[4][2], B0[2][2], B1[2][2];
    const char* cA = (const char*)g.A + (size_t)cur.pm * tstepA; const char* cB = (const char*)g.Bt + (size_t)cur.pn * tstepB;
    S.a_ready(cur);
    PG8_STAGE(PG8_SB(0, 0), cB, voffB); PG8_STAGE(PG8_SB(0, 1), cB + hstepB, voffB); PG8_STAGE(PG8_SA(0, 0), cA, voffA); PG8_STAGE(PG8_SA(0, 1), cA + hstepA, voffA);
    if (wr == 1) PG8_BAR;
    PG8_WAIT_V(2); PG8_BAR;
    PG8_STAGE(PG8_SB(1, 0), cB + kstep, voffB); PG8_STAGE(PG8_SA(1, 0), cA + kstep, voffA); PG8_STAGE(PG8_SB(1, 1), cB + hstepB + kstep, voffB);
    PG8_WAIT_V(6); PG8_BAR;
    for (;;) {
        const bool has_next = S.next(ui + 1, nxt);
        const char* nA = has_next ? (const char*)g.A + (size_t)nxt.pm * tstepA : cA; const char* nB = has_next ? (const char*)g.Bt + (size_t)nxt.pn * tstepB : cB;
        for (int t = 0; t < nt; t += 2) {
            const bool last = (t == nt - 2);
            const char* a1 = cA + (size_t)(t + 1) * kstep;
            const char* a2 = last ? nA : cA + (size_t)(t + 2) * kstep; const char* b2 = last ? nB : cB + (size_t)(t + 2) * kstep;
            const char* a3 = a2 + kstep; const char* b3 = b2 + kstep;
            if (last && has_next) S.a_ready(nxt);
            PG8_LDB(B0, 0, 0); PG8_LDB(B1, 0, 1); PG8_SCHED; PG8_LDA(At, 0, 0); PG8_STAGE(PG8_SA(1, 1), a1 + hstepA, voffA);
            PG8_WAIT_V(8); PG8_WAIT_L(0); PG8_BAR; PG8_MMA(0, 0, At, B0); PG8_MMA(0, 1, At, B1); PG8_BAR; PG8_SCHED;
            PG8_LDA(At, 0, 1); PG8_STAGE(PG8_SB(0, 0), b2, voffB); PG8_STAGE(PG8_SB(0, 1), b2 + hstepB, voffB); PG8_STAGE(PG8_SA(0, 0), a2, voffA);
            PG8_WAIT_V(8); PG8_WAIT_L(0); PG8_BAR; PG8_MMA(1, 0, At, B0); PG8_MMA(1, 1, At, B1); PG8_BAR; PG8_SCHED;
            PG8_LDB(B0, 1, 0); PG8_LDB(B1, 1, 1); PG8_SCHED; PG8_LDA(At, 1, 0); PG8_STAGE(PG8_SA(0, 1), a2 + hstepA, voffA);
            PG8_WAIT_V(8); PG8_WAIT_L(0); PG8_BAR; PG8_MMA(0, 0, At, B0); PG8_MMA(0, 1, At, B1); PG8_BAR; PG8_SCHED;
            PG8_LDA(At, 1, 1); PG8_STAGE(PG8_SB(1, 0), b3, voffB); PG8_STAGE(PG8_SB(1, 1), b3 + hstepB, voffB); PG8_STAGE(PG8_SA(1, 0), a3, voffA);
            PG8_WAIT_V(8); PG8_WAIT_L(0); PG8_BAR; PG8_MMA(1, 0, At, B0); PG8_MMA(1, 1, At, B1); PG8_BAR; PG8_SCHED;
        }
        if (wr == 0) PG8_BAR;
        {
            const int row0 = cur.pm * BM + wr * 64 + fr, col00 = cur.pn * BM + wc * 32 + 8 * fq;
            typename Epi::Regs RA[2], RB[2];
#define PG8_EL(R, gi) do { const int _r = row0 + ((gi) >> 2) * HALF + ((gi) & 3) * 16; E.load(_r, col00, R[0]); E.load(_r, col00 + HALF, R[1]); } while (0)
#define PG8_EA(R, gi) do { const int _r = row0 + ((gi) >> 2) * HALF + ((gi) & 3) * 16; _Pragma("unroll") for (int bj = 0; bj < 2; ++bj) { \
                const f32x4 _p = acc[(gi) >> 2][bj][(gi) & 3][0], _q = acc[(gi) >> 2][bj][(gi) & 3][1]; const float _v[8] = {_p[0], _p[1], _p[2], _p[3], _q[0], _q[1], _q[2], _q[3]}; \
                E.apply(_r, col00 + bj * HALF, _v, R[bj]); } } while (0)
            PG8_EL(RA, 0);
#pragma unroll
            for (int gi = 0; gi < 8; gi += 2) {
                PG8_EL(RB, gi + 1); PG8_SCHED; PG8_EA(RA, gi); PG8_SCHED;
                if (gi + 2 < 8) PG8_EL(RA, gi + 2);
                PG8_SCHED; PG8_EA(RB, gi + 1); PG8_SCHED;
            }
#undef PG8_EL
#undef PG8_EA
        }
        S.done(cur);
        if (!has_next) break;
#pragma unroll
        for (int a = 0; a < 2; ++a)
#pragma unroll
            for (int b = 0; b < 2; ++b)
#pragma unroll
                for (int m = 0; m < 4; ++m)
#pragma unroll
                    for (int n = 0; n < 2; ++n) acc[a][b][m][n] = (f32x4){0.f, 0.f, 0.f, 0.f};
        cur = nxt; cA = nA; cB = nB; ++ui;
        if (wr == 1) PG8_BAR;
    }
    PG8_WAIT_V(0);
    PG8_BAR;
#undef PG8_SA
#undef PG8_SB
#undef PG8_STAGE
#undef PG8_LDA
#undef PG8_LDB
#undef PG8_MMA
#undef PG8_WAIT_V
#undef PG8_WAIT_L
#undef PG8_BAR
#undef PG8_SCHED
}

template <class Epi>
__device__ __forceinline__ void gemm_simple(const Gemm g, const Epi& E, int G, int wg) {
    const int tid = otid(), wid = tid >> 6, lane = tid & 63, fr = lane & 15, fq = lane >> 4;
    const int nbn = g.N / 32, nblk = (g.M / 16) * nbn;
    for (int it = wg * NWAVES + wid; it < nblk; it += G * NWAVES) {
        const int m0 = (it / nbn) * 16, n0 = (it % nbn) * 32;
        f32x4 acc0 = {0.f, 0.f, 0.f, 0.f}, acc1 = {0.f, 0.f, 0.f, 0.f};
        const bf16_t* ap = g.A + (size_t)(m0 + fr) * g.lda + 8 * fq;
        const bf16_t* bp0 = g.Bt + (size_t)(n0 + perm32(fr)) * g.K + 8 * fq;
        const bf16_t* bp1 = g.Bt + (size_t)(n0 + perm32(16 + fr)) * g.K + 8 * fq;
        for (int k0 = 0; k0 < g.K; k0 += 32) {
            const bf16x8 a = *(const bf16x8*)(ap + k0), b0 = *(const bf16x8*)(bp0 + k0), b1 = *(const bf16x8*)(bp1 + k0);
            acc0 = __builtin_amdgcn_mfma_f32_16x16x32_bf16(b0, a, acc0, 0, 0, 0);
            acc1 = __builtin_amdgcn_mfma_f32_16x16x32_bf16(b1, a, acc1, 0, 0, 0);
        }
        const float v[8] = {acc0[0], acc0[1], acc0[2], acc0[3], acc1[0], acc1[1], acc1[2], acc1[3]};
        typename Epi::Regs rg; E.load(m0 + fr, n0 + 8 * fq, rg); E.apply(m0 + fr, n0 + 8 * fq, v, rg);
    }
}
}

#ifndef GEMM_REPEAT
#define GEMM_REPEAT 1
#endif
template <class Epi>
__device__ __forceinline__ void run_gemm(LAS unsigned char* lds, const pg8::Gemm g, const Epi& E, int G, int wg, int rep = 1) {
#if FAST_GEMM
    if (rep < 0) { pg8::gemm_simple<Epi>(g, E, G, wg); return; }
    for (int rr = 0; rr < rep; ++rr) { pg8::StaticOrder S; S.init(g.M, g.N, G, wg); pg8::gemm_phase<Epi, pg8::StaticOrder>(lds, g, S, E); }
#else
    pg8::gemm_simple<Epi>(g, E, G, wg);
#endif
}

constexpr float SSQ_SCALE = 16777216.f, SSQ_INV = 1.f / 16777216.f;
__device__ __forceinline__ void ssq_add(u64* dst, int row, const float (&v)[8]) {
    float s = 0.f;
#pragma unroll
    for (int j = 0; j < 8; ++j) s += v[j] * v[j];
    s += __shfl_xor(s, 16); s += __shfl_xor(s, 32);
    if ((otid() & 63) < 16) atomicAdd(dst + row, (u64)(s * SSQ_SCALE));
}
__device__ __forceinline__ float ld_ssq(const u64* p) { return (float)__hip_atomic_load(p, __ATOMIC_RELAXED, __HIP_MEMORY_SCOPE_AGENT) * SSQ_INV; }
__device__ __forceinline__ void st_f32x8(float* p, const float (&v)[8]) { *(f32x4*)p = (f32x4){v[0], v[1], v[2], v[3]}; *(f32x4*)(p + 4) = (f32x4){v[4], v[5], v[6], v[7]}; }
__device__ __forceinline__ void ld_f32x8(const float* p, float (&v)[8]) { const f32x4 a = *(const f32x4*)p, b = *(const f32x4*)(p + 4); v[0] = a.x; v[1] = a.y; v[2] = a.z; v[3] = a.w; v[4] = b.x; v[5] = b.y; v[6] = b.z; v[7] = b.w; }
__device__ __forceinline__ void ld_bf16x8(const bf16* p, float (&v)[8]) { unpack8(*(const u32x4*)p, v); }

struct EpiInProj {
    const u64* ssq; u64* ssqc; bf16* proj; float* misc;
    struct Regs { float rs; };
    __device__ __forceinline__ void load(int row, int col0, Regs& r) const { r.rs = rsqrtf(ld_ssq(ssq + row) * (1.f / DM) + EPS); }
    __device__ __forceinline__ void apply(int row, int col0, const float (&a)[8], const Regs& r) const {
        float v[8];
#pragma unroll
        for (int j = 0; j < 8; ++j) v[j] = a[j] * r.rs;
        const int tile = col0 >> 8;
        if (tile == 60) { const int c = col0 - PC_KR; if (c < 128) st_f32x8(misc + (size_t)row * 128 + c, v); return; }
        if (tile >= 44) {
#pragma unroll
            for (int j = 0; j < 8; ++j) v[j] = sigmoidf_(v[j]);
        }
        *(u32x4*)(proj + (size_t)row * DINP + col0) = pack8(v);
        if (tile < 4) ssq_add(ssqc + (size_t)(tile >> 1) * M, row, v);
    }
};
struct EpiScaleBf16 {
    const u64* ssq; float inv_n; bf16* O; int ldo;
    struct Regs { float rs; };
    __device__ __forceinline__ void load(int row, int col0, Regs& r) const { r.rs = ssq ? rsqrtf(ld_ssq(ssq + row) * inv_n + EPS) : 1.f; }
    __device__ __forceinline__ void apply(int row, int col0, const float (&a)[8], const Regs& r) const {
        float v[8];
#pragma unroll
        for (int j = 0; j < 8; ++j) v[j] = a[j] * r.rs;
        *(u32x4*)(O + (size_t)row * ldo + col0) = pack8(v);
    }
};
struct EpiGateF32 {
    const bf16* proj; float* T;
    struct Regs { u32x4 g; };
    __device__ __forceinline__ void load(int row, int col0, Regs& r) const { r.g = *(const u32x4*)(proj + (size_t)row * DINP + PC_G + col0); }
    __device__ __forceinline__ void apply(int row, int col0, const float (&a)[8], const Regs& r) const {
        float g[8], v[8]; unpack8(r.g, g);
#pragma unroll
        for (int j = 0; j < 8; ++j) v[j] = a[j] * g[j];
        st_f32x8(T + (size_t)row * DM + col0, v);
    }
};
struct EpiMerge {
    const bf16* proj; const float* T; bf16* O;
    struct Regs { u32x4 g; f32x4 t0, t1; };
    __device__ __forceinline__ void load(int row, int col0, Regs& r) const { r.g = *(const u32x4*)(proj + (size_t)row * DINP + PC_G + DM + col0);
        r.t0 = *(const f32x4*)(T + (size_t)row * DM + col0); r.t1 = *(const f32x4*)(T + (size_t)row * DM + col0 + 4); }
    __device__ __forceinline__ void apply(int row, int col0, const float (&a)[8], const Regs& r) const {
        float g[8], v[8]; unpack8(r.g, g);
        const float t[8] = {r.t0.x, r.t0.y, r.t0.z, r.t0.w, r.t1.x, r.t1.y, r.t1.z, r.t1.w};
#pragma unroll
        for (int j = 0; j < 8; ++j) v[j] = t[j] + a[j] * g[j];
        *(u32x4*)(O + (size_t)row * DM + col0) = pack8(v);
    }
};
struct EpiResid {
    float* X; bf16* XB; u64* ssq_next;
    struct Regs { f32x4 x0, x1; };
    __device__ __forceinline__ void load(int row, int col0, Regs& r) const { r.x0 = *(const f32x4*)(X + (size_t)row * DM + col0); r.x1 = *(const f32x4*)(X + (size_t)row * DM + col0 + 4); }
    __device__ __forceinline__ void apply(int row, int col0, const float (&a)[8], const Regs& r) const {
        float x[8] = {r.x0.x, r.x0.y, r.x0.z, r.x0.w, r.x1.x, r.x1.y, r.x1.z, r.x1.w};
#pragma unroll
        for (int j = 0; j < 8; ++j) x[j] += a[j];
        st_f32x8(X + (size_t)row * DM + col0, x);
        *(u32x4*)(XB + (size_t)row * DM + col0) = pack8(x);
        if (ssq_next) ssq_add(ssq_next, row, x);
    }
};
struct EpiUp {
    const u64* ssq; bf16* U;
    struct Regs { float rs; };
    __device__ __forceinline__ void load(int row, int col0, Regs& r) const { r.rs = rsqrtf(ld_ssq(ssq + row) * (1.f / DM) + EPS); }
    __device__ __forceinline__ void apply(int row, int col0, const float (&a)[8], const Regs& r) const {
        float v[8];
#pragma unroll
        for (int j = 0; j < 8; ++j) { const float t = fmaxf(a[j] * r.rs, 0.f); v[j] = t * t; }
        *(u32x4*)(U + (size_t)row * DFF + col0) = pack8(v);
    }
};
struct EpiPleGate {
    const u64* ssq; const bf16* PE; float* X; bf16* XB; u64* ssq_next;
    struct Regs { float rs; f32x4 x0, x1; u32x4 pe; };
    __device__ __forceinline__ void load(int row, int col0, Regs& r) const { r.rs = rsqrtf(ld_ssq(ssq + row) * (1.f / DM) + EPS);
        r.x0 = *(const f32x4*)(X + (size_t)row * DM + col0); r.x1 = *(const f32x4*)(X + (size_t)row * DM + col0 + 4); r.pe = *(const u32x4*)(PE + (size_t)row * DM + col0); }
    __device__ __forceinline__ void apply(int row, int col0, const float (&a)[8], const Regs& r) const {
        float x[8] = {r.x0.x, r.x0.y, r.x0.z, r.x0.w, r.x1.x, r.x1.y, r.x1.z, r.x1.w}, pe[8]; unpack8(r.pe, pe);
#pragma unroll
        for (int j = 0; j < 8; ++j) x[j] += pe[j] * sigmoidf_(a[j] * r.rs);
        st_f32x8(X + (size_t)row * DM + col0, x);
        *(u32x4*)(XB + (size_t)row * DM + col0) = pack8(x);
        if (ssq_next) ssq_add(ssq_next, row, x);
    }
};

__device__ __forceinline__ void transpose_item(const float* W, int K, int Nsrc, int nsrc0, const float* gain, bf16* WT, int ndst0, int k0, LAS float* scr, int lane) {
#pragma unroll 8
    for (int i = 0; i < 32; ++i) { const int kk = 2 * i + (lane >> 5);
        float w = 0.f; if (nsrc0 >= 0) { w = W[(size_t)(k0 + kk) * Nsrc + nsrc0 + (lane & 31)]; if (gain) w *= gain[k0 + kk]; }
        scr[kk * 33 + (lane & 31)] = w; }
    LDS_WAIT(); asm volatile("" ::: "memory");
    const int c = lane & 7;
#pragma unroll
    for (int j = 0; j < 4; ++j) { const int n = (lane >> 3) + 8 * j; const LAS float* s = scr + (8 * c) * 33 + n;
        u32x4 o; o.x = pk2(s[0 * 33], s[1 * 33]); o.y = pk2(s[2 * 33], s[3 * 33]); o.z = pk2(s[4 * 33], s[5 * 33]); o.w = pk2(s[6 * 33], s[7 * 33]);
        *(u32x4*)(WT + (size_t)(ndst0 + n) * K + k0 + 8 * c) = o; }
    LDS_WAIT(); asm volatile("" ::: "memory");
}
__host__ __device__ __forceinline__ int inproj_src_col(int n) {
    if (n < PC_Z) return n;
    if (n < PC_G) return n + 64;
    if (n < PC_KR) return n + 128;
    if (n < PC_DT) return n - PC_KR + 1024;
    if (n < PC_PAD) return n - PC_DT + 11328;
    return -1;
}
constexpr int I_IN = (DM / 64) * (DINP / 32), I_UQ = (QL / 64) * (NH * QK / 32), I_UKV = (KVL / 64) * (NH * 256 / 32), I_OM = (DM / 64) * (DM / 32), I_OS = (DI / 64) * (DM / 32),
              I_OUT = I_OM, I_UP = (DM / 64) * (DFF / 32), I_DN = (DFF / 64) * (DM / 32), I_PG = I_OM, I_PL = (PLE / 64) * (DM / 32),
              I_LAYER = I_IN + I_UQ + I_UKV + I_OM + I_OS + I_OUT + I_UP + I_DN + I_PG + I_PL;
__device__ __forceinline__ void prologue_weights(const float* const (&inp)[26], unsigned char* ws, LAS unsigned char* lds, int G, int wg) {
    const int wave = otid() >> 6, lane = otid() & 63;
    LAS float* scr = (LAS float*)(lds + RING_OFF + wave * 16384);
    for (int it = wg * NWAVES + wave; it < DEPTH * I_LAYER; it += G * NWAVES) {
        const int l = it / I_LAYER; int r = it % I_LAYER;
        unsigned char* wl = ws + WS_W + (size_t)l * WL_BYTES;
        if (r < I_IN) { const int nblk = DINP / 32, kb = r / nblk, nb = r % nblk;
            transpose_item(inp[4] + (size_t)l * DM * DIN, DM, DIN, inproj_src_col(32 * nb), inp[3] + l * DM, (bf16*)(wl + WL_IN), 32 * nb, 64 * kb, scr, lane); continue; } r -= I_IN;
        if (r < I_UQ) { const int nblk = NH * QK / 32, kb = r / nblk, nb = r % nblk;
            transpose_item(inp[6] + (size_t)l * QL * NH * QK, QL, NH * QK, 32 * nb, inp[5] + l * QL, (bf16*)(wl + WL_UQ), 32 * nb, 64 * kb, scr, lane); continue; } r -= I_UQ;
        if (r < I_UKV) { const int nblk = NH * 256 / 32, kb = r / nblk, nb = r % nblk;
            transpose_item(inp[8] + (size_t)l * KVL * NH * 256, KVL, NH * 256, 32 * nb, inp[7] + l * KVL, (bf16*)(wl + WL_UKV), 32 * nb, 64 * kb, scr, lane); continue; } r -= I_UKV;
        if (r < I_OM) { const int nblk = DM / 32, kb = r / nblk, nb = r % nblk;
            transpose_item(inp[11] + (size_t)l * DM * DM, DM, DM, 32 * nb, nullptr, (bf16*)(wl + WL_OM), 32 * nb, 64 * kb, scr, lane); continue; } r -= I_OM;
        if (r < I_OS) { const int nblk = DM / 32, kb = r / nblk, nb = r % nblk;
            transpose_item(inp[18] + (size_t)l * DI * DM, DI, DM, 32 * nb, inp[17] + l * DI, (bf16*)(wl + WL_OS), 32 * nb, 64 * kb, scr, lane); continue; } r -= I_OS;
        if (r < I_OUT) { const int nblk = DM / 32, kb = r / nblk, nb = r % nblk;
            transpose_item(inp[19] + (size_t)l * DM * DM, DM, DM, 32 * nb, nullptr, (bf16*)(wl + WL_OUT), 32 * nb, 64 * kb, scr, lane); continue; } r -= I_OUT;
        if (r < I_UP) { const int nblk = DFF / 32, kb = r / nblk, nb = r % nblk;
            transpose_item(inp[21] + (size_t)l * DM * DFF, DM, DFF, 32 * nb, inp[20] + l * DM, (bf16*)(wl + WL_UP), 32 * nb, 64 * kb, scr, lane); continue; } r -= I_UP;
        if (r < I_DN) { const int nblk = DM / 32, kb = r / nblk, nb = r % nblk;
            transpose_item(inp[22] + (size_t)l * DFF * DM, DFF, DM, 32 * nb, nullptr, (bf16*)(wl + WL_DN), 32 * nb, 64 * kb, scr, lane); continue; } r -= I_DN;
        if (r < I_PG) { const int nblk = DM / 32, kb = r / nblk, nb = r % nblk;
            transpose_item(inp[24] + (size_t)l * DM * DM, DM, DM, 32 * nb, inp[23] + l * DM, (bf16*)(wl + WL_PG), 32 * nb, 64 * kb, scr, lane); continue; } r -= I_PG;
        { const int nblk = DM / 32, kb = r / nblk, nb = r % nblk;
            transpose_item(inp[25] + (size_t)l * PLE * DM, PLE, DM, 32 * nb, nullptr, (bf16*)(wl + WL_PL), 32 * nb, 64 * kb, scr, lane); }
    }
}
__device__ __forceinline__ void prologue_rows(const float* const (&inp)[26], float* out, unsigned char* ws, int G, int wg) {
    const int wave = otid() >> 6, lane = otid() & 63, gw = wg * NWAVES + wave, NGW = G * NWAVES;
    const float* x = inp[0]; bf16* XB = (bf16*)(ws + WS_XB); u64* ssq0 = (u64*)((unsigned*)(ws + WS_CTL) + CW_SSQX);
    for (int m = gw; m < M; m += NGW) {
        float s = 0.f;
#pragma unroll
        for (int j = 0; j < 8; ++j) { const f32x4 v = *(const f32x4*)(x + (size_t)m * DM + j * 256 + lane * 4);
            *(f32x4*)(out + (size_t)m * DM + j * 256 + lane * 4) = v; s += v.x * v.x + v.y * v.y + v.z * v.z + v.w * v.w;
            u32x2 o; o.x = pk2(v.x, v.y); o.y = pk2(v.z, v.w); *(u32x2*)(XB + (size_t)m * DM + j * 256 + lane * 4) = o; }
        s = wave_sum(s); if (lane == 0) ssq0[m] = (u64)(s * SSQ_SCALE);
    }
    {
        u64* z0 = (u64*)((unsigned*)(ws + WS_CTL) + CW_SSQX) + M; const int nz = (DEPTH * 3 - 1) * M + DEPTH * 2 * M;
        for (int i = wg * NTHR + otid(); i < nz; i += G * NTHR) z0[i] = 0ull;
    }
    const float* p = inp[1]; bf16* PB = (bf16*)(ws + WS_PB);
    for (size_t i = (size_t)wg * NTHR + otid(); i < (size_t)DEPTH * M * PLE / 8; i += (size_t)G * NTHR) { float v[8]; ld_f32x8(p + i * 8, v); *(u32x4*)(PB + i * 8) = pack8(v); }
    const int* pos = (const int*)inp[2]; float* COS = (float*)(ws + WS_COS); float* SIN = (float*)(ws + WS_SIN);
    for (int i = wg * NTHR + otid(); i < M * 32; i += G * NTHR) { const int m = i >> 5, k = i & 31;
        const float invf = 1.0f / (float)pow(10000.0, (double)k / 32.0);
        const float ang = (float)pos[m] * invf;
        COS[i] = (float)cos((double)ang); SIN[i] = (float)sin((double)ang); }
}

__device__ __forceinline__ void phase_kfin(const bf16* KVRAW, const float* MISC, const float* kw, const float* COS, const float* SIN, bf16* KF, int G, int wg) {
    const int wave = otid() >> 6, lane = otid() & 63;
    const float w0 = kw[lane], w1 = kw[64 + lane], w2 = kw[128 + lane];
    for (int it = wg * NWAVES + wave; it < M * NH; it += G * NWAVES) {
        const int m = it >> 4, h = it & 15;
        const float a0 = bf2f(KVRAW[(size_t)m * 4096 + h * 256 + lane]), a1 = bf2f(KVRAW[(size_t)m * 4096 + h * 256 + 64 + lane]), a2 = MISC[(size_t)m * 128 + lane];
        const float ss = wave_sum(a0 * a0 + a1 * a1 + a2 * a2), rs = rsqrtf(ss * (1.f / QK) + EPS);
        const float t2 = a2 * rs * w2, o2 = __shfl_xor(t2, 32);
        const float c = COS[m * 32 + (lane & 31)], s = SIN[m * 32 + (lane & 31)];
        const float r2 = lane < 32 ? (t2 * c - o2 * s) : (o2 * s + t2 * c);
        bf16* o = KF + (size_t)m * (NH * QK) + h * QK;
        o[lane] = (bf16)f2bf(a0 * rs * w0); o[64 + lane] = (bf16)f2bf(a1 * rs * w1); o[128 + lane] = (bf16)f2bf(r2);
    }
}
__device__ __forceinline__ void phase_ssdpre(const bf16* PROJ, const float* MISC, const float* cw, const float* cb, const float* dtb, bf16* XC, float* DTS, int G, int wg) {
    for (int i = wg * NTHR + otid(); i < M * (CONVD / 8); i += G * NTHR) {
        const int m = i / (CONVD / 8), c0 = (i % (CONVD / 8)) * 8, t = m % SEQ;
        float acc[8]; ld_f32x8(cb + c0, acc);
#pragma unroll
        for (int j = 0; j < CW; ++j) { const int tt = t - (CW - 1) + j;
            if (tt >= 0) { float xv[8], wv[8]; ld_bf16x8(PROJ + (size_t)(m - (CW - 1) + j) * DINP + PC_XBC + c0, xv); ld_f32x8(cw + j * CONVD + c0, wv);
#pragma unroll
                for (int e = 0; e < 8; ++e) acc[e] += xv[e] * wv[e]; } }
#pragma unroll
        for (int e = 0; e < 8; ++e) acc[e] = siluf_(acc[e]);
        *(u32x4*)(XC + (size_t)m * CONVD + c0) = pack8(acc);
    }
    for (int i = wg * NTHR + otid(); i < M * SH; i += G * NTHR) { const int m = i >> 6, h = i & 63;
        const float x = MISC[(size_t)m * 128 + 64 + h] + dtb[h], e = __expf(-fabsf(x));
        const float lp = e < 0.01f ? e * (1.f - e * (0.5f - e * (1.f / 3.f))) : __logf(1.f + e); DTS[i] = fmaxf(x, 0.f) + lp; }
}
__device__ __forceinline__ void phase_ssdnorm(const float* YPRE, const bf16* PROJ, bf16* Y, int G, int wg) {
    const int wave = otid() >> 6, lane = otid() & 63;
    for (int it = wg * NWAVES + wave; it < M * SG; it += G * NWAVES) {
        const int m = it >> 3, g = it & 7, c0 = g * 512 + lane * 8;
        float y[8], z[8]; ld_f32x8(YPRE + (size_t)m * DI + c0, y); ld_bf16x8(PROJ + (size_t)m * DINP + PC_Z + c0, z);
        float s = 0.f;
#pragma unroll
        for (int e = 0; e < 8; ++e) { y[e] *= siluf_(z[e]); s += y[e] * y[e]; }
        const float rs = rsqrtf(wave_sum(s) * (1.f / 512.f) + EPS);
#pragma unroll
        for (int e = 0; e < 8; ++e) y[e] *= rs;
        *(u32x4*)(Y + (size_t)m * DI + c0) = pack8(y);
    }
}

namespace attn {
typedef float f32x16 __attribute__((ext_vector_type(16)));
typedef short s16x4 __attribute__((ext_vector_type(4)));
constexpr int KB_BYTES = 64 * QK * 2, VB_BYTES = 64 * VD * 2;
constexpr int L_K0 = 0, L_K1 = KB_BYTES, L_V0 = 2 * KB_BYTES, L_V1 = 2 * KB_BYTES + VB_BYTES, L_WS = 2 * KB_BYTES + 2 * VB_BYTES;
constexpr float QSCALE = 0.07216878364870322f * 1.4426950408889634f;
constexpr float THR2 = 8.f;
#define ASBAR() __builtin_amdgcn_sched_barrier(0)
__device__ __forceinline__ int crow(int r, int hi) { return (r & 3) + 8 * (r >> 2) + 4 * hi; }
__device__ __forceinline__ void partialSM(f32x16& p0, f32x16& p1, float& m_reg, float& alpha) {
    float pmax = p0[0];
#pragma unroll
    for (int r = 1; r < 16; ++r) pmax = fmaxf(pmax, p0[r]);
#pragma unroll
    for (int r = 0; r < 16; ++r) pmax = fmaxf(pmax, p1[r]);
    { auto rr = __builtin_amdgcn_permlane32_swap(__float_as_uint(pmax), __float_as_uint(pmax), false, false); pmax = fmaxf(__uint_as_float(rr[0]), __uint_as_float(rr[1])); }
    float mn;
    if (__builtin_expect(__all(pmax - m_reg <= THR2), 1)) { mn = m_reg; alpha = 1.f; }
    else { mn = fmaxf(m_reg, pmax); alpha = __builtin_amdgcn_exp2f(m_reg - mn); m_reg = mn; }
#pragma unroll
    for (int r = 0; r < 16; ++r) p0[r] = __builtin_amdgcn_exp2f(p0[r] - mn);
#pragma unroll
    for (int r = 0; r < 16; ++r) p1[r] = __builtin_amdgcn_exp2f(p1[r] - mn);
}
__device__ __forceinline__ void finishSM(const f32x16& p0, const f32x16& p1, float alpha, float& l_reg, bf16x8& pa0, bf16x8& pa1, bf16x8& pa2, bf16x8& pa3) {
    float ps = 0.f;
#pragma unroll
    for (int r = 0; r < 16; ++r) ps += p0[r];
#pragma unroll
    for (int r = 0; r < 16; ++r) ps += p1[r];
    { auto rr = __builtin_amdgcn_permlane32_swap(__float_as_uint(ps), __float_as_uint(ps), false, false); ps = __uint_as_float(rr[0]) + __uint_as_float(rr[1]); }
    l_reg = l_reg * alpha + ps;
#define PK4(P, BASE, OUT) do { unsigned a0 = pk2(P[BASE + 0], P[BASE + 1]), a1 = pk2(P[BASE + 2], P[BASE + 3]);   \
    unsigned b0 = pk2(P[BASE + 4], P[BASE + 5]), b1 = pk2(P[BASE + 6], P[BASE + 7]);                              \
    auto r0 = __builtin_amdgcn_permlane32_swap(a0, b0, false, false); auto r1 = __builtin_amdgcn_permlane32_swap(a1, b1, false, false); \
    u32x4 w = {r0[0], r1[0], r0[1], r1[1]}; OUT = __builtin_bit_cast(bf16x8, w); } while (0)
    PK4(p0, 0, pa0); PK4(p0, 8, pa1); PK4(p1, 0, pa2); PK4(p1, 8, pa3);
#undef PK4
}
__device__ __forceinline__ void qkt(f32x16& p0, f32x16& p1, LAS const unsigned char* Ks, const bf16x8 (&qr)[12], int r32, int hi) {
    p0 = (f32x16){0.f, 0.f, 0.f, 0.f, 0.f, 0.f, 0.f, 0.f, 0.f, 0.f, 0.f, 0.f, 0.f, 0.f, 0.f, 0.f}; p1 = p0;
    const int sw = (r32 & 7) << 4, ra = r32 * (QK * 2), rb = (32 + r32) * (QK * 2);
#pragma unroll
    for (int d0 = 0; d0 < 12; ++d0) { const int cb = (d0 * 32 + hi * 16) ^ sw;
        const bf16x8 b0 = *(LAS const bf16x8*)(Ks + ra + cb), b1 = *(LAS const bf16x8*)(Ks + rb + cb);
        p0 = __builtin_amdgcn_mfma_f32_32x32x16_bf16(b0, qr[d0], p0, 0, 0, 0);
        p1 = __builtin_amdgcn_mfma_f32_32x32x16_bf16(b1, qr[d0], p1, 0, 0, 0); }
}
__device__ __forceinline__ void v_pos_src(int p, int& k, int& c) { const int s = p >> 5, kk = (s >> 2) * 8 + ((p & 31) >> 2); c = (s & 3) * 32 + (p & 3) * 8; k = (kk & ~0xC) | ((kk & 4) << 1) | ((kk & 8) >> 1); }
__device__ __forceinline__ int v_rd_base(int lane) { return ((lane & 3) << 3) | (((lane >> 2) & 3) << 6) | (((lane >> 4) & 1) << 5) | (((lane >> 5) & 1) << 8); }
constexpr int v_rd_off(int d0, int ks, int half) { return d0 * 512 + ks * 4096 + half * 2048; }
template <int OFF> __device__ __forceinline__ s16x4 tr_read(int vb) { s16x4 r; asm volatile("ds_read_b64_tr_b16 %0, %1 offset:%2" : "=&v"(r) : "v"(vb), "i"(OFF) : "memory"); return r; }
template <int D0> __device__ __forceinline__ void pv_one(f32x16& od, int vb, bf16x8 pa0, bf16x8 pa1, bf16x8 pa2, bf16x8 pa3) {
    const s16x4 l0 = tr_read<v_rd_off(D0, 0, 0)>(vb), h0 = tr_read<v_rd_off(D0, 0, 1)>(vb), l1 = tr_read<v_rd_off(D0, 1, 0)>(vb), h1 = tr_read<v_rd_off(D0, 1, 1)>(vb);
    const s16x4 l2 = tr_read<v_rd_off(D0, 2, 0)>(vb), h2 = tr_read<v_rd_off(D0, 2, 1)>(vb), l3 = tr_read<v_rd_off(D0, 3, 0)>(vb), h3 = tr_read<v_rd_off(D0, 3, 1)>(vb);
    asm volatile("s_waitcnt lgkmcnt(0)" ::: "memory"); ASBAR();
#define PKV(L, H) (bf16x8){L[0], L[1], L[2], L[3], H[0], H[1], H[2], H[3]}
    od = __builtin_amdgcn_mfma_f32_32x32x16_bf16(pa0, PKV(l0, h0), od, 0, 0, 0);
    od = __builtin_amdgcn_mfma_f32_32x32x16_bf16(pa1, PKV(l1, h1), od, 0, 0, 0);
    od = __builtin_amdgcn_mfma_f32_32x32x16_bf16(pa2, PKV(l2, h2), od, 0, 0, 0);
    od = __builtin_amdgcn_mfma_f32_32x32x16_bf16(pa3, PKV(l3, h3), od, 0, 0, 0);
#undef PKV
}
__device__ __forceinline__ void pv_d0(f32x16 (&o)[4], int vb, bf16x8 pa0, bf16x8 pa1, bf16x8 pa2, bf16x8 pa3) {
    pv_one<0>(o[0], vb, pa0, pa1, pa2, pa3); pv_one<1>(o[1], vb, pa0, pa1, pa2, pa3); pv_one<2>(o[2], vb, pa0, pa1, pa2, pa3); pv_one<3>(o[3], vb, pa0, pa1, pa2, pa3);
}

__device__ __forceinline__ void attn_unit(int b, int h, int qb, const bf16* QRAW, const bf16* KF, const bf16* KVRAW, const float* qw, const float* COS, const float* SIN, bf16* AO, LAS unsigned char* lds) {
    const int tid = otid(), wid = __builtin_amdgcn_readfirstlane(tid >> 6), lane = tid & 63, r32 = lane & 31, hi = lane >> 5;
    LAS float* wsf = (LAS float*)(lds + L_WS) + wid * 64; LAS float* li_l = wsf; LAS float* al_l = wsf + 32;
    const int m = b * SEQ + qb * 256 + wid * 32 + r32;
    bf16x8 qr[12];
    {
        const bf16* qp = QRAW + (size_t)m * (NH * QK) + h * QK + hi * 8;
        u32x4 raw[12]; float ss = 0.f;
#pragma unroll
        for (int d0 = 0; d0 < 12; ++d0) { raw[d0] = *(const u32x4*)(qp + d0 * 16); float f[8]; unpack8(raw[d0], f);
#pragma unroll
            for (int j = 0; j < 8; ++j) ss += f[j] * f[j]; }
        ss += __shfl_xor(ss, 32);
        const float rs = rsqrtf(ss * (1.f / QK) + EPS) * QSCALE;
#pragma unroll
        for (int d0 = 0; d0 < 8; ++d0) { float f[8], w[8]; unpack8(raw[d0], f); ld_f32x8(qw + d0 * 16 + hi * 8, w);
#pragma unroll
            for (int j = 0; j < 8; ++j) f[j] = f[j] * rs * w[j];
            qr[d0] = __builtin_bit_cast(bf16x8, pack8(f)); }
#pragma unroll
        for (int t = 0; t < 2; ++t) { float x1[8], x2[8], w1[8], w2[8], c[8], s[8], o1[8], o2[8];
            unpack8(raw[8 + t], x1); unpack8(raw[10 + t], x2); ld_f32x8(qw + 128 + t * 16 + hi * 8, w1); ld_f32x8(qw + 160 + t * 16 + hi * 8, w2);
            ld_f32x8(COS + (size_t)m * 32 + t * 16 + hi * 8, c); ld_f32x8(SIN + (size_t)m * 32 + t * 16 + hi * 8, s);
#pragma unroll
            for (int j = 0; j < 8; ++j) { const float a = x1[j] * rs * w1[j], bq = x2[j] * rs * w2[j]; o1[j] = a * c[j] - bq * s[j]; o2[j] = a * s[j] + bq * c[j]; }
            qr[8 + t] = __builtin_bit_cast(bf16x8, pack8(o1)); qr[10 + t] = __builtin_bit_cast(bf16x8, pack8(o2)); }
    }
    const bf16* kbase = KF + (size_t)(b * SEQ) * (NH * QK) + h * QK;
    const bf16* vbase = KVRAW + (size_t)(b * SEQ) * 4096 + h * 256 + 128;
    unsigned koff[3], voff[2];
#pragma unroll
    for (int i = 0; i < 3; ++i) { const int p = i * 512 + tid, row = p / 24, cc = (p % 24) ^ (row & 7); koff[i] = (unsigned)(row * (NH * QK) + cc * 8) * 2u; }
#pragma unroll
    for (int i = 0; i < 2; ++i) { int k, c; v_pos_src(i * 512 + tid, k, c); voff[i] = (unsigned)(k * 4096 + c) * 2u; }
    const unsigned ldsw = (unsigned)wid * 1024u;
#define ATT_STAGE(kb, vb_, key0) do { const char* _kg = (const char*)(kbase + (size_t)(key0) * (NH * QK)); const char* _vg = (const char*)(vbase + (size_t)(key0) * 4096); \
        _Pragma("unroll") for (int _i = 0; _i < 3; ++_i) __builtin_amdgcn_global_load_lds((const unsigned*)(_kg + koff[_i]), (LAS unsigned*)(lds + (kb) + ldsw + _i * 8192), 16, 0, 0); \
        _Pragma("unroll") for (int _i = 0; _i < 2; ++_i) __builtin_amdgcn_global_load_lds((const unsigned*)(_vg + voff[_i]), (LAS unsigned*)(lds + (vb_) + ldsw + _i * 8192), 16, 0, 0); } while (0)
    float m_reg = -1e30f, l_reg = 0.f;
    f32x16 o[4];
#pragma unroll
    for (int d = 0; d < 4; ++d) o[d] = (f32x16){0.f, 0.f, 0.f, 0.f, 0.f, 0.f, 0.f, 0.f, 0.f, 0.f, 0.f, 0.f, 0.f, 0.f, 0.f, 0.f};
    const int nt = 4 * qb + 4, myc = 4 * qb + (wid >> 1);
    const int vrd = v_rd_base(lane);
#define ATT_TILE(kb, vb_, j) do { if ((j) <= myc) { f32x16 p0, p1; float alpha; bf16x8 pa0, pa1, pa2, pa3; \
        qkt(p0, p1, (LAS const unsigned char*)(lds + (kb)), qr, r32, hi); partialSM(p0, p1, m_reg, alpha); \
        if (__any(alpha < 1.f)) { if (hi == 0) al_l[r32] = alpha; asm volatile("s_waitcnt lgkmcnt(0)" ::: "memory"); \
            _Pragma("unroll") for (int d = 0; d < 4; ++d) _Pragma("unroll") for (int r = 0; r < 16; ++r) o[d][r] *= al_l[crow(r, hi)]; } \
        finishSM(p0, p1, alpha, l_reg, pa0, pa1, pa2, pa3); ASBAR(); \
        pv_d0(o, (int)(uintptr_t)(lds + (vb_)) + vrd, pa0, pa1, pa2, pa3); } } while (0)
    ATT_STAGE(L_K0, L_V0, 0);
    asm volatile("s_waitcnt vmcnt(0)" ::: "memory"); __syncthreads();
    for (int j = 0; j < nt; j += 2) {
        ATT_STAGE(L_K1, L_V1, (j + 1) * 64);
        ATT_TILE(L_K0, L_V0, j);
        asm volatile("s_waitcnt vmcnt(0)" ::: "memory"); __syncthreads();
        if (j + 2 < nt) ATT_STAGE(L_K0, L_V0, (j + 2) * 64);
        ATT_TILE(L_K1, L_V1, j + 1);
        asm volatile("s_waitcnt vmcnt(0)" ::: "memory"); __syncthreads();
    }
#undef ATT_STAGE
#undef ATT_TILE
    if (hi == 0) li_l[r32] = l_reg;
    asm volatile("s_waitcnt lgkmcnt(0)" ::: "memory");
    float rli[16];
#pragma unroll
    for (int r = 0; r < 16; ++r) rli[r] = __builtin_amdgcn_rcpf(li_l[crow(r, hi)]);
    bf16* ob = AO + (size_t)(b * SEQ + qb * 256 + wid * 32) * DM + h * VD;
#pragma unroll
    for (int r = 0; r < 16; ++r) { const int orow = crow(r, hi);
#pragma unroll
        for (int d0 = 0; d0 < 4; ++d0) ob[(size_t)orow * DM + d0 * 32 + r32] = (bf16)f2bf(o[d0][r] * rli[r]); }
    asm volatile("s_waitcnt lgkmcnt(0)" ::: "memory");
}
__device__ __forceinline__ void phase(const bf16* QRAW, const bf16* KF, const bf16* KVRAW, const float* qw, const float* COS, const float* SIN, bf16* AO, LAS unsigned char* lds, int G, int wg) {
    for (int pr = wg; pr < NB * NH * 8; pr += G) {
        const int x = pr & 7, slot = pr >> 3, bh = x * 4 + (slot >> 3), pi = slot & 7, b = bh / NH, h = bh % NH;
        attn_unit(b, h, 15 - pi, QRAW, KF, KVRAW, qw, COS, SIN, AO, lds);
        attn_unit(b, h, pi, QRAW, KF, KVRAW, qw, COS, SIN, AO, lds);
    }
}
}

__device__ __forceinline__ void phase_attn_simple(const bf16* QRAW, const bf16* KF, const bf16* KVRAW, const float* qw, const float* COS, const float* SIN, bf16* AO, LAS unsigned char* lds, int G, int wg) {
    const int wave = otid() >> 6, lane = otid() & 63;
    LAS float* sc = (LAS float*)(lds + RING_OFF + wave * 16384);
    LAS float* qs = (LAS float*)(lds + EXTRA_OFF + wave * 768);
    const float w0 = qw[lane], w1 = qw[64 + lane], w2 = qw[128 + lane];
    for (int it = wg * NWAVES + wave; it < NB * NH * SEQ; it += G * NWAVES) {
        const int t = it % SEQ, bh = it / SEQ, h = bh % NH, b = bh / NH, m = b * SEQ + t;
        const bf16* qp = QRAW + (size_t)m * (NH * QK) + h * QK;
        const float a0 = bf2f(qp[lane]), a1 = bf2f(qp[64 + lane]), a2 = bf2f(qp[128 + lane]);
        const float ss = wave_sum(a0 * a0 + a1 * a1 + a2 * a2), rs = rsqrtf(ss * (1.f / QK) + EPS);
        const float t2 = a2 * rs * w2, o2 = __shfl_xor(t2, 32);
        const float c = COS[m * 32 + (lane & 31)], s = SIN[m * 32 + (lane & 31)];
        const float r2 = lane < 32 ? (t2 * c - o2 * s) : (o2 * s + t2 * c);
        const float scale = 0.07216878364870322f;
        qs[lane] = a0 * rs * w0 * scale; qs[64 + lane] = a1 * rs * w1 * scale; qs[128 + lane] = r2 * scale;
        LDS_WAIT();
        const int nk = (t / TC + 1) * TC;
        float mx = -3.0e38f;
        for (int j = lane; j < nk; j += 64) {
            const bf16* kp = KF + (size_t)(b * SEQ + j) * (NH * QK) + h * QK;
            float acc = 0.f;
#pragma unroll 4
            for (int d = 0; d < QK; d += 8) { float kv[8]; ld_bf16x8(kp + d, kv);
#pragma unroll
                for (int e = 0; e < 8; ++e) acc += qs[d + e] * kv[e]; }
            sc[j] = acc; mx = fmaxf(mx, acc);
        }
        mx = wave_max(mx);
        LDS_WAIT();
        float l = 0.f;
        for (int j = lane; j < nk; j += 64) { const float p = __expf(sc[j] - mx); sc[j] = p; l += p; }
        l = wave_sum(l);
        LDS_WAIT();
        float o0 = 0.f, o1 = 0.f;
        const bf16* vp = KVRAW + (size_t)(b * SEQ) * 4096 + h * 256 + 128;
#pragma unroll 8
        for (int j = 0; j < nk; ++j) { const float p = sc[j]; o0 += p * bf2f(vp[(size_t)j * 4096 + lane]); o1 += p * bf2f(vp[(size_t)j * 4096 + 64 + lane]); }
        const float il = 1.f / l;
        AO[(size_t)m * DM + h * VD + lane] = (bf16)f2bf(o0 * il); AO[(size_t)m * DM + h * VD + 64 + lane] = (bf16)f2bf(o1 * il);
        LDS_WAIT();
    }
}
__device__ __forceinline__ float wave_scan(float v, int lane) {
#pragma unroll
    for (int o = 1; o < 64; o <<= 1) { const float n = __shfl_up(v, o); if (lane >= o) v += n; }
    return v;
}
__device__ __forceinline__ void phase_ssd_states(const bf16* XC, const float* DTS, const float* a_log, float* ST, float* CDEC, LAS unsigned char* lds, int G, int wg) {
    LAS float* wsh = (LAS float*)(lds + RING_OFF);
    const int tid = otid();
    for (int it = wg; it < NB * NCH * SH; it += G) {
        const int h = it % SH, bc = it / SH, m0 = bc * TC, g = h / HPG;
        __syncthreads();
        if (tid < 64) { const float A = -__expf(a_log[h]), dt = DTS[(size_t)(m0 + tid) * SH + h];
            const float ac = wave_scan(dt * A, tid), last = __shfl(ac, 63);
            wsh[tid] = __expf(last - ac) * dt; if (tid == 63) CDEC[bc * SH + h] = __expf(last); }
        __syncthreads();
        const int p = tid >> 3, n0 = (tid & 7) * 16;
        float acc[16];
#pragma unroll
        for (int e = 0; e < 16; ++e) acc[e] = 0.f;
        for (int s = 0; s < TC; ++s) {
            const float xw = bf2f(XC[(size_t)(m0 + s) * CONVD + h * HD + p]) * wsh[s];
            float b0[8], b1[8]; ld_bf16x8(XC + (size_t)(m0 + s) * CONVD + DI + g * SN + n0, b0); ld_bf16x8(XC + (size_t)(m0 + s) * CONVD + DI + g * SN + n0 + 8, b1);
#pragma unroll
            for (int e = 0; e < 8; ++e) { acc[e] += xw * b0[e]; acc[8 + e] += xw * b1[e]; }
        }
        float* o = ST + (((size_t)bc * SH + h) * HD + p) * SN + n0;
#pragma unroll
        for (int e = 0; e < 16; e += 4) *(f32x4*)(o + e) = (f32x4){acc[e], acc[e + 1], acc[e + 2], acc[e + 3]};
    }
}
__device__ __forceinline__ void phase_ssd_scan(float* ST, const float* CDEC, int G, int wg) {
    constexpr int PER_B = SH * HD * SN;
    for (int e = wg * NTHR + otid(); e < NB * PER_B; e += G * NTHR) {
        const int b = e / PER_B, r = e % PER_B, h = r / (HD * SN);
        float state = 0.f;
        for (int c = 0; c < NCH; ++c) { const size_t idx = (size_t)(b * NCH + c) * PER_B + r; const float tmp = ST[idx]; ST[idx] = state; state = state * CDEC[(b * NCH + c) * SH + h] + tmp; }
    }
}
__device__ __forceinline__ void phase_ssd_out(const bf16* XC, const float* DTS, const float* a_log, const float* dskip, const float* ST, float* YPRE, LAS unsigned char* lds, int G, int wg) {
    LAS float* Mm = (LAS float*)(lds + RING_OFF);
    LAS float* acs = (LAS float*)(lds + RING_OFF + 20480);
    LAS float* dts = acs + 64;
    const int tid = otid();
    for (int it = wg; it < NB * NCH * SH; it += G) {
        const int h = it % SH, bc = it / SH, m0 = bc * TC, g = h / HPG;
        __syncthreads();
        if (tid < 64) { const float A = -__expf(a_log[h]), dt = DTS[(size_t)(m0 + tid) * SH + h]; acs[tid] = wave_scan(dt * A, tid); dts[tid] = dt; }
        __syncthreads();
        for (int i = 0; i < 8; ++i) { const int e = tid + NTHR * i, t = e >> 6, s = e & 63;
            float v = 0.f;
            if (s <= t) { const bf16* cp = XC + (size_t)(m0 + t) * CONVD + DI + SG * SN + g * SN; const bf16* bp = XC + (size_t)(m0 + s) * CONVD + DI + g * SN;
                float dot = 0.f;
#pragma unroll 4
                for (int n = 0; n < SN; n += 8) { float cv[8], bv[8]; ld_bf16x8(cp + n, cv); ld_bf16x8(bp + n, bv);
#pragma unroll
                    for (int q = 0; q < 8; ++q) dot += cv[q] * bv[q]; }
                v = dot * __expf(acs[t] - acs[s]) * dts[s]; }
            Mm[t * 65 + s] = v; }
        __syncthreads();
        const int t = tid >> 3, p0 = (tid & 7) * 8;
        float y[8];
#pragma unroll
        for (int j = 0; j < 8; ++j) y[j] = 0.f;
        for (int s = 0; s < TC; ++s) { float xv[8]; ld_bf16x8(XC + (size_t)(m0 + s) * CONVD + h * HD + p0, xv); const float mv = Mm[t * 65 + s];
#pragma unroll
            for (int j = 0; j < 8; ++j) y[j] += mv * xv[j]; }
        const float ea = __expf(acs[t]), dk = dskip[h];
        const bf16* cp = XC + (size_t)(m0 + t) * CONVD + DI + SG * SN + g * SN;
        float xt[8]; ld_bf16x8(XC + (size_t)(m0 + t) * CONVD + h * HD + p0, xt);
#pragma unroll
        for (int j = 0; j < 8; ++j) { const float* pp = ST + (((size_t)bc * SH + h) * HD + p0 + j) * SN;
            float dot = 0.f;
#pragma unroll 4
            for (int n = 0; n < SN; n += 8) { float cv[8], pv[8]; ld_bf16x8(cp + n, cv); ld_f32x8(pp + n, pv);
#pragma unroll
                for (int q = 0; q < 8; ++q) dot += cv[q] * pv[q]; }
            y[j] += ea * dot + dk * xt[j]; }
        st_f32x8(YPRE + (size_t)(m0 + t) * DI + h * HD + p0, y);
    }
}

#ifndef ATTN_REPEAT
#define ATTN_REPEAT 1
#endif
#ifndef SLOW4
#define SLOW4 1
#endif
constexpr int PPL = 14, NPH = 1 + DEPTH * PPL;
struct Args { const float* in[26]; float* out; unsigned char* ws; int ph_lo, ph_hi; };
__global__ void __launch_bounds__(NTHR, 2) fwd(Args args) {
    extern __shared__ __attribute__((aligned(16))) unsigned char lds_[];
    LAS unsigned char* lds = (LAS unsigned char*)lds_;
    const int tid = threadIdx.x, G = gridDim.x, wg = blockIdx.x;
    for (int u = tid; u < (LDS_BYTES - LDSCTL_OFF) / 4; u += NTHR) ((LAS unsigned*)(lds + LDSCTL_OFF))[u] = 0u;
    __syncthreads();
    unsigned char* const ws0 = args.ws;
    unsigned* const ctl0 = (unsigned*)(ws0 + WS_CTL);
    const int lo = args.ph_lo, hi = args.ph_hi;
    XcdBarrier bar; bar.bar = ctl0 + CW_BAR; bar.x = 0; bar.st = (volatile LAS unsigned*)(lds + MISC_OFF) + 8;
    if (hi - lo > 1) bar = xcd_barrier_post(ctl0 + CW_BAR, (volatile LAS unsigned*)(lds + MISC_OFF) + 8);
#define INP(i) (args.in[i])
#define WSP(T, off) ((T*)(ws + (off)))
#define X (args.out)
#define SSQX ((u64*)(ctl + CW_SSQX))
#define SSQC ((u64*)(ctl + CW_SSQC))
#define XB0 WSP(bf16, WS_XB)
#define XB1 WSP(bf16, WS_XB1)
#define XB2 WSP(bf16, WS_XB2)
#define PROJ WSP(bf16, WS_PROJ)
#define U WSP(bf16, WS_U)
#define MISC WSP(float, WS_MISC)
#define QRAW WSP(bf16, WS_QRAW)
#define KVRAW WSP(bf16, WS_KVRAW)
#define KF WSP(bf16, WS_KF)
#define AO WSP(bf16, WS_AO)
#define XC WSP(bf16, WS_XC)
#define DTS WSP(float, WS_DTS)
#define CDEC WSP(float, WS_CDEC)
#define ST WSP(float, WS_ST)
#define YPRE WSP(float, WS_YPRE)
#define Y WSP(bf16, WS_Y)
#define TMPF WSP(float, WS_TMPF)
#define MERGED WSP(bf16, WS_MERGED)
#define PE WSP(bf16, WS_PE)
#define PB WSP(bf16, WS_PB)
#define COS WSP(float, WS_COS)
#define SIN WSP(float, WS_SIN)
    int ph = 0;
#define PHASE(...) do { if (lo <= ph && ph < hi) { { unsigned char* ws = ws0; asm volatile("" : "+s"(ws)); unsigned* ctl = (unsigned*)(ws + WS_CTL); __VA_ARGS__; } if (ph + 1 < hi) xcd_barrier(bar); } ++ph; } while (0)

    PHASE({ prologue_weights(args.in, ws, lds, G, wg); prologue_rows(args.in, X, ws, G, wg); });

#pragma unroll 1
    for (int l = 0; l < DEPTH; ++l) {
#define wl (ws + WS_W + (size_t)l * WL_BYTES)
#define ssq0 (SSQX + (size_t)(l * 3 + 0) * M)
#define ssq1 (SSQX + (size_t)(l * 3 + 1) * M)
#define ssq2 (SSQX + (size_t)(l * 3 + 2) * M)
#define ssqn ((l + 1 < DEPTH) ? SSQX + (size_t)((l + 1) * 3) * M : (u64*)nullptr)
#define ssqc (SSQC + (size_t)l * 2 * M)
        PHASE({ pg8::Gemm g{XB0, (const bf16*)(wl + WL_IN), M, DINP, DM, DM}; EpiInProj E{ssq0, ssqc, PROJ, MISC}; run_gemm(lds, g, E, G, wg, SLOW4); });
        PHASE({ { pg8::Gemm g{PROJ + PC_CQ, (const bf16*)(wl + WL_UQ), M, NH * QK, QL, DINP}; EpiScaleBf16 E{ssqc, 1.f / QL, QRAW, NH * QK}; run_gemm(lds, g, E, G, wg, GEMM_REPEAT); }
                { pg8::Gemm g{PROJ + PC_CKV, (const bf16*)(wl + WL_UKV), M, NH * 256, KVL, DINP}; EpiScaleBf16 E{ssqc + M, 1.f / KVL, KVRAW, NH * 256}; run_gemm(lds, g, E, G, wg, GEMM_REPEAT); }
                { pg8::Gemm g{PB + (size_t)l * M * PLE, (const bf16*)(wl + WL_PL), M, DM, PLE, PLE}; EpiScaleBf16 E{nullptr, 0.f, PE, DM}; run_gemm(lds, g, E, G, wg, GEMM_REPEAT); } });
        PHASE({ phase_kfin(KVRAW, MISC, INP(10) + l * QK, COS, SIN, KF, G, wg);
                phase_ssdpre(PROJ, MISC, INP(12) + (size_t)l * CW * CONVD, INP(13) + (size_t)l * CONVD, INP(14) + l * SH, XC, DTS, G, wg); });

#if FAST_ATTN
        PHASE({ attn::phase(QRAW, KF, KVRAW, INP(9) + l * QK, COS, SIN, AO, lds, G, wg); });
#else
        PHASE({ phase_attn_simple(QRAW, KF, KVRAW, INP(9) + l * QK, COS, SIN, AO, lds, G, wg); });
#endif

        PHASE({ phase_ssd_states(XC, DTS, INP(15) + l * SH, ST, CDEC, lds, G, wg); });
        PHASE({ phase_ssd_scan(ST, CDEC, G, wg); });
        PHASE({ phase_ssd_out(XC, DTS, INP(15) + l * SH, INP(16) + l * SH, ST, YPRE, lds, G, wg); });
        PHASE({ phase_ssdnorm(YPRE, PROJ, Y, G, wg); });
        PHASE({ pg8::Gemm g{AO, (const bf16*)(wl + WL_OM), M, DM, DM, DM}; EpiGateF32 E{PROJ, TMPF}; run_gemm(lds, g, E, G, wg, GEMM_REPEAT); });
        PHASE({ pg8::Gemm g{Y, (const bf16*)(wl + WL_OS), M, DM, DI, DI}; EpiMerge E{PROJ, TMPF, MERGED}; run_gemm(lds, g, E, G, wg, GEMM_REPEAT); });
        PHASE({ pg8::Gemm g{MERGED, (const bf16*)(wl + WL_OUT), M, DM, DM, DM}; EpiResid E{X, XB1, ssq1}; run_gemm(lds, g, E, G, wg, SLOW4); });
        PHASE({ pg8::Gemm g{XB1, (const bf16*)(wl + WL_UP), M, DFF, DM, DM}; EpiUp E{ssq1, U}; run_gemm(lds, g, E, G, wg, GEMM_REPEAT); });
        PHASE({ pg8::Gemm g{U, (const bf16*)(wl + WL_DN), M, DM, DFF, DFF}; EpiResid E{X, XB2, ssq2}; run_gemm(lds, g, E, G, wg, SLOW4); });
        PHASE({ pg8::Gemm g{XB2, (const bf16*)(wl + WL_PG), M, DM, DM, DM};  EpiPleGate E{ssq2, PE, X, XB0, ssqn}; run_gemm(lds, g, E, G, wg, SLOW4); });
    }
#undef PHASE
}

extern "C" void kernel_launch(void* const* d_in, const int* in_sizes, int n_in, void* d_out, int out_size, void* d_ws, size_t ws_size, hipStream_t stream) {
    static int grid = 0;
    if (grid == 0) {
        if (n_in != 26 || out_size != M * DM || ws_size < WS_END) { fprintf(stderr, "kernel_launch: built for 26 inputs, out %d floats, >= %zu bytes of workspace; got n_in %d out %d ws %zu\n", M * DM, (size_t)WS_END, n_in, out_size, ws_size); grid = -1; return; }
        int dev = 0, cus = 0;
        if (hipGetDevice(&dev) != hipSuccess || hipDeviceGetAttribute(&cus, hipDeviceAttributeMultiprocessorCount, dev) != hipSuccess) { grid = -1; return; }
        if (hipFuncSetAttribute((const void*)fwd, hipFuncAttributeMaxDynamicSharedMemorySize, LDS_BYTES) != hipSuccess) { fprintf(stderr, "kernel_launch: hipFuncSetAttribute failed\n"); grid = -1; return; }
        int per_cu = 0;
        if (hipOccupancyMaxActiveBlocksPerMultiprocessor(&per_cu, (const void*)fwd, NTHR, LDS_BYTES) != hipSuccess || per_cu < 1) fprintf(stderr, "kernel_launch: occupancy query says %d\n", per_cu);
        (void)hipGetLastError();
        grid = cus;
    }
    if (grid < 0) return;
    if (hipMemsetAsync((char*)d_ws + WS_CTL, 0, CTL_ZERO_BYTES, stream) != hipSuccess) return;
    Args a{};
    for (int i = 0; i < 26; ++i) a.in[i] = (const float*)d_in[i];
    a.out = (float*)d_out; a.ws = (unsigned char*)d_ws;
#if MK_ONE_LAUNCH
    a.ph_lo = 0; a.ph_hi = NPH;
    hipLaunchKernelGGL(fwd, dim3(grid), dim3(NTHR), LDS_BYTES, stream, a);
#else
#ifndef STOP_PH
#define STOP_PH NPH
#endif
    for (int ph = 0; ph < STOP_PH; ++ph) {
#ifdef SKIP_LO
        if (ph >= SKIP_LO && ph < SKIP_HI) continue;
#endif
        a.ph_lo = ph; a.ph_hi = ph + 1; hipLaunchKernelGGL(fwd, dim3(grid), dim3(NTHR), LDS_BYTES, stream, a); }
#endif
    const hipError_t le = hipPeekAtLastError();
    if (le != hipSuccess) fprintf(stderr, "kernel_launch: launch failed: %s\n", hipGetErrorName(le));
}
```

```cpp
#define FAST_GEMM 1
#define FAST_ATTN 1
#define FAST_SSD 1
#define MK_ONE_LAUNCH 1
#include <hip/hip_runtime.h>
#include <cstdio>
#include <cstdint>

#ifndef MK_ONE_LAUNCH
#define MK_ONE_LAUNCH 0
#endif
#ifndef FAST_SSD
#define FAST_SSD 0
#endif
#ifndef FAST_ATTN
#define FAST_ATTN 0
#endif
#ifndef FAST_GEMM
#define FAST_GEMM 0
#endif

constexpr int NB = 2, SEQ = 4096, M = NB * SEQ, DM = 2048, DEPTH = 4, PLE = 256;
constexpr float EPS = 1e-6f;
constexpr int NH = 16, QL = 512, KVL = 512, NOPE = 128, ROPE = 64, VD = 128, QK = 192;
constexpr int DI = 4096, HD = 64, SH = 64, SG = 8, SN = 128, HPG = 8, CW = 4, CONVD = 6144, TC = 64, NCH = SEQ / TC;
constexpr int DFF = 8192;
constexpr int DIN = 15488;
constexpr int DINP = 15616;
constexpr int PC_CQ = 0, PC_CKV = 512, PC_Z = 1024, PC_XBC = 5120, PC_G = 11264, PC_KR = 15360, PC_DT = 15424, PC_PAD = 15488;
constexpr int NWAVES = 8, NTHR = 512;

typedef unsigned short bf16;
typedef unsigned u32x4 __attribute__((ext_vector_type(4)));
typedef unsigned u32x2 __attribute__((ext_vector_type(2)));
typedef float f32x4 __attribute__((ext_vector_type(4)));
typedef float f32x2 __attribute__((ext_vector_type(2)));
typedef short bf16x8 __attribute__((ext_vector_type(8)));
#define GAS __attribute__((address_space(1)))
#define LAS __attribute__((address_space(3)))
typedef GAS unsigned gu32;
#define RLX_AGENT __ATOMIC_RELAXED, __HIP_MEMORY_SCOPE_AGENT
#define LDS_WAIT() asm volatile("s_waitcnt lgkmcnt(0)" ::: "memory")
#define VM_WAIT() asm volatile("s_waitcnt vmcnt(0)" ::: "memory")

constexpr size_t MiB = 1u << 20;
constexpr size_t WS_CTL = 0, CTL_ZERO_BYTES = 2 * MiB;
constexpr int CW_TMO = 0, CW_CODE = 1, CW_BAR = 4096;
typedef unsigned long long u64;
constexpr int CW_SSQX = 16384;
constexpr int CW_SSQC = CW_SSQX + 2 * DEPTH * 3 * M;
static_assert((size_t)(CW_SSQC + 2 * DEPTH * 2 * M) * 4 <= CTL_ZERO_BYTES, "ctl");
constexpr size_t WL_IN = 0, WL_UQ = 61 * MiB, WL_UKV = 64 * MiB, WL_OM = 68 * MiB, WL_OS = 76 * MiB, WL_OUT = 92 * MiB, WL_UP = 100 * MiB, WL_DN = 132 * MiB, WL_PG = 164 * MiB, WL_PL = 172 * MiB, WL_BYTES = 173 * MiB;
static_assert((size_t)DINP * DM * 2 == 61 * MiB, "w_in copy");
constexpr size_t WS_W = 2 * MiB;
constexpr size_t WS_ACT = WS_W + DEPTH * WL_BYTES;
constexpr size_t WS_XB = WS_ACT;
constexpr size_t WS_XB1 = WS_XB + 32 * MiB, WS_XB2 = WS_XB1 + 32 * MiB;
constexpr size_t WS_PROJ = WS_XB2 + 32 * MiB;
constexpr size_t WS_U = WS_PROJ;
constexpr size_t WS_MISC = WS_PROJ + 244 * MiB;
constexpr size_t WS_QRAW = WS_MISC + 4 * MiB;
constexpr size_t WS_KVRAW = WS_QRAW + 48 * MiB;
constexpr size_t WS_KF = WS_KVRAW + 64 * MiB;
constexpr size_t WS_AO = WS_KF + 48 * MiB;
constexpr size_t WS_XC = WS_AO + 32 * MiB;
constexpr size_t WS_DTS = WS_XC + 96 * MiB;
constexpr size_t WS_CDEC = WS_DTS + 2 * MiB;
constexpr size_t WS_ST = WS_CDEC + 1 * MiB;
constexpr size_t WS_YPRE = WS_ST + 256 * MiB;
constexpr size_t WS_Y = WS_YPRE + 128 * MiB;
constexpr size_t WS_TMPF = WS_Y + 64 * MiB;
constexpr size_t WS_MERGED = WS_TMPF + 64 * MiB;
constexpr size_t WS_PE = WS_MERGED + 32 * MiB;
constexpr size_t WS_PB = WS_PE + 32 * MiB;
constexpr size_t WS_COS = WS_PB + 16 * MiB;
constexpr size_t WS_SIN = WS_COS + 1 * MiB;
constexpr size_t WS_END = WS_SIN + 1 * MiB;
static_assert(WS_END <= 1936 * MiB, "d_ws budget (4 x the largest input)");

constexpr int RING_OFF = 0, RING_BYTES = 131072;
constexpr int LDSCTL_OFF = RING_BYTES, MISC_OFF = LDSCTL_OFF + 320;
constexpr int EXTRA_OFF = LDSCTL_OFF + 512, LDS_BYTES = 147456, EXTRA_BYTES = LDS_BYTES - EXTRA_OFF;

__device__ __forceinline__ unsigned f2bf(float f) { unsigned u = __builtin_bit_cast(unsigned, f); return (u + 0x7fffu + ((u >> 16) & 1u)) >> 16; }
__device__ __forceinline__ float bf2f(unsigned h) { return __builtin_bit_cast(float, h << 16); }
typedef __bf16 bf16x2_t __attribute__((ext_vector_type(2)));
__device__ __forceinline__ unsigned pk2(float lo, float hi) { const f32x2 v = {lo, hi}; const bf16x2_t b = __builtin_convertvector(v, bf16x2_t); return __builtin_bit_cast(unsigned, b); }
__device__ __forceinline__ u32x4 pack8(const float (&v)[8]) { u32x4 w; w.x = pk2(v[0], v[1]); w.y = pk2(v[2], v[3]); w.z = pk2(v[4], v[5]); w.w = pk2(v[6], v[7]); return w; }
__device__ __forceinline__ void unpack8(u32x4 w, float (&v)[8]) {
    v[0] = bf2f(w.x & 0xffffu); v[1] = bf2f(w.x >> 16); v[2] = bf2f(w.y & 0xffffu); v[3] = bf2f(w.y >> 16);
    v[4] = bf2f(w.z & 0xffffu); v[5] = bf2f(w.z >> 16); v[6] = bf2f(w.w & 0xffffu); v[7] = bf2f(w.w >> 16); }
__device__ __forceinline__ float wave_sum(float v) {
#pragma unroll
    for (int o = 1; o < 64; o <<= 1) v += __shfl_xor(v, o);
    return v;
}
__device__ __forceinline__ float wave_max(float v) {
#pragma unroll
    for (int o = 1; o < 64; o <<= 1) v = fmaxf(v, __shfl_xor(v, o));
    return v;
}
__device__ __forceinline__ int otid() { int t = threadIdx.x; asm volatile("" : "+v"(t)); return t; }
__device__ __forceinline__ float sigmoidf_(float x) { return 1.f / (1.f + __expf(-x)); }
__device__ __forceinline__ float siluf_(float x) { return x / (1.f + __expf(-x)); }

#define XB_TMO      128
#define XB_XCNT(j)  (256  + 64 * (j))
#define XB_XSUB(j)  (1280 + 64 * (j))
#define XB_XGEN(j)  (2304 + 64 * (j))
#define XB_TOP      3328
#define XB_TOPGEN   3392
#define XCD_BAR_WORDS 3456
#define XB_SPIN_CAP (1u << 18)
__device__ __forceinline__ unsigned xb_ld(unsigned* p)              { return __hip_atomic_load(p, __ATOMIC_RELAXED, __HIP_MEMORY_SCOPE_AGENT); }
__device__ __forceinline__ unsigned xb_add(unsigned* p, unsigned v) { return __hip_atomic_fetch_add(p, v, __ATOMIC_RELAXED, __HIP_MEMORY_SCOPE_AGENT); }
__device__ __forceinline__ unsigned xb_xcc_id() { return (unsigned)__builtin_amdgcn_s_getreg((3 << 11) | 20) & 0xFu; }
#define XB_SPIN(cond, bar) do { unsigned _sp = 0; while (cond) { __builtin_amdgcn_s_sleep(1); \
    if ((++_sp & 255u) == 0u) { if (xb_ld(&(bar)[XB_TMO])) break; if (_sp > XB_SPIN_CAP) { atomicAdd(&(bar)[XB_TMO], 1u); break; } } } } while (0)
struct XcdBarrier { unsigned* bar; unsigned x; volatile LAS unsigned* st; };
__device__ __forceinline__ XcdBarrier xcd_barrier_post(unsigned* bar, volatile LAS unsigned* st) {
    XcdBarrier b; b.bar = bar; b.x = xb_xcc_id(); b.st = st;
    if (threadIdx.x == 0) (void)xb_add(&bar[XB_XCNT(b.x)], 1u);
    return b;
}
__device__ __forceinline__ void xcd_barrier_complete(unsigned* bar, unsigned x, unsigned& nloc, unsigned& nx) {
    const unsigned G = gridDim.x * gridDim.y * gridDim.z;
    unsigned sum, cnt, mine, sp = 0u;
    for (;;) {
        sum = 0u; cnt = 0u; mine = 0u;
#pragma unroll
        for (unsigned j = 0; j < 16; ++j) { const unsigned c = xb_ld(&bar[XB_XCNT(j)]); sum += c; cnt += (c > 0u) ? 1u : 0u; mine = (j == x) ? c : mine; }
        if (sum == G) break;
        __builtin_amdgcn_s_sleep(1);
        if ((++sp & 255u) == 0u) { if (xb_ld(&bar[XB_TMO])) break; if (sp > XB_SPIN_CAP) { atomicAdd(&bar[XB_TMO], 1u); break; } }
    }
    nloc = mine > 0u ? mine : 1u; nx = cnt > 0u ? cnt : 1u;
}
__device__ __forceinline__ void xcd_barrier(const XcdBarrier& b) {
    asm volatile("s_waitcnt vmcnt(0)" ::: "memory");
    __syncthreads();
    if (threadIdx.x == 0) {
        unsigned* bar = b.bar;
        __builtin_amdgcn_s_waitcnt(0);
        unsigned nloc = b.st[0], nx = b.st[1];
        if (nloc == 0u) { xcd_barrier_complete(bar, b.x, nloc, nx); b.st[0] = nloc; b.st[1] = nx; }
        const unsigned old = xb_add(&bar[XB_XSUB(b.x)], 1u);
        const unsigned gen = old / nloc;
        if (old + 1u == (gen + 1u) * nloc) {
            __builtin_amdgcn_fence(__ATOMIC_RELEASE, "agent");
            asm volatile("s_waitcnt vmcnt(0)" ::: "memory");
            const unsigned og = xb_add(&bar[XB_TOP], 1u);
            const unsigned tg = og / nx;
            if (og + 1u == (tg + 1u) * nx) xb_add(&bar[XB_TOPGEN], 1u);
            else XB_SPIN(xb_ld(&bar[XB_TOPGEN]) == tg, bar);
            __builtin_amdgcn_fence(__ATOMIC_ACQUIRE, "agent");
            xb_add(&bar[XB_XGEN(b.x)], 1u);
            asm volatile("s_waitcnt vmcnt(0)" ::: "memory");
        } else {
            XB_SPIN(xb_ld(&bar[XB_XGEN(b.x)]) == gen, bar);
            __builtin_amdgcn_fence(__ATOMIC_ACQUIRE, "agent");
            asm volatile("s_waitcnt vmcnt(0)" ::: "memory");
        }
    }
    __syncthreads();
}

namespace pg8 {
typedef unsigned short bf16_t;
constexpr int BM = 256, BK = 64, HALF = 128, HTB = HALF * BK * 2, STAGE_BYTES = 8 * HTB, NXCD = 8, WGM = 8;
__host__ __device__ __forceinline__ int lds_byte(int r, int c) { const int st = (r >> 4) * 2 + (c >> 5), rr = r & 15, cc = c & 31, ob = rr * 64 + cc * 2; return st * 1024 + (ob ^ (((ob >> 9) & 1) << 5)); }
__host__ __device__ __forceinline__ void stage_rc(int b, int& R, int& C) { const int st = b / 1024, sb = b % 1024, swz = sb ^ (((sb >> 9) & 1) << 5); R = (st >> 1) * 16 + swz / 64; C = (st & 1) * 32 + (swz % 64) / 2; }
__host__ __device__ __forceinline__ int perm32(int rho) { const int n = rho >> 4, i = rho & 15; return 8 * (i >> 2) + 4 * n + (i & 3); }
struct Unit { int pm, pn; };
struct Gemm { const bf16_t* A; const bf16_t* Bt; int M, N, K, lda; };
struct StaticOrder {
    int nM, nN, nwg, G, c;
    __host__ __device__ void init(int M_, int N_, int G_, int c_) { nM = M_ / BM; nN = N_ / BM; nwg = nM * nN; G = G_; c = c_; }
    __host__ __device__ bool next(int i, Unit& u) const {
        const long L = (long)i * G + c; if (L >= nwg) return false;
        int wgid = (int)L; { const int q = nwg / NXCD, r = nwg % NXCD, xcd = wgid % NXCD, off = wgid / NXCD; wgid = (xcd < r ? xcd * (q + 1) : r * (q + 1) + (xcd - r) * q) + off; }
        const int nig = WGM * nN, gid = wgid / nig, fm = gid * WGM, gsz = (nM - fm) < WGM ? (nM - fm) : WGM;
        u.pm = fm + ((wgid % nig) % gsz); u.pn = (wgid % nig) / gsz; return true;
    }
    __device__ __forceinline__ void a_ready(const Unit&) const {}
    __device__ __forceinline__ void done(const Unit&) const {}
};

template <class Epi, class Sched>
__device__ __forceinline__ void gemm_phase(LAS unsigned char* lds, const Gemm g, const Sched& S, const Epi& E) {
    const int tid = otid(), wid = __builtin_amdgcn_readfirstlane(tid >> 6), lane = tid & 63, wr = wid >> 2, wc = wid & 3, fr = lane & 15, fq = lane >> 4;
    const int K = g.K, nt = K / BK, lda = g.lda;
    unsigned voffA[2], voffB[2];
#pragma unroll
    for (int i = 0; i < 2; ++i) { int R, C; stage_rc(tid * 16 + i * 8192, R, C); const int Rb = (R & ~31) + perm32(R & 31);
        voffA[i] = (unsigned)(R * lda + C) * 2u; voffB[i] = (unsigned)(Rb * K + C) * 2u; }
    const size_t kstep = (size_t)(BK * 2);
    const size_t hstepA = (size_t)HALF * lda * 2, hstepB = (size_t)HALF * K * 2;
    const size_t tstepA = 2 * hstepA, tstepB = 2 * hstepB;
    const unsigned ldsw = (unsigned)wid * 1024u;
    const int aoff = lds_byte(wr * 64 + fr, fq * 8), boff = lds_byte(wc * 32 + fr, fq * 8);
#define PG8_SA(b, h) (((b) * 2 + (h)) * HTB)
#define PG8_SB(b, h) ((4 + (b) * 2 + (h)) * HTB)
#define PG8_STAGE(bufoff, gbase, voff) do { _Pragma("unroll") for (int _i = 0; _i < 2; ++_i) \
        __builtin_amdgcn_global_load_lds((const unsigned*)((const char*)(gbase) + (voff)[_i]), (LAS unsigned*)(lds + (bufoff) + ldsw + _i * 8192), 16, 0, 0); } while (0)
#define PG8_LDA(dst, b, h) do { _Pragma("unroll") for (int m = 0; m < 4; ++m) _Pragma("unroll") for (int k = 0; k < 2; ++k) dst[m][k] = *(const LAS bf16x8*)(lds + PG8_SA(b, h) + aoff + m * 2048 + k * 1024); } while (0)
#define PG8_LDB(dst, b, h) do { _Pragma("unroll") for (int n = 0; n < 2; ++n) _Pragma("unroll") for (int k = 0; k < 2; ++k) dst[n][k] = *(const LAS bf16x8*)(lds + PG8_SB(b, h) + boff + n * 2048 + k * 1024); } while (0)
#define PG8_MMA(ai, bj, At, Bt) do { __builtin_amdgcn_s_setprio(1); _Pragma("unroll") for (int m = 0; m < 4; ++m) _Pragma("unroll") for (int n = 0; n < 2; ++n) _Pragma("unroll") for (int k = 0; k < 2; ++k) \
        acc[ai][bj][m][n] = __builtin_amdgcn_mfma_f32_16x16x32_bf16(Bt[n][k], At[m][k], acc[ai][bj][m][n], 0, 0, 0); __builtin_amdgcn_s_setprio(0); } while (0)
#define PG8_WAIT_V(n) asm volatile("s_waitcnt vmcnt(" #n ")" ::: "memory")
#define PG8_WAIT_L(n) asm volatile("s_waitcnt lgkmcnt(" #n ")" ::: "memory")
#define PG8_BAR __builtin_amdgcn_s_barrier()
#define PG8_SCHED __builtin_amdgcn_sched_barrier(0)
    Unit cur, nxt; int ui = 0;
    if (!S.next(0, cur)) return;
    f32x4 acc[2][2][4][2];
#pragma unroll
    for (int a = 0; a < 2; ++a)
#pragma unroll
        for (int b = 0; b < 2; ++b)
#pragma unroll
            for (int m = 0; m < 4; ++m)
#pragma unroll
                for (int n = 0; n < 2; ++n) acc[a][b][m][n] = (f32x4){0.f, 0.f, 0.f, 0.f};
    bf16x8 At[4][2], B0[2][2], B1[2][2];
    const char* cA = (const char*)g.A + (size_t)cur.pm * tstepA; const char* cB = (const char*)g.Bt + (size_t)cur.pn * tstepB;
    S.a_ready(cur);
    PG8_STAGE(PG8_SB(0, 0), cB, voffB); PG8_STAGE(PG8_SB(0, 1), cB + hstepB, voffB); PG8_STAGE(PG8_SA(0, 0), cA, voffA); PG8_STAGE(PG8_SA(0, 1), cA + hstepA, voffA);
    if (wr == 1) PG8_BAR;
    PG8_WAIT_V(2); PG8_BAR;
    PG8_STAGE(PG8_SB(1, 0), cB + kstep, voffB); PG8_STAGE(PG8_SA(1, 0), cA + kstep, voffA); PG8_STAGE(PG8_SB(1, 1), cB + hstepB + kstep, voffB);
    PG8_WAIT_V(6); PG8_BAR;
    for (;;) {
        const bool has_next = S.next(ui + 1, nxt);
        const char* nA = has_next ? (const char*)g.A + (size_t)nxt.pm * tstepA : cA; const char* nB = has_next ? (const char*)g.Bt + (size_t)nxt.pn * tstepB : cB;
        for (int t = 0; t < nt; t += 2) {
            const bool last = (t == nt - 2);
            const char* a1 = cA + (size_t)(t + 1) * kstep;
            const char* a2 = last ? nA : cA + (size_t)(t + 2) * kstep; const char* b2 = last ? nB : cB + (size_t)(t + 2) * kstep;
            const char* a3 = a2 + kstep; const char* b3 = b2 + kstep;
            if (last && has_next) S.a_ready(nxt);
            PG8_LDB(B0, 0, 0); PG8_LDB(B1, 0, 1); PG8_SCHED; PG8_LDA(At, 0, 0); PG8_STAGE(PG8_SA(1, 1), a1 + hstepA, voffA);
            PG8_WAIT_V(8); PG8_WAIT_L(0); PG8_BAR; PG8_MMA(0, 0, At, B0); PG8_MMA(0, 1, At, B1); PG8_BAR; PG8_SCHED;
            PG8_LDA(At, 0, 1); PG8_STAGE(PG8_SB(0, 0), b2, voffB); PG8_STAGE(PG8_SB(0, 1), b2 + hstepB, voffB); PG8_STAGE(PG8_SA(0, 0), a2, voffA);
            PG8_WAIT_V(8); PG8_WAIT_L(0); PG8_BAR; PG8_MMA(1, 0, At, B0); PG8_MMA(1, 1, At, B1); PG8_BAR; PG8_SCHED;
            PG8_LDB(B0, 1, 0); PG8_LDB(B1, 1, 1); PG8_SCHED; PG8_LDA(At, 1, 0); PG8_STAGE(PG8_SA(0, 1), a2 + hstepA, voffA);
            PG8_WAIT_V(8); PG8_WAIT_L(0); PG8_BAR; PG8_MMA(0, 0, At, B0); PG8_MMA(0, 1, At, B1); PG8_BAR; PG8_SCHED;
            PG8_LDA(At, 1, 1); PG8_STAGE(PG8_SB(1, 0), b3, voffB); PG8_STAGE(PG8_SB(1, 1), b3 + hstepB, voffB); PG8_STAGE(PG8_SA(1, 0), a3, voffA);
            PG8_WAIT_V(8); PG8_WAIT_L(0); PG8_BAR; PG8_MMA(1, 0, At, B0); PG8_MMA(1, 1, At, B1); PG8_BAR; PG8_SCHED;
        }
        if (wr == 0) PG8_BAR;
        {
            const int row0 = cur.pm * BM + wr * 64 + fr, col00 = cur.pn * BM + wc * 32 + 8 * fq;
            typename Epi::Regs RA[2], RB[2];
#define PG8_EL(R, gi) do { const int _r = row0 + ((gi) >> 2) * HALF + ((gi) & 3) * 16; E.load(_r, col00, R[0]); E.load(_r, col00 + HALF, R[1]); } while (0)
#define PG8_EA(R, gi) do { const int _r = row0 + ((gi) >> 2) * HALF + ((gi) & 3) * 16; _Pragma("unroll") for (int bj = 0; bj < 2; ++bj) { \
                const f32x4 _p = acc[(gi) >> 2][bj][(gi) & 3][0], _q = acc[(gi) >> 2][bj][(gi) & 3][1]; const float _v[8] = {_p[0], _p[1], _p[2], _p[3], _q[0], _q[1], _q[2], _q[3]}; \
                E.apply(_r, col00 + bj * HALF, _v, R[bj]); } } while (0)
            PG8_EL(RA, 0);
#pragma unroll
            for (int gi = 0; gi < 8; gi += 2) {
                PG8_EL(RB, gi + 1); PG8_SCHED; PG8_EA(RA, gi); PG8_SCHED;
                if (gi + 2 < 8) PG8_EL(RA, gi + 2);
                PG8_SCHED; PG8_EA(RB, gi + 1); PG8_SCHED;
            }
#undef PG8_EL
#undef PG8_EA
        }
        S.done(cur);
        if (!has_next) break;
#pragma unroll
        for (int a = 0; a < 2; ++a)
#pragma unroll
            for (int b = 0; b < 2; ++b)
#pragma unroll
                for (int m = 0; m < 4; ++m)
#pragma unroll
                    for (int n = 0; n < 2; ++n) acc[a][b][m][n] = (f32x4){0.f, 0.f, 0.f, 0.f};
        cur = nxt; cA = nA; cB = nB; ++ui;
        if (wr == 1) PG8_BAR;
    }
    PG8_WAIT_V(0);
    PG8_BAR;
#undef PG8_SA
#undef PG8_SB
#undef PG8_STAGE
#undef PG8_LDA
#undef PG8_LDB
#undef PG8_MMA
#undef PG8_WAIT_V
#undef PG8_WAIT_L
#undef PG8_BAR
#undef PG8_SCHED
}

template <class Epi>
__device__ __forceinline__ void gemm_simple(const Gemm g, const Epi& E, int G, int wg) {
    const int tid = otid(), wid = tid >> 6, lane = tid & 63, fr = lane & 15, fq = lane >> 4;
    const int nbn = g.N / 32, nblk = (g.M / 16) * nbn;
    for (int it = wg * NWAVES + wid; it < nblk; it += G * NWAVES) {
        const int m0 = (it / nbn) * 16, n0 = (it % nbn) * 32;
        f32x4 acc0 = {0.f, 0.f, 0.f, 0.f}, acc1 = {0.f, 0.f, 0.f, 0.f};
        const bf16_t* ap = g.A + (size_t)(m0 + fr) * g.lda + 8 * fq;
        const bf16_t* bp0 = g.Bt + (size_t)(n0 + perm32(fr)) * g.K + 8 * fq;
        const bf16_t* bp1 = g.Bt + (size_t)(n0 + perm32(16 + fr)) * g.K + 8 * fq;
        for (int k0 = 0; k0 < g.K; k0 += 32) {
            const bf16x8 a = *(const bf16x8*)(ap + k0), b0 = *(const bf16x8*)(bp0 + k0), b1 = *(const bf16x8*)(bp1 + k0);
            acc0 = __builtin_amdgcn_mfma_f32_16x16x32_bf16(b0, a, acc0, 0, 0, 0);
            acc1 = __builtin_amdgcn_mfma_f32_16x16x32_bf16(b1, a, acc1, 0, 0, 0);
        }
        const float v[8] = {acc0[0], acc0[1], acc0[2], acc0[3], acc1[0], acc1[1], acc1[2], acc1[3]};
        typename Epi::Regs rg; E.load(m0 + fr, n0 + 8 * fq, rg); E.apply(m0 + fr, n0 + 8 * fq, v, rg);
    }
}
}

#ifndef GEMM_REPEAT
#define GEMM_REPEAT 1
#endif
template <class Epi>
__device__ __forceinline__ void run_gemm(LAS unsigned char* lds, const pg8::Gemm g, const Epi& E, int G, int wg, int rep = 1) {
#if FAST_GEMM
    if (rep < 0) { pg8::gemm_simple<Epi>(g, E, G, wg); return; }
    for (int rr = 0; rr < rep; ++rr) { pg8::StaticOrder S; S.init(g.M, g.N, G, wg); pg8::gemm_phase<Epi, pg8::StaticOrder>(lds, g, S, E); }
#else
    pg8::gemm_simple<Epi>(g, E, G, wg);
#endif
}

constexpr float SSQ_SCALE = 16777216.f, SSQ_INV = 1.f / 16777216.f;
__device__ __forceinline__ void ssq_add(u64* dst, int row, const float (&v)[8]) {
    float s = 0.f;
#pragma unroll
    for (int j = 0; j < 8; ++j) s += v[j] * v[j];
    s += __shfl_xor(s, 16); s += __shfl_xor(s, 32);
    if ((otid() & 63) < 16) atomicAdd(dst + row, (u64)(s * SSQ_SCALE));
}
__device__ __forceinline__ float ld_ssq(const u64* p) { return (float)__hip_atomic_load(p, __ATOMIC_RELAXED, __HIP_MEMORY_SCOPE_AGENT) * SSQ_INV; }
__device__ __forceinline__ void st_f32x8(float* p, const float (&v)[8]) { *(f32x4*)p = (f32x4){v[0], v[1], v[2], v[3]}; *(f32x4*)(p + 4) = (f32x4){v[4], v[5], v[6], v[7]}; }
__device__ __forceinline__ void ld_f32x8(const float* p, float (&v)[8]) { const f32x4 a = *(const f32x4*)p, b = *(const f32x4*)(p + 4); v[0] = a.x; v[1] = a.y; v[2] = a.z; v[3] = a.w; v[4] = b.x; v[5] = b.y; v[6] = b.z; v[7] = b.w; }
__device__ __forceinline__ void ld_bf16x8(const bf16* p, float (&v)[8]) { unpack8(*(const u32x4*)p, v); }

struct EpiInProj {
    const u64* ssq; u64* ssqc; bf16* proj; float* misc;
    struct Regs { float rs; };
    __device__ __forceinline__ void load(int row, int col0, Regs& r) const { r.rs = rsqrtf(ld_ssq(ssq + row) * (1.f / DM) + EPS); }
    __device__ __forceinline__ void apply(int row, int col0, const float (&a)[8], const Regs& r) const {
        float v[8];
#pragma unroll
        for (int j = 0; j < 8; ++j) v[j] = a[j] * r.rs;
        const int tile = col0 >> 8;
        if (tile == 60) { const int c = col0 - PC_KR; if (c < 128) st_f32x8(misc + (size_t)row * 128 + c, v); return; }
        if (tile >= 44) {
#pragma unroll
            for (int j = 0; j < 8; ++j) v[j] = sigmoidf_(v[j]);
        }
        *(u32x4*)(proj + (size_t)row * DINP + col0) = pack8(v);
        if (tile < 4) ssq_add(ssqc + (size_t)(tile >> 1) * M, row, v);
    }
};
struct EpiScaleBf16 {
    const u64* ssq; float inv_n; bf16* O; int ldo;
    struct Regs { float rs; };
    __device__ __forceinline__ void load(int row, int col0, Regs& r) const { r.rs = ssq ? rsqrtf(ld_ssq(ssq + row) * inv_n + EPS) : 1.f; }
    __device__ __forceinline__ void apply(int row, int col0, const float (&a)[8], const Regs& r) const {
        float v[8];
#pragma unroll
        for (int j = 0; j < 8; ++j) v[j] = a[j] * r.rs;
        *(u32x4*)(O + (size_t)row * ldo + col0) = pack8(v);
    }
};
struct EpiGateF32 {
    const bf16* proj; float* T;
    struct Regs { u32x4 g; };
    __device__ __forceinline__ void load(int row, int col0, Regs& r) const { r.g = *(const u32x4*)(proj + (size_t)row * DINP + PC_G + col0); }
    __device__ __forceinline__ void apply(int row, int col0, const float (&a)[8], const Regs& r) const {
        float g[8], v[8]; unpack8(r.g, g);
#pragma unroll
        for (int j = 0; j < 8; ++j) v[j] = a[j] * g[j];
        st_f32x8(T + (size_t)row * DM + col0, v);
    }
};
struct EpiMerge {
    const bf16* proj; const float* T; bf16* O;
    struct Regs { u32x4 g; f32x4 t0, t1; };
    __device__ __forceinline__ void load(int row, int col0, Regs& r) const { r.g = *(const u32x4*)(proj + (size_t)row * DINP + PC_G + DM + col0);
        r.t0 = *(const f32x4*)(T + (size_t)row * DM + col0); r.t1 = *(const f32x4*)(T + (size_t)row * DM + col0 + 4); }
    __device__ __forceinline__ void apply(int row, int col0, const float (&a)[8], const Regs& r) const {
        float g[8], v[8]; unpack8(r.g, g);
        const float t[8] = {r.t0.x, r.t0.y, r.t0.z, r.t0.w, r.t1.x, r.t1.y, r.t1.z, r.t1.w};
#pragma unroll
        for (int j = 0; j < 8; ++j) v[j] = t[j] + a[j] * g[j];
        *(u32x4*)(O + (size_t)row * DM + col0) = pack8(v);
    }
};
struct EpiResid {
    float* X; bf16* XB; u64* ssq_next;
    struct Regs { f32x4 x0, x1; };
    __device__ __forceinline__ void load(int row, int col0, Regs& r) const { r.x0 = *(const f32x4*)(X + (size_t)row * DM + col0); r.x1 = *(const f32x4*)(X + (size_t)row * DM + col0 + 4); }
    __device__ __forceinline__ void apply(int row, int col0, const float (&a)[8], const Regs& r) const {
        float x[8] = {r.x0.x, r.x0.y, r.x0.z, r.x0.w, r.x1.x, r.x1.y, r.x1.z, r.x1.w};
#pragma unroll
        for (int j = 0; j < 8; ++j) x[j] += a[j];
        st_f32x8(X + (size_t)row * DM + col0, x);
        *(u32x4*)(XB + (size_t)row * DM + col0) = pack8(x);
        if (ssq_next) ssq_add(ssq_next, row, x);
    }
};
struct EpiUp {
    const u64* ssq; bf16* U;
    struct Regs { float rs; };
    __device__ __forceinline__ void load(int row, int col0, Regs& r) const { r.rs = rsqrtf(ld_ssq(ssq + row) * (1.f / DM) + EPS); }
    __device__ __forceinline__ void apply(int row, int col0, const float (&a)[8], const Regs& r) const {
        float v[8];
#pragma unroll
        for (int j = 0; j < 8; ++j) { const float t = fmaxf(a[j] * r.rs, 0.f); v[j] = t * t; }
        *(u32x4*)(U + (size_t)row * DFF + col0) = pack8(v);
    }
};
struct EpiPleGate {
    const u64* ssq; const bf16* PE; float* X; bf16* XB; u64* ssq_next;
    struct Regs { float rs; f32x4 x0, x1; u32x4 pe; };
    __device__ __forceinline__ void load(int row, int col0, Regs& r) const { r.rs = rsqrtf(ld_ssq(ssq + row) * (1.f / DM) + EPS);
        r.x0 = *(const f32x4*)(X + (size_t)row * DM + col0); r.x1 = *(const f32x4*)(X + (size_t)row * DM + col0 + 4); r.pe = *(const u32x4*)(PE + (size_t)row * DM + col0); }
    __device__ __forceinline__ void apply(int row, int col0, const float (&a)[8], const Regs& r) const {
        float x[8] = {r.x0.x, r.x0.y, r.x0.z, r.x0.w, r.x1.x, r.x1.y, r.x1.z, r.x1.w}, pe[8]; unpack8(r.pe, pe);
#pragma unroll
        for (int j = 0; j < 8; ++j) x[j] += pe[j] * sigmoidf_(a[j] * r.rs);
        st_f32x8(X + (size_t)row * DM + col0, x);
        *(u32x4*)(XB + (size_t)row * DM + col0) = pack8(x);
        if (ssq_next) ssq_add(ssq_next, row, x);
    }
};

__device__ __forceinline__ void transpose_item(const float* W, int K, int Nsrc, int nsrc0, const float* gain, bf16* WT, int ndst0, int k0, LAS float* scr, int lane) {
#pragma unroll 8
    for (int i = 0; i < 32; ++i) { const int kk = 2 * i + (lane >> 5);
        float w = 0.f; if (nsrc0 >= 0) { w = W[(size_t)(k0 + kk) * Nsrc + nsrc0 + (lane & 31)]; if (gain) w *= gain[k0 + kk]; }
        scr[kk * 33 + (lane & 31)] = w; }
    LDS_WAIT(); asm volatile("" ::: "memory");
    const int c = lane & 7;
#pragma unroll
    for (int j = 0; j < 4; ++j) { const int n = (lane >> 3) + 8 * j; const LAS float* s = scr + (8 * c) * 33 + n;
        u32x4 o; o.x = pk2(s[0 * 33], s[1 * 33]); o.y = pk2(s[2 * 33], s[3 * 33]); o.z = pk2(s[4 * 33], s[5 * 33]); o.w = pk2(s[6 * 33], s[7 * 33]);
        *(u32x4*)(WT + (size_t)(ndst0 + n) * K + k0 + 8 * c) = o; }
    LDS_WAIT(); asm volatile("" ::: "memory");
}
__host__ __device__ __forceinline__ int inproj_src_col(int n) {
    if (n < PC_Z) return n;
    if (n < PC_G) return n + 64;
    if (n < PC_KR) return n + 128;
    if (n < PC_DT) return n - PC_KR + 1024;
    if (n < PC_PAD) return n - PC_DT + 11328;
    return -1;
}
constexpr int I_IN = (DM / 64) * (DINP / 32), I_UQ = (QL / 64) * (NH * QK / 32), I_UKV = (KVL / 64) * (NH * 256 / 32), I_OM = (DM / 64) * (DM / 32), I_OS = (DI / 64) * (DM / 32),
              I_OUT = I_OM, I_UP = (DM / 64) * (DFF / 32), I_DN = (DFF / 64) * (DM / 32), I_PG = I_OM, I_PL = (PLE / 64) * (DM / 32),
              I_LAYER = I_IN + I_UQ + I_UKV + I_OM + I_OS + I_OUT + I_UP + I_DN + I_PG + I_PL;
__device__ __forceinline__ void prologue_weights(const float* const (&inp)[26], unsigned char* ws, LAS unsigned char* lds, int G, int wg) {
    const int wave = otid() >> 6, lane = otid() & 63;
    LAS float* scr = (LAS float*)(lds + RING_OFF + wave * 16384);
    for (int it = wg * NWAVES + wave; it < DEPTH * I_LAYER; it += G * NWAVES) {
        const int l = it / I_LAYER; int r = it % I_LAYER;
        unsigned char* wl = ws + WS_W + (size_t)l * WL_BYTES;
        if (r < I_IN) { const int nblk = DINP / 32, kb = r / nblk, nb = r % nblk;
            transpose_item(inp[4] + (size_t)l * DM * DIN, DM, DIN, inproj_src_col(32 * nb), inp[3] + l * DM, (bf16*)(wl + WL_IN), 32 * nb, 64 * kb, scr, lane); continue; } r -= I_IN;
        if (r < I_UQ) { const int nblk = NH * QK / 32, kb = r / nblk, nb = r % nblk;
            transpose_item(inp[6] + (size_t)l * QL * NH * QK, QL, NH * QK, 32 * nb, inp[5] + l * QL, (bf16*)(wl + WL_UQ), 32 * nb, 64 * kb, scr, lane); continue; } r -= I_UQ;
        if (r < I_UKV) { const int nblk = NH * 256 / 32, kb = r / nblk, nb = r % nblk;
            transpose_item(inp[8] + (size_t)l * KVL * NH * 256, KVL, NH * 256, 32 * nb, inp[7] + l * KVL, (bf16*)(wl + WL_UKV), 32 * nb, 64 * kb, scr, lane); continue; } r -= I_UKV;
        if (r < I_OM) { const int nblk = DM / 32, kb = r / nblk, nb = r % nblk;
            transpose_item(inp[11] + (size_t)l * DM * DM, DM, DM, 32 * nb, nullptr, (bf16*)(wl + WL_OM), 32 * nb, 64 * kb, scr, lane); continue; } r -= I_OM;
        if (r < I_OS) { const int nblk = DM / 32, kb = r / nblk, nb = r % nblk;
            transpose_item(inp[18] + (size_t)l * DI * DM, DI, DM, 32 * nb, inp[17] + l * DI, (bf16*)(wl + WL_OS), 32 * nb, 64 * kb, scr, lane); continue; } r -= I_OS;
        if (r < I_OUT) { const int nblk = DM / 32, kb = r / nblk, nb = r % nblk;
            transpose_item(inp[19] + (size_t)l * DM * DM, DM, DM, 32 * nb, nullptr, (bf16*)(wl + WL_OUT), 32 * nb, 64 * kb, scr, lane); continue; } r -= I_OUT;
        if (r < I_UP) { const int nblk = DFF / 32, kb = r / nblk, nb = r % nblk;
            transpose_item(inp[21] + (size_t)l * DM * DFF, DM, DFF, 32 * nb, inp[20] + l * DM, (bf16*)(wl + WL_UP), 32 * nb, 64 * kb, scr, lane); continue; } r -= I_UP;
        if (r < I_DN) { const int nblk = DM / 32, kb = r / nblk, nb = r % nblk;
            transpose_item(inp[22] + (size_t)l * DFF * DM, DFF, DM, 32 * nb, nullptr, (bf16*)(wl + WL_DN), 32 * nb, 64 * kb, scr, lane); continue; } r -= I_DN;
        if (r < I_PG) { const int nblk = DM / 32, kb = r / nblk, nb = r % nblk;
            transpose_item(inp[24] + (size_t)l * DM * DM, DM, DM, 32 * nb, inp[23] + l * DM, (bf16*)(wl + WL_PG), 32 * nb, 64 * kb, scr, lane); continue; } r -= I_PG;
        { const int nblk = DM / 32, kb = r / nblk, nb = r % nblk;
            transpose_item(inp[25] + (size_t)l * PLE * DM, PLE, DM, 32 * nb, nullptr, (bf16*)(wl + WL_PL), 32 * nb, 64 * kb, scr, lane); }
    }
}
__device__ __forceinline__ void prologue_rows(const float* const (&inp)[26], float* out, unsigned char* ws, int G, int wg) {
    const int wave = otid() >> 6, lane = otid() & 63, gw = wg * NWAVES + wave, NGW = G * NWAVES;
    const float* x = inp[0]; bf16* XB = (bf16*)(ws + WS_XB); u64* ssq0 = (u64*)((unsigned*)(ws + WS_CTL) + CW_SSQX);
    for (int m = gw; m < M; m += NGW) {
        float s = 0.f;
#pragma unroll
        for (int j = 0; j < 8; ++j) { const f32x4 v = *(const f32x4*)(x + (size_t)m * DM + j * 256 + lane * 4);
            *(f32x4*)(out + (size_t)m * DM + j * 256 + lane * 4) = v; s += v.x * v.x + v.y * v.y + v.z * v.z + v.w * v.w;
            u32x2 o; o.x = pk2(v.x, v.y); o.y = pk2(v.z, v.w); *(u32x2*)(XB + (size_t)m * DM + j * 256 + lane * 4) = o; }
        s = wave_sum(s); if (lane == 0) ssq0[m] = (u64)(s * SSQ_SCALE);
    }
    {
        u64* z0 = (u64*)((unsigned*)(ws + WS_CTL) + CW_SSQX) + M; const int nz = (DEPTH * 3 - 1) * M + DEPTH * 2 * M;
        for (int i = wg * NTHR + otid(); i < nz; i += G * NTHR) z0[i] = 0ull;
    }
    const float* p = inp[1]; bf16* PB = (bf16*)(ws + WS_PB);
    for (size_t i = (size_t)wg * NTHR + otid(); i < (size_t)DEPTH * M * PLE / 8; i += (size_t)G * NTHR) { float v[8]; ld_f32x8(p + i * 8, v); *(u32x4*)(PB + i * 8) = pack8(v); }
    const int* pos = (const int*)inp[2]; float* COS = (float*)(ws + WS_COS); float* SIN = (float*)(ws + WS_SIN);
    for (int i = wg * NTHR + otid(); i < M * 32; i += G * NTHR) { const int m = i >> 5, k = i & 31;
        const float invf = 1.0f / (float)pow(10000.0, (double)k / 32.0);
        const float ang = (float)pos[m] * invf;
        COS[i] = (float)cos((double)ang); SIN[i] = (float)sin((double)ang); }
}

__device__ __forceinline__ void phase_kfin(const bf16* KVRAW, const float* MISC, const float* kw, const float* COS, const float* SIN, bf16* KF, int G, int wg) {
    const int wave = otid() >> 6, lane = otid() & 63;
    const float w0 = kw[lane], w1 = kw[64 + lane], w2 = kw[128 + lane];
    for (int it = wg * NWAVES + wave; it < M * NH; it += G * NWAVES) {
        const int m = it >> 4, h = it & 15;
        const float a0 = bf2f(KVRAW[(size_t)m * 4096 + h * 256 + lane]), a1 = bf2f(KVRAW[(size_t)m * 4096 + h * 256 + 64 + lane]), a2 = MISC[(size_t)m * 128 + lane];
        const float ss = wave_sum(a0 * a0 + a1 * a1 + a2 * a2), rs = rsqrtf(ss * (1.f / QK) + EPS);
        const float t2 = a2 * rs * w2, o2 = __shfl_xor(t2, 32);
        const float c = COS[m * 32 + (lane & 31)], s = SIN[m * 32 + (lane & 31)];
        const float r2 = lane < 32 ? (t2 * c - o2 * s) : (o2 * s + t2 * c);
        bf16* o = KF + (size_t)m * (NH * QK) + h * QK;
        o[lane] = (bf16)f2bf(a0 * rs * w0); o[64 + lane] = (bf16)f2bf(a1 * rs * w1); o[128 + lane] = (bf16)f2bf(r2);
    }
}
__device__ __forceinline__ void phase_ssdpre(const bf16* PROJ, const float* MISC, const float* cw, const float* cb, const float* dtb, bf16* XC, float* DTS, int G, int wg) {
    for (int i = wg * NTHR + otid(); i < M * (CONVD / 8); i += G * NTHR) {
        const int m = i / (CONVD / 8), c0 = (i % (CONVD / 8)) * 8, t = m % SEQ;
        float acc[8]; ld_f32x8(cb + c0, acc);
#pragma unroll
        for (int j = 0; j < CW; ++j) { const int tt = t - (CW - 1) + j;
            if (tt >= 0) { float xv[8], wv[8]; ld_bf16x8(PROJ + (size_t)(m - (CW - 1) + j) * DINP + PC_XBC + c0, xv); ld_f32x8(cw + j * CONVD + c0, wv);
#pragma unroll
                for (int e = 0; e < 8; ++e) acc[e] += xv[e] * wv[e]; } }
#pragma unroll
        for (int e = 0; e < 8; ++e) acc[e] = siluf_(acc[e]);
        *(u32x4*)(XC + (size_t)m * CONVD + c0) = pack8(acc);
    }
    for (int i = wg * NTHR + otid(); i < M * SH; i += G * NTHR) { const int m = i >> 6, h = i & 63;
        const float x = MISC[(size_t)m * 128 + 64 + h] + dtb[h], e = __expf(-fabsf(x));
        const float lp = e < 0.01f ? e * (1.f - e * (0.5f - e * (1.f / 3.f))) : __logf(1.f + e); DTS[i] = fmaxf(x, 0.f) + lp; }
}
__device__ __forceinline__ void phase_ssdnorm(const float* YPRE, const bf16* PROJ, bf16* Y, int G, int wg) {
    const int wave = otid() >> 6, lane = otid() & 63;
    for (int it = wg * NWAVES + wave; it < M * SG; it += G * NWAVES) {
        const int m = it >> 3, g = it & 7, c0 = g * 512 + lane * 8;
        float y[8], z[8]; ld_f32x8(YPRE + (size_t)m * DI + c0, y); ld_bf16x8(PROJ + (size_t)m * DINP + PC_Z + c0, z);
        float s = 0.f;
#pragma unroll
        for (int e = 0; e < 8; ++e) { y[e] *= siluf_(z[e]); s += y[e] * y[e]; }
        const float rs = rsqrtf(wave_sum(s) * (1.f / 512.f) + EPS);
#pragma unroll
        for (int e = 0; e < 8; ++e) y[e] *= rs;
        *(u32x4*)(Y + (size_t)m * DI + c0) = pack8(y);
    }
}

namespace attn {
typedef float f32x16 __attribute__((ext_vector_type(16)));
typedef short s16x4 __attribute__((ext_vector_type(4)));
constexpr int KB_BYTES = 64 * QK * 2, VB_BYTES = 64 * VD * 2;
constexpr int L_K0 = 0, L_K1 = KB_BYTES, L_V0 = 2 * KB_BYTES, L_V1 = 2 * KB_BYTES + VB_BYTES, L_WS = 2 * KB_BYTES + 2 * VB_BYTES;
constexpr float QSCALE = 0.07216878364870322f * 1.4426950408889634f;
constexpr float THR2 = 8.f;
#define ASBAR() __builtin_amdgcn_sched_barrier(0)
__device__ __forceinline__ int crow(int r, int hi) { return (r & 3) + 8 * (r >> 2) + 4 * hi; }
__device__ __forceinline__ void partialSM(f32x16& p0, f32x16& p1, float& m_reg, float& alpha) {
    float pmax = p0[0];
#pragma unroll
    for (int r = 1; r < 16; ++r) pmax = fmaxf(pmax, p0[r]);
#pragma unroll
    for (int r = 0; r < 16; ++r) pmax = fmaxf(pmax, p1[r]);
    { auto rr = __builtin_amdgcn_permlane32_swap(__float_as_uint(pmax), __float_as_uint(pmax), false, false); pmax = fmaxf(__uint_as_float(rr[0]), __uint_as_float(rr[1])); }
    float mn;
    if (__builtin_expect(__all(pmax - m_reg <= THR2), 1)) { mn = m_reg; alpha = 1.f; }
    else { mn = fmaxf(m_reg, pmax); alpha = __builtin_amdgcn_exp2f(m_reg - mn); m_reg = mn; }
#pragma unroll
    for (int r = 0; r < 16; ++r) p0[r] = __builtin_amdgcn_exp2f(p0[r] - mn);
#pragma unroll
    for (int r = 0; r < 16; ++r) p1[r] = __builtin_amdgcn_exp2f(p1[r] - mn);
}
__device__ __forceinline__ void finishSM(const f32x16& p0, const f32x16& p1, float alpha, float& l_reg, bf16x8& pa0, bf16x8& pa1, bf16x8& pa2, bf16x8& pa3) {
    float ps = 0.f;
#pragma unroll
    for (int r = 0; r < 16; ++r) ps += p0[r];
#pragma unroll
    for (int r = 0; r < 16; ++r) ps += p1[r];
    { auto rr = __builtin_amdgcn_permlane32_swap(__float_as_uint(ps), __float_as_uint(ps), false, false); ps = __uint_as_float(rr[0]) + __uint_as_float(rr[1]); }
    l_reg = l_reg * alpha + ps;
#define PK4(P, BASE, OUT) do { unsigned a0 = pk2(P[BASE + 0], P[BASE + 1]), a1 = pk2(P[BASE + 2], P[BASE + 3]);   \
    unsigned b0 = pk2(P[BASE + 4], P[BASE + 5]), b1 = pk2(P[BASE + 6], P[BASE + 7]);                              \
    auto r0 = __builtin_amdgcn_permlane32_swap(a0, b0, false, false); auto r1 = __builtin_amdgcn_permlane32_swap(a1, b1, false, false); \
    u32x4 w = {r0[0], r1[0], r0[1], r1[1]}; OUT = __builtin_bit_cast(bf16x8, w); } while (0)
    PK4(p0, 0, pa0); PK4(p0, 8, pa1); PK4(p1, 0, pa2); PK4(p1, 8, pa3);
#undef PK4
}
__device__ __forceinline__ void qkt(f32x16& p0, f32x16& p1, LAS const unsigned char* Ks, const bf16x8 (&qr)[12], int r32, int hi) {
    p0 = (f32x16){0.f, 0.f, 0.f, 0.f, 0.f, 0.f, 0.f, 0.f, 0.f, 0.f, 0.f, 0.f, 0.f, 0.f, 0.f, 0.f}; p1 = p0;
    const int sw = (r32 & 7) << 4, ra = r32 * (QK * 2), rb = (32 + r32) * (QK * 2);
#pragma unroll
    for (int d0 = 0; d0 < 12; ++d0) { const int cb = (d0 * 32 + hi * 16) ^ sw;
        const bf16x8 b0 = *(LAS const bf16x8*)(Ks + ra + cb), b1 = *(LAS const bf16x8*)(Ks + rb + cb);
        p0 = __builtin_amdgcn_mfma_f32_32x32x16_bf16(b0, qr[d0], p0, 0, 0, 0);
        p1 = __builtin_amdgcn_mfma_f32_32x32x16_bf16(b1, qr[d0], p1, 0, 0, 0); }
}
__device__ __forceinline__ void v_pos_src(int p, int& k, int& c) { const int s = p >> 5, kk = (s >> 2) * 8 + ((p & 31) >> 2); c = (s & 3) * 32 + (p & 3) * 8; k = (kk & ~0xC) | ((kk & 4) << 1) | ((kk & 8) >> 1); }
__device__ __forceinline__ int v_rd_base(int lane) { return ((lane & 3) << 3) | (((lane >> 2) & 3) << 6) | (((lane >> 4) & 1) << 5) | (((lane >> 5) & 1) << 8); }
constexpr int v_rd_off(int d0, int ks, int half) { return d0 * 512 + ks * 4096 + half * 2048; }
template <int OFF> __device__ __forceinline__ s16x4 tr_read(int vb) { s16x4 r; asm volatile("ds_read_b64_tr_b16 %0, %1 offset:%2" : "=&v"(r) : "v"(vb), "i"(OFF) : "memory"); return r; }
template <int D0> __device__ __forceinline__ void pv_one(f32x16& od, int vb, bf16x8 pa0, bf16x8 pa1, bf16x8 pa2, bf16x8 pa3) {
    const s16x4 l0 = tr_read<v_rd_off(D0, 0, 0)>(vb), h0 = tr_read<v_rd_off(D0, 0, 1)>(vb), l1 = tr_read<v_rd_off(D0, 1, 0)>(vb), h1 = tr_read<v_rd_off(D0, 1, 1)>(vb);
    const s16x4 l2 = tr_read<v_rd_off(D0, 2, 0)>(vb), h2 = tr_read<v_rd_off(D0, 2, 1)>(vb), l3 = tr_read<v_rd_off(D0, 3, 0)>(vb), h3 = tr_read<v_rd_off(D0, 3, 1)>(vb);
    asm volatile("s_waitcnt lgkmcnt(0)" ::: "memory"); ASBAR();
#define PKV(L, H) (bf16x8){L[0], L[1], L[2], L[3], H[0], H[1], H[2], H[3]}
    od = __builtin_amdgcn_mfma_f32_32x32x16_bf16(pa0, PKV(l0, h0), od, 0, 0, 0);
    od = __builtin_amdgcn_mfma_f32_32x32x16_bf16(pa1, PKV(l1, h1), od, 0, 0, 0);
    od = __builtin_amdgcn_mfma_f32_32x32x16_bf16(pa2, PKV(l2, h2), od, 0, 0, 0);
    od = __builtin_amdgcn_mfma_f32_32x32x16_bf16(pa3, PKV(l3, h3), od, 0, 0, 0);
#undef PKV
}
__device__ __forceinline__ void pv_d0(f32x16 (&o)[4], int vb, bf16x8 pa0, bf16x8 pa1, bf16x8 pa2, bf16x8 pa3) {
    pv_one<0>(o[0], vb, pa0, pa1, pa2, pa3); pv_one<1>(o[1], vb, pa0, pa1, pa2, pa3); pv_one<2>(o[2], vb, pa0, pa1, pa2, pa3); pv_one<3>(o[3], vb, pa0, pa1, pa2, pa3);
}

__device__ __forceinline__ void attn_unit(int b, int h, int qb, const bf16* QRAW, const bf16* KF, const bf16* KVRAW, const float* qw, const float* COS, const float* SIN, bf16* AO, LAS unsigned char* lds) {
    const int tid = otid(), wid = __builtin_amdgcn_readfirstlane(tid >> 6), lane = tid & 63, r32 = lane & 31, hi = lane >> 5;
    LAS float* wsf = (LAS float*)(lds + L_WS) + wid * 64; LAS float* li_l = wsf; LAS float* al_l = wsf + 32;
    const int m = b * SEQ + qb * 256 + wid * 32 + r32;
    bf16x8 qr[12];
    {
        const bf16* qp = QRAW + (size_t)m * (NH * QK) + h * QK + hi * 8;
        u32x4 raw[12]; float ss = 0.f;
#pragma unroll
        for (int d0 = 0; d0 < 12; ++d0) { raw[d0] = *(const u32x4*)(qp + d0 * 16); float f[8]; unpack8(raw[d0], f);
#pragma unroll
            for (int j = 0; j < 8; ++j) ss += f[j] * f[j]; }
        ss += __shfl_xor(ss, 32);
        const float rs = rsqrtf(ss * (1.f / QK) + EPS) * QSCALE;
#pragma unroll
        for (int d0 = 0; d0 < 8; ++d0) { float f[8], w[8]; unpack8(raw[d0], f); ld_f32x8(qw + d0 * 16 + hi * 8, w);
#pragma unroll
            for (int j = 0; j < 8; ++j) f[j] = f[j] * rs * w[j];
            qr[d0] = __builtin_bit_cast(bf16x8, pack8(f)); }
#pragma unroll
        for (int t = 0; t < 2; ++t) { float x1[8], x2[8], w1[8], w2[8], c[8], s[8], o1[8], o2[8];
            unpack8(raw[8 + t], x1); unpack8(raw[10 + t], x2); ld_f32x8(qw + 128 + t * 16 + hi * 8, w1); ld_f32x8(qw + 160 + t * 16 + hi * 8, w2);
            ld_f32x8(COS + (size_t)m * 32 + t * 16 + hi * 8, c); ld_f32x8(SIN + (size_t)m * 32 + t * 16 + hi * 8, s);
#pragma unroll
            for (int j = 0; j < 8; ++j) { const float a = x1[j] * rs * w1[j], bq = x2[j] * rs * w2[j]; o1[j] = a * c[j] - bq * s[j]; o2[j] = a * s[j] + bq * c[j]; }
            qr[8 + t] = __builtin_bit_cast(bf16x8, pack8(o1)); qr[10 + t] = __builtin_bit_cast(bf16x8, pack8(o2)); }
    }
    const bf16* kbase = KF + (size_t)(b * SEQ) * (NH * QK) + h * QK;
    const bf16* vbase = KVRAW + (size_t)(b * SEQ) * 4096 + h * 256 + 128;
    unsigned koff[3], voff[2];
#pragma unroll
    for (int i = 0; i < 3; ++i) { const int p = i * 512 + tid, row = p / 24, cc = (p % 24) ^ (row & 7); koff[i] = (unsigned)(row * (NH * QK) + cc * 8) * 2u; }
#pragma unroll
    for (int i = 0; i < 2; ++i) { int k, c; v_pos_src(i * 512 + tid, k, c); voff[i] = (unsigned)(k * 4096 + c) * 2u; }
    const unsigned ldsw = (unsigned)wid * 1024u;
#define ATT_STAGE(kb, vb_, key0) do { const char* _kg = (const char*)(kbase + (size_t)(key0) * (NH * QK)); const char* _vg = (const char*)(vbase + (size_t)(key0) * 4096); \
        _Pragma("unroll") for (int _i = 0; _i < 3; ++_i) __builtin_amdgcn_global_load_lds((const unsigned*)(_kg + koff[_i]), (LAS unsigned*)(lds + (kb) + ldsw + _i * 8192), 16, 0, 0); \
        _Pragma("unroll") for (int _i = 0; _i < 2; ++_i) __builtin_amdgcn_global_load_lds((const unsigned*)(_vg + voff[_i]), (LAS unsigned*)(lds + (vb_) + ldsw + _i * 8192), 16, 0, 0); } while (0)
    float m_reg = -1e30f, l_reg = 0.f;
    f32x16 o[4];
#pragma unroll
    for (int d = 0; d < 4; ++d) o[d] = (f32x16){0.f, 0.f, 0.f, 0.f, 0.f, 0.f, 0.f, 0.f, 0.f, 0.f, 0.f, 0.f, 0.f, 0.f, 0.f, 0.f};
    const int nt = 4 * qb + 4, myc = 4 * qb + (wid >> 1);
    const int vrd = v_rd_base(lane);
#define ATT_TILE(kb, vb_, j) do { if ((j) <= myc) { f32x16 p0, p1; float alpha; bf16x8 pa0, pa1, pa2, pa3; \
        qkt(p0, p1, (LAS const unsigned char*)(lds + (kb)), qr, r32, hi); partialSM(p0, p1, m_reg, alpha); \
        if (__any(alpha < 1.f)) { if (hi == 0) al_l[r32] = alpha; asm volatile("s_waitcnt lgkmcnt(0)" ::: "memory"); \
            _Pragma("unroll") for (int d = 0; d < 4; ++d) _Pragma("unroll") for (int r = 0; r < 16; ++r) o[d][r] *= al_l[crow(r, hi)]; } \
        finishSM(p0, p1, alpha, l_reg, pa0, pa1, pa2, pa3); ASBAR(); \
        pv_d0(o, (int)(uintptr_t)(lds + (vb_)) + vrd, pa0, pa1, pa2, pa3); } } while (0)
    ATT_STAGE(L_K0, L_V0, 0);
    asm volatile("s_waitcnt vmcnt(0)" ::: "memory"); __syncthreads();
    for (int j = 0; j < nt; j += 2) {
        ATT_STAGE(L_K1, L_V1, (j + 1) * 64);
        ATT_TILE(L_K0, L_V0, j);
        asm volatile("s_waitcnt vmcnt(0)" ::: "memory"); __syncthreads();
        if (j + 2 < nt) ATT_STAGE(L_K0, L_V0, (j + 2) * 64);
        ATT_TILE(L_K1, L_V1, j + 1);
        asm volatile("s_waitcnt vmcnt(0)" ::: "memory"); __syncthreads();
    }
#undef ATT_STAGE
#undef ATT_TILE
    if (hi == 0) li_l[r32] = l_reg;
    asm volatile("s_waitcnt lgkmcnt(0)" ::: "memory");
    float rli[16];
#pragma unroll
    for (int r = 0; r < 16; ++r) rli[r] = __builtin_amdgcn_rcpf(li_l[crow(r, hi)]);
    bf16* ob = AO + (size_t)(b * SEQ + qb * 256 + wid * 32) * DM + h * VD;
#pragma unroll
    for (int r = 0; r < 16; ++r) { const int orow = crow(r, hi);
#pragma unroll
        for (int d0 = 0; d0 < 4; ++d0) ob[(size_t)orow * DM + d0 * 32 + r32] = (bf16)f2bf(o[d0][r] * rli[r]); }
    asm volatile("s_waitcnt lgkmcnt(0)" ::: "memory");
}
__device__ __forceinline__ void phase(const bf16* QRAW, const bf16* KF, const bf16* KVRAW, const float* qw, const float* COS, const float* SIN, bf16* AO, LAS unsigned char* lds, int G, int wg) {
    for (int pr = wg; pr < NB * NH * 8; pr += G) {
        const int x = pr & 7, slot = pr >> 3, bh = x * 4 + (slot >> 3), pi = slot & 7, b = bh / NH, h = bh % NH;
        attn_unit(b, h, 15 - pi, QRAW, KF, KVRAW, qw, COS, SIN, AO, lds);
        attn_unit(b, h, pi, QRAW, KF, KVRAW, qw, COS, SIN, AO, lds);
    }
}
}

namespace ssd {
using attn::f32x16; using attn::s16x4; using attn::crow; using attn::v_rd_base; using attn::tr_read;
constexpr int L_BT = 0, L_XT = 16384, L_WSH = 16384 + 65536, L_SSQ = L_WSH + 8192, L_END = L_SSQ + 2048;
static_assert(L_END <= RING_BYTES, "ssd lds");
template <int NCS> __device__ __forceinline__ void vimg_src(int p, int& k, int& c) { const int s = p >> 5, kk = (s / NCS) * 8 + ((p & 31) >> 2); c = (s % NCS) * 32 + (p & 3) * 8; k = (kk & ~0xC) | ((kk & 4) << 1) | ((kk & 8) >> 1); }
template <int NCS> constexpr int vimg_off(int d0, int ks, int half) { return ((2 * ks + half) * NCS + d0) * 512; }
#define SSD_PKV(L, H) (bf16x8){L[0], L[1], L[2], L[3], H[0], H[1], H[2], H[3]}
#define SSD_LWAIT() do { asm volatile("s_waitcnt lgkmcnt(0)" ::: "memory"); __builtin_amdgcn_sched_barrier(0); } while (0)
constexpr f32x16 Z16 = {0.f, 0.f, 0.f, 0.f, 0.f, 0.f, 0.f, 0.f, 0.f, 0.f, 0.f, 0.f, 0.f, 0.f, 0.f, 0.f};
__device__ __forceinline__ float wave_scan64(float v, int lane) {
#pragma unroll
    for (int o = 1; o < 64; o <<= 1) { const float n = __shfl_up(v, o); if (lane >= o) v += n; }
    return v;
}
__device__ __forceinline__ void stage_x(const bf16* XC, int m0, int h, LAS unsigned char* xt, int lane) {
    u32x4 v[8];
#pragma unroll
    for (int i = 0; i < 8; ++i) { int k, c; vimg_src<2>(i * 64 + lane, k, c); v[i] = *(const u32x4*)(XC + (size_t)(m0 + k) * CONVD + h * HD + c); }
#pragma unroll
    for (int i = 0; i < 8; ++i) *(LAS u32x4*)(xt + (i * 64 + lane) * 16) = v[i];
}

__device__ __forceinline__ void phase_states(const bf16* XC, const float* DTS, const float* a_log, bf16* ST16, float* CDEC, LAS unsigned char* lds, int G, int wg) {
    const int tid = otid(), wid = __builtin_amdgcn_readfirstlane(tid >> 6), lane = tid & 63, r32 = lane & 31, hi = lane >> 5;
    LAS unsigned char* xt = lds + L_XT + wid * 8192; LAS float* wsh = (LAS float*)(lds + L_WSH + wid * 1024);
    const int vrd = v_rd_base(lane);
    for (int it = wg; it < NB * NCH * SG; it += G) {
        const int g = it % SG, bc = it / SG, m0 = bc * TC, h = g * HPG + wid;
        __syncthreads();
        {
            u32x4 v[2];
#pragma unroll
            for (int i = 0; i < 2; ++i) { int k, c; vimg_src<4>(i * 512 + tid, k, c); v[i] = *(const u32x4*)(XC + (size_t)(m0 + k) * CONVD + DI + g * SN + c); }
#pragma unroll
            for (int i = 0; i < 2; ++i) *(LAS u32x4*)(lds + L_BT + (i * 512 + tid) * 16) = v[i];
        }
        stage_x(XC, m0, h, xt, lane);
        { const float A = -__expf(a_log[h]), dt = DTS[(size_t)(m0 + lane) * SH + h]; const float ac = wave_scan64(dt * A, lane), last = __shfl(ac, 63);
          wsh[lane] = __expf(last - ac) * dt; if (lane == 63) CDEC[bc * SH + h] = __expf(last); }
        __syncthreads();
        f32x16 acc[2][4];
#pragma unroll
        for (int a = 0; a < 2; ++a)
#pragma unroll
            for (int b = 0; b < 4; ++b) acc[a][b] = Z16;
        const int xb = (int)(uintptr_t)xt + vrd, bb = (int)(uintptr_t)(lds + L_BT) + vrd;
#define SSD_KS(KSI) do { \
            const s16x4 xl0 = tr_read<vimg_off<2>(0, KSI, 0)>(xb), xh0 = tr_read<vimg_off<2>(0, KSI, 1)>(xb), xl1 = tr_read<vimg_off<2>(1, KSI, 0)>(xb), xh1 = tr_read<vimg_off<2>(1, KSI, 1)>(xb); \
            const s16x4 bl0 = tr_read<vimg_off<4>(0, KSI, 0)>(bb), bh0 = tr_read<vimg_off<4>(0, KSI, 1)>(bb), bl1 = tr_read<vimg_off<4>(1, KSI, 0)>(bb), bh1 = tr_read<vimg_off<4>(1, KSI, 1)>(bb); \
            const s16x4 bl2 = tr_read<vimg_off<4>(2, KSI, 0)>(bb), bh2 = tr_read<vimg_off<4>(2, KSI, 1)>(bb), bl3 = tr_read<vimg_off<4>(3, KSI, 0)>(bb), bh3 = tr_read<vimg_off<4>(3, KSI, 1)>(bb); \
            const f32x4 w0 = *(LAS const f32x4*)(wsh + 16 * KSI + 8 * hi), w1 = *(LAS const f32x4*)(wsh + 16 * KSI + 8 * hi + 4); \
            SSD_LWAIT(); \
            bf16x8 xa[2]; { const bf16x8 r0 = SSD_PKV(xl0, xh0), r1 = SSD_PKV(xl1, xh1); float f[8]; \
                unpack8(__builtin_bit_cast(u32x4, r0), f); f[0] *= w0.x; f[1] *= w0.y; f[2] *= w0.z; f[3] *= w0.w; f[4] *= w1.x; f[5] *= w1.y; f[6] *= w1.z; f[7] *= w1.w; xa[0] = __builtin_bit_cast(bf16x8, pack8(f)); \
                unpack8(__builtin_bit_cast(u32x4, r1), f); f[0] *= w0.x; f[1] *= w0.y; f[2] *= w0.z; f[3] *= w0.w; f[4] *= w1.x; f[5] *= w1.y; f[6] *= w1.z; f[7] *= w1.w; xa[1] = __builtin_bit_cast(bf16x8, pack8(f)); } \
            const bf16x8 bf0 = SSD_PKV(bl0, bh0), bf1 = SSD_PKV(bl1, bh1), bf2 = SSD_PKV(bl2, bh2), bf3 = SSD_PKV(bl3, bh3); \
            _Pragma("unroll") for (int a = 0; a < 2; ++a) { \
                acc[a][0] = __builtin_amdgcn_mfma_f32_32x32x16_bf16(xa[a], bf0, acc[a][0], 0, 0, 0); acc[a][1] = __builtin_amdgcn_mfma_f32_32x32x16_bf16(xa[a], bf1, acc[a][1], 0, 0, 0); \
                acc[a][2] = __builtin_amdgcn_mfma_f32_32x32x16_bf16(xa[a], bf2, acc[a][2], 0, 0, 0); acc[a][3] = __builtin_amdgcn_mfma_f32_32x32x16_bf16(xa[a], bf3, acc[a][3], 0, 0, 0); } } while (0)
        SSD_KS(0); SSD_KS(1); SSD_KS(2); SSD_KS(3);
#undef SSD_KS
        bf16* o = ST16 + ((size_t)bc * SH + h) * (HD * SN);
#pragma unroll
        for (int a = 0; a < 2; ++a)
#pragma unroll
            for (int r = 0; r < 16; ++r) { const int p = 32 * a + crow(r, hi);
#pragma unroll
                for (int b = 0; b < 4; ++b) o[p * SN + 32 * b + r32] = (bf16)f2bf(acc[a][b][r]); }
    }
}

__device__ __forceinline__ void phase_scan(bf16* ST16, const float* CDEC, int G, int wg) {
    constexpr int PER_B8 = SH * HD * SN / 8;
    for (int e = wg * NTHR + otid(); e < NB * PER_B8; e += G * NTHR) {
        const int b = e / PER_B8, r8 = e % PER_B8, h = r8 / (HD * SN / 8);
        float st[8];
#pragma unroll
        for (int j = 0; j < 8; ++j) st[j] = 0.f;
        bf16* base = ST16 + (size_t)b * NCH * (SH * HD * SN) + (size_t)r8 * 8;
#pragma unroll 8
        for (int c = 0; c < NCH; ++c) { bf16* p = base + (size_t)c * (SH * HD * SN); float v[8]; ld_bf16x8(p, v); *(u32x4*)p = pack8(st); const float cd = CDEC[(b * NCH + c) * SH + h];
#pragma unroll
            for (int j = 0; j < 8; ++j) st[j] = st[j] * cd + v[j]; }
    }
}

__device__ __forceinline__ void phase_out(const bf16* XC, const float* DTS, const float* a_log, const float* dskip, const bf16* ST16, const bf16* PROJ, bf16* Y, LAS unsigned char* lds, int G, int wg) {
    const int tid = otid(), wid = __builtin_amdgcn_readfirstlane(tid >> 6), lane = tid & 63, r32 = lane & 31, hi = lane >> 5;
    LAS unsigned char* xt = lds + L_XT + wid * 8192; LAS float* acs = (LAS float*)(lds + L_WSH + wid * 1024); LAS float* dts = acs + 64; LAS float* rsl = acs + 128;
    LAS float* ssqx = (LAS float*)(lds + L_SSQ);
    const int vrd = v_rd_base(lane);
    for (int it = wg; it < NB * NCH * SG; it += G) {
        const int g = it % SG, bc = it / SG, m0 = bc * TC, h = g * HPG + wid;
        __syncthreads();
        stage_x(XC, m0, h, xt, lane);
        { const float A = -__expf(a_log[h]), dt = DTS[(size_t)(m0 + lane) * SH + h]; acs[lane] = wave_scan64(dt * A, lane); dts[lane] = dt; }
        const float dk = dskip[h];
        const bf16* cg = XC + (size_t)(m0 + r32) * CONVD + DI + SG * SN + g * SN + 8 * hi;
        const bf16* bg = XC + (size_t)(m0 + r32) * CONVD + DI + g * SN + 8 * hi;
        const bf16* pg = ST16 + (((size_t)bc * SH + h) * HD + r32) * SN + 8 * hi;
        f32x16 acc[2][2];
#pragma unroll
        for (int a = 0; a < 2; ++a)
#pragma unroll
            for (int b = 0; b < 2; ++b) acc[a][b] = Z16;
#pragma unroll 2
        for (int kn = 0; kn < 8; ++kn) {
            const bf16x8 c0 = *(const bf16x8*)(cg + kn * 16), c1 = *(const bf16x8*)(cg + (size_t)32 * CONVD + kn * 16);
            const bf16x8 q0 = *(const bf16x8*)(pg + kn * 16), q1 = *(const bf16x8*)(pg + 32 * SN + kn * 16);
            acc[0][0] = __builtin_amdgcn_mfma_f32_32x32x16_bf16(c0, q0, acc[0][0], 0, 0, 0); acc[0][1] = __builtin_amdgcn_mfma_f32_32x32x16_bf16(c0, q1, acc[0][1], 0, 0, 0);
            acc[1][0] = __builtin_amdgcn_mfma_f32_32x32x16_bf16(c1, q0, acc[1][0], 0, 0, 0); acc[1][1] = __builtin_amdgcn_mfma_f32_32x32x16_bf16(c1, q1, acc[1][1], 0, 0, 0);
        }
        LDS_WAIT();
#pragma unroll
        for (int a = 0; a < 2; ++a)
#pragma unroll
            for (int r = 0; r < 16; ++r) { const float ea = __expf(acs[32 * a + crow(r, hi)]); acc[a][0][r] *= ea; acc[a][1][r] *= ea; }
        const int xb = (int)(uintptr_t)xt + vrd;
#define SSD_TB(TB) do { f32x16 p0 = Z16, p1 = Z16; \
            _Pragma("unroll 2") for (int kn = 0; kn < 8; ++kn) { const bf16x8 cf = *(const bf16x8*)(cg + (size_t)(32 * TB) * CONVD + kn * 16), b0 = *(const bf16x8*)(bg + kn * 16); \
                p0 = __builtin_amdgcn_mfma_f32_32x32x16_bf16(b0, cf, p0, 0, 0, 0); \
                if (TB == 1) { const bf16x8 b1 = *(const bf16x8*)(bg + (size_t)32 * CONVD + kn * 16); p1 = __builtin_amdgcn_mfma_f32_32x32x16_bf16(b1, cf, p1, 0, 0, 0); } } \
            const int t = 32 * TB + r32; const float at = acs[t]; \
            _Pragma("unroll") for (int r = 0; r < 16; ++r) { const int s0 = crow(r, hi); \
                { const float w = (s0 <= t) ? __expf(fminf(at - acs[s0], 0.f)) * dts[s0] : 0.f; p0[r] = p0[r] * w + ((s0 == t) ? dk : 0.f); } \
                if (TB == 1) { const int s1 = 32 + s0; const float w = (s1 <= t) ? __expf(fminf(at - acs[s1], 0.f)) * dts[s1] : 0.f; p1[r] = p1[r] * w + ((s1 == t) ? dk : 0.f); } } \
            bf16x8 pa0, pa1, pa2, pa3; \
            { PK4_(p0, 0, pa0); PK4_(p0, 8, pa1); if (TB == 1) { PK4_(p1, 0, pa2); PK4_(p1, 8, pa3); } } \
            _Pragma("unroll") for (int pb = 0; pb < 2; ++pb) { \
                const s16x4 l0 = pb ? tr_read<vimg_off<2>(1, 0, 0)>(xb) : tr_read<vimg_off<2>(0, 0, 0)>(xb), h0 = pb ? tr_read<vimg_off<2>(1, 0, 1)>(xb) : tr_read<vimg_off<2>(0, 0, 1)>(xb); \
                const s16x4 l1 = pb ? tr_read<vimg_off<2>(1, 1, 0)>(xb) : tr_read<vimg_off<2>(0, 1, 0)>(xb), h1 = pb ? tr_read<vimg_off<2>(1, 1, 1)>(xb) : tr_read<vimg_off<2>(0, 1, 1)>(xb); \
                s16x4 l2 = l0, h2 = h0, l3 = l1, h3 = h1; \
                if (TB == 1) { l2 = pb ? tr_read<vimg_off<2>(1, 2, 0)>(xb) : tr_read<vimg_off<2>(0, 2, 0)>(xb); h2 = pb ? tr_read<vimg_off<2>(1, 2, 1)>(xb) : tr_read<vimg_off<2>(0, 2, 1)>(xb); \
                               l3 = pb ? tr_read<vimg_off<2>(1, 3, 0)>(xb) : tr_read<vimg_off<2>(0, 3, 0)>(xb); h3 = pb ? tr_read<vimg_off<2>(1, 3, 1)>(xb) : tr_read<vimg_off<2>(0, 3, 1)>(xb); } \
                SSD_LWAIT(); \
                acc[TB][pb] = __builtin_amdgcn_mfma_f32_32x32x16_bf16(pa0, SSD_PKV(l0, h0), acc[TB][pb], 0, 0, 0); acc[TB][pb] = __builtin_amdgcn_mfma_f32_32x32x16_bf16(pa1, SSD_PKV(l1, h1), acc[TB][pb], 0, 0, 0); \
                if (TB == 1) { acc[TB][pb] = __builtin_amdgcn_mfma_f32_32x32x16_bf16(pa2, SSD_PKV(l2, h2), acc[TB][pb], 0, 0, 0); acc[TB][pb] = __builtin_amdgcn_mfma_f32_32x32x16_bf16(pa3, SSD_PKV(l3, h3), acc[TB][pb], 0, 0, 0); } } } while (0)
#define PK4_(P, BASE, OUT) do { unsigned a0_ = pk2(P[BASE + 0], P[BASE + 1]), a1_ = pk2(P[BASE + 2], P[BASE + 3]); unsigned b0_ = pk2(P[BASE + 4], P[BASE + 5]), b1_ = pk2(P[BASE + 6], P[BASE + 7]); \
    auto r0_ = __builtin_amdgcn_permlane32_swap(a0_, b0_, false, false); auto r1_ = __builtin_amdgcn_permlane32_swap(a1_, b1_, false, false); \
    u32x4 w_ = {r0_[0], r1_[0], r0_[1], r1_[1]}; OUT = __builtin_bit_cast(bf16x8, w_); } while (0)
        SSD_TB(0); SSD_TB(1);
#undef SSD_TB
#undef PK4_
        LAS unsigned short* zt = (LAS unsigned short*)xt;
        {
            u32x4 zv[8];
#pragma unroll
            for (int i = 0; i < 8; ++i) zv[i] = *(const u32x4*)(PROJ + (size_t)(m0 + i * 8 + (lane >> 3)) * DINP + PC_Z + h * HD + (lane & 7) * 8);
            LDS_WAIT();
#pragma unroll
            for (int i = 0; i < 8; ++i) *(LAS u32x4*)(xt + (i * 64 + lane) * 16) = zv[i];
        }
        LDS_WAIT();
#pragma unroll
        for (int a = 0; a < 2; ++a)
#pragma unroll
            for (int r = 0; r < 16; ++r) { const int t = 32 * a + crow(r, hi);
                acc[a][0][r] *= siluf_(bf2f(zt[t * 64 + r32])); acc[a][1][r] *= siluf_(bf2f(zt[t * 64 + 32 + r32])); }
        LDS_WAIT();
        LAS float* red = (LAS float*)xt;
#pragma unroll
        for (int a = 0; a < 2; ++a)
#pragma unroll
            for (int r = 0; r < 16; ++r) red[(32 * a + crow(r, hi)) * 32 + r32] = acc[a][0][r] * acc[a][0][r] + acc[a][1][r] * acc[a][1][r];
        LDS_WAIT();
        { float sm = 0.f;
#pragma unroll
          for (int q = 0; q < 8; ++q) { const f32x4 v = *(LAS const f32x4*)(red + lane * 32 + q * 4); sm += (v.x + v.y) + (v.z + v.w); }
          ssqx[wid * 64 + lane] = sm; }
        __syncthreads();
        { float sm = 0.f;
#pragma unroll
          for (int w = 0; w < 8; ++w) sm += ssqx[w * 64 + lane];
          rsl[lane] = rsqrtf(sm * (1.f / 512.f) + EPS); }
        LDS_WAIT();
#pragma unroll
        for (int a = 0; a < 2; ++a)
#pragma unroll
            for (int r = 0; r < 16; ++r) { const int t = 32 * a + crow(r, hi); const float rs = rsl[t];
                zt[t * 64 + r32] = (unsigned short)f2bf(acc[a][0][r] * rs); zt[t * 64 + 32 + r32] = (unsigned short)f2bf(acc[a][1][r] * rs); }
        LDS_WAIT();
#pragma unroll
        for (int i = 0; i < 8; ++i) *(u32x4*)(Y + (size_t)(m0 + i * 8 + (lane >> 3)) * DI + h * HD + (lane & 7) * 8) = *(LAS const u32x4*)(xt + (i * 64 + lane) * 16);
    }
}
}

__device__ __forceinline__ void phase_attn_simple(const bf16* QRAW, const bf16* KF, const bf16* KVRAW, const float* qw, const float* COS, const float* SIN, bf16* AO, LAS unsigned char* lds, int G, int wg) {
    const int wave = otid() >> 6, lane = otid() & 63;
    LAS float* sc = (LAS float*)(lds + RING_OFF + wave * 16384);
    LAS float* qs = (LAS float*)(lds + EXTRA_OFF + wave * 768);
    const float w0 = qw[lane], w1 = qw[64 + lane], w2 = qw[128 + lane];
    for (int it = wg * NWAVES + wave; it < NB * NH * SEQ; it += G * NWAVES) {
        const int t = it % SEQ, bh = it / SEQ, h = bh % NH, b = bh / NH, m = b * SEQ + t;
        const bf16* qp = QRAW + (size_t)m * (NH * QK) + h * QK;
        const float a0 = bf2f(qp[lane]), a1 = bf2f(qp[64 + lane]), a2 = bf2f(qp[128 + lane]);
        const float ss = wave_sum(a0 * a0 + a1 * a1 + a2 * a2), rs = rsqrtf(ss * (1.f / QK) + EPS);
        const float t2 = a2 * rs * w2, o2 = __shfl_xor(t2, 32);
        const float c = COS[m * 32 + (lane & 31)], s = SIN[m * 32 + (lane & 31)];
        const float r2 = lane < 32 ? (t2 * c - o2 * s) : (o2 * s + t2 * c);
        const float scale = 0.07216878364870322f;
        qs[lane] = a0 * rs * w0 * scale; qs[64 + lane] = a1 * rs * w1 * scale; qs[128 + lane] = r2 * scale;
        LDS_WAIT();
        const int nk = (t / TC + 1) * TC;
        float mx = -3.0e38f;
        for (int j = lane; j < nk; j += 64) {
            const bf16* kp = KF + (size_t)(b * SEQ + j) * (NH * QK) + h * QK;
            float acc = 0.f;
#pragma unroll 4
            for (int d = 0; d < QK; d += 8) { float kv[8]; ld_bf16x8(kp + d, kv);
#pragma unroll
                for (int e = 0; e < 8; ++e) acc += qs[d + e] * kv[e]; }
            sc[j] = acc; mx = fmaxf(mx, acc);
        }
        mx = wave_max(mx);
        LDS_WAIT();
        float l = 0.f;
        for (int j = lane; j < nk; j += 64) { const float p = __expf(sc[j] - mx); sc[j] = p; l += p; }
        l = wave_sum(l);
        LDS_WAIT();
        float o0 = 0.f, o1 = 0.f;
        const bf16* vp = KVRAW + (size_t)(b * SEQ) * 4096 + h * 256 + 128;
#pragma unroll 8
        for (int j = 0; j < nk; ++j) { const float p = sc[j]; o0 += p * bf2f(vp[(size_t)j * 4096 + lane]); o1 += p * bf2f(vp[(size_t)j * 4096 + 64 + lane]); }
        const float il = 1.f / l;
        AO[(size_t)m * DM + h * VD + lane] = (bf16)f2bf(o0 * il); AO[(size_t)m * DM + h * VD + 64 + lane] = (bf16)f2bf(o1 * il);
        LDS_WAIT();
    }
}
__device__ __forceinline__ float wave_scan(float v, int lane) {
#pragma unroll
    for (int o = 1; o < 64; o <<= 1) { const float n = __shfl_up(v, o); if (lane >= o) v += n; }
    return v;
}
__device__ __forceinline__ void phase_ssd_states(const bf16* XC, const float* DTS, const float* a_log, float* ST, float* CDEC, LAS unsigned char* lds, int G, int wg) {
    LAS float* wsh = (LAS float*)(lds + RING_OFF);
    const int tid = otid();
    for (int it = wg; it < NB * NCH * SH; it += G) {
        const int h = it % SH, bc = it / SH, m0 = bc * TC, g = h / HPG;
        __syncthreads();
        if (tid < 64) { const float A = -__expf(a_log[h]), dt = DTS[(size_t)(m0 + tid) * SH + h];
            const float ac = wave_scan(dt * A, tid), last = __shfl(ac, 63);
            wsh[tid] = __expf(last - ac) * dt; if (tid == 63) CDEC[bc * SH + h] = __expf(last); }
        __syncthreads();
        const int p = tid >> 3, n0 = (tid & 7) * 16;
        float acc[16];
#pragma unroll
        for (int e = 0; e < 16; ++e) acc[e] = 0.f;
        for (int s = 0; s < TC; ++s) {
            const float xw = bf2f(XC[(size_t)(m0 + s) * CONVD + h * HD + p]) * wsh[s];
            float b0[8], b1[8]; ld_bf16x8(XC + (size_t)(m0 + s) * CONVD + DI + g * SN + n0, b0); ld_bf16x8(XC + (size_t)(m0 + s) * CONVD + DI + g * SN + n0 + 8, b1);
#pragma unroll
            for (int e = 0; e < 8; ++e) { acc[e] += xw * b0[e]; acc[8 + e] += xw * b1[e]; }
        }
        float* o = ST + (((size_t)bc * SH + h) * HD + p) * SN + n0;
#pragma unroll
        for (int e = 0; e < 16; e += 4) *(f32x4*)(o + e) = (f32x4){acc[e], acc[e + 1], acc[e + 2], acc[e + 3]};
    }
}
__device__ __forceinline__ void phase_ssd_scan(float* ST, const float* CDEC, int G, int wg) {
    constexpr int PER_B = SH * HD * SN;
    for (int e = wg * NTHR + otid(); e < NB * PER_B; e += G * NTHR) {
        const int b = e / PER_B, r = e % PER_B, h = r / (HD * SN);
        float state = 0.f;
        for (int c = 0; c < NCH; ++c) { const size_t idx = (size_t)(b * NCH + c) * PER_B + r; const float tmp = ST[idx]; ST[idx] = state; state = state * CDEC[(b * NCH + c) * SH + h] + tmp; }
    }
}
__device__ __forceinline__ void phase_ssd_out(const bf16* XC, const float* DTS, const float* a_log, const float* dskip, const float* ST, float* YPRE, LAS unsigned char* lds, int G, int wg) {
    LAS float* Mm = (LAS float*)(lds + RING_OFF);
    LAS float* acs = (LAS float*)(lds + RING_OFF + 20480);
    LAS float* dts = acs + 64;
    const int tid = otid();
    for (int it = wg; it < NB * NCH * SH; it += G) {
        const int h = it % SH, bc = it / SH, m0 = bc * TC, g = h / HPG;
        __syncthreads();
        if (tid < 64) { const float A = -__expf(a_log[h]), dt = DTS[(size_t)(m0 + tid) * SH + h]; acs[tid] = wave_scan(dt * A, tid); dts[tid] = dt; }
        __syncthreads();
        for (int i = 0; i < 8; ++i) { const int e = tid + NTHR * i, t = e >> 6, s = e & 63;
            float v = 0.f;
            if (s <= t) { const bf16* cp = XC + (size_t)(m0 + t) * CONVD + DI + SG * SN + g * SN; const bf16* bp = XC + (size_t)(m0 + s) * CONVD + DI + g * SN;
                float dot = 0.f;
#pragma unroll 4
                for (int n = 0; n < SN; n += 8) { float cv[8], bv[8]; ld_bf16x8(cp + n, cv); ld_bf16x8(bp + n, bv);
#pragma unroll
                    for (int q = 0; q < 8; ++q) dot += cv[q] * bv[q]; }
                v = dot * __expf(acs[t] - acs[s]) * dts[s]; }
            Mm[t * 65 + s] = v; }
        __syncthreads();
        const int t = tid >> 3, p0 = (tid & 7) * 8;
        float y[8];
#pragma unroll
        for (int j = 0; j < 8; ++j) y[j] = 0.f;
        for (int s = 0; s < TC; ++s) { float xv[8]; ld_bf16x8(XC + (size_t)(m0 + s) * CONVD + h * HD + p0, xv); const float mv = Mm[t * 65 + s];
#pragma unroll
            for (int j = 0; j < 8; ++j) y[j] += mv * xv[j]; }
        const float ea = __expf(acs[t]), dk = dskip[h];
        const bf16* cp = XC + (size_t)(m0 + t) * CONVD + DI + SG * SN + g * SN;
        float xt[8]; ld_bf16x8(XC + (size_t)(m0 + t) * CONVD + h * HD + p0, xt);
#pragma unroll
        for (int j = 0; j < 8; ++j) { const float* pp = ST + (((size_t)bc * SH + h) * HD + p0 + j) * SN;
            float dot = 0.f;
#pragma unroll 4
            for (int n = 0; n < SN; n += 8) { float cv[8], pv[8]; ld_bf16x8(cp + n, cv); ld_f32x8(pp + n, pv);
#pragma unroll
                for (int q = 0; q < 8; ++q) dot += cv[q] * pv[q]; }
            y[j] += ea * dot + dk * xt[j]; }
        st_f32x8(YPRE + (size_t)(m0 + t) * DI + h * HD + p0, y);
    }
}

#ifndef ATTN_REPEAT
#define ATTN_REPEAT 1
#endif
#ifndef SLOW4
#define SLOW4 1
#endif
constexpr int PPL = FAST_SSD ? 13 : 14, NPH = 1 + DEPTH * PPL;
struct Args { const float* in[26]; float* out; unsigned char* ws; int ph_lo, ph_hi; };
__global__ void __launch_bounds__(NTHR, 2) fwd(Args args) {
    extern __shared__ __attribute__((aligned(16))) unsigned char lds_[];
    LAS unsigned char* lds = (LAS unsigned char*)lds_;
    const int tid = threadIdx.x, G = gridDim.x, wg = blockIdx.x;
    for (int u = tid; u < (LDS_BYTES - LDSCTL_OFF) / 4; u += NTHR) ((LAS unsigned*)(lds + LDSCTL_OFF))[u] = 0u;
    __syncthreads();
    unsigned char* const ws0 = args.ws;
    unsigned* const ctl0 = (unsigned*)(ws0 + WS_CTL);
    const int lo = args.ph_lo, hi = args.ph_hi;
    XcdBarrier bar; bar.bar = ctl0 + CW_BAR; bar.x = 0; bar.st = (volatile LAS unsigned*)(lds + MISC_OFF) + 8;
    if (hi - lo > 1) bar = xcd_barrier_post(ctl0 + CW_BAR, (volatile LAS unsigned*)(lds + MISC_OFF) + 8);
#define INP(i) (args.in[i])
#define WSP(T, off) ((T*)(ws + (off)))
#define X (args.out)
#define SSQX ((u64*)(ctl + CW_SSQX))
#define SSQC ((u64*)(ctl + CW_SSQC))
#define XB0 WSP(bf16, WS_XB)
#define XB1 WSP(bf16, WS_XB1)
#define XB2 WSP(bf16, WS_XB2)
#define PROJ WSP(bf16, WS_PROJ)
#define U WSP(bf16, WS_U)
#define MISC WSP(float, WS_MISC)
#define QRAW WSP(bf16, WS_QRAW)
#define KVRAW WSP(bf16, WS_KVRAW)
#define KF WSP(bf16, WS_KF)
#define AO WSP(bf16, WS_AO)
#define XC WSP(bf16, WS_XC)
#define DTS WSP(float, WS_DTS)
#define CDEC WSP(float, WS_CDEC)
#define ST WSP(float, WS_ST)
#define YPRE WSP(float, WS_YPRE)
#define Y WSP(bf16, WS_Y)
#define TMPF WSP(float, WS_TMPF)
#define MERGED WSP(bf16, WS_MERGED)
#define PE WSP(bf16, WS_PE)
#define PB WSP(bf16, WS_PB)
#define COS WSP(float, WS_COS)
#define SIN WSP(float, WS_SIN)
    int ph = 0;
#define PHASE(...) do { if (lo <= ph && ph < hi) { { unsigned char* ws = ws0; asm volatile("" : "+s"(ws)); unsigned* ctl = (unsigned*)(ws + WS_CTL); __VA_ARGS__; } if (ph + 1 < hi) xcd_barrier(bar); } ++ph; } while (0)

    PHASE({ prologue_weights(args.in, ws, lds, G, wg); prologue_rows(args.in, X, ws, G, wg); });

#pragma unroll 1
    for (int l = 0; l < DEPTH; ++l) {
#define wl (ws + WS_W + (size_t)l * WL_BYTES)
#define ssq0 (SSQX + (size_t)(l * 3 + 0) * M)
#define ssq1 (SSQX + (size_t)(l * 3 + 1) * M)
#define ssq2 (SSQX + (size_t)(l * 3 + 2) * M)
#define ssqn ((l + 1 < DEPTH) ? SSQX + (size_t)((l + 1) * 3) * M : (u64*)nullptr)
#define ssqc (SSQC + (size_t)l * 2 * M)
        PHASE({ pg8::Gemm g{XB0, (const bf16*)(wl + WL_IN), M, DINP, DM, DM}; EpiInProj E{ssq0, ssqc, PROJ, MISC}; run_gemm(lds, g, E, G, wg, SLOW4); });
        PHASE({ { pg8::Gemm g{PROJ + PC_CQ, (const bf16*)(wl + WL_UQ), M, NH * QK, QL, DINP}; EpiScaleBf16 E{ssqc, 1.f / QL, QRAW, NH * QK}; run_gemm(lds, g, E, G, wg, GEMM_REPEAT); }
                { pg8::Gemm g{PROJ + PC_CKV, (const bf16*)(wl + WL_UKV), M, NH * 256, KVL, DINP}; EpiScaleBf16 E{ssqc + M, 1.f / KVL, KVRAW, NH * 256}; run_gemm(lds, g, E, G, wg, GEMM_REPEAT); }
                { pg8::Gemm g{PB + (size_t)l * M * PLE, (const bf16*)(wl + WL_PL), M, DM, PLE, PLE}; EpiScaleBf16 E{nullptr, 0.f, PE, DM}; run_gemm(lds, g, E, G, wg, GEMM_REPEAT); } });
        PHASE({ phase_kfin(KVRAW, MISC, INP(10) + l * QK, COS, SIN, KF, G, wg);
                phase_ssdpre(PROJ, MISC, INP(12) + (size_t)l * CW * CONVD, INP(13) + (size_t)l * CONVD, INP(14) + l * SH, XC, DTS, G, wg); });

#if FAST_ATTN
        PHASE({ attn::phase(QRAW, KF, KVRAW, INP(9) + l * QK, COS, SIN, AO, lds, G, wg); });
#else
        PHASE({ phase_attn_simple(QRAW, KF, KVRAW, INP(9) + l * QK, COS, SIN, AO, lds, G, wg); });
#endif

#if FAST_SSD
        PHASE({ ssd::phase_states(XC, DTS, INP(15) + l * SH, (bf16*)ST, CDEC, lds, G, wg); });
        PHASE({ ssd::phase_scan((bf16*)ST, CDEC, G, wg); });
        PHASE({ ssd::phase_out(XC, DTS, INP(15) + l * SH, INP(16) + l * SH, (const bf16*)ST, PROJ, Y, lds, G, wg); });
#else
        PHASE({ phase_ssd_states(XC, DTS, INP(15) + l * SH, ST, CDEC, lds, G, wg); });
        PHASE({ phase_ssd_scan(ST, CDEC, G, wg); });
        PHASE({ phase_ssd_out(XC, DTS, INP(15) + l * SH, INP(16) + l * SH, ST, YPRE, lds, G, wg); });
        PHASE({ phase_ssdnorm(YPRE, PROJ, Y, G, wg); });
#endif
        PHASE({ pg8::Gemm g{AO, (const bf16*)(wl + WL_OM), M, DM, DM, DM}; EpiGateF32 E{PROJ, TMPF}; run_gemm(lds, g, E, G, wg, GEMM_REPEAT); });
        PHASE({ pg8::Gemm g{Y, (const bf16*)(wl + WL_OS), M, DM, DI, DI}; EpiMerge E{PROJ, TMPF, MERGED}; run_gemm(lds, g, E, G, wg, GEMM_REPEAT); });
        PHASE({ pg8::Gemm g{MERGED, (const bf16*)(wl + WL_OUT), M, DM, DM, DM}; EpiResid E{X, XB1, ssq1}; run_gemm(lds, g, E, G, wg, SLOW4); });
        PHASE({ pg8::Gemm g{XB1, (const bf16*)(wl + WL_UP), M, DFF, DM, DM}; EpiUp E{ssq1, U}; run_gemm(lds, g, E, G, wg, GEMM_REPEAT); });
        PHASE({ pg8::Gemm g{U, (const bf16*)(wl + WL_DN), M, DM, DFF, DFF}; EpiResid E{X, XB2, ssq2}; run_gemm(lds, g, E, G, wg, SLOW4); });
        PHASE({ pg8::Gemm g{XB2, (const bf16*)(wl + WL_PG), M, DM, DM, DM};  EpiPleGate E{ssq2, PE, X, XB0, ssqn}; run_gemm(lds, g, E, G, wg, SLOW4); });
    }
#undef PHASE
}

extern "C" void kernel_launch(void* const* d_in, const int* in_sizes, int n_in, void* d_out, int out_size, void* d_ws, size_t ws_size, hipStream_t stream) {
    static int grid = 0;
    if (grid == 0) {
        if (n_in != 26 || out_size != M * DM || ws_size < WS_END) { fprintf(stderr, "kernel_launch: built for 26 inputs, out %d floats, >= %zu bytes of workspace; got n_in %d out %d ws %zu\n", M * DM, (size_t)WS_END, n_in, out_size, ws_size); grid = -1; return; }
        int dev = 0, cus = 0;
        if (hipGetDevice(&dev) != hipSuccess || hipDeviceGetAttribute(&cus, hipDeviceAttributeMultiprocessorCount, dev) != hipSuccess) { grid = -1; return; }
        if (hipFuncSetAttribute((const void*)fwd, hipFuncAttributeMaxDynamicSharedMemorySize, LDS_BYTES) != hipSuccess) { fprintf(stderr, "kernel_launch: hipFuncSetAttribute failed\n"); grid = -1; return; }
        int per_cu = 0;
        if (hipOccupancyMaxActiveBlocksPerMultiprocessor(&per_cu, (const void*)fwd, NTHR, LDS_BYTES) != hipSuccess || per_cu < 1) fprintf(stderr, "kernel_launch: occupancy query says %d\n", per_cu);
        (void)hipGetLastError();
        grid = cus;
    }
    if (grid < 0) return;
    if (hipMemsetAsync((char*)d_ws + WS_CTL, 0, CTL_ZERO_BYTES, stream) != hipSuccess) return;
    Args a{};
    for (int i = 0; i < 26; ++i) a.in[i] = (const float*)d_in[i];
    a.out = (float*)d_out; a.ws = (unsigned char*)d_ws;
#if MK_ONE_LAUNCH
    a.ph_lo = 0; a.ph_hi = NPH;
    hipLaunchKernelGGL(fwd, dim3(grid), dim3(NTHR), LDS_BYTES, stream, a);
#else
#ifndef STOP_PH
#define STOP_PH NPH
#endif
    for (int ph = 0; ph < STOP_PH; ++ph) {
#ifdef SKIP_LO
        if (ph >= SKIP_LO && ph < SKIP_HI) continue;
#endif
        a.ph_lo = ph; a.ph_hi = ph + 1; hipLaunchKernelGGL(fwd, dim3(grid), dim3(NTHR), LDS_BYTES, stream, a); }
#endif
    const hipError_t le = hipPeekAtLastError();
    if (le != hipSuccess) fprintf(stderr, "kernel_launch: launch failed: %s\n", hipGetErrorName(le));
}
```

```cpp
#define FAST_GEMM 1
#define FAST_ATTN 1
#define FAST_SSD 1
#define MK_ONE_LAUNCH 1
#include <hip/hip_runtime.h>
#include <cstdio>
#include <cstdint>

#ifndef MK_ONE_LAUNCH
#define MK_ONE_LAUNCH 0
#endif
#ifndef FAST_SSD
#define FAST_SSD 0
#endif
#ifndef FAST_ATTN
#define FAST_ATTN 0
#endif
#ifndef FAST_GEMM
#define FAST_GEMM 0
#endif

constexpr int NB = 2, SEQ = 4096, M = NB * SEQ, DM = 2048, DEPTH = 4, PLE = 256;
constexpr float EPS = 1e-6f;
constexpr int NH = 16, QL = 512, KVL = 512, NOPE = 128, ROPE = 64, VD = 128, QK = 192;
constexpr int DI = 4096, HD = 64, SH = 64, SG = 8, SN = 128, HPG = 8, CW = 4, CONVD = 6144, TC = 64, NCH = SEQ / TC;
constexpr int DFF = 8192;
constexpr int DIN = 15488;
constexpr int DINP = 15616;
constexpr int PC_CQ = 0, PC_CKV = 512, PC_Z = 1024, PC_XBC = 5120, PC_G = 11264, PC_KR = 15360, PC_DT = 15424, PC_PAD = 15488;
constexpr int NWAVES = 8, NTHR = 512;

typedef unsigned short bf16;
typedef unsigned u32x4 __attribute__((ext_vector_type(4)));
typedef unsigned u32x2 __attribute__((ext_vector_type(2)));
typedef float f32x4 __attribute__((ext_vector_type(4)));
typedef float f32x2 __attribute__((ext_vector_type(2)));
typedef short bf16x8 __attribute__((ext_vector_type(8)));
#define GAS __attribute__((address_space(1)))
#define LAS __attribute__((address_space(3)))
typedef GAS unsigned gu32;
#define RLX_AGENT __ATOMIC_RELAXED, __HIP_MEMORY_SCOPE_AGENT
#define LDS_WAIT() asm volatile("s_waitcnt lgkmcnt(0)" ::: "memory")
#define VM_WAIT() asm volatile("s_waitcnt vmcnt(0)" ::: "memory")

constexpr size_t MiB = 1u << 20;
constexpr size_t WS_CTL = 0, CTL_ZERO_BYTES = 2 * MiB;
constexpr int CW_TMO = 0, CW_CODE = 1, CW_BAR = 4096;
typedef unsigned long long u64;
constexpr int CW_SSQX = 16384;
constexpr int CW_SSQC = CW_SSQX + 2 * DEPTH * 3 * M;
static_assert((size_t)(CW_SSQC + 2 * DEPTH * 2 * M) * 4 <= CTL_ZERO_BYTES, "ctl");
constexpr size_t WL_IN = 0, WL_UQ = 61 * MiB, WL_UKV = 64 * MiB, WL_OM = 68 * MiB, WL_OS = 76 * MiB, WL_OUT = 92 * MiB, WL_UP = 100 * MiB, WL_DN = 132 * MiB, WL_PG = 164 * MiB, WL_PL = 172 * MiB, WL_BYTES = 173 * MiB;
static_assert((size_t)DINP * DM * 2 == 61 * MiB, "w_in copy");
constexpr size_t WS_W = 2 * MiB;
constexpr size_t WS_ACT = WS_W + DEPTH * WL_BYTES;
constexpr size_t WS_XB = WS_ACT;
constexpr size_t WS_XB1 = WS_XB + 32 * MiB, WS_XB2 = WS_XB1 + 32 * MiB;
constexpr size_t WS_PROJ = WS_XB2 + 32 * MiB;
constexpr size_t WS_U = WS_PROJ;
constexpr size_t WS_MISC = WS_PROJ + 244 * MiB;
constexpr size_t WS_QRAW = WS_MISC + 4 * MiB;
constexpr size_t WS_KVRAW = WS_QRAW + 48 * MiB;
constexpr size_t WS_KF = WS_KVRAW + 64 * MiB;
constexpr size_t WS_AO = WS_KF + 48 * MiB;
constexpr size_t WS_XC = WS_AO + 32 * MiB;
constexpr size_t WS_DTS = WS_XC + 96 * MiB;
constexpr size_t WS_CDEC = WS_DTS + 2 * MiB;
constexpr size_t WS_ST = WS_CDEC + 1 * MiB;
constexpr size_t WS_YPRE = WS_ST + 256 * MiB;
constexpr size_t WS_Y = WS_YPRE + 128 * MiB;
constexpr size_t WS_TMPF = WS_Y + 64 * MiB;
constexpr size_t WS_MERGED = WS_TMPF + 64 * MiB;
constexpr size_t WS_PE = WS_MERGED + 32 * MiB;
constexpr size_t WS_PB = WS_PE + 32 * MiB;
constexpr size_t WS_COS = WS_PB + 16 * MiB;
constexpr size_t WS_SIN = WS_COS + 1 * MiB;
constexpr size_t WS_END = WS_SIN + 1 * MiB;
static_assert(WS_END <= 1936 * MiB, "d_ws budget (4 x the largest input)");

constexpr int RING_OFF = 0, RING_BYTES = 131072;
constexpr int LDSCTL_OFF = RING_BYTES, MISC_OFF = LDSCTL_OFF + 320;
constexpr int EXTRA_OFF = LDSCTL_OFF + 512, LDS_BYTES = 147456, EXTRA_BYTES = LDS_BYTES - EXTRA_OFF;

__device__ __forceinline__ unsigned f2bf(float f) { unsigned u = __builtin_bit_cast(unsigned, f); return (u + 0x7fffu + ((u >> 16) & 1u)) >> 16; }
__device__ __forceinline__ float bf2f(unsigned h) { return __builtin_bit_cast(float, h << 16); }
typedef __bf16 bf16x2_t __attribute__((ext_vector_type(2)));
__device__ __forceinline__ unsigned pk2(float lo, float hi) { const f32x2 v = {lo, hi}; const bf16x2_t b = __builtin_convertvector(v, bf16x2_t); return __builtin_bit_cast(unsigned, b); }
__device__ __forceinline__ u32x4 pack8(const float (&v)[8]) { u32x4 w; w.x = pk2(v[0], v[1]); w.y = pk2(v[2], v[3]); w.z = pk2(v[4], v[5]); w.w = pk2(v[6], v[7]); return w; }
__device__ __forceinline__ void unpack8(u32x4 w, float (&v)[8]) {
    v[0] = bf2f(w.x & 0xffffu); v[1] = bf2f(w.x >> 16); v[2] = bf2f(w.y & 0xffffu); v[3] = bf2f(w.y >> 16);
    v[4] = bf2f(w.z & 0xffffu); v[5] = bf2f(w.z >> 16); v[6] = bf2f(w.w & 0xffffu); v[7] = bf2f(w.w >> 16); }
__device__ __forceinline__ float wave_sum(float v) {
#pragma unroll
    for (int o = 1; o < 64; o <<= 1) v += __shfl_xor(v, o);
    return v;
}
__device__ __forceinline__ float wave_max(float v) {
#pragma unroll
    for (int o = 1; o < 64; o <<= 1) v = fmaxf(v, __shfl_xor(v, o));
    return v;
}
__device__ __forceinline__ int otid() { int t = threadIdx.x; asm volatile("" : "+v"(t)); return t; }
__device__ __forceinline__ float sigmoidf_(float x) { return 1.f / (1.f + __expf(-x)); }
__device__ __forceinline__ float siluf_(float x) { return x / (1.f + __expf(-x)); }

#define XB_TMO      128
#define XB_XCNT(j)  (256  + 64 * (j))
#define XB_XSUB(j)  (1280 + 64 * (j))
#define XB_XGEN(j)  (2304 + 64 * (j))
#define XB_TOP      3328
#define XB_TOPGEN   3392
#define XCD_BAR_WORDS 3456
#define XB_SPIN_CAP (1u << 18)
__device__ __forceinline__ unsigned xb_ld(unsigned* p)              { return __hip_atomic_load(p, __ATOMIC_RELAXED, __HIP_MEMORY_SCOPE_AGENT); }
__device__ __forceinline__ unsigned xb_add(unsigned* p, unsigned v) { return __hip_atomic_fetch_add(p, v, __ATOMIC_RELAXED, __HIP_MEMORY_SCOPE_AGENT); }
__device__ __forceinline__ unsigned xb_xcc_id() { return (unsigned)__builtin_amdgcn_s_getreg((3 << 11) | 20) & 0xFu; }
#define XB_SPIN(cond, bar) do { unsigned _sp = 0; while (cond) { __builtin_amdgcn_s_sleep(1); \
    if ((++_sp & 255u) == 0u) { if (xb_ld(&(bar)[XB_TMO])) break; if (_sp > XB_SPIN_CAP) { atomicAdd(&(bar)[XB_TMO], 1u); break; } } } } while (0)
struct XcdBarrier { unsigned* bar; unsigned x; volatile LAS unsigned* st; };
__device__ __forceinline__ XcdBarrier xcd_barrier_post(unsigned* bar, volatile LAS unsigned* st) {
    XcdBarrier b; b.bar = bar; b.x = xb_xcc_id(); b.st = st;
    if (threadIdx.x == 0) (void)xb_add(&bar[XB_XCNT(b.x)], 1u);
    return b;
}
__device__ __forceinline__ void xcd_barrier_complete(unsigned* bar, unsigned x, unsigned& nloc, unsigned& nx) {
    const unsigned G = gridDim.x * gridDim.y * gridDim.z;
    unsigned sum, cnt, mine, sp = 0u;
    for (;;) {
        sum = 0u; cnt = 0u; mine = 0u;
#pragma unroll
        for (unsigned j = 0; j < 16; ++j) { const unsigned c = xb_ld(&bar[XB_XCNT(j)]); sum += c; cnt += (c > 0u) ? 1u : 0u; mine = (j == x) ? c : mine; }
        if (sum == G) break;
        __builtin_amdgcn_s_sleep(1);
        if ((++sp & 255u) == 0u) { if (xb_ld(&bar[XB_TMO])) break; if (sp > XB_SPIN_CAP) { atomicAdd(&bar[XB_TMO], 1u); break; } }
    }
    nloc = mine > 0u ? mine : 1u; nx = cnt > 0u ? cnt : 1u;
}
__device__ __forceinline__ void xcd_barrier(const XcdBarrier& b) {
    asm volatile("s_waitcnt vmcnt(0)" ::: "memory");
    __syncthreads();
    if (threadIdx.x == 0) {
        unsigned* bar = b.bar;
        __builtin_amdgcn_s_waitcnt(0);
        unsigned nloc = b.st[0], nx = b.st[1];
        if (nloc == 0u) { xcd_barrier_complete(bar, b.x, nloc, nx); b.st[0] = nloc; b.st[1] = nx; }
        const unsigned old = xb_add(&bar[XB_XSUB(b.x)], 1u);
        const unsigned gen = old / nloc;
        if (old + 1u == (gen + 1u) * nloc) {
            __builtin_amdgcn_fence(__ATOMIC_RELEASE, "agent");
            asm volatile("s_waitcnt vmcnt(0)" ::: "memory");
            const unsigned og = xb_add(&bar[XB_TOP], 1u);
            const unsigned tg = og / nx;
            if (og + 1u == (tg + 1u) * nx) xb_add(&bar[XB_TOPGEN], 1u);
            else XB_SPIN(xb_ld(&bar[XB_TOPGEN]) == tg, bar);
            __builtin_amdgcn_fence(__ATOMIC_ACQUIRE, "agent");
            xb_add(&bar[XB_XGEN(b.x)], 1u);
            asm volatile("s_waitcnt vmcnt(0)" ::: "memory");
        } else {
            XB_SPIN(xb_ld(&bar[XB_XGEN(b.x)]) == gen, bar);
            __builtin_amdgcn_fence(__ATOMIC_ACQUIRE, "agent");
            asm volatile("s_waitcnt vmcnt(0)" ::: "memory");
        }
    }
    __syncthreads();
}

namespace pg8 {
typedef unsigned short bf16_t;
constexpr int BM = 256, BK = 64, HALF = 128, HTB = HALF * BK * 2, STAGE_BYTES = 8 * HTB, NXCD = 8, WGM = 8;
__host__ __device__ __forceinline__ int lds_byte(int r, int c) { const int st = (r >> 4) * 2 + (c >> 5), rr = r & 15, cc = c & 31, ob = rr * 64 + cc * 2; return st * 1024 + (ob ^ (((ob >> 9) & 1) << 5)); }
__host__ __device__ __forceinline__ void stage_rc(int b, int& R, int& C) { const int st = b / 1024, sb = b % 1024, swz = sb ^ (((sb >> 9) & 1) << 5); R = (st >> 1) * 16 + swz / 64; C = (st & 1) * 32 + (swz % 64) / 2; }
__host__ __device__ __forceinline__ int perm32(int rho) { const int n = rho >> 4, i = rho & 15; return 8 * (i >> 2) + 4 * n + (i & 3); }
struct Unit { int pm, pn; };
struct Gemm { const bf16_t* A; const bf16_t* Bt; int M, N, K, lda; };
struct StaticOrder {
    int nM, nN, nwg, G, c;
    __host__ __device__ void init(int M_, int N_, int G_, int c_) { nM = M_ / BM; nN = N_ / BM; nwg = nM * nN; G = G_; c = c_; }
    __host__ __device__ bool next(int i, Unit& u) const {
        const long L = (long)i * G + c; if (L >= nwg) return false;
        int wgid = (int)L; { const int q = nwg / NXCD, r = nwg % NXCD, xcd = wgid % NXCD, off = wgid / NXCD; wgid = (xcd < r ? xcd * (q + 1) : r * (q + 1) + (xcd - r) * q) + off; }
        const int nig = WGM * nN, gid = wgid / nig, fm = gid * WGM, gsz = (nM - fm) < WGM ? (nM - fm) : WGM;
        u.pm = fm + ((wgid % nig) % gsz); u.pn = (wgid % nig) / gsz; return true;
    }
    __device__ __forceinline__ void a_ready(const Unit&) const {}
    __device__ __forceinline__ void done(const Unit&) const {}
};

template <class Epi, class Sched>
__device__ __forceinline__ void gemm_phase(LAS unsigned char* lds, const Gemm g, const Sched& S, const Epi& E) {
    const int tid = otid(), wid = __builtin_amdgcn_readfirstlane(tid >> 6), lane = tid & 63, wr = wid >> 2, wc = wid & 3, fr = lane & 15, fq = lane >> 4;
    const int K = g.K, nt = K / BK, lda = g.lda;
    unsigned voffA[2], voffB[2];
#pragma unroll
    for (int i = 0; i < 2; ++i) { int R, C; stage_rc(tid * 16 + i * 8192, R, C); const int Rb = (R & ~31) + perm32(R & 31);
        voffA[i] = (unsigned)(R * lda + C) * 2u; voffB[i] = (unsigned)(Rb * K + C) * 2u; }
    const size_t kstep = (size_t)(BK * 2);
    const size_t hstepA = (size_t)HALF * lda * 2, hstepB = (size_t)HALF * K * 2;
    const size_t tstepA = 2 * hstepA, tstepB = 2 * hstepB;
    const unsigned ldsw = (unsigned)wid * 1024u;
    const int aoff = lds_byte(wr * 64 + fr, fq * 8), boff = lds_byte(wc * 32 + fr, fq * 8);
#define PG8_SA(b, h) (((b) * 2 + (h)) * HTB)
#define PG8_SB(b, h) ((4 + (b) * 2 + (h)) * HTB)
#define PG8_STAGE(bufoff, gbase, voff) do { _Pragma("unroll") for (int _i = 0; _i < 2; ++_i) \
        __builtin_amdgcn_global_load_lds((const unsigned*)((const char*)(gbase) + (voff)[_i]), (LAS unsigned*)(lds + (bufoff) + ldsw + _i * 8192), 16, 0, 0); } while (0)
#define PG8_LDA(dst, b, h) do { _Pragma("unroll") for (int m = 0; m < 4; ++m) _Pragma("unroll") for (int k = 0; k < 2; ++k) dst[m][k] = *(const LAS bf16x8*)(lds + PG8_SA(b, h) + aoff + m * 2048 + k * 1024); } while (0)
#define PG8_LDB(dst, b, h) do { _Pragma("unroll") for (int n = 0; n < 2; ++n) _Pragma("unroll") for (int k = 0; k < 2; ++k) dst[n][k] = *(const LAS bf16x8*)(lds + PG8_SB(b, h) + boff + n * 2048 + k * 1024); } while (0)
#define PG8_MMA(ai, bj, At, Bt) do { __builtin_amdgcn_s_setprio(1); _Pragma("unroll") for (int m = 0; m < 4; ++m) _Pragma("unroll") for (int n = 0; n < 2; ++n) _Pragma("unroll") for (int k = 0; k < 2; ++k) \
        acc[ai][bj][m][n] = __builtin_amdgcn_mfma_f32_16x16x32_bf16(Bt[n][k], At[m][k], acc[ai][bj][m][n], 0, 0, 0); __builtin_amdgcn_s_setprio(0); } while (0)
#define PG8_WAIT_V(n) asm volatile("s_waitcnt vmcnt(" #n ")" ::: "memory")
#define PG8_WAIT_L(n) asm volatile("s_waitcnt lgkmcnt(" #n ")" ::: "memory")
#define PG8_BAR __builtin_amdgcn_s_barrier()
#define PG8_SCHED __builtin_amdgcn_sched_barrier(0)
    Unit cur, nxt; int ui = 0;
    if (!S.next(0, cur)) return;
    f32x4 acc[2][2][4][2];
#pragma unroll
    for (int a = 0; a < 2; ++a)
#pragma unroll
        for (int b = 0; b < 2; ++b)
#pragma unroll
            for (int m = 0; m < 4; ++m)
#pragma unroll
                for (int n = 0; n < 2; ++n) acc[a][b][m][n] = (f32x4){0.f, 0.f, 0.f, 0.f};
    bf16x8 At[4][2], B0[2][2], B1[2][2];
    const char* cA = (const char*)g.A + (size_t)cur.pm * tstepA; const char* cB = (const char*)g.Bt + (size_t)cur.pn * tstepB;
    S.a_ready(cur);
    PG8_STAGE(PG8_SB(0, 0), cB, voffB); PG8_STAGE(PG8_SB(0, 1), cB + hstepB, voffB); PG8_STAGE(PG8_SA(0, 0), cA, voffA); PG8_STAGE(PG8_SA(0, 1), cA + hstepA, voffA);
    if (wr == 1) PG8_BAR;
    PG8_WAIT_V(2); PG8_BAR;
    PG8_STAGE(PG8_SB(1, 0), cB + kstep, voffB); PG8_STAGE(PG8_SA(1, 0), cA + kstep, voffA); PG8_STAGE(PG8_SB(1, 1), cB + hstepB + kstep, voffB);
    PG8_WAIT_V(6); PG8_BAR;
    for (;;) {
        const bool has_next = S.next(ui + 1, nxt);
        const char* nA = has_next ? (const char*)g.A + (size_t)nxt.pm * tstepA : cA; const char* nB = has_next ? (const char*)g.Bt + (size_t)nxt.pn * tstepB : cB;
        for (int t = 0; t < nt; t += 2) {
            const bool last = (t == nt - 2);
            const char* a1 = cA + (size_t)(t + 1) * kstep;
            const char* a2 = last ? nA : cA + (size_t)(t + 2) * kstep; const char* b2 = last ? nB : cB + (size_t)(t + 2) * kstep;
            const char* a3 = a2 + kstep; const char* b3 = b2 + kstep;
            if (last && has_next) S.a_ready(nxt);
            PG8_LDB(B0, 0, 0); PG8_LDB(B1, 0, 1); PG8_SCHED; PG8_LDA(At, 0, 0); PG8_STAGE(PG8_SA(1, 1), a1 + hstepA, voffA);
            PG8_WAIT_V(8); PG8_WAIT_L(0); PG8_BAR; PG8_MMA(0, 0, At, B0); PG8_MMA(0, 1, At, B1); PG8_BAR; PG8_SCHED;
            PG8_LDA(At, 0, 1); PG8_STAGE(PG8_SB(0, 0), b2, voffB); PG8_STAGE(PG8_SB(0, 1), b2 + hstepB, voffB); PG8_STAGE(PG8_SA(0, 0), a2, voffA);
            PG8_WAIT_V(8); PG8_WAIT_L(0); PG8_BAR; PG8_MMA(1, 0, At, B0); PG8_MMA(1, 1, At, B1); PG8_BAR; PG8_SCHED;
            PG8_LDB(B0, 1, 0); PG8_LDB(B1, 1, 1); PG8_SCHED; PG8_LDA(At, 1, 0); PG8_STAGE(PG8_SA(0, 1), a2 + hstepA, voffA);
            PG8_WAIT_V(8); PG8_WAIT_L(0); PG8_BAR; PG8_MMA(0, 0, At, B0); PG8_MMA(0, 1, At, B1); PG8_BAR; PG8_SCHED;
            PG8_LDA(At, 1, 1); PG8_STAGE(PG8_SB(1, 0), b3, voffB); PG8_STAGE(PG8_SB(1, 1), b3 + hstepB, voffB); PG8_STAGE(PG8_SA(1, 0), a3, voffA);
            PG8_WAIT_V(8); PG8_WAIT_L(0); PG8_BAR; PG8_MMA(1, 0, At, B0); PG8_MMA(1, 1, At, B1); PG8_BAR; PG8_SCHED;
        }
        if (wr == 0) PG8_BAR;
        {
            const int row0 = cur.pm * BM + wr * 64 + fr, col00 = cur.pn * BM + wc * 32 + 8 * fq;
            typename Epi::Regs RA[2], RB[2];
#define PG8_EL(R, gi) do { const int _r = row0 + ((gi) >> 2) * HALF + ((gi) & 3) * 16; E.load(_r, col00, R[0]); E.load(_r, col00 + HALF, R[1]); } while (0)
#define PG8_EA(R, gi) do { const int _r = row0 + ((gi) >> 2) * HALF + ((gi) & 3) * 16; _Pragma("unroll") for (int bj = 0; bj < 2; ++bj) { \
                const f32x4 _p = acc[(gi) >> 2][bj][(gi) & 3][0], _q = acc[(gi) >> 2][bj][(gi) & 3][1]; const float _v[8] = {_p[0], _p[1], _p[2], _p[3], _q[0], _q[1], _q[2], _q[3]}; \
                E.apply(_r, col00 + bj * HALF, _v, R[bj]); } } while (0)
            PG8_EL(RA, 0);
#pragma unroll
            for (int gi = 0; gi < 8; gi += 2) {
                PG8_EL(RB, gi + 1); PG8_SCHED; PG8_EA(RA, gi); PG8_SCHED;
                if (gi + 2 < 8) PG8_EL(RA, gi + 2);
                PG8_SCHED; PG8_EA(RB, gi + 1); PG8_SCHED;
            }
#undef PG8_EL
#undef PG8_EA
        }
        S.done(cur);
        if (!has_next) break;
#pragma unroll
        for (int a = 0; a < 2; ++a)
#pragma unroll
            for (int b = 0; b < 2; ++b)
#pragma unroll
                for (int m = 0; m < 4; ++m)
#pragma unroll
                    for (int n = 0; n < 2; ++n) acc[a][b][m][n] = (f32x4){0.f, 0.f, 0.f, 0.f};
        cur = nxt; cA = nA; cB = nB; ++ui;
        if (wr == 1) PG8_BAR;
    }
    PG8_WAIT_V(0);
    PG8_BAR;
#undef PG8_SA
#undef PG8_SB
#undef PG8_STAGE
#undef PG8_LDA
#undef PG8_LDB
#undef PG8_MMA
#undef PG8_WAIT_V
#undef PG8_WAIT_L
#undef PG8_BAR
#undef PG8_SCHED
}

template <class Epi>
__device__ __forceinline__ void gemm_simple(const Gemm g, const Epi& E, int G, int wg) {
    const int tid = otid(), wid = tid >> 6, lane = tid & 63, fr = lane & 15, fq = lane >> 4;
    const int nbn = g.N / 32, nblk = (g.M / 16) * nbn;
    for (int it = wg * NWAVES + wid; it < nblk; it += G * NWAVES) {
        const int m0 = (it / nbn) * 16, n0 = (it % nbn) * 32;
        f32x4 acc0 = {0.f, 0.f, 0.f, 0.f}, acc1 = {0.f, 0.f, 0.f, 0.f};
        const bf16_t* ap = g.A + (size_t)(m0 + fr) * g.lda + 8 * fq;
        const bf16_t* bp0 = g.Bt + (size_t)(n0 + perm32(fr)) * g.K + 8 * fq;
        const bf16_t* bp1 = g.Bt + (size_t)(n0 + perm32(16 + fr)) * g.K + 8 * fq;
        for (int k0 = 0; k0 < g.K; k0 += 32) {
            const bf16x8 a = *(const bf16x8*)(ap + k0), b0 = *(const bf16x8*)(bp0 + k0), b1 = *(const bf16x8*)(bp1 + k0);
            acc0 = __builtin_amdgcn_mfma_f32_16x16x32_bf16(b0, a, acc0, 0, 0, 0);
            acc1 = __builtin_amdgcn_mfma_f32_16x16x32_bf16(b1, a, acc1, 0, 0, 0);
        }
        const float v[8] = {acc0[0], acc0[1], acc0[2], acc0[3], acc1[0], acc1[1], acc1[2], acc1[3]};
        typename Epi::Regs rg; E.load(m0 + fr, n0 + 8 * fq, rg); E.apply(m0 + fr, n0 + 8 * fq, v, rg);
    }
}
}

#ifndef GEMM_REPEAT
#define GEMM_REPEAT 1
#endif
template <class Epi>
__device__ __forceinline__ void run_gemm(LAS unsigned char* lds, const pg8::Gemm g, const Epi& E, int G, int wg, int rep = 1) {
#if FAST_GEMM
    if (rep < 0) { pg8::gemm_simple<Epi>(g, E, G, wg); return; }
    for (int rr = 0; rr < rep; ++rr) { pg8::StaticOrder S; S.init(g.M, g.N, G, wg); pg8::gemm_phase<Epi, pg8::StaticOrder>(lds, g, S, E); }
#else
    pg8::gemm_simple<Epi>(g, E, G, wg);
#endif
}

constexpr float SSQ_SCALE = 16777216.f, SSQ_INV = 1.f / 16777216.f;
__device__ __forceinline__ void ssq_add(u64* dst, int row, const float (&v)[8]) {
    float s = 0.f;
#pragma unroll
    for (int j = 0; j < 8; ++j) s += v[j] * v[j];
    s += __shfl_xor(s, 16); s += __shfl_xor(s, 32);
    if ((otid() & 63) < 16) atomicAdd(dst + row, (u64)(s * SSQ_SCALE));
}
__device__ __forceinline__ float ld_ssq(const u64* p) { return (float)__hip_atomic_load(p, __ATOMIC_RELAXED, __HIP_MEMORY_SCOPE_AGENT) * SSQ_INV; }
__device__ __forceinline__ void st_f32x8(float* p, const float (&v)[8]) { *(f32x4*)p = (f32x4){v[0], v[1], v[2], v[3]}; *(f32x4*)(p + 4) = (f32x4){v[4], v[5], v[6], v[7]}; }
__device__ __forceinline__ void ld_f32x8(const float* p, float (&v)[8]) { const f32x4 a = *(const f32x4*)p, b = *(const f32x4*)(p + 4); v[0] = a.x; v[1] = a.y; v[2] = a.z; v[3] = a.w; v[4] = b.x; v[5] = b.y; v[6] = b.z; v[7] = b.w; }
__device__ __forceinline__ void ld_bf16x8(const bf16* p, float (&v)[8]) { unpack8(*(const u32x4*)p, v); }

struct EpiInProj {
    const u64* ssq; u64* ssqc; bf16* proj; float* misc;
    struct Regs { float rs; };
    __device__ __forceinline__ void load(int row, int col0, Regs& r) const { r.rs = rsqrtf(ld_ssq(ssq + row) * (1.f / DM) + EPS); }
    __device__ __forceinline__ void apply(int row, int col0, const float (&a)[8], const Regs& r) const {
        float v[8];
#pragma unroll
        for (int j = 0; j < 8; ++j) v[j] = a[j] * r.rs;
        const int tile = col0 >> 8;
        if (tile == 60) { const int c = col0 - PC_KR; if (c < 128) st_f32x8(misc + (size_t)row * 128 + c, v); return; }
        if (tile >= 44) {
#pragma unroll
            for (int j = 0; j < 8; ++j) v[j] = sigmoidf_(v[j]);
        }
        *(u32x4*)(proj + (size_t)row * DINP + col0) = pack8(v);
        if (tile < 4) ssq_add(ssqc + (size_t)(tile >> 1) * M, row, v);
    }
};
struct EpiScaleBf16 {
    const u64* ssq; float inv_n; bf16* O; int ldo;
    struct Regs { float rs; };
    __device__ __forceinline__ void load(int row, int col0, Regs& r) const { r.rs = ssq ? rsqrtf(ld_ssq(ssq + row) * inv_n + EPS) : 1.f; }
    __device__ __forceinline__ void apply(int row, int col0, const float (&a)[8], const Regs& r) const {
        float v[8];
#pragma unroll
        for (int j = 0; j < 8; ++j) v[j] = a[j] * r.rs;
        *(u32x4*)(O + (size_t)row * ldo + col0) = pack8(v);
    }
};
struct EpiGateF32 {
    const bf16* proj; float* T;
    struct Regs { u32x4 g; };
    __device__ __forceinline__ void load(int row, int col0, Regs& r) const { r.g = *(const u32x4*)(proj + (size_t)row * DINP + PC_G + col0); }
    __device__ __forceinline__ void apply(int row, int col0, const float (&a)[8], const Regs& r) const {
        float g[8], v[8]; unpack8(r.g, g);
#pragma unroll
        for (int j = 0; j < 8; ++j) v[j] = a[j] * g[j];
        st_f32x8(T + (size_t)row * DM + col0, v);
    }
};
struct EpiMerge {
    const bf16* proj; const float* T; bf16* O;
    struct Regs { u32x4 g; f32x4 t0, t1; };
    __device__ __forceinline__ void load(int row, int col0, Regs& r) const { r.g = *(const u32x4*)(proj + (size_t)row * DINP + PC_G + DM + col0);
        r.t0 = *(const f32x4*)(T + (size_t)row * DM + col0); r.t1 = *(const f32x4*)(T + (size_t)row * DM + col0 + 4); }
    __device__ __forceinline__ void apply(int row, int col0, const float (&a)[8], const Regs& r) const {
        float g[8], v[8]; unpack8(r.g, g);
        const float t[8] = {r.t0.x, r.t0.y, r.t0.z, r.t0.w, r.t1.x, r.t1.y, r.t1.z, r.t1.w};
#pragma unroll
        for (int j = 0; j < 8; ++j) v[j] = t[j] + a[j] * g[j];
        *(u32x4*)(O + (size_t)row * DM + col0) = pack8(v);
    }
};
struct EpiResid {
    float* X; bf16* XB; u64* ssq_next;
    struct Regs { f32x4 x0, x1; };
    __device__ __forceinline__ void load(int row, int col0, Regs& r) const { r.x0 = *(const f32x4*)(X + (size_t)row * DM + col0); r.x1 = *(const f32x4*)(X + (size_t)row * DM + col0 + 4); }
    __device__ __forceinline__ void apply(int row, int col0, const float (&a)[8], const Regs& r) const {
        float x[8] = {r.x0.x, r.x0.y, r.x0.z, r.x0.w, r.x1.x, r.x1.y, r.x1.z, r.x1.w};
#pragma unroll
        for (int j = 0; j < 8; ++j) x[j] += a[j];
        st_f32x8(X + (size_t)row * DM + col0, x);
        *(u32x4*)(XB + (size_t)row * DM + col0) = pack8(x);
        if (ssq_next) ssq_add(ssq_next, row, x);
    }
};
struct EpiUp {
    const u64* ssq; bf16* U;
    struct Regs { float rs; };
    __device__ __forceinline__ void load(int row, int col0, Regs& r) const { r.rs = rsqrtf(ld_ssq(ssq + row) * (1.f / DM) + EPS); }
    __device__ __forceinline__ void apply(int row, int col0, const float (&a)[8], const Regs& r) const {
        float v[8];
#pragma unroll
        for (int j = 0; j < 8; ++j) { const float t = fmaxf(a[j] * r.rs, 0.f); v[j] = t * t; }
        *(u32x4*)(U + (size_t)row * DFF + col0) = pack8(v);
    }
};
struct EpiPleGate {
    const u64* ssq; const bf16* PE; float* X; bf16* XB; u64* ssq_next;
    struct Regs { float rs; f32x4 x0, x1; u32x4 pe; };
    __device__ __forceinline__ void load(int row, int col0, Regs& r) const { r.rs = rsqrtf(ld_ssq(ssq + row) * (1.f / DM) + EPS);
        r.x0 = *(const f32x4*)(X + (size_t)row * DM + col0); r.x1 = *(const f32x4*)(X + (size_t)row * DM + col0 + 4); r.pe = *(const u32x4*)(PE + (size_t)row * DM + col0); }
    __device__ __forceinline__ void apply(int row, int col0, const float (&a)[8], const Regs& r) const {
        float x[8] = {r.x0.x, r.x0.y, r.x0.z, r.x0.w, r.x1.x, r.x1.y, r.x1.z, r.x1.w}, pe[8]; unpack8(r.pe, pe);
#pragma unroll
        for (int j = 0; j < 8; ++j) x[j] += pe[j] * sigmoidf_(a[j] * r.rs);
        st_f32x8(X + (size_t)row * DM + col0, x);
        *(u32x4*)(XB + (size_t)row * DM + col0) = pack8(x);
        if (ssq_next) ssq_add(ssq_next, row, x);
    }
};

__device__ __forceinline__ void transpose_item(const float* W, int K, int Nsrc, int nsrc0, const float* gain, bf16* WT, int ndst0, int k0, LAS float* scr, int lane) {
    f32x4 v[16];
    const int rq = lane >> 4, c4 = (lane & 15) * 4;
    if (nsrc0 >= 0) {
#pragma unroll
        for (int i = 0; i < 16; ++i) v[i] = *(const f32x4*)(W + (size_t)(k0 + 4 * i + rq) * Nsrc + nsrc0 + c4);
        if (gain) {
#pragma unroll
            for (int i = 0; i < 16; ++i) v[i] = v[i] * gain[k0 + 4 * i + rq];
        }
    } else {
#pragma unroll
        for (int i = 0; i < 16; ++i) v[i] = (f32x4){0.f, 0.f, 0.f, 0.f};
    }
#pragma unroll
    for (int hh = 0; hh < 2; ++hh) {
#pragma unroll
        for (int i = 0; i < 8; ++i) { LAS float* d = scr + (4 * i + rq) * 65 + c4; const f32x4 t = v[8 * hh + i]; d[0] = t.x; d[1] = t.y; d[2] = t.z; d[3] = t.w; }
        LDS_WAIT(); asm volatile("" ::: "memory");
        const int c = lane & 3, nq = lane >> 2;
#pragma unroll
        for (int j = 0; j < 4; ++j) { const int n = 16 * j + nq; const LAS float* s = scr + (8 * c) * 65 + n;
            u32x4 o; o.x = pk2(s[0 * 65], s[1 * 65]); o.y = pk2(s[2 * 65], s[3 * 65]); o.z = pk2(s[4 * 65], s[5 * 65]); o.w = pk2(s[6 * 65], s[7 * 65]);
            *(u32x4*)(WT + (size_t)(ndst0 + n) * K + k0 + 32 * hh + 8 * c) = o; }
        LDS_WAIT(); asm volatile("" ::: "memory");
    }
}
__host__ __device__ __forceinline__ int inproj_src_col(int n) {
    if (n < PC_Z) return n;
    if (n < PC_G) return n + 64;
    if (n < PC_KR) return n + 128;
    if (n < PC_DT) return n - PC_KR + 1024;
    if (n < PC_PAD) return n - PC_DT + 11328;
    return -1;
}
constexpr int I_IN = (DM / 64) * (DINP / 64), I_UQ = (QL / 64) * (NH * QK / 64), I_UKV = (KVL / 64) * (NH * 256 / 64), I_OM = (DM / 64) * (DM / 64), I_OS = (DI / 64) * (DM / 64),
              I_OUT = I_OM, I_UP = (DM / 64) * (DFF / 64), I_DN = (DFF / 64) * (DM / 64), I_PG = I_OM, I_PL = (PLE / 64) * (DM / 64),
              I_LAYER = I_IN + I_UQ + I_UKV + I_OM + I_OS + I_OUT + I_UP + I_DN + I_PG + I_PL;
__device__ __forceinline__ void prologue_weights(const float* const (&inp)[26], unsigned char* ws, LAS unsigned char* lds, int G, int wg) {
    const int wave = otid() >> 6, lane = otid() & 63;
    LAS float* scr = (LAS float*)(lds + RING_OFF + wave * 16384);
    for (int it = wg * NWAVES + wave; it < DEPTH * I_LAYER; it += G * NWAVES) {
        const int l = it / I_LAYER; int r = it % I_LAYER;
        unsigned char* wl = ws + WS_W + (size_t)l * WL_BYTES;
        if (r < I_IN) { const int nblk = DINP / 64, kb = r / nblk, nb = r % nblk;
            transpose_item(inp[4] + (size_t)l * DM * DIN, DM, DIN, inproj_src_col(64 * nb), inp[3] + l * DM, (bf16*)(wl + WL_IN), 64 * nb, 64 * kb, scr, lane); continue; } r -= I_IN;
        if (r < I_UQ) { const int nblk = NH * QK / 64, kb = r / nblk, nb = r % nblk;
            transpose_item(inp[6] + (size_t)l * QL * NH * QK, QL, NH * QK, 64 * nb, inp[5] + l * QL, (bf16*)(wl + WL_UQ), 64 * nb, 64 * kb, scr, lane); continue; } r -= I_UQ;
        if (r < I_UKV) { const int nblk = NH * 256 / 64, kb = r / nblk, nb = r % nblk;
            transpose_item(inp[8] + (size_t)l * KVL * NH * 256, KVL, NH * 256, 64 * nb, inp[7] + l * KVL, (bf16*)(wl + WL_UKV), 64 * nb, 64 * kb, scr, lane); continue; } r -= I_UKV;
        if (r < I_OM) { const int nblk = DM / 64, kb = r / nblk, nb = r % nblk;
            transpose_item(inp[11] + (size_t)l * DM * DM, DM, DM, 64 * nb, nullptr, (bf16*)(wl + WL_OM), 64 * nb, 64 * kb, scr, lane); continue; } r -= I_OM;
        if (r < I_OS) { const int nblk = DM / 64, kb = r / nblk, nb = r % nblk;
            transpose_item(inp[18] + (size_t)l * DI * DM, DI, DM, 64 * nb, inp[17] + l * DI, (bf16*)(wl + WL_OS), 64 * nb, 64 * kb, scr, lane); continue; } r -= I_OS;
        if (r < I_OUT) { const int nblk = DM / 64, kb = r / nblk, nb = r % nblk;
            transpose_item(inp[19] + (size_t)l * DM * DM, DM, DM, 64 * nb, nullptr, (bf16*)(wl + WL_OUT), 64 * nb, 64 * kb, scr, lane); continue; } r -= I_OUT;
        if (r < I_UP) { const int nblk = DFF / 64, kb = r / nblk, nb = r % nblk;
            transpose_item(inp[21] + (size_t)l * DM * DFF, DM, DFF, 64 * nb, inp[20] + l * DM, (bf16*)(wl + WL_UP), 64 * nb, 64 * kb, scr, lane); continue; } r -= I_UP;
        if (r < I_DN) { const int nblk = DM / 64, kb = r / nblk, nb = r % nblk;
            transpose_item(inp[22] + (size_t)l * DFF * DM, DFF, DM, 64 * nb, nullptr, (bf16*)(wl + WL_DN), 64 * nb, 64 * kb, scr, lane); continue; } r -= I_DN;
        if (r < I_PG) { const int nblk = DM / 64, kb = r / nblk, nb = r % nblk;
            transpose_item(inp[24] + (size_t)l * DM * DM, DM, DM, 64 * nb, inp[23] + l * DM, (bf16*)(wl + WL_PG), 64 * nb, 64 * kb, scr, lane); continue; } r -= I_PG;
        { const int nblk = DM / 64, kb = r / nblk, nb = r % nblk;
            transpose_item(inp[25] + (size_t)l * PLE * DM, PLE, DM, 64 * nb, nullptr, (bf16*)(wl + WL_PL), 64 * nb, 64 * kb, scr, lane); }
    }
}
__device__ __forceinline__ void prologue_rows(const float* const (&inp)[26], float* out, unsigned char* ws, int G, int wg) {
    const int wave = otid() >> 6, lane = otid() & 63, gw = wg * NWAVES + wave, NGW = G * NWAVES;
    const float* x = inp[0]; bf16* XB = (bf16*)(ws + WS_XB); u64* ssq0 = (u64*)((unsigned*)(ws + WS_CTL) + CW_SSQX);
    for (int m = gw; m < M; m += NGW) {
        float s = 0.f;
#pragma unroll
        for (int j = 0; j < 8; ++j) { const f32x4 v = *(const f32x4*)(x + (size_t)m * DM + j * 256 + lane * 4);
            *(f32x4*)(out + (size_t)m * DM + j * 256 + lane * 4) = v; s += v.x * v.x + v.y * v.y + v.z * v.z + v.w * v.w;
            u32x2 o; o.x = pk2(v.x, v.y); o.y = pk2(v.z, v.w); *(u32x2*)(XB + (size_t)m * DM + j * 256 + lane * 4) = o; }
        s = wave_sum(s); if (lane == 0) ssq0[m] = (u64)(s * SSQ_SCALE);
    }
    {
        u64* z0 = (u64*)((unsigned*)(ws + WS_CTL) + CW_SSQX) + M; const int nz = (DEPTH * 3 - 1) * M + DEPTH * 2 * M;
        for (int i = wg * NTHR + otid(); i < nz; i += G * NTHR) z0[i] = 0ull;
    }
    const float* p = inp[1]; bf16* PB = (bf16*)(ws + WS_PB);
    for (size_t i = (size_t)wg * NTHR + otid(); i < (size_t)DEPTH * M * PLE / 8; i += (size_t)G * NTHR) { float v[8]; ld_f32x8(p + i * 8, v); *(u32x4*)(PB + i * 8) = pack8(v); }
    const int* pos = (const int*)inp[2]; float* COS = (float*)(ws + WS_COS); float* SIN = (float*)(ws + WS_SIN);
    for (int i = wg * NTHR + otid(); i < M * 32; i += G * NTHR) { const int m = i >> 5, k = i & 31;
        const float invf = 1.0f / (float)pow(10000.0, (double)k / 32.0);
        const float ang = (float)pos[m] * invf;
        COS[i] = (float)cos((double)ang); SIN[i] = (float)sin((double)ang); }
}

__device__ __forceinline__ void phase_kfin(const bf16* KVRAW, const float* MISC, const float* kw, const float* COS, const float* SIN, bf16* KF, LAS unsigned char* lds, int G, int wg) {
    const int tid = otid(), wave = __builtin_amdgcn_readfirstlane(tid >> 6), lane = tid & 63, hh = lane >> 2, q4 = lane & 3;
    LAS float* krl = (LAS float*)(lds + RING_OFF) + wave * 64;
    float wn[32];
#pragma unroll
    for (int j = 0; j < 32; j += 4) { const f32x4 t = *(const f32x4*)(kw + q4 * 32 + j); wn[j] = t.x; wn[j + 1] = t.y; wn[j + 2] = t.z; wn[j + 3] = t.w; }
    const float wr = kw[128 + lane];
    for (int m = wg * NWAVES + wave; m < M; m += G * NWAVES) {
        u32x4 raw[4];
#pragma unroll
        for (int i = 0; i < 4; ++i) raw[i] = *(const u32x4*)(KVRAW + (size_t)m * 4096 + hh * 256 + q4 * 32 + i * 8);
        const float kr = MISC[(size_t)m * 128 + lane], cs = COS[m * 32 + (lane & 31)], sn = SIN[m * 32 + (lane & 31)];
        float f[32], ss = 0.f;
#pragma unroll
        for (int i = 0; i < 4; ++i) { float t[8]; unpack8(raw[i], t);
#pragma unroll
            for (int j = 0; j < 8; ++j) { f[i * 8 + j] = t[j]; ss += t[j] * t[j]; } }
        ss += __shfl_xor(ss, 1); ss += __shfl_xor(ss, 2);
        const float rs = rsqrtf((ss + wave_sum(kr * kr)) * (1.f / QK) + EPS);
        const float t2 = kr * wr, o2 = __shfl_xor(t2, 32);
        krl[lane] = lane < 32 ? (t2 * cs - o2 * sn) : (o2 * sn + t2 * cs);
        bf16* o = KF + (size_t)m * (NH * QK) + hh * QK;
#pragma unroll
        for (int i = 0; i < 4; ++i) { float t[8];
#pragma unroll
            for (int j = 0; j < 8; ++j) t[j] = f[i * 8 + j] * rs * wn[i * 8 + j];
            *(u32x4*)(o + q4 * 32 + i * 8) = pack8(t); }
        LDS_WAIT();
#pragma unroll
        for (int i = 0; i < 2; ++i) { const f32x4 a0 = *(LAS const f32x4*)(krl + q4 * 16 + i * 8), a1 = *(LAS const f32x4*)(krl + q4 * 16 + i * 8 + 4);
            const float t[8] = {a0.x * rs, a0.y * rs, a0.z * rs, a0.w * rs, a1.x * rs, a1.y * rs, a1.z * rs, a1.w * rs};
            *(u32x4*)(o + 128 + q4 * 16 + i * 8) = pack8(t); }
        LDS_WAIT();
    }
}
__device__ __forceinline__ void phase_ssdpre(const bf16* PROJ, const float* MISC, const float* cw, const float* cb, const float* dtb, bf16* XC, float* DTS, int G, int wg) {
    const int tid = otid();
    for (int gid = wg * NTHR + tid; gid < (CONVD / 8) * (M / TC); gid += G * NTHR) {
        const int c0 = (gid % (CONVD / 8)) * 8, seg = gid / (CONVD / 8), m0 = seg * TC;
        float w0[8], w1[8], w2[8], w3[8], bs[8], xa[8], xb[8], xc[8];
        ld_f32x8(cw + c0, w0); ld_f32x8(cw + CONVD + c0, w1); ld_f32x8(cw + 2 * CONVD + c0, w2); ld_f32x8(cw + 3 * CONVD + c0, w3); ld_f32x8(cb + c0, bs);
        const bf16* src = PROJ + (size_t)m0 * DINP + PC_XBC + c0; bf16* dst = XC + (size_t)m0 * CONVD + c0;
        if (m0 % SEQ != 0) { ld_bf16x8(src - 3 * (size_t)DINP, xa); ld_bf16x8(src - 2 * (size_t)DINP, xb); ld_bf16x8(src - (size_t)DINP, xc); }
        else {
#pragma unroll
            for (int e = 0; e < 8; ++e) { xa[e] = 0.f; xb[e] = 0.f; xc[e] = 0.f; } }
        for (int t0 = 0; t0 < TC; t0 += 8) {
            u32x4 r[8];
#pragma unroll
            for (int i = 0; i < 8; ++i) r[i] = *(const u32x4*)(src + (size_t)(t0 + i) * DINP);
#pragma unroll
            for (int i = 0; i < 8; ++i) { float xd[8], acc[8]; unpack8(r[i], xd);
#pragma unroll
                for (int e = 0; e < 8; ++e) { acc[e] = siluf_(bs[e] + xa[e] * w0[e] + xb[e] * w1[e] + xc[e] * w2[e] + xd[e] * w3[e]); xa[e] = xb[e]; xb[e] = xc[e]; xc[e] = xd[e]; }
                *(u32x4*)(dst + (size_t)(t0 + i) * CONVD) = pack8(acc); }
        }
    }
    for (int i = wg * NTHR + tid; i < M * SH; i += G * NTHR) { const int m = i >> 6, h = i & 63;
        const float x = MISC[(size_t)m * 128 + 64 + h] + dtb[h], e = __expf(-fabsf(x));
        const float lp = e < 0.01f ? e * (1.f - e * (0.5f - e * (1.f / 3.f))) : __logf(1.f + e); DTS[i] = fmaxf(x, 0.f) + lp; }
}
__device__ __forceinline__ void phase_ssdnorm(const float* YPRE, const bf16* PROJ, bf16* Y, int G, int wg) {
    const int wave = otid() >> 6, lane = otid() & 63;
    for (int it = wg * NWAVES + wave; it < M * SG; it += G * NWAVES) {
        const int m = it >> 3, g = it & 7, c0 = g * 512 + lane * 8;
        float y[8], z[8]; ld_f32x8(YPRE + (size_t)m * DI + c0, y); ld_bf16x8(PROJ + (size_t)m * DINP + PC_Z + c0, z);
        float s = 0.f;
#pragma unroll
        for (int e = 0; e < 8; ++e) { y[e] *= siluf_(z[e]); s += y[e] * y[e]; }
        const float rs = rsqrtf(wave_sum(s) * (1.f / 512.f) + EPS);
#pragma unroll
        for (int e = 0; e < 8; ++e) y[e] *= rs;
        *(u32x4*)(Y + (size_t)m * DI + c0) = pack8(y);
    }
}

namespace attn {
typedef float f32x16 __attribute__((ext_vector_type(16)));
typedef short s16x4 __attribute__((ext_vector_type(4)));
constexpr int KB_BYTES = 64 * QK * 2, VB_BYTES = 64 * VD * 2;
constexpr int L_K0 = 0, L_K1 = KB_BYTES, L_V0 = 2 * KB_BYTES, L_V1 = 2 * KB_BYTES + VB_BYTES, L_WS = 2 * KB_BYTES + 2 * VB_BYTES;
constexpr float QSCALE = 0.07216878364870322f * 1.4426950408889634f;
constexpr float THR2 = 8.f;
#define ASBAR() __builtin_amdgcn_sched_barrier(0)
__device__ __forceinline__ int crow(int r, int hi) { return (r & 3) + 8 * (r >> 2) + 4 * hi; }
__device__ __forceinline__ void partialSM(f32x16& p0, f32x16& p1, float& m_reg, float& alpha) {
    float pmax = p0[0];
#pragma unroll
    for (int r = 1; r < 16; ++r) pmax = fmaxf(pmax, p0[r]);
#pragma unroll
    for (int r = 0; r < 16; ++r) pmax = fmaxf(pmax, p1[r]);
    { auto rr = __builtin_amdgcn_permlane32_swap(__float_as_uint(pmax), __float_as_uint(pmax), false, false); pmax = fmaxf(__uint_as_float(rr[0]), __uint_as_float(rr[1])); }
    float mn;
    if (__builtin_expect(__all(pmax - m_reg <= THR2), 1)) { mn = m_reg; alpha = 1.f; }
    else { mn = fmaxf(m_reg, pmax); alpha = __builtin_amdgcn_exp2f(m_reg - mn); m_reg = mn; }
#pragma unroll
    for (int r = 0; r < 16; ++r) p0[r] = __builtin_amdgcn_exp2f(p0[r] - mn);
#pragma unroll
    for (int r = 0; r < 16; ++r) p1[r] = __builtin_amdgcn_exp2f(p1[r] - mn);
}
__device__ __forceinline__ void finishSM(const f32x16& p0, const f32x16& p1, float alpha, float& l_reg, bf16x8& pa0, bf16x8& pa1, bf16x8& pa2, bf16x8& pa3) {
    float ps = 0.f;
#pragma unroll
    for (int r = 0; r < 16; ++r) ps += p0[r];
#pragma unroll
    for (int r = 0; r < 16; ++r) ps += p1[r];
    { auto rr = __builtin_amdgcn_permlane32_swap(__float_as_uint(ps), __float_as_uint(ps), false, false); ps = __uint_as_float(rr[0]) + __uint_as_float(rr[1]); }
    l_reg = l_reg * alpha + ps;
#define PK4(P, BASE, OUT) do { unsigned a0 = pk2(P[BASE + 0], P[BASE + 1]), a1 = pk2(P[BASE + 2], P[BASE + 3]);   \
    unsigned b0 = pk2(P[BASE + 4], P[BASE + 5]), b1 = pk2(P[BASE + 6], P[BASE + 7]);                              \
    auto r0 = __builtin_amdgcn_permlane32_swap(a0, b0, false, false); auto r1 = __builtin_amdgcn_permlane32_swap(a1, b1, false, false); \
    u32x4 w = {r0[0], r1[0], r0[1], r1[1]}; OUT = __builtin_bit_cast(bf16x8, w); } while (0)
    PK4(p0, 0, pa0); PK4(p0, 8, pa1); PK4(p1, 0, pa2); PK4(p1, 8, pa3);
#undef PK4
}
__device__ __forceinline__ void qkt(f32x16& p0, f32x16& p1, LAS const unsigned char* Ks, const bf16x8 (&qr)[12], int r32, int hi) {
    p0 = (f32x16){0.f, 0.f, 0.f, 0.f, 0.f, 0.f, 0.f, 0.f, 0.f, 0.f, 0.f, 0.f, 0.f, 0.f, 0.f, 0.f}; p1 = p0;
    const int sw = (r32 & 7) << 4, ra = r32 * (QK * 2), rb = (32 + r32) * (QK * 2);
#pragma unroll
    for (int d0 = 0; d0 < 12; ++d0) { const int cb = (d0 * 32 + hi * 16) ^ sw;
        const bf16x8 b0 = *(LAS const bf16x8*)(Ks + ra + cb), b1 = *(LAS const bf16x8*)(Ks + rb + cb);
        p0 = __builtin_amdgcn_mfma_f32_32x32x16_bf16(b0, qr[d0], p0, 0, 0, 0);
        p1 = __builtin_amdgcn_mfma_f32_32x32x16_bf16(b1, qr[d0], p1, 0, 0, 0); }
}
__device__ __forceinline__ void v_pos_src(int p, int& k, int& c) { const int s = p >> 5, kk = (s >> 2) * 8 + ((p & 31) >> 2); c = (s & 3) * 32 + (p & 3) * 8; k = (kk & ~0xC) | ((kk & 4) << 1) | ((kk & 8) >> 1); }
__device__ __forceinline__ int v_rd_base(int lane) { return ((lane & 3) << 3) | (((lane >> 2) & 3) << 6) | (((lane >> 4) & 1) << 5) | (((lane >> 5) & 1) << 8); }
constexpr int v_rd_off(int d0, int ks, int half) { return d0 * 512 + ks * 4096 + half * 2048; }
template <int OFF> __device__ __forceinline__ s16x4 tr_read(int vb) { s16x4 r; asm volatile("ds_read_b64_tr_b16 %0, %1 offset:%2" : "=&v"(r) : "v"(vb), "i"(OFF) : "memory"); return r; }
template <int D0> __device__ __forceinline__ void pv_one(f32x16& od, int vb, bf16x8 pa0, bf16x8 pa1, bf16x8 pa2, bf16x8 pa3) {
    const s16x4 l0 = tr_read<v_rd_off(D0, 0, 0)>(vb), h0 = tr_read<v_rd_off(D0, 0, 1)>(vb), l1 = tr_read<v_rd_off(D0, 1, 0)>(vb), h1 = tr_read<v_rd_off(D0, 1, 1)>(vb);
    const s16x4 l2 = tr_read<v_rd_off(D0, 2, 0)>(vb), h2 = tr_read<v_rd_off(D0, 2, 1)>(vb), l3 = tr_read<v_rd_off(D0, 3, 0)>(vb), h3 = tr_read<v_rd_off(D0, 3, 1)>(vb);
    asm volatile("s_waitcnt lgkmcnt(0)" ::: "memory"); ASBAR();
#define PKV(L, H) (bf16x8){L[0], L[1], L[2], L[3], H[0], H[1], H[2], H[3]}
    od = __builtin_amdgcn_mfma_f32_32x32x16_bf16(pa0, PKV(l0, h0), od, 0, 0, 0);
    od = __builtin_amdgcn_mfma_f32_32x32x16_bf16(pa1, PKV(l1, h1), od, 0, 0, 0);
    od = __builtin_amdgcn_mfma_f32_32x32x16_bf16(pa2, PKV(l2, h2), od, 0, 0, 0);
    od = __builtin_amdgcn_mfma_f32_32x32x16_bf16(pa3, PKV(l3, h3), od, 0, 0, 0);
#undef PKV
}
__device__ __forceinline__ void pv_d0(f32x16 (&o)[4], int vb, bf16x8 pa0, bf16x8 pa1, bf16x8 pa2, bf16x8 pa3) {
    pv_one<0>(o[0], vb, pa0, pa1, pa2, pa3); pv_one<1>(o[1], vb, pa0, pa1, pa2, pa3); pv_one<2>(o[2], vb, pa0, pa1, pa2, pa3); pv_one<3>(o[3], vb, pa0, pa1, pa2, pa3);
}

__device__ __forceinline__ void attn_unit(int b, int h, int qb, const bf16* QRAW, const bf16* KF, const bf16* KVRAW, const float* qw, const float* COS, const float* SIN, bf16* AO, LAS unsigned char* lds) {
    const int tid = otid(), wid = __builtin_amdgcn_readfirstlane(tid >> 6), lane = tid & 63, r32 = lane & 31, hi = lane >> 5;
    LAS float* wsf = (LAS float*)(lds + L_WS) + wid * 64; LAS float* li_l = wsf; LAS float* al_l = wsf + 32;
    const int m = b * SEQ + qb * 256 + wid * 32 + r32;
    bf16x8 qr[12];
    {
        const bf16* qp = QRAW + (size_t)m * (NH * QK) + h * QK + hi * 8;
        u32x4 raw[12]; float ss = 0.f;
#pragma unroll
        for (int d0 = 0; d0 < 12; ++d0) { raw[d0] = *(const u32x4*)(qp + d0 * 16); float f[8]; unpack8(raw[d0], f);
#pragma unroll
            for (int j = 0; j < 8; ++j) ss += f[j] * f[j]; }
        ss += __shfl_xor(ss, 32);
        const float rs = rsqrtf(ss * (1.f / QK) + EPS) * QSCALE;
#pragma unroll
        for (int d0 = 0; d0 < 8; ++d0) { float f[8], w[8]; unpack8(raw[d0], f); ld_f32x8(qw + d0 * 16 + hi * 8, w);
#pragma unroll
            for (int j = 0; j < 8; ++j) f[j] = f[j] * rs * w[j];
            qr[d0] = __builtin_bit_cast(bf16x8, pack8(f)); }
#pragma unroll
        for (int t = 0; t < 2; ++t) { float x1[8], x2[8], w1[8], w2[8], c[8], s[8], o1[8], o2[8];
            unpack8(raw[8 + t], x1); unpack8(raw[10 + t], x2); ld_f32x8(qw + 128 + t * 16 + hi * 8, w1); ld_f32x8(qw + 160 + t * 16 + hi * 8, w2);
            ld_f32x8(COS + (size_t)m * 32 + t * 16 + hi * 8, c); ld_f32x8(SIN + (size_t)m * 32 + t * 16 + hi * 8, s);
#pragma unroll
            for (int j = 0; j < 8; ++j) { const float a = x1[j] * rs * w1[j], bq = x2[j] * rs * w2[j]; o1[j] = a * c[j] - bq * s[j]; o2[j] = a * s[j] + bq * c[j]; }
            qr[8 + t] = __builtin_bit_cast(bf16x8, pack8(o1)); qr[10 + t] = __builtin_bit_cast(bf16x8, pack8(o2)); }
    }
    const bf16* kbase = KF + (size_t)(b * SEQ) * (NH * QK) + h * QK;
    const bf16* vbase = KVRAW + (size_t)(b * SEQ) * 4096 + h * 256 + 128;
    unsigned koff[3], voff[2];
#pragma unroll
    for (int i = 0; i < 3; ++i) { const int p = i * 512 + tid, row = p / 24, cc = (p % 24) ^ (row & 7); koff[i] = (unsigned)(row * (NH * QK) + cc * 8) * 2u; }
#pragma unroll
    for (int i = 0; i < 2; ++i) { int k, c; v_pos_src(i * 512 + tid, k, c); voff[i] = (unsigned)(k * 4096 + c) * 2u; }
    const unsigned ldsw = (unsigned)wid * 1024u;
#define ATT_STAGE(kb, vb_, key0) do { const char* _kg = (const char*)(kbase + (size_t)(key0) * (NH * QK)); const char* _vg = (const char*)(vbase + (size_t)(key0) * 4096); \
        _Pragma("unroll") for (int _i = 0; _i < 3; ++_i) __builtin_amdgcn_global_load_lds((const unsigned*)(_kg + koff[_i]), (LAS unsigned*)(lds + (kb) + ldsw + _i * 8192), 16, 0, 0); \
        _Pragma("unroll") for (int _i = 0; _i < 2; ++_i) __builtin_amdgcn_global_load_lds((const unsigned*)(_vg + voff[_i]), (LAS unsigned*)(lds + (vb_) + ldsw + _i * 8192), 16, 0, 0); } while (0)
    float m_reg = -1e30f, l_reg = 0.f;
    f32x16 o[4];
#pragma unroll
    for (int d = 0; d < 4; ++d) o[d] = (f32x16){0.f, 0.f, 0.f, 0.f, 0.f, 0.f, 0.f, 0.f, 0.f, 0.f, 0.f, 0.f, 0.f, 0.f, 0.f, 0.f};
    const int nt = 4 * qb + 4, myc = 4 * qb + (wid >> 1);
    const int vrd = v_rd_base(lane);
#define ATT_TILE(kb, vb_, j) do { if ((j) <= myc) { f32x16 p0, p1; float alpha; bf16x8 pa0, pa1, pa2, pa3; \
        qkt(p0, p1, (LAS const unsigned char*)(lds + (kb)), qr, r32, hi); partialSM(p0, p1, m_reg, alpha); \
        if (__any(alpha < 1.f)) { if (hi == 0) al_l[r32] = alpha; asm volatile("s_waitcnt lgkmcnt(0)" ::: "memory"); \
            _Pragma("unroll") for (int d = 0; d < 4; ++d) _Pragma("unroll") for (int r = 0; r < 16; ++r) o[d][r] *= al_l[crow(r, hi)]; } \
        finishSM(p0, p1, alpha, l_reg, pa0, pa1, pa2, pa3); ASBAR(); \
        pv_d0(o, (int)(uintptr_t)(lds + (vb_)) + vrd, pa0, pa1, pa2, pa3); } } while (0)
    ATT_STAGE(L_K0, L_V0, 0);
    asm volatile("s_waitcnt vmcnt(0)" ::: "memory"); __syncthreads();
    for (int j = 0; j < nt; j += 2) {
        ATT_STAGE(L_K1, L_V1, (j + 1) * 64);
        ATT_TILE(L_K0, L_V0, j);
        asm volatile("s_waitcnt vmcnt(0)" ::: "memory"); __syncthreads();
        if (j + 2 < nt) ATT_STAGE(L_K0, L_V0, (j + 2) * 64);
        ATT_TILE(L_K1, L_V1, j + 1);
        asm volatile("s_waitcnt vmcnt(0)" ::: "memory"); __syncthreads();
    }
#undef ATT_STAGE
#undef ATT_TILE
    if (hi == 0) li_l[r32] = l_reg;
    asm volatile("s_waitcnt lgkmcnt(0)" ::: "memory");
    float rli[16];
#pragma unroll
    for (int r = 0; r < 16; ++r) rli[r] = __builtin_amdgcn_rcpf(li_l[crow(r, hi)]);
    bf16* ob = AO + (size_t)(b * SEQ + qb * 256 + wid * 32) * DM + h * VD;
#pragma unroll
    for (int r = 0; r < 16; ++r) { const int orow = crow(r, hi);
#pragma unroll
        for (int d0 = 0; d0 < 4; ++d0) ob[(size_t)orow * DM + d0 * 32 + r32] = (bf16)f2bf(o[d0][r] * rli[r]); }
    asm volatile("s_waitcnt lgkmcnt(0)" ::: "memory");
}
__device__ __forceinline__ void phase(const bf16* QRAW, const bf16* KF, const bf16* KVRAW, const float* qw, const float* COS, const float* SIN, bf16* AO, LAS unsigned char* lds, int G, int wg) {
    for (int pr = wg; pr < NB * NH * 8; pr += G) {
        const int x = pr & 7, slot = pr >> 3, bh = x * 4 + (slot >> 3), pi = slot & 7, b = bh / NH, h = bh % NH;
#pragma unroll 1
        for (int u = 0; u < 2; ++u) attn_unit(b, h, u ? pi : 15 - pi, QRAW, KF, KVRAW, qw, COS, SIN, AO, lds);
    }
}
}

namespace ssd {
using attn::f32x16; using attn::s16x4; using attn::crow; using attn::v_rd_base; using attn::tr_read;
constexpr int L_BT = 0, L_XT = 16384, L_WSH = 16384 + 65536, L_SSQ = L_WSH + 8192, L_END = L_SSQ + 2048;
static_assert(L_END <= RING_BYTES, "ssd lds");
template <int NCS> __device__ __forceinline__ void vimg_src(int p, int& k, int& c) { const int s = p >> 5, kk = (s / NCS) * 8 + ((p & 31) >> 2); c = (s % NCS) * 32 + (p & 3) * 8; k = (kk & ~0xC) | ((kk & 4) << 1) | ((kk & 8) >> 1); }
template <int NCS> constexpr int vimg_off(int d0, int ks, int half) { return ((2 * ks + half) * NCS + d0) * 512; }
#define SSD_PKV(L, H) (bf16x8){L[0], L[1], L[2], L[3], H[0], H[1], H[2], H[3]}
#define SSD_LWAIT() do { asm volatile("s_waitcnt lgkmcnt(0)" ::: "memory"); __builtin_amdgcn_sched_barrier(0); } while (0)
constexpr f32x16 Z16 = {0.f, 0.f, 0.f, 0.f, 0.f, 0.f, 0.f, 0.f, 0.f, 0.f, 0.f, 0.f, 0.f, 0.f, 0.f, 0.f};
__device__ __forceinline__ float wave_scan64(float v, int lane) {
#pragma unroll
    for (int o = 1; o < 64; o <<= 1) { const float n = __shfl_up(v, o); if (lane >= o) v += n; }
    return v;
}
__device__ __forceinline__ void stage_x(const bf16* XC, int m0, int h, LAS unsigned char* xt, int lane) {
    u32x4 v[8];
#pragma unroll
    for (int i = 0; i < 8; ++i) { int k, c; vimg_src<2>(i * 64 + lane, k, c); v[i] = *(const u32x4*)(XC + (size_t)(m0 + k) * CONVD + h * HD + c); }
#pragma unroll
    for (int i = 0; i < 8; ++i) *(LAS u32x4*)(xt + (i * 64 + lane) * 16) = v[i];
}

__device__ __forceinline__ void phase_states(const bf16* XC, const float* DTS, const float* a_log, bf16* ST16, float* CDEC, LAS unsigned char* lds, int G, int wg) {
    const int tid = otid(), wid = __builtin_amdgcn_readfirstlane(tid >> 6), lane = tid & 63, r32 = lane & 31, hi = lane >> 5;
    LAS unsigned char* xt = lds + L_XT + wid * 8192; LAS float* wsh = (LAS float*)(lds + L_WSH + wid * 1024);
    const int vrd = v_rd_base(lane);
    for (int it = wg; it < NB * NCH * SG; it += G) {
        const int g = it % SG, bc = it / SG, m0 = bc * TC, h = g * HPG + wid;
        __syncthreads();
        {
            u32x4 v[2];
#pragma unroll
            for (int i = 0; i < 2; ++i) { int k, c; vimg_src<4>(i * 512 + tid, k, c); v[i] = *(const u32x4*)(XC + (size_t)(m0 + k) * CONVD + DI + g * SN + c); }
#pragma unroll
            for (int i = 0; i < 2; ++i) *(LAS u32x4*)(lds + L_BT + (i * 512 + tid) * 16) = v[i];
        }
        stage_x(XC, m0, h, xt, lane);
        { const float A = -__expf(a_log[h]), dt = DTS[(size_t)(m0 + lane) * SH + h]; const float ac = wave_scan64(dt * A, lane), last = __shfl(ac, 63);
          wsh[lane] = __expf(last - ac) * dt; if (lane == 63) CDEC[bc * SH + h] = __expf(last); }
        __syncthreads();
        f32x16 acc[2][4];
#pragma unroll
        for (int a = 0; a < 2; ++a)
#pragma unroll
            for (int b = 0; b < 4; ++b) acc[a][b] = Z16;
        const int xb = (int)(uintptr_t)xt + vrd, bb = (int)(uintptr_t)(lds + L_BT) + vrd;
#define SSD_KS(KSI) do { \
            const s16x4 xl0 = tr_read<vimg_off<2>(0, KSI, 0)>(xb), xh0 = tr_read<vimg_off<2>(0, KSI, 1)>(xb), xl1 = tr_read<vimg_off<2>(1, KSI, 0)>(xb), xh1 = tr_read<vimg_off<2>(1, KSI, 1)>(xb); \
            const s16x4 bl0 = tr_read<vimg_off<4>(0, KSI, 0)>(bb), bh0 = tr_read<vimg_off<4>(0, KSI, 1)>(bb), bl1 = tr_read<vimg_off<4>(1, KSI, 0)>(bb), bh1 = tr_read<vimg_off<4>(1, KSI, 1)>(bb); \
            const s16x4 bl2 = tr_read<vimg_off<4>(2, KSI, 0)>(bb), bh2 = tr_read<vimg_off<4>(2, KSI, 1)>(bb), bl3 = tr_read<vimg_off<4>(3, KSI, 0)>(bb), bh3 = tr_read<vimg_off<4>(3, KSI, 1)>(bb); \
            const f32x4 w0 = *(LAS const f32x4*)(wsh + 16 * KSI + 8 * hi), w1 = *(LAS const f32x4*)(wsh + 16 * KSI + 8 * hi + 4); \
            SSD_LWAIT(); \
            bf16x8 xa[2]; { const bf16x8 r0 = SSD_PKV(xl0, xh0), r1 = SSD_PKV(xl1, xh1); float f[8]; \
                unpack8(__builtin_bit_cast(u32x4, r0), f); f[0] *= w0.x; f[1] *= w0.y; f[2] *= w0.z; f[3] *= w0.w; f[4] *= w1.x; f[5] *= w1.y; f[6] *= w1.z; f[7] *= w1.w; xa[0] = __builtin_bit_cast(bf16x8, pack8(f)); \
                unpack8(__builtin_bit_cast(u32x4, r1), f); f[0] *= w0.x; f[1] *= w0.y; f[2] *= w0.z; f[3] *= w0.w; f[4] *= w1.x; f[5] *= w1.y; f[6] *= w1.z; f[7] *= w1.w; xa[1] = __builtin_bit_cast(bf16x8, pack8(f)); } \
            const bf16x8 bf0 = SSD_PKV(bl0, bh0), bf1 = SSD_PKV(bl1, bh1), bf2 = SSD_PKV(bl2, bh2), bf3 = SSD_PKV(bl3, bh3); \
            _Pragma("unroll") for (int a = 0; a < 2; ++a) { \
                acc[a][0] = __builtin_amdgcn_mfma_f32_32x32x16_bf16(xa[a], bf0, acc[a][0], 0, 0, 0); acc[a][1] = __builtin_amdgcn_mfma_f32_32x32x16_bf16(xa[a], bf1, acc[a][1], 0, 0, 0); \
                acc[a][2] = __builtin_amdgcn_mfma_f32_32x32x16_bf16(xa[a], bf2, acc[a][2], 0, 0, 0); acc[a][3] = __builtin_amdgcn_mfma_f32_32x32x16_bf16(xa[a], bf3, acc[a][3], 0, 0, 0); } } while (0)
        SSD_KS(0); SSD_KS(1); SSD_KS(2); SSD_KS(3);
#undef SSD_KS
        bf16* o = ST16 + ((size_t)bc * SH + h) * (HD * SN);
#pragma unroll
        for (int a = 0; a < 2; ++a)
#pragma unroll
            for (int r = 0; r < 16; ++r) { const int p = 32 * a + crow(r, hi);
#pragma unroll
                for (int b = 0; b < 4; ++b) o[p * SN + 32 * b + r32] = (bf16)f2bf(acc[a][b][r]); }
    }
}

__device__ __forceinline__ void phase_scan(bf16* ST16, const float* CDEC, int G, int wg) {
    constexpr int PER_B8 = SH * HD * SN / 8;
    for (int e = wg * NTHR + otid(); e < NB * PER_B8; e += G * NTHR) {
        const int b = e / PER_B8, r8 = e % PER_B8, h = r8 / (HD * SN / 8);
        float st[8];
#pragma unroll
        for (int j = 0; j < 8; ++j) st[j] = 0.f;
        bf16* base = ST16 + (size_t)b * NCH * (SH * HD * SN) + (size_t)r8 * 8;
#pragma unroll 8
        for (int c = 0; c < NCH; ++c) { bf16* p = base + (size_t)c * (SH * HD * SN); float v[8]; ld_bf16x8(p, v); *(u32x4*)p = pack8(st); const float cd = CDEC[(b * NCH + c) * SH + h];
#pragma unroll
            for (int j = 0; j < 8; ++j) st[j] = st[j] * cd + v[j]; }
    }
}

__device__ __forceinline__ void phase_out(const bf16* XC, const float* DTS, const float* a_log, const float* dskip, const bf16* ST16, const bf16* PROJ, bf16* Y, LAS unsigned char* lds, int G, int wg) {
    const int tid = otid(), wid = __builtin_amdgcn_readfirstlane(tid >> 6), lane = tid & 63, r32 = lane & 31, hi = lane >> 5;
    LAS unsigned char* xt = lds + L_XT + wid * 8192; LAS float* acs = (LAS float*)(lds + L_WSH + wid * 1024); LAS float* dts = acs + 64; LAS float* rsl = acs + 128;
    LAS float* ssqx = (LAS float*)(lds + L_SSQ);
    const int vrd = v_rd_base(lane);
    for (int it = wg; it < NB * NCH * SG; it += G) {
        const int g = it % SG, bc = it / SG, m0 = bc * TC, h = g * HPG + wid;
        __syncthreads();
        stage_x(XC, m0, h, xt, lane);
        { const float A = -__expf(a_log[h]), dt = DTS[(size_t)(m0 + lane) * SH + h]; acs[lane] = wave_scan64(dt * A, lane); dts[lane] = dt; }
        const float dk = dskip[h];
        const bf16* cg = XC + (size_t)(m0 + r32) * CONVD + DI + SG * SN + g * SN + 8 * hi;
        const bf16* bg = XC + (size_t)(m0 + r32) * CONVD + DI + g * SN + 8 * hi;
        const bf16* pg = ST16 + (((size_t)bc * SH + h) * HD + r32) * SN + 8 * hi;
        f32x16 acc[2][2];
#pragma unroll
        for (int a = 0; a < 2; ++a)
#pragma unroll
            for (int b = 0; b < 2; ++b) acc[a][b] = Z16;
#pragma unroll 2
        for (int kn = 0; kn < 8; ++kn) {
            const bf16x8 c0 = *(const bf16x8*)(cg + kn * 16), c1 = *(const bf16x8*)(cg + (size_t)32 * CONVD + kn * 16);
            const bf16x8 q0 = *(const bf16x8*)(pg + kn * 16), q1 = *(const bf16x8*)(pg + 32 * SN + kn * 16);
            acc[0][0] = __builtin_amdgcn_mfma_f32_32x32x16_bf16(c0, q0, acc[0][0], 0, 0, 0); acc[0][1] = __builtin_amdgcn_mfma_f32_32x32x16_bf16(c0, q1, acc[0][1], 0, 0, 0);
            acc[1][0] = __builtin_amdgcn_mfma_f32_32x32x16_bf16(c1, q0, acc[1][0], 0, 0, 0); acc[1][1] = __builtin_amdgcn_mfma_f32_32x32x16_bf16(c1, q1, acc[1][1], 0, 0, 0);
        }
        LDS_WAIT();
#pragma unroll
        for (int a = 0; a < 2; ++a)
#pragma unroll
            for (int r = 0; r < 16; ++r) { const float ea = __expf(acs[32 * a + crow(r, hi)]); acc[a][0][r] *= ea; acc[a][1][r] *= ea; }
        const int xb = (int)(uintptr_t)xt + vrd;
#define SSD_TB(TB) do { f32x16 p0 = Z16, p1 = Z16; \
            _Pragma("unroll 2") for (int kn = 0; kn < 8; ++kn) { const bf16x8 cf = *(const bf16x8*)(cg + (size_t)(32 * TB) * CONVD + kn * 16), b0 = *(const bf16x8*)(bg + kn * 16); \
                p0 = __builtin_amdgcn_mfma_f32_32x32x16_bf16(b0, cf, p0, 0, 0, 0); \
                if (TB == 1) { const bf16x8 b1 = *(const bf16x8*)(bg + (size_t)32 * CONVD + kn * 16); p1 = __builtin_amdgcn_mfma_f32_32x32x16_bf16(b1, cf, p1, 0, 0, 0); } } \
            const int t = 32 * TB + r32; const float at = acs[t]; \
            _Pragma("unroll") for (int r = 0; r < 16; ++r) { const int s0 = crow(r, hi); \
                { const float w = (s0 <= t) ? __expf(fminf(at - acs[s0], 0.f)) * dts[s0] : 0.f; p0[r] = p0[r] * w + ((s0 == t) ? dk : 0.f); } \
                if (TB == 1) { const int s1 = 32 + s0; const float w = (s1 <= t) ? __expf(fminf(at - acs[s1], 0.f)) * dts[s1] : 0.f; p1[r] = p1[r] * w + ((s1 == t) ? dk : 0.f); } } \
            bf16x8 pa0, pa1, pa2, pa3; \
            { PK4_(p0, 0, pa0); PK4_(p0, 8, pa1); if (TB == 1) { PK4_(p1, 0, pa2); PK4_(p1, 8, pa3); } } \
            _Pragma("unroll") for (int pb = 0; pb < 2; ++pb) { \
                const s16x4 l0 = pb ? tr_read<vimg_off<2>(1, 0, 0)>(xb) : tr_read<vimg_off<2>(0, 0, 0)>(xb), h0 = pb ? tr_read<vimg_off<2>(1, 0, 1)>(xb) : tr_read<vimg_off<2>(0, 0, 1)>(xb); \
                const s16x4 l1 = pb ? tr_read<vimg_off<2>(1, 1, 0)>(xb) : tr_read<vimg_off<2>(0, 1, 0)>(xb), h1 = pb ? tr_read<vimg_off<2>(1, 1, 1)>(xb) : tr_read<vimg_off<2>(0, 1, 1)>(xb); \
                s16x4 l2 = l0, h2 = h0, l3 = l1, h3 = h1; \
                if (TB == 1) { l2 = pb ? tr_read<vimg_off<2>(1, 2, 0)>(xb) : tr_read<vimg_off<2>(0, 2, 0)>(xb); h2 = pb ? tr_read<vimg_off<2>(1, 2, 1)>(xb) : tr_read<vimg_off<2>(0, 2, 1)>(xb); \
                               l3 = pb ? tr_read<vimg_off<2>(1, 3, 0)>(xb) : tr_read<vimg_off<2>(0, 3, 0)>(xb); h3 = pb ? tr_read<vimg_off<2>(1, 3, 1)>(xb) : tr_read<vimg_off<2>(0, 3, 1)>(xb); } \
                SSD_LWAIT(); \
                acc[TB][pb] = __builtin_amdgcn_mfma_f32_32x32x16_bf16(pa0, SSD_PKV(l0, h0), acc[TB][pb], 0, 0, 0); acc[TB][pb] = __builtin_amdgcn_mfma_f32_32x32x16_bf16(pa1, SSD_PKV(l1, h1), acc[TB][pb], 0, 0, 0); \
                if (TB == 1) { acc[TB][pb] = __builtin_amdgcn_mfma_f32_32x32x16_bf16(pa2, SSD_PKV(l2, h2), acc[TB][pb], 0, 0, 0); acc[TB][pb] = __builtin_amdgcn_mfma_f32_32x32x16_bf16(pa3, SSD_PKV(l3, h3), acc[TB][pb], 0, 0, 0); } } } while (0)
#define PK4_(P, BASE, OUT) do { unsigned a0_ = pk2(P[BASE + 0], P[BASE + 1]), a1_ = pk2(P[BASE + 2], P[BASE + 3]); unsigned b0_ = pk2(P[BASE + 4], P[BASE + 5]), b1_ = pk2(P[BASE + 6], P[BASE + 7]); \
    auto r0_ = __builtin_amdgcn_permlane32_swap(a0_, b0_, false, false); auto r1_ = __builtin_amdgcn_permlane32_swap(a1_, b1_, false, false); \
    u32x4 w_ = {r0_[0], r1_[0], r0_[1], r1_[1]}; OUT = __builtin_bit_cast(bf16x8, w_); } while (0)
        SSD_TB(0); SSD_TB(1);
#undef SSD_TB
#undef PK4_
        LAS unsigned short* zt = (LAS unsigned short*)xt;
        {
            u32x4 zv[8];
#pragma unroll
            for (int i = 0; i < 8; ++i) zv[i] = *(const u32x4*)(PROJ + (size_t)(m0 + i * 8 + (lane >> 3)) * DINP + PC_Z + h * HD + (lane & 7) * 8);
            LDS_WAIT();
#pragma unroll
            for (int i = 0; i < 8; ++i) *(LAS u32x4*)(xt + (i * 64 + lane) * 16) = zv[i];
        }
        LDS_WAIT();
#pragma unroll
        for (int a = 0; a < 2; ++a)
#pragma unroll
            for (int r = 0; r < 16; ++r) { const int t = 32 * a + crow(r, hi);
                acc[a][0][r] *= siluf_(bf2f(zt[t * 64 + r32])); acc[a][1][r] *= siluf_(bf2f(zt[t * 64 + 32 + r32])); }
        LDS_WAIT();
        LAS float* red = (LAS float*)xt;
#pragma unroll
        for (int a = 0; a < 2; ++a)
#pragma unroll
            for (int r = 0; r < 16; ++r) red[(32 * a + crow(r, hi)) * 32 + r32] = acc[a][0][r] * acc[a][0][r] + acc[a][1][r] * acc[a][1][r];
        LDS_WAIT();
        { float sm = 0.f;
#pragma unroll
          for (int q = 0; q < 8; ++q) { const f32x4 v = *(LAS const f32x4*)(red + lane * 32 + q * 4); sm += (v.x + v.y) + (v.z + v.w); }
          ssqx[wid * 64 + lane] = sm; }
        __syncthreads();
        { float sm = 0.f;
#pragma unroll
          for (int w = 0; w < 8; ++w) sm += ssqx[w * 64 + lane];
          rsl[lane] = rsqrtf(sm * (1.f / 512.f) + EPS); }
        LDS_WAIT();
#pragma unroll
        for (int a = 0; a < 2; ++a)
#pragma unroll
            for (int r = 0; r < 16; ++r) { const int t = 32 * a + crow(r, hi); const float rs = rsl[t];
                zt[t * 64 + r32] = (unsigned short)f2bf(acc[a][0][r] * rs); zt[t * 64 + 32 + r32] = (unsigned short)f2bf(acc[a][1][r] * rs); }
        LDS_WAIT();
#pragma unroll
        for (int i = 0; i < 8; ++i) *(u32x4*)(Y + (size_t)(m0 + i * 8 + (lane >> 3)) * DI + h * HD + (lane & 7) * 8) = *(LAS const u32x4*)(xt + (i * 64 + lane) * 16);
    }
}
}

__device__ __forceinline__ void phase_attn_simple(const bf16* QRAW, const bf16* KF, const bf16* KVRAW, const float* qw, const float* COS, const float* SIN, bf16* AO, LAS unsigned char* lds, int G, int wg) {
    const int wave = otid() >> 6, lane = otid() & 63;
    LAS float* sc = (LAS float*)(lds + RING_OFF + wave * 16384);
    LAS float* qs = (LAS float*)(lds + EXTRA_OFF + wave * 768);
    const float w0 = qw[lane], w1 = qw[64 + lane], w2 = qw[128 + lane];
    for (int it = wg * NWAVES + wave; it < NB * NH * SEQ; it += G * NWAVES) {
        const int t = it % SEQ, bh = it / SEQ, h = bh % NH, b = bh / NH, m = b * SEQ + t;
        const bf16* qp = QRAW + (size_t)m * (NH * QK) + h * QK;
        const float a0 = bf2f(qp[lane]), a1 = bf2f(qp[64 + lane]), a2 = bf2f(qp[128 + lane]);
        const float ss = wave_sum(a0 * a0 + a1 * a1 + a2 * a2), rs = rsqrtf(ss * (1.f / QK) + EPS);
        const float t2 = a2 * rs * w2, o2 = __shfl_xor(t2, 32);
        const float c = COS[m * 32 + (lane & 31)], s = SIN[m * 32 + (lane & 31)];
        const float r2 = lane < 32 ? (t2 * c - o2 * s) : (o2 * s + t2 * c);
        const float scale = 0.07216878364870322f;
        qs[lane] = a0 * rs * w0 * scale; qs[64 + lane] = a1 * rs * w1 * scale; qs[128 + lane] = r2 * scale;
        LDS_WAIT();
        const int nk = (t / TC + 1) * TC;
        float mx = -3.0e38f;
        for (int j = lane; j < nk; j += 64) {
            const bf16* kp = KF + (size_t)(b * SEQ + j) * (NH * QK) + h * QK;
            float acc = 0.f;
#pragma unroll 4
            for (int d = 0; d < QK; d += 8) { float kv[8]; ld_bf16x8(kp + d, kv);
#pragma unroll
                for (int e = 0; e < 8; ++e) acc += qs[d + e] * kv[e]; }
            sc[j] = acc; mx = fmaxf(mx, acc);
        }
        mx = wave_max(mx);
        LDS_WAIT();
        float l = 0.f;
        for (int j = lane; j < nk; j += 64) { const float p = __expf(sc[j] - mx); sc[j] = p; l += p; }
        l = wave_sum(l);
        LDS_WAIT();
        float o0 = 0.f, o1 = 0.f;
        const bf16* vp = KVRAW + (size_t)(b * SEQ) * 4096 + h * 256 + 128;
#pragma unroll 8
        for (int j = 0; j < nk; ++j) { const float p = sc[j]; o0 += p * bf2f(vp[(size_t)j * 4096 + lane]); o1 += p * bf2f(vp[(size_t)j * 4096 + 64 + lane]); }
        const float il = 1.f / l;
        AO[(size_t)m * DM + h * VD + lane] = (bf16)f2bf(o0 * il); AO[(size_t)m * DM + h * VD + 64 + lane] = (bf16)f2bf(o1 * il);
        LDS_WAIT();
    }
}
__device__ __forceinline__ float wave_scan(float v, int lane) {
#pragma unroll
    for (int o = 1; o < 64; o <<= 1) { const float n = __shfl_up(v, o); if (lane >= o) v += n; }
    return v;
}
__device__ __forceinline__ void phase_ssd_states(const bf16* XC, const float* DTS, const float* a_log, float* ST, float* CDEC, LAS unsigned char* lds, int G, int wg) {
    LAS float* wsh = (LAS float*)(lds + RING_OFF);
    const int tid = otid();
    for (int it = wg; it < NB * NCH * SH; it += G) {
        const int h = it % SH, bc = it / SH, m0 = bc * TC, g = h / HPG;
        __syncthreads();
        if (tid < 64) { const float A = -__expf(a_log[h]), dt = DTS[(size_t)(m0 + tid) * SH + h];
            const float ac = wave_scan(dt * A, tid), last = __shfl(ac, 63);
            wsh[tid] = __expf(last - ac) * dt; if (tid == 63) CDEC[bc * SH + h] = __expf(last); }
        __syncthreads();
        const int p = tid >> 3, n0 = (tid & 7) * 16;
        float acc[16];
#pragma unroll
        for (int e = 0; e < 16; ++e) acc[e] = 0.f;
        for (int s = 0; s < TC; ++s) {
            const float xw = bf2f(XC[(size_t)(m0 + s) * CONVD + h * HD + p]) * wsh[s];
            float b0[8], b1[8]; ld_bf16x8(XC + (size_t)(m0 + s) * CONVD + DI + g * SN + n0, b0); ld_bf16x8(XC + (size_t)(m0 + s) * CONVD + DI + g * SN + n0 + 8, b1);
#pragma unroll
            for (int e = 0; e < 8; ++e) { acc[e] += xw * b0[e]; acc[8 + e] += xw * b1[e]; }
        }
        float* o = ST + (((size_t)bc * SH + h) * HD + p) * SN + n0;
#pragma unroll
        for (int e = 0; e < 16; e += 4) *(f32x4*)(o + e) = (f32x4){acc[e], acc[e + 1], acc[e + 2], acc[e + 3]};
    }
}
__device__ __forceinline__ void phase_ssd_scan(float* ST, const float* CDEC, int G, int wg) {
    constexpr int PER_B = SH * HD * SN;
    for (int e = wg * NTHR + otid(); e < NB * PER_B; e += G * NTHR) {
        const int b = e / PER_B, r = e % PER_B, h = r / (HD * SN);
        float state = 0.f;
        for (int c = 0; c < NCH; ++c) { const size_t idx = (size_t)(b * NCH + c) * PER_B + r; const float tmp = ST[idx]; ST[idx] = state; state = state * CDEC[(b * NCH + c) * SH + h] + tmp; }
    }
}
__device__ __forceinline__ void phase_ssd_out(const bf16* XC, const float* DTS, const float* a_log, const float* dskip, const float* ST, float* YPRE, LAS unsigned char* lds, int G, int wg) {
    LAS float* Mm = (LAS float*)(lds + RING_OFF);
    LAS float* acs = (LAS float*)(lds + RING_OFF + 20480);
    LAS float* dts = acs + 64;
    const int tid = otid();
    for (int it = wg; it < NB * NCH * SH; it += G) {
        const int h = it % SH, bc = it / SH, m0 = bc * TC, g = h / HPG;
        __syncthreads();
        if (tid < 64) { const float A = -__expf(a_log[h]), dt = DTS[(size_t)(m0 + tid) * SH + h]; acs[tid] = wave_scan(dt * A, tid); dts[tid] = dt; }
        __syncthreads();
        for (int i = 0; i < 8; ++i) { const int e = tid + NTHR * i, t = e >> 6, s = e & 63;
            float v = 0.f;
            if (s <= t) { const bf16* cp = XC + (size_t)(m0 + t) * CONVD + DI + SG * SN + g * SN; const bf16* bp = XC + (size_t)(m0 + s) * CONVD + DI + g * SN;
                float dot = 0.f;
#pragma unroll 4
                for (int n = 0; n < SN; n += 8) { float cv[8], bv[8]; ld_bf16x8(cp + n, cv); ld_bf16x8(bp + n, bv);
#pragma unroll
                    for (int q = 0; q < 8; ++q) dot += cv[q] * bv[q]; }
                v = dot * __expf(acs[t] - acs[s]) * dts[s]; }
            Mm[t * 65 + s] = v; }
        __syncthreads();
        const int t = tid >> 3, p0 = (tid & 7) * 8;
        float y[8];
#pragma unroll
        for (int j = 0; j < 8; ++j) y[j] = 0.f;
        for (int s = 0; s < TC; ++s) { float xv[8]; ld_bf16x8(XC + (size_t)(m0 + s) * CONVD + h * HD + p0, xv); const float mv = Mm[t * 65 + s];
#pragma unroll
            for (int j = 0; j < 8; ++j) y[j] += mv * xv[j]; }
        const float ea = __expf(acs[t]), dk = dskip[h];
        const bf16* cp = XC + (size_t)(m0 + t) * CONVD + DI + SG * SN + g * SN;
        float xt[8]; ld_bf16x8(XC + (size_t)(m0 + t) * CONVD + h * HD + p0, xt);
#pragma unroll
        for (int j = 0; j < 8; ++j) { const float* pp = ST + (((size_t)bc * SH + h) * HD + p0 + j) * SN;
            float dot = 0.f;
#pragma unroll 4
            for (int n = 0; n < SN; n += 8) { float cv[8], pv[8]; ld_bf16x8(cp + n, cv); ld_f32x8(pp + n, pv);
#pragma unroll
                for (int q = 0; q < 8; ++q) dot += cv[q] * pv[q]; }
            y[j] += ea * dot + dk * xt[j]; }
        st_f32x8(YPRE + (size_t)(m0 + t) * DI + h * HD + p0, y);
    }
}

#ifndef REP_PRO
#define REP_PRO 1
#endif
#ifndef REP_THIN
#define REP_THIN 1
#endif
#ifndef REP_ATTN
#define REP_ATTN 1
#endif
#ifndef REP_SSD
#define REP_SSD 1
#endif
#ifndef ATTN_REPEAT
#define ATTN_REPEAT 1
#endif
#ifndef SLOW4
#define SLOW4 1
#endif
constexpr int PPL = FAST_SSD ? 13 : 14, NPH = 1 + DEPTH * PPL;
struct Args { const float* in[26]; float* out; unsigned char* ws; int ph_lo, ph_hi; };
__global__ void __launch_bounds__(NTHR, 2) fwd(Args args) {
    extern __shared__ __attribute__((aligned(16))) unsigned char lds_[];
    LAS unsigned char* lds = (LAS unsigned char*)lds_;
    const int tid = threadIdx.x, G = gridDim.x, wg = blockIdx.x;
    for (int u = tid; u < (LDS_BYTES - LDSCTL_OFF) / 4; u += NTHR) ((LAS unsigned*)(lds + LDSCTL_OFF))[u] = 0u;
    __syncthreads();
    unsigned char* const ws0 = args.ws;
    unsigned* const ctl0 = (unsigned*)(ws0 + WS_CTL);
    const int lo = args.ph_lo, hi = args.ph_hi;
    XcdBarrier bar; bar.bar = ctl0 + CW_BAR; bar.x = 0; bar.st = (volatile LAS unsigned*)(lds + MISC_OFF) + 8;
    if (hi - lo > 1) bar = xcd_barrier_post(ctl0 + CW_BAR, (volatile LAS unsigned*)(lds + MISC_OFF) + 8);
#define INP(i) (args.in[i])
#define WSP(T, off) ((T*)(ws + (off)))
#define X (args.out)
#define SSQX ((u64*)(ctl + CW_SSQX))
#define SSQC ((u64*)(ctl + CW_SSQC))
#define XB0 WSP(bf16, WS_XB)
#define XB1 WSP(bf16, WS_XB1)
#define XB2 WSP(bf16, WS_XB2)
#define PROJ WSP(bf16, WS_PROJ)
#define U WSP(bf16, WS_U)
#define MISC WSP(float, WS_MISC)
#define QRAW WSP(bf16, WS_QRAW)
#define KVRAW WSP(bf16, WS_KVRAW)
#define KF WSP(bf16, WS_KF)
#define AO WSP(bf16, WS_AO)
#define XC WSP(bf16, WS_XC)
#define DTS WSP(float, WS_DTS)
#define CDEC WSP(float, WS_CDEC)
#define ST WSP(float, WS_ST)
#define YPRE WSP(float, WS_YPRE)
#define Y WSP(bf16, WS_Y)
#define TMPF WSP(float, WS_TMPF)
#define MERGED WSP(bf16, WS_MERGED)
#define PE WSP(bf16, WS_PE)
#define PB WSP(bf16, WS_PB)
#define COS WSP(float, WS_COS)
#define SIN WSP(float, WS_SIN)
    int ph = 0;
#define PHASE(...) do { if (lo <= ph && ph < hi) { { unsigned char* ws = ws0; asm volatile("" : "+s"(ws)); unsigned* ctl = (unsigned*)(ws + WS_CTL); __VA_ARGS__; } if (ph + 1 < hi) xcd_barrier(bar); } ++ph; } while (0)

    PHASE({ for (int rr = 0; rr < REP_PRO; ++rr) { prologue_weights(args.in, ws, lds, G, wg); prologue_rows(args.in, X, ws, G, wg); } });

#pragma unroll 1
    for (int l = 0; l < DEPTH; ++l) {
#define wl (ws + WS_W + (size_t)l * WL_BYTES)
#define ssq0 (SSQX + (size_t)(l * 3 + 0) * M)
#define ssq1 (SSQX + (size_t)(l * 3 + 1) * M)
#define ssq2 (SSQX + (size_t)(l * 3 + 2) * M)
#define ssqn ((l + 1 < DEPTH) ? SSQX + (size_t)((l + 1) * 3) * M : (u64*)nullptr)
#define ssqc (SSQC + (size_t)l * 2 * M)
        PHASE({ pg8::Gemm g{XB0, (const bf16*)(wl + WL_IN), M, DINP, DM, DM}; EpiInProj E{ssq0, ssqc, PROJ, MISC}; run_gemm(lds, g, E, G, wg, SLOW4); });
        PHASE({ { pg8::Gemm g{PROJ + PC_CQ, (const bf16*)(wl + WL_UQ), M, NH * QK, QL, DINP}; EpiScaleBf16 E{ssqc, 1.f / QL, QRAW, NH * QK}; run_gemm(lds, g, E, G, wg, GEMM_REPEAT); }
                { pg8::Gemm g{PROJ + PC_CKV, (const bf16*)(wl + WL_UKV), M, NH * 256, KVL, DINP}; EpiScaleBf16 E{ssqc + M, 1.f / KVL, KVRAW, NH * 256}; run_gemm(lds, g, E, G, wg, GEMM_REPEAT); }
                { pg8::Gemm g{PB + (size_t)l * M * PLE, (const bf16*)(wl + WL_PL), M, DM, PLE, PLE}; EpiScaleBf16 E{nullptr, 0.f, PE, DM}; run_gemm(lds, g, E, G, wg, GEMM_REPEAT); } });
        PHASE({ for (int rr = 0; rr < REP_THIN; ++rr) { phase_kfin(KVRAW, MISC, INP(10) + l * QK, COS, SIN, KF, lds, G, wg);
                phase_ssdpre(PROJ, MISC, INP(12) + (size_t)l * CW * CONVD, INP(13) + (size_t)l * CONVD, INP(14) + l * SH, XC, DTS, G, wg); } });

#if FAST_ATTN
        PHASE({ for (int rr = 0; rr < REP_ATTN; ++rr) attn::phase(QRAW, KF, KVRAW, INP(9) + l * QK, COS, SIN, AO, lds, G, wg); });
#else
        PHASE({ phase_attn_simple(QRAW, KF, KVRAW, INP(9) + l * QK, COS, SIN, AO, lds, G, wg); });
#endif

#if FAST_SSD
        PHASE({ for (int rr = 0; rr < REP_SSD; ++rr) ssd::phase_states(XC, DTS, INP(15) + l * SH, (bf16*)ST, CDEC, lds, G, wg); });
        PHASE({ ssd::phase_scan((bf16*)ST, CDEC, G, wg); });
        PHASE({ for (int rr = 0; rr < REP_SSD; ++rr) ssd::phase_out(XC, DTS, INP(15) + l * SH, INP(16) + l * SH, (const bf16*)ST, PROJ, Y, lds, G, wg); });
#else
        PHASE({ phase_ssd_states(XC, DTS, INP(15) + l * SH, ST, CDEC, lds, G, wg); });
        PHASE({ phase_ssd_scan(ST, CDEC, G, wg); });
        PHASE({ phase_ssd_out(XC, DTS, INP(15) + l * SH, INP(16) + l * SH, ST, YPRE, lds, G, wg); });
        PHASE({ phase_ssdnorm(YPRE, PROJ, Y, G, wg); });
#endif
        PHASE({ pg8::Gemm g{AO, (const bf16*)(wl + WL_OM), M, DM, DM, DM}; EpiGateF32 E{PROJ, TMPF}; run_gemm(lds, g, E, G, wg, GEMM_REPEAT); });
        PHASE({ pg8::Gemm g{Y, (const bf16*)(wl + WL_OS), M, DM, DI, DI}; EpiMerge E{PROJ, TMPF, MERGED}; run_gemm(lds, g, E, G, wg, GEMM_REPEAT); });
        PHASE({ pg8::Gemm g{MERGED, (const bf16*)(wl + WL_OUT), M, DM, DM, DM}; EpiResid E{X, XB1, ssq1}; run_gemm(lds, g, E, G, wg, SLOW4); });
        PHASE({ pg8::Gemm g{XB1, (const bf16*)(wl + WL_UP), M, DFF, DM, DM}; EpiUp E{ssq1, U}; run_gemm(lds, g, E, G, wg, GEMM_REPEAT); });
        PHASE({ pg8::Gemm g{U, (const bf16*)(wl + WL_DN), M, DM, DFF, DFF}; EpiResid E{X, XB2, ssq2}; run_gemm(lds, g, E, G, wg, SLOW4); });
        PHASE({ pg8::Gemm g{XB2, (const bf16*)(wl + WL_PG), M, DM, DM, DM};  EpiPleGate E{ssq2, PE, X, XB0, ssqn}; run_gemm(lds, g, E, G, wg, SLOW4); });
    }
#undef PHASE
}

extern "C" void kernel_launch(void* const* d_in, const int* in_sizes, int n_in, void* d_out, int out_size, void* d_ws, size_t ws_size, hipStream_t stream) {
    static int grid = 0;
    if (grid == 0) {
        if (n_in != 26 || out_size != M * DM || ws_size < WS_END) { fprintf(stderr, "kernel_launch: built for 26 inputs, out %d floats, >= %zu bytes of workspace; got n_in %d out %d ws %zu\n", M * DM, (size_t)WS_END, n_in, out_size, ws_size); grid = -1; return; }
        int dev = 0, cus = 0;
        if (hipGetDevice(&dev) != hipSuccess || hipDeviceGetAttribute(&cus, hipDeviceAttributeMultiprocessorCount, dev) != hipSuccess) { grid = -1; return; }
        if (hipFuncSetAttribute((const void*)fwd, hipFuncAttributeMaxDynamicSharedMemorySize, LDS_BYTES) != hipSuccess) { fprintf(stderr, "kernel_launch: hipFuncSetAttribute failed\n"); grid = -1; return; }
        int per_cu = 0;
        if (hipOccupancyMaxActiveBlocksPerMultiprocessor(&per_cu, (const void*)fwd, NTHR, LDS_BYTES) != hipSuccess || per_cu < 1) fprintf(stderr, "kernel_launch: occupancy query says %d\n", per_cu);
        (void)hipGetLastError();
        grid = cus;
    }
    if (grid < 0) return;
    if (hipMemsetAsync((char*)d_ws + WS_CTL, 0, CTL_ZERO_BYTES, stream) != hipSuccess) return;
    Args a{};
    for (int i = 0; i < 26; ++i) a.in[i] = (const float*)d_in[i];
    a.out = (float*)d_out; a.ws = (unsigned char*)d_ws;
#if MK_ONE_LAUNCH
    a.ph_lo = 0; a.ph_hi = NPH;
    hipLaunchKernelGGL(fwd, dim3(grid), dim3(NTHR), LDS_BYTES, stream, a);
#else
#ifndef STOP_PH
#define STOP_PH NPH
#endif
    for (int ph = 0; ph < STOP_PH; ++ph) {
#ifdef SKIP_LO
        if (ph >= SKIP_LO && ph < SKIP_HI) continue;
#endif
        a.ph_lo = ph; a.ph_hi = ph + 1; hipLaunchKernelGGL(fwd, dim3(grid), dim3(NTHR), LDS_BYTES, stream, a); }
#endif
    const hipError_t le = hipPeekAtLastError();
    if (le != hipSuccess) fprintf(stderr, "kernel_launch: launch failed: %s\n", hipGetErrorName(le));
}
```

```cpp
#include <hip/hip_runtime.h>
#include <cstdio>
#include <cstdint>

#ifndef MK_ONE_LAUNCH
#define MK_ONE_LAUNCH 1
#endif
#ifndef DYN_GEMM
#define DYN_GEMM 1
#endif
#ifndef FAST_SSD
#define FAST_SSD 1
#endif
#ifndef FAST_ATTN
#define FAST_ATTN 1
#endif
#ifndef FAST_GEMM
#define FAST_GEMM 1
#endif
#ifndef GEMM32
#define GEMM32 0
#endif
#ifndef JIT_W
#define JIT_W 1
#endif

constexpr int NB = 2, SEQ = 4096, M = NB * SEQ, DM = 2048, DEPTH = 4, PLE = 256;
constexpr float EPS = 1e-6f;
constexpr int NH = 16, QL = 512, KVL = 512, NOPE = 128, ROPE = 64, VD = 128, QK = 192;
constexpr int DI = 4096, HD = 64, SH = 64, SG = 8, SN = 128, HPG = 8, CW = 4, CONVD = 6144, TC = 64, NCH = SEQ / TC;
constexpr int DFF = 8192;
constexpr int DIN = 15488;
constexpr int DINP = 15616;
constexpr int PC_CQ = 0, PC_CKV = 512, PC_Z = 1024, PC_XBC = 5120, PC_G = 11264, PC_KR = 15360, PC_DT = 15424, PC_PAD = 15488;
constexpr int NWAVES = 8, NTHR = 512;

typedef unsigned short bf16;
typedef unsigned u32x4 __attribute__((ext_vector_type(4)));
typedef unsigned u32x2 __attribute__((ext_vector_type(2)));
typedef float f32x4 __attribute__((ext_vector_type(4)));
typedef float f32x2 __attribute__((ext_vector_type(2)));
typedef short bf16x8 __attribute__((ext_vector_type(8)));
#define GAS __attribute__((address_space(1)))
#define LAS __attribute__((address_space(3)))
typedef GAS unsigned gu32;
#define RLX_AGENT __ATOMIC_RELAXED, __HIP_MEMORY_SCOPE_AGENT
#define LDS_WAIT() asm volatile("s_waitcnt lgkmcnt(0)" ::: "memory")
#define VM_WAIT() asm volatile("s_waitcnt vmcnt(0)" ::: "memory")

constexpr size_t MiB = 1u << 20;
constexpr size_t WS_CTL = 0, CTL_ZERO_BYTES = 2 * MiB;
constexpr int CW_TMO = 0, CW_CODE = 1, CW_BAR = 4096;
typedef unsigned long long u64;
constexpr int CW_SSQX = 16384;
constexpr int CW_SSQC = CW_SSQX + 2 * DEPTH * 3 * M;
static_assert((size_t)(CW_SSQC + 2 * DEPTH * 2 * M) * 4 <= CTL_ZERO_BYTES, "ctl");
constexpr int CW_AQ = 390000;
constexpr int CW_Q = 400000;
static_assert(CW_AQ >= CW_SSQC + 2 * DEPTH * 2 * M && CW_AQ + DEPTH * 8 * 64 <= CW_Q && CW_Q >= CW_SSQC + 2 * DEPTH * 2 * M && (size_t)(CW_Q + DEPTH * 5 * 8 * 64) * 4 <= CTL_ZERO_BYTES, "ctl q");
constexpr size_t WL_IN = 0, WL_UQ = 61 * MiB, WL_UKV = 64 * MiB, WL_OM = 68 * MiB, WL_OS = 76 * MiB, WL_OUT = 92 * MiB, WL_UP = 100 * MiB, WL_DN = 132 * MiB, WL_PG = 164 * MiB, WL_PL = 172 * MiB, WL_BYTES = 173 * MiB;
static_assert((size_t)DINP * DM * 2 == 61 * MiB, "w_in copy");
constexpr size_t WS_W = 2 * MiB;
constexpr size_t WS_ACT = WS_W + DEPTH * WL_BYTES;
constexpr size_t WS_XB = WS_ACT;
constexpr size_t WS_XB1 = WS_XB + 32 * MiB, WS_XB2 = WS_XB1 + 32 * MiB;
constexpr size_t WS_PROJ = WS_XB2 + 32 * MiB;
constexpr size_t WS_U = WS_PROJ;
constexpr size_t WS_MISC = WS_PROJ + 244 * MiB;
constexpr size_t WS_QRAW = WS_MISC + 4 * MiB;
constexpr size_t WS_KVRAW = WS_QRAW + 48 * MiB;
constexpr size_t WS_KF = WS_KVRAW + 64 * MiB;
constexpr size_t WS_AO = WS_KF + 48 * MiB;
constexpr size_t WS_XC = WS_AO + 32 * MiB;
constexpr size_t WS_DTS = WS_XC + 96 * MiB;
constexpr size_t WS_CDEC = WS_DTS + 2 * MiB;
constexpr size_t WS_ST = WS_CDEC + 1 * MiB;
constexpr size_t WS_YPRE = WS_ST + 256 * MiB;
constexpr size_t WS_Y = WS_YPRE + 128 * MiB;
constexpr size_t WS_TMPF = WS_Y + 64 * MiB;
constexpr size_t WS_MERGED = WS_TMPF + 64 * MiB;
constexpr size_t WS_PE = WS_MERGED + 32 * MiB;
constexpr size_t WS_PB = WS_PE + 32 * MiB;
constexpr size_t WS_COS = WS_PB + 16 * MiB;
constexpr size_t WS_SIN = WS_COS + 1 * MiB;
constexpr size_t WS_END = WS_SIN + 1 * MiB;
static_assert(WS_END <= 1936 * MiB, "d_ws budget (4 x the largest input)");

constexpr int RING_OFF = 0, RING_BYTES = 131072;
constexpr int LDSCTL_OFF = RING_BYTES, MISC_OFF = LDSCTL_OFF + 320;
constexpr int QSLOT_OFF = LDSCTL_OFF + 448;
constexpr int EXTRA_OFF = LDSCTL_OFF + 512, LDS_BYTES = 147456, EXTRA_BYTES = LDS_BYTES - EXTRA_OFF;

__device__ __forceinline__ unsigned f2bf(float f) { unsigned u = __builtin_bit_cast(unsigned, f); return (u + 0x7fffu + ((u >> 16) & 1u)) >> 16; }
__device__ __forceinline__ float bf2f(unsigned h) { return __builtin_bit_cast(float, h << 16); }
typedef __bf16 bf16x2_t __attribute__((ext_vector_type(2)));
__device__ __forceinline__ unsigned pk2(float lo, float hi) { const f32x2 v = {lo, hi}; const bf16x2_t b = __builtin_convertvector(v, bf16x2_t); return __builtin_bit_cast(unsigned, b); }
__device__ __forceinline__ u32x4 pack8(const float (&v)[8]) { u32x4 w; w.x = pk2(v[0], v[1]); w.y = pk2(v[2], v[3]); w.z = pk2(v[4], v[5]); w.w = pk2(v[6], v[7]); return w; }
__device__ __forceinline__ void unpack8(u32x4 w, float (&v)[8]) {
    v[0] = bf2f(w.x & 0xffffu); v[1] = bf2f(w.x >> 16); v[2] = bf2f(w.y & 0xffffu); v[3] = bf2f(w.y >> 16);
    v[4] = bf2f(w.z & 0xffffu); v[5] = bf2f(w.z >> 16); v[6] = bf2f(w.w & 0xffffu); v[7] = bf2f(w.w >> 16); }
template <int MASK> __device__ __forceinline__ float swz_xor(float v) { static_assert(MASK > 0 && MASK < 32, "ds_swizzle bit mode"); return __builtin_bit_cast(float, __builtin_amdgcn_ds_swizzle(__builtin_bit_cast(int, v), (MASK << 10) | 0x1f)); }
__device__ __forceinline__ float sum_xor32(float v) { auto rr = __builtin_amdgcn_permlane32_swap(__float_as_uint(v), __float_as_uint(v), false, false); return __uint_as_float(rr[0]) + __uint_as_float(rr[1]); }
__device__ __forceinline__ float max_xor32(float v) { auto rr = __builtin_amdgcn_permlane32_swap(__float_as_uint(v), __float_as_uint(v), false, false); return fmaxf(__uint_as_float(rr[0]), __uint_as_float(rr[1])); }
__device__ __forceinline__ float get_xor32(float v, int lane) { auto rr = __builtin_amdgcn_permlane32_swap(__float_as_uint(v), __float_as_uint(v), false, false); return __uint_as_float(lane < 32 ? rr[1] : rr[0]); }
__device__ __forceinline__ float wave_sum(float v) { v += swz_xor<1>(v); v += swz_xor<2>(v); v += swz_xor<4>(v); v += swz_xor<8>(v); v += swz_xor<16>(v); return sum_xor32(v); }
__device__ __forceinline__ float wave_max(float v) { v = fmaxf(v, swz_xor<1>(v)); v = fmaxf(v, swz_xor<2>(v)); v = fmaxf(v, swz_xor<4>(v)); v = fmaxf(v, swz_xor<8>(v)); v = fmaxf(v, swz_xor<16>(v)); return max_xor32(v); }
__device__ __forceinline__ float lane_up(float v, int o, int lane) { return __builtin_bit_cast(float, __builtin_amdgcn_ds_bpermute((lane - o) << 2, __builtin_bit_cast(int, v))); }
constexpr int WTAB_OFF = 131072;
__device__ __forceinline__ unsigned hw_slot() { return (unsigned)__builtin_amdgcn_s_getreg((5 << 11) | 4) & 63u; }
__device__ __forceinline__ void otid_init() { if ((threadIdx.x & 63) == 0) ((LAS unsigned*)(uintptr_t)WTAB_OFF)[hw_slot()] = threadIdx.x >> 6; }
__device__ __forceinline__ int otid() { const unsigned w = ((volatile LAS unsigned*)(uintptr_t)WTAB_OFF)[hw_slot()];
    int l; asm volatile("v_mbcnt_lo_u32_b32 %0, -1, 0\n\tv_mbcnt_hi_u32_b32 %0, -1, %0" : "=v"(l));
    return (int)(w * 64u) + l; }
__device__ __forceinline__ float sigmoidf_(float x) { return 1.f / (1.f + __expf(-x)); }
__device__ __forceinline__ float siluf_(float x) { return x / (1.f + __expf(-x)); }

#define XB_TMO      128
#define XB_XCNT(j)  (256  + 64 * (j))
#define XB_XSUB(j)  (1280 + 64 * (j))
#define XB_XGEN(j)  (2304 + 64 * (j))
#define XB_TOP      3328
#define XB_TOPGEN   3392
#define XCD_BAR_WORDS 3456
#define XB_SPIN_CAP (1u << 18)
__device__ __forceinline__ unsigned xb_ld(unsigned* p)              { return __hip_atomic_load(p, __ATOMIC_RELAXED, __HIP_MEMORY_SCOPE_AGENT); }
__device__ __forceinline__ unsigned xb_add(unsigned* p, unsigned v) { return __hip_atomic_fetch_add(p, v, __ATOMIC_RELAXED, __HIP_MEMORY_SCOPE_AGENT); }
__device__ __forceinline__ unsigned xb_xcc_id() { return (unsigned)__builtin_amdgcn_s_getreg((3 << 11) | 20) & 0xFu; }
#define XB_SPIN(cond, bar) do { unsigned _sp = 0; while (cond) { __builtin_amdgcn_s_sleep(1); \
    if ((++_sp & 255u) == 0u) { if (xb_ld(&(bar)[XB_TMO])) break; if (_sp > XB_SPIN_CAP) { atomicAdd(&(bar)[XB_TMO], 1u); break; } } } } while (0)
struct XcdBarrier { unsigned* bar; unsigned x; volatile LAS unsigned* st; };
__device__ __forceinline__ XcdBarrier xcd_barrier_post(unsigned* bar, volatile LAS unsigned* st) {
    XcdBarrier b; b.bar = bar; b.x = xb_xcc_id(); b.st = st;
    if (otid() == 0) (void)xb_add(&bar[XB_XCNT(b.x)], 1u);
    return b;
}
__device__ __forceinline__ void xcd_barrier_complete(unsigned* bar, unsigned x, unsigned& nloc, unsigned& nx) {
    const unsigned G = gridDim.x * gridDim.y * gridDim.z;
    unsigned sum, cnt, mine, sp = 0u;
    for (;;) {
        sum = 0u; cnt = 0u; mine = 0u;
#pragma unroll
        for (unsigned j = 0; j < 16; ++j) { const unsigned c = xb_ld(&bar[XB_XCNT(j)]); sum += c; cnt += (c > 0u) ? 1u : 0u; mine = (j == x) ? c : mine; }
        if (sum == G) break;
        __builtin_amdgcn_s_sleep(1);
        if ((++sp & 255u) == 0u) { if (xb_ld(&bar[XB_TMO])) break; if (sp > XB_SPIN_CAP) { atomicAdd(&bar[XB_TMO], 1u); break; } }
    }
    nloc = mine > 0u ? mine : 1u; nx = cnt > 0u ? cnt : 1u;
}
__device__ __forceinline__ void xcd_barrier(const XcdBarrier& b) {
    asm volatile("s_waitcnt vmcnt(0)" ::: "memory");
    __syncthreads();
    if (otid() == 0) {
        unsigned* bar = b.bar;
        __builtin_amdgcn_s_waitcnt(0);
        unsigned nloc = b.st[0], nx = b.st[1];
        if (nloc == 0u) { xcd_barrier_complete(bar, b.x, nloc, nx); b.st[0] = nloc; b.st[1] = nx; }
        const unsigned old = xb_add(&bar[XB_XSUB(b.x)], 1u);
        const unsigned gen = old / nloc;
        if (old + 1u == (gen + 1u) * nloc) {
            __builtin_amdgcn_fence(__ATOMIC_RELEASE, "agent");
            asm volatile("s_waitcnt vmcnt(0)" ::: "memory");
            const unsigned og = xb_add(&bar[XB_TOP], 1u);
            const unsigned tg = og / nx;
            if (og + 1u == (tg + 1u) * nx) xb_add(&bar[XB_TOPGEN], 1u);
            else XB_SPIN(xb_ld(&bar[XB_TOPGEN]) == tg, bar);
            __builtin_amdgcn_fence(__ATOMIC_ACQUIRE, "agent");
            xb_add(&bar[XB_XGEN(b.x)], 1u);
            asm volatile("s_waitcnt vmcnt(0)" ::: "memory");
        } else {
            XB_SPIN(xb_ld(&bar[XB_XGEN(b.x)]) == gen, bar);
            __builtin_amdgcn_fence(__ATOMIC_ACQUIRE, "agent");
            asm volatile("s_waitcnt vmcnt(0)" ::: "memory");
        }
    }
    __syncthreads();
}

namespace pg8 {
typedef unsigned short bf16_t;
constexpr int BM = 256, BK = 64, HALF = 128, HTB = HALF * BK * 2, STAGE_BYTES = 8 * HTB, NXCD = 8, WGM = 8;
#if GEMM32
__host__ __device__ __forceinline__ int lds_byte(int r, int c) { const int st = (r >> 4) * 2 + (c >> 5), rr = r & 15, cc = c & 31, ob = rr * 64 + cc * 2; return st * 1024 + (ob ^ (((ob >> 8) & 3) << 4)); }
__host__ __device__ __forceinline__ void stage_rc(int b, int& R, int& C) { const int st = b / 1024, sb = b % 1024, swz = sb ^ (((sb >> 8) & 3) << 4); R = (st >> 1) * 16 + swz / 64; C = (st & 1) * 32 + (swz % 64) / 2; }
__host__ __device__ __forceinline__ int perm32(int rho) { return 16 * ((rho >> 2) & 1) + (rho & 3) + 4 * (rho >> 3); }
#else
__host__ __device__ __forceinline__ int lds_byte(int r, int c) { const int st = (r >> 4) * 2 + (c >> 5), rr = r & 15, cc = c & 31, ob = rr * 64 + cc * 2; return st * 1024 + (ob ^ (((ob >> 9) & 1) << 5)); }
__host__ __device__ __forceinline__ void stage_rc(int b, int& R, int& C) { const int st = b / 1024, sb = b % 1024, swz = sb ^ (((sb >> 9) & 1) << 5); R = (st >> 1) * 16 + swz / 64; C = (st & 1) * 32 + (swz % 64) / 2; }
__host__ __device__ __forceinline__ int perm32(int rho) { const int n = rho >> 4, i = rho & 15; return 8 * (i >> 2) + 4 * n + (i & 3); }
#endif
__host__ __device__ __forceinline__ int perm32_16(int rho) { const int n = rho >> 4, i = rho & 15; return 8 * (i >> 2) + 4 * n + (i & 3); }
struct Unit { int pm, pn; };
struct Gemm { const bf16_t* A; const bf16_t* Bt; int M, N, K, lda; };
struct StaticOrder {
    static constexpr bool DYN = false;
    int nM, nN, nwg, G, c;
    __host__ __device__ void init(int M_, int N_, int G_, int c_) { nM = M_ / BM; nN = N_ / BM; nwg = nM * nN; G = G_; c = c_; }
    __host__ __device__ bool next(int i, Unit& u) const {
        const long L = (long)i * G + c; if (L >= nwg) return false;
        int wgid = (int)L; { const int q = nwg / NXCD, r = nwg % NXCD, xcd = wgid % NXCD, off = wgid / NXCD; wgid = (xcd < r ? xcd * (q + 1) : r * (q + 1) + (xcd - r) * q) + off; }
        const int nig = WGM * nN, gid = wgid / nig, fm = gid * WGM, gsz = (nM - fm) < WGM ? (nM - fm) : WGM;
        u.pm = fm + ((wgid % nig) % gsz); u.pn = (wgid % nig) / gsz; return true;
    }
    __device__ __forceinline__ void a_ready(const Unit&) const {}
    __device__ __forceinline__ void done(const Unit&) const {}
};

struct DynOrder {
    static constexpr bool DYN = true;
    int nM, nN, q, x; unsigned* head;
    __device__ void init(int M_, int N_, int c_, unsigned* head_base) { nM = M_ / BM; nN = N_ / BM; q = (nM * nN) / NXCD; x = c_ % NXCD; head = head_base + 64 * x; }
    __device__ __forceinline__ int pull() const { return (int)__hip_atomic_fetch_add(head, 1u, __ATOMIC_RELAXED, __HIP_MEMORY_SCOPE_AGENT); }
    __device__ __forceinline__ bool unit_of(int e, Unit& u) const {
        if (e >= q) return false;
        const int wgid = x * q + e, nig = WGM * nN, gid = wgid / nig, fm = gid * WGM, gsz = (nM - fm) < WGM ? (nM - fm) : WGM;
        u.pm = fm + ((wgid % nig) % gsz); u.pn = (wgid % nig) / gsz; return true;
    }
    __device__ __forceinline__ bool next(int, Unit&) const { return false; }
    __device__ __forceinline__ void a_ready(const Unit&) const {}
    __device__ __forceinline__ void done(const Unit&) const {}
};

template <class Epi, class Sched>
__device__ __forceinline__ void gemm_phase(LAS unsigned char* lds, const Gemm g, const Sched& S, const Epi& E) {
    const int tid = otid(), wid = __builtin_amdgcn_readfirstlane(tid >> 6), lane = tid & 63, wr = wid >> 2, wc = wid & 3, fr = lane & 15, fq = lane >> 4;
    const int K = g.K, nt = K / BK, lda = g.lda;
    unsigned voffA[2], voffB[2];
#pragma unroll
    for (int i = 0; i < 2; ++i) { int R, C; stage_rc(tid * 16 + i * 8192, R, C); const int Rb = (R & ~31) + perm32(R & 31);
        voffA[i] = (unsigned)(R * lda + C) * 2u; voffB[i] = (unsigned)(Rb * K + C) * 2u; }
    const size_t kstep = (size_t)(BK * 2);
    const size_t hstepA = (size_t)HALF * lda * 2, hstepB = (size_t)HALF * K * 2;
    const size_t tstepA = 2 * hstepA, tstepB = 2 * hstepB;
    const unsigned ldsw = (unsigned)wid * 1024u;
#if GEMM32
    const int r32 = lane & 31, hi = lane >> 5;
    const int aE = lds_byte(wr * 64 + r32, hi * 8), aO = lds_byte(wr * 64 + r32, 16 + hi * 8), bE = lds_byte(wc * 32 + r32, hi * 8), bO = lds_byte(wc * 32 + r32, 16 + hi * 8);
#else
    const int aoff = lds_byte(wr * 64 + fr, fq * 8), boff = lds_byte(wc * 32 + fr, fq * 8);
#endif
#define PG8_SA(b, h) (((b) * 2 + (h)) * HTB)
#define PG8_SB(b, h) ((4 + (b) * 2 + (h)) * HTB)
#define PG8_STAGE(bufoff, gbase, voff) do { _Pragma("unroll") for (int _i = 0; _i < 2; ++_i) \
        __builtin_amdgcn_global_load_lds((const unsigned*)((const char*)(gbase) + (voff)[_i]), (LAS unsigned*)(lds + (bufoff) + ldsw + _i * 8192), 16, 0, 0); } while (0)
#if GEMM32
#define PG8_LDA(dst, b, h) do { _Pragma("unroll") for (int m = 0; m < 2; ++m) _Pragma("unroll") for (int k = 0; k < 4; ++k) dst[m][k] = *(const LAS bf16x8*)(lds + PG8_SA(b, h) + ((k & 1) ? aO : aE) + m * 4096 + (k >> 1) * 1024); } while (0)
#define PG8_LDB(dst, b, h) do { _Pragma("unroll") for (int k = 0; k < 4; ++k) dst[k] = *(const LAS bf16x8*)(lds + PG8_SB(b, h) + ((k & 1) ? bO : bE) + (k >> 1) * 1024); } while (0)
#define PG8_MMA(ai, bj, At, Bt) do { __builtin_amdgcn_s_setprio(1); _Pragma("unroll") for (int k = 0; k < 4; ++k) _Pragma("unroll") for (int m = 0; m < 2; ++m) \
        acc[ai][bj][m] = __builtin_amdgcn_mfma_f32_32x32x16_bf16(Bt[k], At[m][k], acc[ai][bj][m], 0, 0, 0); __builtin_amdgcn_s_setprio(0); } while (0)
#else
#define PG8_LDA(dst, b, h) do { _Pragma("unroll") for (int m = 0; m < 4; ++m) _Pragma("unroll") for (int k = 0; k < 2; ++k) dst[m][k] = *(const LAS bf16x8*)(lds + PG8_SA(b, h) + aoff + m * 2048 + k * 1024); } while (0)
#define PG8_LDB(dst, b, h) do { _Pragma("unroll") for (int n = 0; n < 2; ++n) _Pragma("unroll") for (int k = 0; k < 2; ++k) dst[n][k] = *(const LAS bf16x8*)(lds + PG8_SB(b, h) + boff + n * 2048 + k * 1024); } while (0)
#define PG8_MMA(ai, bj, At, Bt) do { __builtin_amdgcn_s_setprio(1); _Pragma("unroll") for (int m = 0; m < 4; ++m) _Pragma("unroll") for (int n = 0; n < 2; ++n) _Pragma("unroll") for (int k = 0; k < 2; ++k) \
        acc[ai][bj][m][n] = __builtin_amdgcn_mfma_f32_16x16x32_bf16(Bt[n][k], At[m][k], acc[ai][bj][m][n], 0, 0, 0); __builtin_amdgcn_s_setprio(0); } while (0)
#endif
#define PG8_WAIT_V(n) asm volatile("s_waitcnt vmcnt(" #n ")" ::: "memory")
#define PG8_WAIT_L(n) asm volatile("s_waitcnt lgkmcnt(" #n ")" ::: "memory")
#define PG8_BAR __builtin_amdgcn_s_barrier()
#define PG8_SCHED __builtin_amdgcn_sched_barrier(0)
    Unit cur, nxt; int ui = 0;
    LAS volatile int* qs = (LAS volatile int*)(lds + QSLOT_OFF);
    if constexpr (Sched::DYN) { if (tid == 0) { qs[0] = S.pull(); qs[1] = S.pull(); } __syncthreads(); if (!S.unit_of(qs[0], cur)) return; }
    else { if (!S.next(0, cur)) return; }
#if GEMM32
    typedef float f32x16 __attribute__((ext_vector_type(16)));
    f32x16 acc[2][2][2];
#define PG8_ZERO() do { _Pragma("unroll") for (int a = 0; a < 2; ++a) _Pragma("unroll") for (int b = 0; b < 2; ++b) _Pragma("unroll") for (int m = 0; m < 2; ++m) \
        acc[a][b][m] = (f32x16){0.f, 0.f, 0.f, 0.f, 0.f, 0.f, 0.f, 0.f, 0.f, 0.f, 0.f, 0.f, 0.f, 0.f, 0.f, 0.f}; } while (0)
    PG8_ZERO();
    bf16x8 At[2][4], B0[4], B1[4];
#else
    f32x4 acc[2][2][4][2];
#define PG8_ZERO() do { _Pragma("unroll") for (int a = 0; a < 2; ++a) _Pragma("unroll") for (int b = 0; b < 2; ++b) _Pragma("unroll") for (int m = 0; m < 4; ++m) _Pragma("unroll") for (int n = 0; n < 2; ++n) \
        acc[a][b][m][n] = (f32x4){0.f, 0.f, 0.f, 0.f}; } while (0)
    PG8_ZERO();
    bf16x8 At[4][2], B0[2][2], B1[2][2];
#endif
#define PG8_AP(u) ((const char*)g.A + (size_t)(u).pm * tstepA)
    const char* cA = PG8_AP(cur); const char* cB = (const char*)g.Bt + (size_t)cur.pn * tstepB;
    S.a_ready(cur);
    PG8_STAGE(PG8_SB(0, 0), cB, voffB); PG8_STAGE(PG8_SB(0, 1), cB + hstepB, voffB); PG8_STAGE(PG8_SA(0, 0), cA, voffA); PG8_STAGE(PG8_SA(0, 1), cA + hstepA, voffA);
    if (wr == 1) PG8_BAR;
    PG8_WAIT_V(2); PG8_BAR;
    PG8_STAGE(PG8_SB(1, 0), cB + kstep, voffB); PG8_STAGE(PG8_SA(1, 0), cA + kstep, voffA); PG8_STAGE(PG8_SB(1, 1), cB + hstepB + kstep, voffB);
    PG8_WAIT_V(6); PG8_BAR;
    for (;;) {
        bool has_next = false; const char* nA = cA; const char* nB = cB;
        if constexpr (!Sched::DYN) { has_next = S.next(ui + 1, nxt); if (has_next) { nA = PG8_AP(nxt); nB = (const char*)g.Bt + (size_t)nxt.pn * tstepB; } }
        for (int t = 0; t < nt; t += 2) {
            const bool last = (t == nt - 2);
            if constexpr (Sched::DYN) { if (last) { has_next = S.unit_of(qs[(ui + 1) & 1], nxt); if (has_next) { nA = PG8_AP(nxt); nB = (const char*)g.Bt + (size_t)nxt.pn * tstepB; } } }
            const char* a1 = cA + (size_t)(t + 1) * kstep;
            const char* a2 = last ? nA : cA + (size_t)(t + 2) * kstep; const char* b2 = last ? nB : cB + (size_t)(t + 2) * kstep;
            const char* a3 = a2 + kstep; const char* b3 = b2 + kstep;
            if (last && has_next) S.a_ready(nxt);
            PG8_LDB(B0, 0, 0); PG8_LDB(B1, 0, 1); PG8_SCHED; PG8_LDA(At, 0, 0); PG8_STAGE(PG8_SA(1, 1), a1 + hstepA, voffA);
            PG8_WAIT_V(8); PG8_WAIT_L(0); PG8_BAR; PG8_MMA(0, 0, At, B0); PG8_MMA(0, 1, At, B1); PG8_BAR; PG8_SCHED;
            PG8_LDA(At, 0, 1); PG8_STAGE(PG8_SB(0, 0), b2, voffB); PG8_STAGE(PG8_SB(0, 1), b2 + hstepB, voffB); PG8_STAGE(PG8_SA(0, 0), a2, voffA);
            PG8_WAIT_V(8); PG8_WAIT_L(0); PG8_BAR; PG8_MMA(1, 0, At, B0); PG8_MMA(1, 1, At, B1); PG8_BAR; PG8_SCHED;
            PG8_LDB(B0, 1, 0); PG8_LDB(B1, 1, 1); PG8_SCHED; PG8_LDA(At, 1, 0); PG8_STAGE(PG8_SA(0, 1), a2 + hstepA, voffA);
            PG8_WAIT_V(8); PG8_WAIT_L(0); PG8_BAR; PG8_MMA(0, 0, At, B0); PG8_MMA(0, 1, At, B1); PG8_BAR; PG8_SCHED;
            PG8_LDA(At, 1, 1); PG8_STAGE(PG8_SB(1, 0), b3, voffB); PG8_STAGE(PG8_SB(1, 1), b3 + hstepB, voffB); PG8_STAGE(PG8_SA(1, 0), a3, voffA);
            PG8_WAIT_V(8); PG8_WAIT_L(0); PG8_BAR; PG8_MMA(1, 0, At, B0); PG8_MMA(1, 1, At, B1); PG8_BAR; PG8_SCHED;
        }
        if (wr == 0) PG8_BAR;
        {
#if GEMM32
            const int row0 = cur.pm * BM + wr * 64 + r32, col00 = cur.pn * BM + wc * 32 + 16 * hi;
#define PG8_EROW(cc) (row0 + ((cc) >> 3) * HALF + (((cc) >> 2) & 1) * 32)
#define PG8_ECOL(cc) (col00 + (((cc) >> 1) & 1) * HALF + ((cc) & 1) * 8)
#define PG8_EVAL(cc, j) acc[(cc) >> 3][((cc) >> 1) & 1][((cc) >> 2) & 1][8 * ((cc) & 1) + (j)]
#else
            const int row0 = cur.pm * BM + wr * 64 + fr, col00 = cur.pn * BM + wc * 32 + 8 * fq;
#define PG8_EROW(cc) (row0 + ((cc) >> 3) * HALF + (((cc) >> 1) & 3) * 16)
#define PG8_ECOL(cc) (col00 + ((cc) & 1) * HALF)
#define PG8_EVAL(cc, j) acc[(cc) >> 3][(cc) & 1][((cc) >> 1) & 3][(j) >> 2][(j) & 3]
#endif
            int e2 = 0; if constexpr (Sched::DYN) { if (tid == 0) e2 = S.pull(); }
            constexpr int NBT = sizeof(typename Epi::Regs) <= 8 ? 16 : (sizeof(typename Epi::Regs) <= 32 ? 8 : 4);
#pragma unroll
            for (int c0 = 0; c0 < 16; c0 += NBT) {
                typename Epi::Regs R[NBT];
#pragma unroll
                for (int c = 0; c < NBT; ++c) { const int cc = c0 + c; E.load(PG8_EROW(cc), PG8_ECOL(cc), R[c]); }
                PG8_SCHED;
#pragma unroll
                for (int c = 0; c < NBT; ++c) { const int cc = c0 + c;
                    const float _v[8] = {PG8_EVAL(cc, 0), PG8_EVAL(cc, 1), PG8_EVAL(cc, 2), PG8_EVAL(cc, 3), PG8_EVAL(cc, 4), PG8_EVAL(cc, 5), PG8_EVAL(cc, 6), PG8_EVAL(cc, 7)};
                    E.apply(PG8_EROW(cc), PG8_ECOL(cc), _v, R[c]); }
                PG8_SCHED;
            }
#undef PG8_EROW
#undef PG8_ECOL
#undef PG8_EVAL
            if constexpr (Sched::DYN) { if (tid == 0) qs[ui & 1] = e2; }
        }
        S.done(cur);
        if (!has_next) break;
        PG8_ZERO();
        cur = nxt; cA = nA; cB = nB; ++ui;
        if (wr == 1) PG8_BAR;
    }
    PG8_WAIT_V(0);
    PG8_BAR;
#undef PG8_AP
#undef PG8_ZERO
#undef PG8_SA
#undef PG8_SB
#undef PG8_STAGE
#undef PG8_LDA
#undef PG8_LDB
#undef PG8_MMA
#undef PG8_WAIT_V
#undef PG8_WAIT_L
#undef PG8_BAR
#undef PG8_SCHED
}

template <class Epi>
__device__ __forceinline__ void gemm_simple(const Gemm g, const Epi& E, int G, int wg) {
    const int tid = otid(), wid = tid >> 6, lane = tid & 63, fr = lane & 15, fq = lane >> 4;
    const int nbn = g.N / 32, nblk = (g.M / 16) * nbn;
    for (int it = wg * NWAVES + wid; it < nblk; it += G * NWAVES) {
        const int m0 = (it / nbn) * 16, n0 = (it % nbn) * 32;
        f32x4 acc0 = {0.f, 0.f, 0.f, 0.f}, acc1 = {0.f, 0.f, 0.f, 0.f};
        const bf16_t* ap = g.A + (size_t)(m0 + fr) * g.lda + 8 * fq;
        const bf16_t* bp0 = g.Bt + (size_t)(n0 + perm32_16(fr)) * g.K + 8 * fq;
        const bf16_t* bp1 = g.Bt + (size_t)(n0 + perm32_16(16 + fr)) * g.K + 8 * fq;
        for (int k0 = 0; k0 < g.K; k0 += 32) {
            const bf16x8 a = *(const bf16x8*)(ap + k0), b0 = *(const bf16x8*)(bp0 + k0), b1 = *(const bf16x8*)(bp1 + k0);
            acc0 = __builtin_amdgcn_mfma_f32_16x16x32_bf16(b0, a, acc0, 0, 0, 0);
            acc1 = __builtin_amdgcn_mfma_f32_16x16x32_bf16(b1, a, acc1, 0, 0, 0);
        }
        const float v[8] = {acc0[0], acc0[1], acc0[2], acc0[3], acc1[0], acc1[1], acc1[2], acc1[3]};
        typename Epi::Regs rg; E.load(m0 + fr, n0 + 8 * fq, rg); E.apply(m0 + fr, n0 + 8 * fq, v, rg);
    }
}
}

#ifndef GEMM_REPEAT
#define GEMM_REPEAT 1
#endif
template <class Epi>
__device__ __forceinline__ void run_gemm(LAS unsigned char* lds, const pg8::Gemm g, const Epi& E, int G, int wg, int rep = 1) {
#if FAST_GEMM
    if (rep < 0) { pg8::gemm_simple<Epi>(g, E, G, wg); return; }
    for (int rr = 0; rr < rep; ++rr) { pg8::StaticOrder S; S.init(g.M, g.N, G, wg); pg8::gemm_phase<Epi, pg8::StaticOrder>(lds, g, S, E); }
#else
    pg8::gemm_simple<Epi>(g, E, G, wg);
#endif
}
template <class Epi>
__device__ __forceinline__ void run_gemm_dyn(LAS unsigned char* lds, const pg8::Gemm g, const Epi& E, int G, int wg, unsigned* heads) {
#if FAST_GEMM && DYN_GEMM
    pg8::DynOrder S; S.init(g.M, g.N, wg, heads); pg8::gemm_phase<Epi, pg8::DynOrder>(lds, g, S, E);
#else
    run_gemm(lds, g, E, G, wg, 1);
#endif
}

constexpr float SSQ_SCALE = 16777216.f, SSQ_INV = 1.f / 16777216.f;
__device__ __forceinline__ void ssq_add(u64* dst, int row, const float (&v)[8]) {
    float s = 0.f;
#pragma unroll
    for (int j = 0; j < 8; ++j) s += v[j] * v[j];
#if GEMM32
    s = sum_xor32(s);
    if ((otid() & 63) < 32) atomicAdd(dst + row, (u64)(s * SSQ_SCALE));
#else
    s += swz_xor<16>(s); s = sum_xor32(s);
    if ((otid() & 63) < 16) atomicAdd(dst + row, (u64)(s * SSQ_SCALE));
#endif
}
__device__ __forceinline__ float ld_ssq(const u64* p) { return (float)__hip_atomic_load(p, __ATOMIC_RELAXED, __HIP_MEMORY_SCOPE_AGENT) * SSQ_INV; }
__device__ __forceinline__ void st_f32x8(float* p, const float (&v)[8]) { *(f32x4*)p = (f32x4){v[0], v[1], v[2], v[3]}; *(f32x4*)(p + 4) = (f32x4){v[4], v[5], v[6], v[7]}; }
__device__ __forceinline__ void ld_f32x8(const float* p, float (&v)[8]) { const f32x4 a = *(const f32x4*)p, b = *(const f32x4*)(p + 4); v[0] = a.x; v[1] = a.y; v[2] = a.z; v[3] = a.w; v[4] = b.x; v[5] = b.y; v[6] = b.z; v[7] = b.w; }
__device__ __forceinline__ void ld_bf16x8(const bf16* p, float (&v)[8]) { unpack8(*(const u32x4*)p, v); }

struct EpiInProj {
    const u64* ssq; u64* ssqc; bf16* proj; float* misc; int live = 1;
    struct Regs { float rs; };
    __device__ __forceinline__ void load(int row, int col0, Regs& r) const { r.rs = rsqrtf(ld_ssq(ssq + row) * (1.f / DM) + EPS); }
    __device__ __forceinline__ void apply(int row, int col0, const float (&a)[8], const Regs& r) const {
        float v[8];
#pragma unroll
        for (int j = 0; j < 8; ++j) v[j] = a[j] * r.rs;
        const int tile = col0 >> 8;
        if (tile == 60) { const int c = col0 - PC_KR; if (c < 128) st_f32x8(misc + (size_t)row * 128 + c, v); return; }
        if (tile >= 44) {
#pragma unroll
            for (int j = 0; j < 8; ++j) v[j] = sigmoidf_(v[j]);
        }
        *(u32x4*)(proj + (size_t)row * DINP + col0) = pack8(v);
        if (tile < 4 && live) ssq_add(ssqc + (size_t)(tile >> 1) * M, row, v);
    }
};
struct EpiScaleBf16 {
    const u64* ssq; float inv_n; bf16* O; int ldo;
    struct Regs { float rs; };
    __device__ __forceinline__ void load(int row, int col0, Regs& r) const { r.rs = ssq ? rsqrtf(ld_ssq(ssq + row) * inv_n + EPS) : 1.f; }
    __device__ __forceinline__ void apply(int row, int col0, const float (&a)[8], const Regs& r) const {
        float v[8];
#pragma unroll
        for (int j = 0; j < 8; ++j) v[j] = a[j] * r.rs;
        *(u32x4*)(O + (size_t)row * ldo + col0) = pack8(v);
    }
};
struct EpiQKV {
    const u64* ssqc; bf16* Q; bf16* KV;
    struct Regs { float rs; };
    __device__ __forceinline__ void load(int row, int col0, Regs& r) const { const bool isq = col0 < NH * QK; r.rs = rsqrtf(ld_ssq(ssqc + (isq ? 0 : M) + row) * (1.f / QL) + EPS); }
    __device__ __forceinline__ void apply(int row, int col0, const float (&a)[8], const Regs& r) const {
        float v[8];
#pragma unroll
        for (int j = 0; j < 8; ++j) v[j] = a[j] * r.rs;
        if (col0 < NH * QK) *(u32x4*)(Q + (size_t)row * (NH * QK) + col0) = pack8(v);
        else *(u32x4*)(KV + (size_t)row * (NH * 256) + (col0 - NH * QK)) = pack8(v);
    }
};
struct EpiGateF32 {
    const bf16* proj; bf16* T;
    struct Regs { u32x4 g; };
    __device__ __forceinline__ void load(int row, int col0, Regs& r) const { r.g = *(const u32x4*)(proj + (size_t)row * DINP + PC_G + col0); }
    __device__ __forceinline__ void apply(int row, int col0, const float (&a)[8], const Regs& r) const {
        float g[8], v[8]; unpack8(r.g, g);
#pragma unroll
        for (int j = 0; j < 8; ++j) v[j] = a[j] * g[j];
        *(u32x4*)(T + (size_t)row * DM + col0) = pack8(v);
    }
};
struct EpiMerge {
    const bf16* proj; const bf16* T; bf16* O;
    struct Regs { u32x4 g; u32x4 t; };
    __device__ __forceinline__ void load(int row, int col0, Regs& r) const { r.g = *(const u32x4*)(proj + (size_t)row * DINP + PC_G + DM + col0); r.t = *(const u32x4*)(T + (size_t)row * DM + col0); }
    __device__ __forceinline__ void apply(int row, int col0, const float (&a)[8], const Regs& r) const {
        float g[8], t[8], v[8]; unpack8(r.g, g); unpack8(r.t, t);
#pragma unroll
        for (int j = 0; j < 8; ++j) v[j] = t[j] + a[j] * g[j];
        *(u32x4*)(O + (size_t)row * DM + col0) = pack8(v);
    }
};
struct EpiResid {
    const bf16* XBo; bf16* XBn; u64* ssq_next; float live = 1.f;
    struct Regs { u32x4 x; };
    __device__ __forceinline__ void load(int row, int col0, Regs& r) const { r.x = *(const u32x4*)(XBo + (size_t)row * DM + col0); }
    __device__ __forceinline__ void apply(int row, int col0, const float (&a)[8], const Regs& r) const {
        float x[8]; unpack8(r.x, x);
#pragma unroll
        for (int j = 0; j < 8; ++j) x[j] += a[j] * live;
        *(u32x4*)(XBn + (size_t)row * DM + col0) = pack8(x);
        if (ssq_next && live != 0.f) ssq_add(ssq_next, row, x);
    }
};
struct EpiUp {
    const u64* ssq; bf16* U;
    struct Regs { float rs; };
    __device__ __forceinline__ void load(int row, int col0, Regs& r) const { r.rs = rsqrtf(ld_ssq(ssq + row) * (1.f / DM) + EPS); }
    __device__ __forceinline__ void apply(int row, int col0, const float (&a)[8], const Regs& r) const {
        float v[8];
#pragma unroll
        for (int j = 0; j < 8; ++j) { const float t = fmaxf(a[j] * r.rs, 0.f); v[j] = t * t; }
        *(u32x4*)(U + (size_t)row * DFF + col0) = pack8(v);
    }
};
struct EpiPleGate {
    const u64* ssq; const bf16* PE; const bf16* XBo; bf16* XBn; float* OUT; u64* ssq_next; float live = 1.f;
    struct Regs { float rs; u32x4 x; u32x4 pe; };
    __device__ __forceinline__ void load(int row, int col0, Regs& r) const { r.rs = rsqrtf(ld_ssq(ssq + row) * (1.f / DM) + EPS);
        r.x = *(const u32x4*)(XBo + (size_t)row * DM + col0); r.pe = *(const u32x4*)(PE + (size_t)row * DM + col0); }
    __device__ __forceinline__ void apply(int row, int col0, const float (&a)[8], const Regs& r) const {
        float x[8], pe[8]; unpack8(r.x, x); unpack8(r.pe, pe);
#pragma unroll
        for (int j = 0; j < 8; ++j) x[j] += pe[j] * sigmoidf_(a[j] * r.rs) * live;
        if (OUT) st_f32x8(OUT + (size_t)row * DM + col0, x);
        else *(u32x4*)(XBn + (size_t)row * DM + col0) = pack8(x);
        if (ssq_next && live != 0.f) ssq_add(ssq_next, row, x);
    }
};

__device__ __forceinline__ void transpose_item(const float* W, int K, int Nsrc, int nsrc0, const float* gain, bf16* WT, int ndst0, int k0, LAS float* scr, int lane) {
    f32x4 v[16];
    const int rq = lane >> 4, c4 = (lane & 15) * 4;
    if (nsrc0 >= 0) {
#pragma unroll
        for (int i = 0; i < 16; ++i) v[i] = *(const f32x4*)(W + (size_t)(k0 + 4 * i + rq) * Nsrc + nsrc0 + c4);
        if (gain) {
#pragma unroll
            for (int i = 0; i < 16; ++i) v[i] = v[i] * gain[k0 + 4 * i + rq];
        }
    } else {
#pragma unroll
        for (int i = 0; i < 16; ++i) v[i] = (f32x4){0.f, 0.f, 0.f, 0.f};
    }
#pragma unroll
    for (int hh = 0; hh < 2; ++hh) {
#pragma unroll
        for (int i = 0; i < 8; ++i) { LAS float* d = scr + (4 * i + rq) * 65 + c4; const f32x4 t = v[8 * hh + i]; d[0] = t.x; d[1] = t.y; d[2] = t.z; d[3] = t.w; }
        LDS_WAIT(); asm volatile("" ::: "memory");
        const int c = lane & 3, nq = lane >> 2;
#pragma unroll
        for (int j = 0; j < 4; ++j) { const int n = 16 * j + nq; const LAS float* s = scr + (8 * c) * 65 + n;
            u32x4 o; o.x = pk2(s[0 * 65], s[1 * 65]); o.y = pk2(s[2 * 65], s[3 * 65]); o.z = pk2(s[4 * 65], s[5 * 65]); o.w = pk2(s[6 * 65], s[7 * 65]);
            *(u32x4*)(WT + (size_t)(ndst0 + n) * K + k0 + 32 * hh + 8 * c) = o; }
        LDS_WAIT(); asm volatile("" ::: "memory");
    }
}
__host__ __device__ __forceinline__ int inproj_src_col(int n) {
    if (n < PC_Z) return n;
    if (n < PC_G) return n + 64;
    if (n < PC_KR) return n + 128;
    if (n < PC_DT) return n - PC_KR + 1024;
    if (n < PC_PAD) return n - PC_DT + 11328;
    return -1;
}
constexpr int I_IN = (DM / 64) * (DINP / 64), I_UQ = (QL / 64) * (NH * QK / 64), I_UKV = (KVL / 64) * (NH * 256 / 64), I_OM = (DM / 64) * (DM / 64), I_OS = (DI / 64) * (DM / 64),
              I_OUT = I_OM, I_UP = (DM / 64) * (DFF / 64), I_DN = (DFF / 64) * (DM / 64), I_PG = I_OM, I_PL = (PLE / 64) * (DM / 64),
              I_LAYER = I_IN + I_UQ + I_UKV + I_OM + I_OS + I_OUT + I_UP + I_DN + I_PG + I_PL;
__device__ __forceinline__ void prologue_weights(const float* const (&inp)[26], unsigned char* ws, LAS unsigned char* lds, int G, int wg, int l_lo, int l_hi) {
    const int wave = otid() >> 6, lane = otid() & 63;
    LAS float* scr = (LAS float*)(lds + RING_OFF + wave * 16384);
    for (int it = l_lo * I_LAYER + wg * NWAVES + wave; it < l_hi * I_LAYER; it += G * NWAVES) {
        const int l = it / I_LAYER; int r = it % I_LAYER;
        unsigned char* wl = ws + WS_W + (size_t)l * WL_BYTES;
        if (r < I_IN) { const int nblk = DINP / 64, kb = r / nblk, nb = r % nblk;
            transpose_item(inp[4] + (size_t)l * DM * DIN, DM, DIN, inproj_src_col(64 * nb), inp[3] + l * DM, (bf16*)(wl + WL_IN), 64 * nb, 64 * kb, scr, lane); continue; } r -= I_IN;
        if (r < I_UQ) { const int nblk = NH * QK / 64, kb = r / nblk, nb = r % nblk;
            transpose_item(inp[6] + (size_t)l * QL * NH * QK, QL, NH * QK, 64 * nb, inp[5] + l * QL, (bf16*)(wl + WL_UQ), 64 * nb, 64 * kb, scr, lane); continue; } r -= I_UQ;
        if (r < I_UKV) { const int nblk = NH * 256 / 64, kb = r / nblk, nb = r % nblk;
            transpose_item(inp[8] + (size_t)l * KVL * NH * 256, KVL, NH * 256, 64 * nb, inp[7] + l * KVL, (bf16*)(wl + WL_UKV), 64 * nb, 64 * kb, scr, lane); continue; } r -= I_UKV;
        if (r < I_OM) { const int nblk = DM / 64, kb = r / nblk, nb = r % nblk;
            transpose_item(inp[11] + (size_t)l * DM * DM, DM, DM, 64 * nb, nullptr, (bf16*)(wl + WL_OM), 64 * nb, 64 * kb, scr, lane); continue; } r -= I_OM;
        if (r < I_OS) { const int nblk = DM / 64, kb = r / nblk, nb = r % nblk;
            transpose_item(inp[18] + (size_t)l * DI * DM, DI, DM, 64 * nb, inp[17] + l * DI, (bf16*)(wl + WL_OS), 64 * nb, 64 * kb, scr, lane); continue; } r -= I_OS;
        if (r < I_OUT) { const int nblk = DM / 64, kb = r / nblk, nb = r % nblk;
            transpose_item(inp[19] + (size_t)l * DM * DM, DM, DM, 64 * nb, nullptr, (bf16*)(wl + WL_OUT), 64 * nb, 64 * kb, scr, lane); continue; } r -= I_OUT;
        if (r < I_UP) { const int nblk = DFF / 64, kb = r / nblk, nb = r % nblk;
            transpose_item(inp[21] + (size_t)l * DM * DFF, DM, DFF, 64 * nb, inp[20] + l * DM, (bf16*)(wl + WL_UP), 64 * nb, 64 * kb, scr, lane); continue; } r -= I_UP;
        if (r < I_DN) { const int nblk = DM / 64, kb = r / nblk, nb = r % nblk;
            transpose_item(inp[22] + (size_t)l * DFF * DM, DFF, DM, 64 * nb, nullptr, (bf16*)(wl + WL_DN), 64 * nb, 64 * kb, scr, lane); continue; } r -= I_DN;
        if (r < I_PG) { const int nblk = DM / 64, kb = r / nblk, nb = r % nblk;
            transpose_item(inp[24] + (size_t)l * DM * DM, DM, DM, 64 * nb, inp[23] + l * DM, (bf16*)(wl + WL_PG), 64 * nb, 64 * kb, scr, lane); continue; } r -= I_PG;
        { const int nblk = DM / 64, kb = r / nblk, nb = r % nblk;
            transpose_item(inp[25] + (size_t)l * PLE * DM, PLE, DM, 64 * nb, nullptr, (bf16*)(wl + WL_PL), 64 * nb, 64 * kb, scr, lane); }
    }
}
__device__ __forceinline__ void prologue_rows(const float* const (&inp)[26], float* out, unsigned char* ws, int G, int wg) {
    const int wave = otid() >> 6, lane = otid() & 63, gw = wg * NWAVES + wave, NGW = G * NWAVES;
    const float* x = inp[0]; bf16* XB = (bf16*)(ws + WS_XB); u64* ssq0 = (u64*)((unsigned*)(ws + WS_CTL) + CW_SSQX);
    for (int m = gw; m < M; m += NGW) {
        float s = 0.f;
#pragma unroll
        for (int j = 0; j < 8; ++j) { const f32x4 v = *(const f32x4*)(x + (size_t)m * DM + j * 256 + lane * 4);
            s += v.x * v.x + v.y * v.y + v.z * v.z + v.w * v.w;
            u32x2 o; o.x = pk2(v.x, v.y); o.y = pk2(v.z, v.w); *(u32x2*)(XB + (size_t)m * DM + j * 256 + lane * 4) = o; }
        s = wave_sum(s); if (lane == 0) ssq0[m] = (u64)(s * SSQ_SCALE);
    }
    {
        u64* z0 = (u64*)((unsigned*)(ws + WS_CTL) + CW_SSQX) + M; const int nz = (DEPTH * 3 - 1) * M + DEPTH * 2 * M;
        for (int i = wg * NTHR + otid(); i < nz; i += G * NTHR) z0[i] = 0ull;
    }
    const float* p = inp[1]; bf16* PB = (bf16*)(ws + WS_PB);
    for (size_t i = (size_t)wg * NTHR + otid(); i < (size_t)DEPTH * M * PLE / 8; i += (size_t)G * NTHR) { float v[8]; ld_f32x8(p + i * 8, v); *(u32x4*)(PB + i * 8) = pack8(v); }
    const int* pos = (const int*)inp[2]; float* COS = (float*)(ws + WS_COS); float* SIN = (float*)(ws + WS_SIN);
    for (int i = wg * NTHR + otid(); i < M * 32; i += G * NTHR) { const int m = i >> 5, k = i & 31;
        const float invf = 1.0f / (float)pow(10000.0, (double)k / 32.0);
        const float ang = (float)pos[m] * invf;
        COS[i] = (float)cos((double)ang); SIN[i] = (float)sin((double)ang); }
}

__device__ __forceinline__ void phase_kfin(const bf16* KVRAW, const float* MISC, const float* kw, const float* COS, const float* SIN, bf16* KF, LAS unsigned char* lds, int G, int wg) {
    const int tid = otid(), wave = __builtin_amdgcn_readfirstlane(tid >> 6), lane = tid & 63, hh = lane >> 2, q4 = lane & 3;
    LAS float* krl = (LAS float*)(lds + RING_OFF) + wave * 64;
    float wn[32];
#pragma unroll
    for (int j = 0; j < 32; j += 4) { const f32x4 t = *(const f32x4*)(kw + q4 * 32 + j); wn[j] = t.x; wn[j + 1] = t.y; wn[j + 2] = t.z; wn[j + 3] = t.w; }
    const float wr = kw[128 + lane];
    for (int m = wg * NWAVES + wave; m < M; m += G * NWAVES) {
        u32x4 raw[4];
#pragma unroll
        for (int i = 0; i < 4; ++i) raw[i] = *(const u32x4*)(KVRAW + (size_t)m * 4096 + hh * 256 + q4 * 32 + i * 8);
        const float kr = MISC[(size_t)m * 128 + lane], cs = COS[m * 32 + (lane & 31)], sn = SIN[m * 32 + (lane & 31)];
        float f[32], ss = 0.f;
#pragma unroll
        for (int i = 0; i < 4; ++i) { float t[8]; unpack8(raw[i], t);
#pragma unroll
            for (int j = 0; j < 8; ++j) { f[i * 8 + j] = t[j]; ss += t[j] * t[j]; } }
        ss += swz_xor<1>(ss); ss += swz_xor<2>(ss);
        const float rs = rsqrtf((ss + wave_sum(kr * kr)) * (1.f / QK) + EPS);
        const float t2 = kr * wr, o2 = get_xor32(t2, lane);
        krl[lane] = lane < 32 ? (t2 * cs - o2 * sn) : (o2 * sn + t2 * cs);
        bf16* o = KF + (size_t)m * (NH * QK) + hh * QK;
#pragma unroll
        for (int i = 0; i < 4; ++i) { float t[8];
#pragma unroll
            for (int j = 0; j < 8; ++j) t[j] = f[i * 8 + j] * rs * wn[i * 8 + j];
            *(u32x4*)(o + q4 * 32 + i * 8) = pack8(t); }
        LDS_WAIT();
#pragma unroll
        for (int i = 0; i < 2; ++i) { const f32x4 a0 = *(LAS const f32x4*)(krl + q4 * 16 + i * 8), a1 = *(LAS const f32x4*)(krl + q4 * 16 + i * 8 + 4);
            const float t[8] = {a0.x * rs, a0.y * rs, a0.z * rs, a0.w * rs, a1.x * rs, a1.y * rs, a1.z * rs, a1.w * rs};
            *(u32x4*)(o + 128 + q4 * 16 + i * 8) = pack8(t); }
        LDS_WAIT();
    }
}
__device__ __forceinline__ void phase_ssdpre(const bf16* PROJ, const float* MISC, const float* cw, const float* cb, const float* dtb, bf16* XC, float* DTS, int G, int wg) {
    const int tid = otid();
    for (int gid = wg * NTHR + tid; gid < (CONVD / 8) * (M / TC); gid += G * NTHR) {
        const int c0 = (gid % (CONVD / 8)) * 8, seg = gid / (CONVD / 8), m0 = seg * TC;
        float w0[8], w1[8], w2[8], w3[8], bs[8], xa[8], xb[8], xc[8];
        ld_f32x8(cw + c0, w0); ld_f32x8(cw + CONVD + c0, w1); ld_f32x8(cw + 2 * CONVD + c0, w2); ld_f32x8(cw + 3 * CONVD + c0, w3); ld_f32x8(cb + c0, bs);
        const bf16* src = PROJ + (size_t)m0 * DINP + PC_XBC + c0; bf16* dst = XC + (size_t)m0 * CONVD + c0;
        if (m0 % SEQ != 0) { ld_bf16x8(src - 3 * (size_t)DINP, xa); ld_bf16x8(src - 2 * (size_t)DINP, xb); ld_bf16x8(src - (size_t)DINP, xc); }
        else {
#pragma unroll
            for (int e = 0; e < 8; ++e) { xa[e] = 0.f; xb[e] = 0.f; xc[e] = 0.f; } }
        for (int t0 = 0; t0 < TC; t0 += 8) {
            u32x4 r[8];
#pragma unroll
            for (int i = 0; i < 8; ++i) r[i] = *(const u32x4*)(src + (size_t)(t0 + i) * DINP);
#pragma unroll
            for (int i = 0; i < 8; ++i) { float xd[8], acc[8]; unpack8(r[i], xd);
#pragma unroll
                for (int e = 0; e < 8; ++e) { acc[e] = siluf_(bs[e] + xa[e] * w0[e] + xb[e] * w1[e] + xc[e] * w2[e] + xd[e] * w3[e]); xa[e] = xb[e]; xb[e] = xc[e]; xc[e] = xd[e]; }
                *(u32x4*)(dst + (size_t)(t0 + i) * CONVD) = pack8(acc); }
        }
    }
    for (int i = wg * NTHR + tid; i < M * SH; i += G * NTHR) { const int m = i >> 6, h = i & 63;
        const float x = MISC[(size_t)m * 128 + 64 + h] + dtb[h], e = __expf(-fabsf(x));
        const float lp = e < 0.01f ? e * (1.f - e * (0.5f - e * (1.f / 3.f))) : __logf(1.f + e); DTS[i] = fmaxf(x, 0.f) + lp; }
}
__device__ __forceinline__ void phase_ssdnorm(const float* YPRE, const bf16* PROJ, bf16* Y, int G, int wg) {
    const int wave = otid() >> 6, lane = otid() & 63;
    for (int it = wg * NWAVES + wave; it < M * SG; it += G * NWAVES) {
        const int m = it >> 3, g = it & 7, c0 = g * 512 + lane * 8;
        float y[8], z[8]; ld_f32x8(YPRE + (size_t)m * DI + c0, y); ld_bf16x8(PROJ + (size_t)m * DINP + PC_Z + c0, z);
        float s = 0.f;
#pragma unroll
        for (int e = 0; e < 8; ++e) { y[e] *= siluf_(z[e]); s += y[e] * y[e]; }
        const float rs = rsqrtf(wave_sum(s) * (1.f / 512.f) + EPS);
#pragma unroll
        for (int e = 0; e < 8; ++e) y[e] *= rs;
        *(u32x4*)(Y + (size_t)m * DI + c0) = pack8(y);
    }
}

namespace attn {
typedef float f32x16 __attribute__((ext_vector_type(16)));
typedef short s16x4 __attribute__((ext_vector_type(4)));
constexpr int KB_BYTES = 64 * QK * 2, VB_BYTES = 64 * VD * 2;
constexpr int L_K0 = 0, L_K1 = KB_BYTES, L_V0 = 2 * KB_BYTES, L_V1 = 2 * KB_BYTES + VB_BYTES, L_WS = 2 * KB_BYTES + 2 * VB_BYTES;
constexpr float QSCALE = 0.07216878364870322f * 1.4426950408889634f;
constexpr float THR2 = 8.f;
#define ASBAR() __builtin_amdgcn_sched_barrier(0)
#ifndef ATT_PRIO
#define ATT_PRIO 0
#endif
#if ATT_PRIO
#define AT_PRIO(x) __builtin_amdgcn_s_setprio(x)
#else
#define AT_PRIO(x)
#endif
__device__ __forceinline__ int crow(int r, int hi) { return (r & 3) + 8 * (r >> 2) + 4 * hi; }
__device__ __forceinline__ float sm_moff(float m_reg) { return (m_reg < -1e29f) ? 0.f : m_reg; }
__device__ __forceinline__ void softSM(f32x16& p0, f32x16& p1, float& m_reg, float& alpha) {
    float pmax = __builtin_fmaxf(__builtin_fmaxf(p0[0], p0[1]), p1[0]);
    pmax = __builtin_fmaxf(__builtin_fmaxf(pmax, p1[1]), p0[2]);
#pragma unroll
    for (int r = 3; r < 16; r += 2) pmax = __builtin_fmaxf(__builtin_fmaxf(pmax, p0[r]), p0[r + (r + 1 < 16 ? 1 : 0)]);
#pragma unroll
    for (int r = 2; r < 16; r += 2) pmax = __builtin_fmaxf(__builtin_fmaxf(pmax, p1[r]), p1[r + 1]);
    { auto rr = __builtin_amdgcn_permlane32_swap(__float_as_uint(pmax), __float_as_uint(pmax), false, false); pmax = fmaxf(__uint_as_float(rr[0]), __uint_as_float(rr[1])); }
    const float moff = sm_moff(m_reg);
    if (__builtin_expect(__all(pmax + moff - m_reg <= THR2), 1)) {
        alpha = 1.f;
#pragma unroll
        for (int r = 0; r < 16; ++r) p0[r] = __builtin_amdgcn_exp2f(p0[r]);
#pragma unroll
        for (int r = 0; r < 16; ++r) p1[r] = __builtin_amdgcn_exp2f(p1[r]);
    } else {
        const float mn = fmaxf(m_reg, pmax + moff), sh = mn - moff;
        alpha = __builtin_amdgcn_exp2f(m_reg - mn); m_reg = mn;
#pragma unroll
        for (int r = 0; r < 16; ++r) p0[r] = __builtin_amdgcn_exp2f(p0[r] - sh);
#pragma unroll
        for (int r = 0; r < 16; ++r) p1[r] = __builtin_amdgcn_exp2f(p1[r] - sh);
    }
}
__device__ __forceinline__ void finishSM(const f32x16& p0, const f32x16& p1, float alpha, float& l_reg, bf16x8& pa0, bf16x8& pa1, bf16x8& pa2, bf16x8& pa3) {
    typedef float f32x2_ __attribute__((ext_vector_type(2)));
    f32x2_ ps2 = (f32x2_){p0[0], p0[1]} + (f32x2_){p1[0], p1[1]};
#pragma unroll
    for (int r = 2; r < 16; r += 2) { ps2 += (f32x2_){p0[r], p0[r + 1]}; ps2 += (f32x2_){p1[r], p1[r + 1]}; }
    float ps = ps2.x + ps2.y;
    { auto rr = __builtin_amdgcn_permlane32_swap(__float_as_uint(ps), __float_as_uint(ps), false, false); ps = __uint_as_float(rr[0]) + __uint_as_float(rr[1]); }
    l_reg = l_reg * alpha + ps;
#define PK4(P, BASE, OUT) do { unsigned a0 = pk2(P[BASE + 0], P[BASE + 1]), a1 = pk2(P[BASE + 2], P[BASE + 3]);   \
    unsigned b0 = pk2(P[BASE + 4], P[BASE + 5]), b1 = pk2(P[BASE + 6], P[BASE + 7]);                              \
    auto r0 = __builtin_amdgcn_permlane32_swap(a0, b0, false, false); auto r1 = __builtin_amdgcn_permlane32_swap(a1, b1, false, false); \
    u32x4 w = {r0[0], r1[0], r0[1], r1[1]}; OUT = __builtin_bit_cast(bf16x8, w); } while (0)
    PK4(p0, 0, pa0); PK4(p0, 8, pa1); PK4(p1, 0, pa2); PK4(p1, 8, pa3);
#undef PK4
}
#define AT_KRD(dst, addr, OFF) asm volatile("ds_read_b128 %0, %1 offset:%2" : "=&v"(dst) : "v"(addr), "i"(OFF) : "memory")
#define AT_KWAIT(n) do { asm volatile("s_waitcnt lgkmcnt(" #n ")" ::: "memory"); ASBAR(); } while (0)
template <int KOFF> __device__ __forceinline__ void qkt(f32x16& p0, f32x16& p1, const int (&ka)[4], const bf16x8 (&qr)[12], float c0) {
    p0 = (f32x16){c0, c0, c0, c0, c0, c0, c0, c0, c0, c0, c0, c0, c0, c0, c0, c0}; p1 = p0;
    bf16x8 a0, b0, a1, b1, a2, b2, a3, b3;
    constexpr int RB = 32 * QK * 2;
    AT_KWAIT(0);
#define AT_KR(S, A, B) do { AT_KRD(A, ka[(S) & 3], KOFF + ((S) >> 2) * 128); AT_KRD(B, ka[(S) & 3], KOFF + ((S) >> 2) * 128 + RB); } while (0)
#define AT_STEP(S, A, B, AN, BN, W) do { if ((S) + 3 < 12) AT_KR((S) + 3, AN, BN); AT_KWAIT(W); \
        p0 = __builtin_amdgcn_mfma_f32_32x32x16_bf16(A, qr[(S)], p0, 0, 0, 0); p1 = __builtin_amdgcn_mfma_f32_32x32x16_bf16(B, qr[(S)], p1, 0, 0, 0); ASBAR(); } while (0)
    AT_KR(0, a0, b0); AT_KR(1, a1, b1); AT_KR(2, a2, b2);
    AT_PRIO(1);
    AT_STEP(0, a0, b0, a3, b3, 6); AT_STEP(1, a1, b1, a0, b0, 6); AT_STEP(2, a2, b2, a1, b1, 6); AT_STEP(3, a3, b3, a2, b2, 6);
    AT_STEP(4, a0, b0, a3, b3, 6); AT_STEP(5, a1, b1, a0, b0, 6); AT_STEP(6, a2, b2, a1, b1, 6); AT_STEP(7, a3, b3, a2, b2, 6);
    AT_STEP(8, a0, b0, a3, b3, 6); AT_STEP(9, a1, b1, a0, b0, 4); AT_STEP(10, a2, b2, a1, b1, 2); AT_STEP(11, a3, b3, a2, b2, 0);
#undef AT_STEP
#undef AT_KR
    AT_PRIO(0);
}
__device__ __forceinline__ void v_pos_src(int p, int& k, int& c) { const int s = p >> 5, kk = (s >> 2) * 8 + ((p & 31) >> 2); c = (s & 3) * 32 + (p & 3) * 8; k = (kk & ~0xC) | ((kk & 4) << 1) | ((kk & 8) >> 1); }
__device__ __forceinline__ int v_rd_base(int lane) { return ((lane & 3) << 3) | (((lane >> 2) & 3) << 6) | (((lane >> 4) & 1) << 5) | (((lane >> 5) & 1) << 8); }
constexpr int v_rd_off(int d0, int ks, int half) { return d0 * 512 + ks * 4096 + half * 2048; }
template <int OFF> __device__ __forceinline__ s16x4 tr_read(int vb) { s16x4 r; asm volatile("ds_read_b64_tr_b16 %0, %1 offset:%2" : "=&v"(r) : "v"(vb), "i"(OFF) : "memory"); return r; }
struct VFrag { s16x4 l0, h0, l1, h1, l2, h2, l3, h3; };
template <int D0, int VO> __device__ __forceinline__ void v_read(VFrag& f, int vb) {
    f.l0 = tr_read<VO + v_rd_off(D0, 0, 0)>(vb); f.h0 = tr_read<VO + v_rd_off(D0, 0, 1)>(vb); f.l1 = tr_read<VO + v_rd_off(D0, 1, 0)>(vb); f.h1 = tr_read<VO + v_rd_off(D0, 1, 1)>(vb);
    f.l2 = tr_read<VO + v_rd_off(D0, 2, 0)>(vb); f.h2 = tr_read<VO + v_rd_off(D0, 2, 1)>(vb); f.l3 = tr_read<VO + v_rd_off(D0, 3, 0)>(vb); f.h3 = tr_read<VO + v_rd_off(D0, 3, 1)>(vb);
}
#define PKV(L, H) (bf16x8){L[0], L[1], L[2], L[3], H[0], H[1], H[2], H[3]}
__device__ __forceinline__ void v_mma(f32x16& od, const VFrag& f, bf16x8 pa0, bf16x8 pa1, bf16x8 pa2, bf16x8 pa3) {
    od = __builtin_amdgcn_mfma_f32_32x32x16_bf16(pa0, PKV(f.l0, f.h0), od, 0, 0, 0);
    od = __builtin_amdgcn_mfma_f32_32x32x16_bf16(pa1, PKV(f.l1, f.h1), od, 0, 0, 0);
    od = __builtin_amdgcn_mfma_f32_32x32x16_bf16(pa2, PKV(f.l2, f.h2), od, 0, 0, 0);
    od = __builtin_amdgcn_mfma_f32_32x32x16_bf16(pa3, PKV(f.l3, f.h3), od, 0, 0, 0);
}
#undef PKV
template <int VO> __device__ __forceinline__ void pv_main(f32x16 (&o)[4], int vb, VFrag& fa, bf16x8 pa0, bf16x8 pa1, bf16x8 pa2, bf16x8 pa3) {
    VFrag fb, fc;
    AT_PRIO(1);
    v_read<1, VO>(fb, vb); AT_KWAIT(8);
    v_read<2, VO>(fc, vb); ASBAR(); v_mma(o[0], fa, pa0, pa1, pa2, pa3); ASBAR(); AT_KWAIT(8);
    v_read<3, VO>(fa, vb); ASBAR(); v_mma(o[1], fb, pa0, pa1, pa2, pa3); ASBAR(); AT_KWAIT(8);
    v_mma(o[2], fc, pa0, pa1, pa2, pa3); ASBAR(); AT_KWAIT(0);
    v_mma(o[3], fa, pa0, pa1, pa2, pa3);
    AT_PRIO(0);
}

__device__ __forceinline__ void attn_unit(int b, int h, int qb, const bf16* QRAW, const bf16* KF, const bf16* KVRAW, const float* qw, const float* COS, const float* SIN, bf16* AO, LAS unsigned char* lds) {
    const int tid = otid(), wid = __builtin_amdgcn_readfirstlane(tid >> 6), lane = tid & 63, r32 = lane & 31, hi = lane >> 5;
    LAS float* wsf = (LAS float*)(lds + L_WS) + wid * 64; LAS float* li_l = wsf; LAS float* al_l = wsf + 32;
    const int m = b * SEQ + qb * 256 + wid * 32 + r32;
    bf16x8 qr[12];
    {
        const bf16* qp = QRAW + (size_t)m * (NH * QK) + h * QK + hi * 8;
        u32x4 raw[12]; float ss = 0.f;
#pragma unroll
        for (int d0 = 0; d0 < 12; ++d0) { raw[d0] = *(const u32x4*)(qp + d0 * 16); float f[8]; unpack8(raw[d0], f);
#pragma unroll
            for (int j = 0; j < 8; ++j) ss += f[j] * f[j]; }
        ss = sum_xor32(ss);
        const float rs = rsqrtf(ss * (1.f / QK) + EPS) * QSCALE;
#pragma unroll
        for (int d0 = 0; d0 < 8; ++d0) { float f[8], w[8]; unpack8(raw[d0], f); ld_f32x8(qw + d0 * 16 + hi * 8, w);
#pragma unroll
            for (int j = 0; j < 8; ++j) f[j] = f[j] * rs * w[j];
            qr[d0] = __builtin_bit_cast(bf16x8, pack8(f)); }
#pragma unroll
        for (int t = 0; t < 2; ++t) { float x1[8], x2[8], w1[8], w2[8], c[8], s[8], o1[8], o2[8];
            unpack8(raw[8 + t], x1); unpack8(raw[10 + t], x2); ld_f32x8(qw + 128 + t * 16 + hi * 8, w1); ld_f32x8(qw + 160 + t * 16 + hi * 8, w2);
            ld_f32x8(COS + (size_t)m * 32 + t * 16 + hi * 8, c); ld_f32x8(SIN + (size_t)m * 32 + t * 16 + hi * 8, s);
#pragma unroll
            for (int j = 0; j < 8; ++j) { const float a = x1[j] * rs * w1[j], bq = x2[j] * rs * w2[j]; o1[j] = a * c[j] - bq * s[j]; o2[j] = a * s[j] + bq * c[j]; }
            qr[8 + t] = __builtin_bit_cast(bf16x8, pack8(o1)); qr[10 + t] = __builtin_bit_cast(bf16x8, pack8(o2)); }
    }
    const bf16* kbase = KF + (size_t)(b * SEQ) * (NH * QK) + h * QK;
    const bf16* vbase = KVRAW + (size_t)(b * SEQ) * 4096 + h * 256 + 128;
    unsigned koff[3], voff[2];
#pragma unroll
    for (int i = 0; i < 3; ++i) { const int p = i * 512 + tid, row = p / 24, cc = (p % 24) ^ (row & 7); koff[i] = (unsigned)(row * (NH * QK) + cc * 8) * 2u; }
#pragma unroll
    for (int i = 0; i < 2; ++i) { int k, c; v_pos_src(i * 512 + tid, k, c); voff[i] = (unsigned)(k * 4096 + c) * 2u; }
    const unsigned ldsw = (unsigned)wid * 1024u;
#define ATT_ISSUE_K(kb, key0) do { const char* _kg = (const char*)(kbase + (size_t)(key0) * (NH * QK)); \
        _Pragma("unroll") for (int _i = 0; _i < 3; ++_i) __builtin_amdgcn_global_load_lds((const unsigned*)(_kg + koff[_i]), (LAS unsigned*)(lds + (kb) + ldsw + _i * 8192), 16, 0, 0); } while (0)
#define ATT_ISSUE_V(vb_, key0) do { const char* _vg = (const char*)(vbase + (size_t)(key0) * 4096); \
        _Pragma("unroll") for (int _i = 0; _i < 2; ++_i) __builtin_amdgcn_global_load_lds((const unsigned*)(_vg + voff[_i]), (LAS unsigned*)(lds + (vb_) + ldsw + _i * 8192), 16, 0, 0); } while (0)
    float m_reg = -1e30f, l_reg = 0.f;
    f32x16 o[4];
#pragma unroll
    for (int d = 0; d < 4; ++d) o[d] = (f32x16){0.f, 0.f, 0.f, 0.f, 0.f, 0.f, 0.f, 0.f, 0.f, 0.f, 0.f, 0.f, 0.f, 0.f, 0.f, 0.f};
    const int nt = 4 * qb + 4, myc = 4 * qb + (wid >> 1);
    const int vrd = (int)(uintptr_t)(lds + L_V0) + v_rd_base(lane);
    int kad[4];
#pragma unroll
    for (int i = 0; i < 4; ++i) kad[i] = (int)(uintptr_t)lds + r32 * (QK * 2) + ((i * 32 + hi * 16) ^ ((r32 & 7) << 4));
    f32x16 p0, p1;
#define VMW(n) asm volatile("s_waitcnt vmcnt(" #n ")" ::: "memory")
#define HBAR() do { asm volatile("s_waitcnt lgkmcnt(0)" ::: "memory"); ASBAR(); __builtin_amdgcn_s_barrier(); ASBAR(); } while (0)
#define ATT_TILE(kb, vb_, j) do { if ((j) <= myc) { float alpha; bf16x8 pa0, pa1, pa2, pa3; VFrag fa; \
        qkt<(kb)>(p0, p1, kad, qr, -sm_moff(m_reg)); ASBAR(); \
        v_read<0, (vb_) - L_V0>(fa, vrd); ASBAR(); \
        softSM(p0, p1, m_reg, alpha); \
        if (__any(alpha < 1.f)) { if (hi == 0) al_l[r32] = alpha; asm volatile("s_waitcnt lgkmcnt(0)" ::: "memory"); \
            _Pragma("unroll") for (int d = 0; d < 4; ++d) _Pragma("unroll") for (int r = 0; r < 16; ++r) o[d][r] *= al_l[crow(r, hi)]; } \
        finishSM(p0, p1, alpha, l_reg, pa0, pa1, pa2, pa3); ASBAR(); \
        pv_main<(vb_) - L_V0>(o, vrd, fa, pa0, pa1, pa2, pa3); } } while (0)
    ATT_ISSUE_K(L_K0, 0); ATT_ISSUE_V(L_V0, 0);
    VMW(0); HBAR();
    for (int j = 0; j < nt; j += 2) {
        ATT_ISSUE_K(L_K1, (j + 1) * 64); ATT_ISSUE_V(L_V1, (j + 1) * 64); ASBAR();
        ATT_TILE(L_K0, L_V0, j); ASBAR(); VMW(0); HBAR();
        if (j + 2 < nt) { ATT_ISSUE_K(L_K0, (j + 2) * 64); ATT_ISSUE_V(L_V0, (j + 2) * 64); } ASBAR();
        ATT_TILE(L_K1, L_V1, j + 1); ASBAR(); VMW(0); HBAR();
    }
#undef ATT_TILE
#undef ATT_ISSUE_K
#undef ATT_ISSUE_V
    if (hi == 0) li_l[r32] = l_reg;
    asm volatile("s_waitcnt lgkmcnt(0)" ::: "memory");
    float rli[16];
#pragma unroll
    for (int r = 0; r < 16; ++r) rli[r] = __builtin_amdgcn_rcpf(li_l[crow(r, hi)]);
    bf16* ob = AO + (size_t)(b * SEQ + qb * 256 + wid * 32) * DM + h * VD;
#pragma unroll
    for (int r = 0; r < 16; ++r) { const int orow = crow(r, hi);
#pragma unroll
        for (int d0 = 0; d0 < 4; ++d0) ob[(size_t)orow * DM + d0 * 32 + r32] = (bf16)f2bf(o[d0][r] * rli[r]); }
    asm volatile("s_waitcnt lgkmcnt(0)" ::: "memory");
}
template <int ABL> __device__ __forceinline__ void phase(const bf16* QRAW, const bf16* KF, const bf16* KVRAW, const float* qw, const float* COS, const float* SIN, bf16* AO, LAS unsigned char* lds, int G, int wg) {
    for (int pr = wg; pr < NB * NH * 8; pr += G) {
        const int x = pr & 7, slot = pr >> 3, bh = x * 4 + (slot >> 3), pi = slot & 7, b = bh / NH, h = bh % NH;
#pragma unroll 1
        for (int u = 0; u < 2; ++u) attn_unit(b, h, u ? pi : 15 - pi, QRAW, KF, KVRAW, qw, COS, SIN, AO, lds);
    }
}
__device__ __forceinline__ void phase_dyn(const bf16* QRAW, const bf16* KF, const bf16* KVRAW, const float* qw, const float* COS, const float* SIN, bf16* AO, LAS unsigned char* lds, int wg, unsigned* head) {
    LAS volatile int* qs = (LAS volatile int*)(lds + QSLOT_OFF);
    for (;;) {
        __syncthreads();
        if (otid() == 0) qs[0] = (int)__hip_atomic_fetch_add(head, 1u, __ATOMIC_RELAXED, __HIP_MEMORY_SCOPE_AGENT);
        __syncthreads();
        const int e = qs[0];
        if (e >= 64) break;
        const int bh = (wg & 7) * 4 + (e & 3), qb = 15 - (e >> 2);
        attn_unit(bh / NH, bh % NH, qb, QRAW, KF, KVRAW, qw, COS, SIN, AO, lds);
    }
}
}

namespace ssd {
using attn::f32x16; using attn::s16x4; using attn::crow; using attn::v_rd_base; using attn::tr_read;
constexpr int L_BT = 0, L_XT = 16384, L_WSH = 16384 + 65536, L_SSQ = L_WSH + 8192, L_END = L_SSQ + 2048;
static_assert(L_END <= RING_BYTES, "ssd lds");
template <int NCS> __device__ __forceinline__ void vimg_src(int p, int& k, int& c) { const int s = p >> 5, kk = (s / NCS) * 8 + ((p & 31) >> 2); c = (s % NCS) * 32 + (p & 3) * 8; k = (kk & ~0xC) | ((kk & 4) << 1) | ((kk & 8) >> 1); }
template <int NCS> constexpr int vimg_off(int d0, int ks, int half) { return ((2 * ks + half) * NCS + d0) * 512; }
#define SSD_PKV(L, H) (bf16x8){L[0], L[1], L[2], L[3], H[0], H[1], H[2], H[3]}
#define SSD_LWAIT() do { asm volatile("s_waitcnt lgkmcnt(0)" ::: "memory"); __builtin_amdgcn_sched_barrier(0); } while (0)
constexpr f32x16 Z16 = {0.f, 0.f, 0.f, 0.f, 0.f, 0.f, 0.f, 0.f, 0.f, 0.f, 0.f, 0.f, 0.f, 0.f, 0.f, 0.f};
__device__ __forceinline__ float wave_scan64(float v, int lane) {
#pragma unroll
    for (int o = 1; o < 64; o <<= 1) { const float n = lane_up(v, o, lane); if (lane >= o) v += n; }
    return v;
}
__device__ __forceinline__ void load_x(const bf16* XC, int m0, int h, int lane, u32x4 (&v)[8]) {
#pragma unroll
    for (int i = 0; i < 8; ++i) { int k, c; vimg_src<2>(i * 64 + lane, k, c); v[i] = *(const u32x4*)(XC + (size_t)(m0 + k) * CONVD + h * HD + c); }
}
__device__ __forceinline__ void store_x(LAS unsigned char* xt, int lane, const u32x4 (&v)[8]) {
#pragma unroll
    for (int i = 0; i < 8; ++i) *(LAS u32x4*)(xt + (i * 64 + lane) * 16) = v[i];
}

__device__ __forceinline__ void phase_states(const bf16* XC, const float* DTS, const float* a_log, bf16* ST16, float* CDEC, LAS unsigned char* lds, int G, int wg) {
    for (int it = wg; it < NB * NCH * SG; it += G) {
        const int tid = otid(), wid = __builtin_amdgcn_readfirstlane(tid >> 6), lane = tid & 63, r32 = lane & 31, hi = lane >> 5;
        LAS unsigned char* xt = lds + L_XT + wid * 8192; LAS float* wsh = (LAS float*)(lds + L_WSH + wid * 1024);
        const int vrd = v_rd_base(lane);
        const int g = it % SG, bc = it / SG, m0 = bc * TC, h = g * HPG + wid;
        __syncthreads();
        {
            u32x4 v[2], xv[8];
#pragma unroll
            for (int i = 0; i < 2; ++i) { int k, c; vimg_src<4>(i * 512 + tid, k, c); v[i] = *(const u32x4*)(XC + (size_t)(m0 + k) * CONVD + DI + g * SN + c); }
            load_x(XC, m0, h, lane, xv);
            const float A = -__expf(a_log[h]), dt = DTS[(size_t)(m0 + lane) * SH + h];
#pragma unroll
            for (int i = 0; i < 2; ++i) *(LAS u32x4*)(lds + L_BT + (i * 512 + tid) * 16) = v[i];
            store_x(xt, lane, xv);
            const float ac = wave_scan64(dt * A, lane), last = __builtin_bit_cast(float, __builtin_amdgcn_readlane(__builtin_bit_cast(int, ac), 63));
            wsh[lane] = __expf(last - ac) * dt; if (lane == 63) CDEC[bc * SH + h] = __expf(last);
        }
        __syncthreads();
        f32x16 acc[2][4];
#pragma unroll
        for (int a = 0; a < 2; ++a)
#pragma unroll
            for (int b = 0; b < 4; ++b) acc[a][b] = Z16;
        const int xb = (int)(uintptr_t)xt + vrd, bb = (int)(uintptr_t)(lds + L_BT) + vrd;
#define SSD_KS(KSI) do { \
            const s16x4 xl0 = tr_read<vimg_off<2>(0, KSI, 0)>(xb), xh0 = tr_read<vimg_off<2>(0, KSI, 1)>(xb), xl1 = tr_read<vimg_off<2>(1, KSI, 0)>(xb), xh1 = tr_read<vimg_off<2>(1, KSI, 1)>(xb); \
            const s16x4 bl0 = tr_read<vimg_off<4>(0, KSI, 0)>(bb), bh0 = tr_read<vimg_off<4>(0, KSI, 1)>(bb), bl1 = tr_read<vimg_off<4>(1, KSI, 0)>(bb), bh1 = tr_read<vimg_off<4>(1, KSI, 1)>(bb); \
            const s16x4 bl2 = tr_read<vimg_off<4>(2, KSI, 0)>(bb), bh2 = tr_read<vimg_off<4>(2, KSI, 1)>(bb), bl3 = tr_read<vimg_off<4>(3, KSI, 0)>(bb), bh3 = tr_read<vimg_off<4>(3, KSI, 1)>(bb); \
            const f32x4 w0 = *(LAS const f32x4*)(wsh + 16 * KSI + 8 * hi), w1 = *(LAS const f32x4*)(wsh + 16 * KSI + 8 * hi + 4); \
            SSD_LWAIT(); \
            bf16x8 xa[2]; { const bf16x8 r0 = SSD_PKV(xl0, xh0), r1 = SSD_PKV(xl1, xh1); float f[8]; \
                unpack8(__builtin_bit_cast(u32x4, r0), f); f[0] *= w0.x; f[1] *= w0.y; f[2] *= w0.z; f[3] *= w0.w; f[4] *= w1.x; f[5] *= w1.y; f[6] *= w1.z; f[7] *= w1.w; xa[0] = __builtin_bit_cast(bf16x8, pack8(f)); \
                unpack8(__builtin_bit_cast(u32x4, r1), f); f[0] *= w0.x; f[1] *= w0.y; f[2] *= w0.z; f[3] *= w0.w; f[4] *= w1.x; f[5] *= w1.y; f[6] *= w1.z; f[7] *= w1.w; xa[1] = __builtin_bit_cast(bf16x8, pack8(f)); } \
            const bf16x8 bf0 = SSD_PKV(bl0, bh0), bf1 = SSD_PKV(bl1, bh1), bf2 = SSD_PKV(bl2, bh2), bf3 = SSD_PKV(bl3, bh3); \
            _Pragma("unroll") for (int a = 0; a < 2; ++a) { \
                acc[a][0] = __builtin_amdgcn_mfma_f32_32x32x16_bf16(xa[a], bf0, acc[a][0], 0, 0, 0); acc[a][1] = __builtin_amdgcn_mfma_f32_32x32x16_bf16(xa[a], bf1, acc[a][1], 0, 0, 0); \
                acc[a][2] = __builtin_amdgcn_mfma_f32_32x32x16_bf16(xa[a], bf2, acc[a][2], 0, 0, 0); acc[a][3] = __builtin_amdgcn_mfma_f32_32x32x16_bf16(xa[a], bf3, acc[a][3], 0, 0, 0); } } while (0)
        SSD_KS(0); SSD_KS(1); SSD_KS(2); SSD_KS(3);
#undef SSD_KS
        bf16* o = ST16 + ((size_t)bc * SH + h) * (HD * SN);
#pragma unroll
        for (int a = 0; a < 2; ++a)
#pragma unroll
            for (int r = 0; r < 16; ++r) { const int p = 32 * a + crow(r, hi);
#pragma unroll
                for (int b = 0; b < 4; ++b) o[p * SN + 32 * b + r32] = (bf16)f2bf(acc[a][b][r]); }
    }
}

__device__ __forceinline__ void phase_scan(bf16* ST16, const float* CDEC, int G, int wg) {
    constexpr int PER_B8 = SH * HD * SN / 8;
    for (int e = wg * NTHR + otid(); e < NB * PER_B8; e += G * NTHR) {
        const int b = e / PER_B8, r8 = e % PER_B8, h = r8 / (HD * SN / 8);
        float st[8];
#pragma unroll
        for (int j = 0; j < 8; ++j) st[j] = 0.f;
        bf16* base = ST16 + (size_t)b * NCH * (SH * HD * SN) + (size_t)r8 * 8;
        for (int c0 = 0; c0 < NCH; c0 += 8) {
            u32x4 raw[8]; float cd[8];
#pragma unroll
            for (int i = 0; i < 8; ++i) { raw[i] = *(const u32x4*)(base + (size_t)(c0 + i) * (SH * HD * SN)); cd[i] = CDEC[(b * NCH + c0 + i) * SH + h]; }
#pragma unroll
            for (int i = 0; i < 8; ++i) { float v[8]; unpack8(raw[i], v); *(u32x4*)(base + (size_t)(c0 + i) * (SH * HD * SN)) = pack8(st);
#pragma unroll
                for (int j = 0; j < 8; ++j) st[j] = st[j] * cd[i] + v[j]; }
        }
    }
}

constexpr int O_CT = 0, O_BT = 17408, O_XT = 34816, O_WSH = O_XT + 65536, O_SSQ = O_WSH + 8192, O_END = O_SSQ + 2048, O_ROW = 272;
static_assert(O_END <= RING_BYTES, "ssd out lds");
__device__ __forceinline__ void phase_out(const bf16* XC, const float* DTS, const float* a_log, const float* dskip, const bf16* ST16, const bf16* PROJ, bf16* Y, LAS unsigned char* lds, int G, int wg) {
    for (int it = wg; it < NB * NCH * SG; it += G) {
        const int tid = otid(), wid = __builtin_amdgcn_readfirstlane(tid >> 6), lane = tid & 63, r32 = lane & 31, hi = lane >> 5;
        LAS unsigned char* xt = lds + O_XT + wid * 8192; LAS float* acs = (LAS float*)(lds + O_WSH + wid * 1024); LAS float* dts = acs + 64; LAS float* rsl = acs + 128;
        LAS float* ssqx = (LAS float*)(lds + O_SSQ);
        const int vrd = v_rd_base(lane);
        LAS const unsigned char* cl = lds + O_CT + r32 * O_ROW + hi * 16;
        LAS const unsigned char* bl = lds + O_BT + r32 * O_ROW + hi * 16;
        const int g = it % SG, bc = it / SG, m0 = bc * TC, h = g * HPG + wid;
        __syncthreads();
        u32x4 cv[2], bv[2], xv[8];
#pragma unroll
        for (int i = 0; i < 2; ++i) { const int q = i * 512 + tid, row = q >> 4, c16 = q & 15;
            cv[i] = *(const u32x4*)(XC + (size_t)(m0 + row) * CONVD + DI + SG * SN + g * SN + c16 * 8); bv[i] = *(const u32x4*)(XC + (size_t)(m0 + row) * CONVD + DI + g * SN + c16 * 8); }
        const bf16* pg = ST16 + (((size_t)bc * SH + h) * HD + r32) * SN + 8 * hi;
        bf16x8 pf[2][8];
#pragma unroll
        for (int kn = 0; kn < 8; ++kn) { pf[0][kn] = *(const bf16x8*)(pg + kn * 16); pf[1][kn] = *(const bf16x8*)(pg + 32 * SN + kn * 16); }
        load_x(XC, m0, h, lane, xv);
        const float A_ = -__expf(a_log[h]), dt_ = DTS[(size_t)(m0 + lane) * SH + h];
        __builtin_amdgcn_sched_barrier(0);
#pragma unroll
        for (int i = 0; i < 2; ++i) { const int q = i * 512 + tid, row = q >> 4, c16 = q & 15;
            *(LAS u32x4*)(lds + O_CT + row * O_ROW + c16 * 16) = cv[i]; *(LAS u32x4*)(lds + O_BT + row * O_ROW + c16 * 16) = bv[i]; }
        store_x(xt, lane, xv);
        { acs[lane] = wave_scan64(dt_ * A_, lane); dts[lane] = dt_; }
        __builtin_amdgcn_sched_barrier(0);
        const float dk = dskip[h];
        __syncthreads();
        f32x16 acc[2][2];
#pragma unroll
        for (int a = 0; a < 2; ++a)
#pragma unroll
            for (int b = 0; b < 2; ++b) acc[a][b] = Z16;
#pragma unroll
        for (int kn = 0; kn < 8; ++kn) {
            const bf16x8 c0 = *(LAS const bf16x8*)(cl + kn * 32), c1 = *(LAS const bf16x8*)(cl + 32 * O_ROW + kn * 32);
            acc[0][0] = __builtin_amdgcn_mfma_f32_32x32x16_bf16(c0, pf[0][kn], acc[0][0], 0, 0, 0); acc[0][1] = __builtin_amdgcn_mfma_f32_32x32x16_bf16(c0, pf[1][kn], acc[0][1], 0, 0, 0);
            acc[1][0] = __builtin_amdgcn_mfma_f32_32x32x16_bf16(c1, pf[0][kn], acc[1][0], 0, 0, 0); acc[1][1] = __builtin_amdgcn_mfma_f32_32x32x16_bf16(c1, pf[1][kn], acc[1][1], 0, 0, 0);
        }
        u32x4 zv[8];
#pragma unroll
        for (int i = 0; i < 8; ++i) zv[i] = *(const u32x4*)(PROJ + (size_t)(m0 + i * 8 + (lane >> 3)) * DINP + PC_Z + h * HD + (lane & 7) * 8);
        LDS_WAIT();
#pragma unroll
        for (int a = 0; a < 2; ++a)
#pragma unroll
            for (int r = 0; r < 16; ++r) { const float ea = __expf(acs[32 * a + crow(r, hi)]); acc[a][0][r] *= ea; acc[a][1][r] *= ea; }
        const int xb = (int)(uintptr_t)xt + vrd;
#define SSD_TB(TB) do { f32x16 p0 = Z16, p1 = Z16; \
            _Pragma("unroll") for (int kn = 0; kn < 8; ++kn) { const bf16x8 cf = *(LAS const bf16x8*)(cl + (32 * TB) * O_ROW + kn * 32), b0 = *(LAS const bf16x8*)(bl + kn * 32); \
                p0 = __builtin_amdgcn_mfma_f32_32x32x16_bf16(b0, cf, p0, 0, 0, 0); \
                if (TB == 1) { const bf16x8 b1 = *(LAS const bf16x8*)(bl + 32 * O_ROW + kn * 32); p1 = __builtin_amdgcn_mfma_f32_32x32x16_bf16(b1, cf, p1, 0, 0, 0); } } \
            const int t = 32 * TB + r32; const float at = acs[t]; \
            _Pragma("unroll") for (int r = 0; r < 16; ++r) { const int s0 = crow(r, hi); \
                { const float w = (s0 <= t) ? __expf(fminf(at - acs[s0], 0.f)) * dts[s0] : 0.f; p0[r] = p0[r] * w + ((s0 == t) ? dk : 0.f); } \
                if (TB == 1) { const int s1 = 32 + s0; const float w = (s1 <= t) ? __expf(fminf(at - acs[s1], 0.f)) * dts[s1] : 0.f; p1[r] = p1[r] * w + ((s1 == t) ? dk : 0.f); } } \
            bf16x8 pa0, pa1, pa2, pa3; \
            { PK4_(p0, 0, pa0); PK4_(p0, 8, pa1); if (TB == 1) { PK4_(p1, 0, pa2); PK4_(p1, 8, pa3); } } \
            _Pragma("unroll") for (int pb = 0; pb < 2; ++pb) { \
                const s16x4 l0 = pb ? tr_read<vimg_off<2>(1, 0, 0)>(xb) : tr_read<vimg_off<2>(0, 0, 0)>(xb), h0 = pb ? tr_read<vimg_off<2>(1, 0, 1)>(xb) : tr_read<vimg_off<2>(0, 0, 1)>(xb); \
                const s16x4 l1 = pb ? tr_read<vimg_off<2>(1, 1, 0)>(xb) : tr_read<vimg_off<2>(0, 1, 0)>(xb), h1 = pb ? tr_read<vimg_off<2>(1, 1, 1)>(xb) : tr_read<vimg_off<2>(0, 1, 1)>(xb); \
                s16x4 l2 = l0, h2 = h0, l3 = l1, h3 = h1; \
                if (TB == 1) { l2 = pb ? tr_read<vimg_off<2>(1, 2, 0)>(xb) : tr_read<vimg_off<2>(0, 2, 0)>(xb); h2 = pb ? tr_read<vimg_off<2>(1, 2, 1)>(xb) : tr_read<vimg_off<2>(0, 2, 1)>(xb); \
                               l3 = pb ? tr_read<vimg_off<2>(1, 3, 0)>(xb) : tr_read<vimg_off<2>(0, 3, 0)>(xb); h3 = pb ? tr_read<vimg_off<2>(1, 3, 1)>(xb) : tr_read<vimg_off<2>(0, 3, 1)>(xb); } \
                SSD_LWAIT(); \
                acc[TB][pb] = __builtin_amdgcn_mfma_f32_32x32x16_bf16(pa0, SSD_PKV(l0, h0), acc[TB][pb], 0, 0, 0); acc[TB][pb] = __builtin_amdgcn_mfma_f32_32x32x16_bf16(pa1, SSD_PKV(l1, h1), acc[TB][pb], 0, 0, 0); \
                if (TB == 1) { acc[TB][pb] = __builtin_amdgcn_mfma_f32_32x32x16_bf16(pa2, SSD_PKV(l2, h2), acc[TB][pb], 0, 0, 0); acc[TB][pb] = __builtin_amdgcn_mfma_f32_32x32x16_bf16(pa3, SSD_PKV(l3, h3), acc[TB][pb], 0, 0, 0); } } } while (0)
#define PK4_(P, BASE, OUT) do { unsigned a0_ = pk2(P[BASE + 0], P[BASE + 1]), a1_ = pk2(P[BASE + 2], P[BASE + 3]); unsigned b0_ = pk2(P[BASE + 4], P[BASE + 5]), b1_ = pk2(P[BASE + 6], P[BASE + 7]); \
    auto r0_ = __builtin_amdgcn_permlane32_swap(a0_, b0_, false, false); auto r1_ = __builtin_amdgcn_permlane32_swap(a1_, b1_, false, false); \
    u32x4 w_ = {r0_[0], r1_[0], r0_[1], r1_[1]}; OUT = __builtin_bit_cast(bf16x8, w_); } while (0)
        SSD_TB(0); SSD_TB(1);
#undef SSD_TB
#undef PK4_
        LAS unsigned short* zt = (LAS unsigned short*)xt;
        {
            LDS_WAIT();
#pragma unroll
            for (int i = 0; i < 8; ++i) *(LAS u32x4*)(xt + (i * 64 + lane) * 16) = zv[i];
        }
        LDS_WAIT();
#pragma unroll
        for (int a = 0; a < 2; ++a)
#pragma unroll
            for (int r = 0; r < 16; ++r) { const int t = 32 * a + crow(r, hi);
                acc[a][0][r] *= siluf_(bf2f(zt[t * 64 + r32])); acc[a][1][r] *= siluf_(bf2f(zt[t * 64 + 32 + r32])); }
        LDS_WAIT();
        LAS float* red = (LAS float*)xt;
#pragma unroll
        for (int a = 0; a < 2; ++a)
#pragma unroll
            for (int r = 0; r < 16; ++r) red[(32 * a + crow(r, hi)) * 32 + r32] = acc[a][0][r] * acc[a][0][r] + acc[a][1][r] * acc[a][1][r];
        LDS_WAIT();
        { float sm = 0.f;
#pragma unroll
          for (int q = 0; q < 8; ++q) { const f32x4 v = *(LAS const f32x4*)(red + lane * 32 + q * 4); sm += (v.x + v.y) + (v.z + v.w); }
          ssqx[wid * 64 + lane] = sm; }
        __syncthreads();
        { float sm = 0.f;
#pragma unroll
          for (int w = 0; w < 8; ++w) sm += ssqx[w * 64 + lane];
          rsl[lane] = rsqrtf(sm * (1.f / 512.f) + EPS); }
        LDS_WAIT();
#pragma unroll
        for (int a = 0; a < 2; ++a)
#pragma unroll
            for (int r = 0; r < 16; ++r) { const int t = 32 * a + crow(r, hi); const float rs = rsl[t];
                zt[t * 64 + r32] = (unsigned short)f2bf(acc[a][0][r] * rs); zt[t * 64 + 32 + r32] = (unsigned short)f2bf(acc[a][1][r] * rs); }
        LDS_WAIT();
#pragma unroll
        for (int i = 0; i < 8; ++i) *(u32x4*)(Y + (size_t)(m0 + i * 8 + (lane >> 3)) * DI + h * HD + (lane & 7) * 8) = *(LAS const u32x4*)(xt + (i * 64 + lane) * 16);
    }
}
}

__device__ __forceinline__ void phase_attn_simple(const bf16* QRAW, const bf16* KF, const bf16* KVRAW, const float* qw, const float* COS, const float* SIN, bf16* AO, LAS unsigned char* lds, int G, int wg) {
    const int wave = otid() >> 6, lane = otid() & 63;
    LAS float* sc = (LAS float*)(lds + RING_OFF + wave * 16384);
    LAS float* qs = (LAS float*)(lds + EXTRA_OFF + wave * 768);
    const float w0 = qw[lane], w1 = qw[64 + lane], w2 = qw[128 + lane];
    for (int it = wg * NWAVES + wave; it < NB * NH * SEQ; it += G * NWAVES) {
        const int t = it % SEQ, bh = it / SEQ, h = bh % NH, b = bh / NH, m = b * SEQ + t;
        const bf16* qp = QRAW + (size_t)m * (NH * QK) + h * QK;
        const float a0 = bf2f(qp[lane]), a1 = bf2f(qp[64 + lane]), a2 = bf2f(qp[128 + lane]);
        const float ss = wave_sum(a0 * a0 + a1 * a1 + a2 * a2), rs = rsqrtf(ss * (1.f / QK) + EPS);
        const float t2 = a2 * rs * w2, o2 = get_xor32(t2, lane);
        const float c = COS[m * 32 + (lane & 31)], s = SIN[m * 32 + (lane & 31)];
        const float r2 = lane < 32 ? (t2 * c - o2 * s) : (o2 * s + t2 * c);
        const float scale = 0.07216878364870322f;
        qs[lane] = a0 * rs * w0 * scale; qs[64 + lane] = a1 * rs * w1 * scale; qs[128 + lane] = r2 * scale;
        LDS_WAIT();
        const int nk = (t / TC + 1) * TC;
        float mx = -3.0e38f;
        for (int j = lane; j < nk; j += 64) {
            const bf16* kp = KF + (size_t)(b * SEQ + j) * (NH * QK) + h * QK;
            float acc = 0.f;
#pragma unroll 4
            for (int d = 0; d < QK; d += 8) { float kv[8]; ld_bf16x8(kp + d, kv);
#pragma unroll
                for (int e = 0; e < 8; ++e) acc += qs[d + e] * kv[e]; }
            sc[j] = acc; mx = fmaxf(mx, acc);
        }
        mx = wave_max(mx);
        LDS_WAIT();
        float l = 0.f;
        for (int j = lane; j < nk; j += 64) { const float p = __expf(sc[j] - mx); sc[j] = p; l += p; }
        l = wave_sum(l);
        LDS_WAIT();
        float o0 = 0.f, o1 = 0.f;
        const bf16* vp = KVRAW + (size_t)(b * SEQ) * 4096 + h * 256 + 128;
#pragma unroll 8
        for (int j = 0; j < nk; ++j) { const float p = sc[j]; o0 += p * bf2f(vp[(size_t)j * 4096 + lane]); o1 += p * bf2f(vp[(size_t)j * 4096 + 64 + lane]); }
        const float il = 1.f / l;
        AO[(size_t)m * DM + h * VD + lane] = (bf16)f2bf(o0 * il); AO[(size_t)m * DM + h * VD + 64 + lane] = (bf16)f2bf(o1 * il);
        LDS_WAIT();
    }
}
__device__ __forceinline__ float wave_scan(float v, int lane) {
#pragma unroll
    for (int o = 1; o < 64; o <<= 1) { const float n = lane_up(v, o, lane); if (lane >= o) v += n; }
    return v;
}
__device__ __forceinline__ void phase_ssd_states(const bf16* XC, const float* DTS, const float* a_log, float* ST, float* CDEC, LAS unsigned char* lds, int G, int wg) {
    LAS float* wsh = (LAS float*)(lds + RING_OFF);
    const int tid = otid();
    for (int it = wg; it < NB * NCH * SH; it += G) {
        const int h = it % SH, bc = it / SH, m0 = bc * TC, g = h / HPG;
        __syncthreads();
        if (tid < 64) { const float A = -__expf(a_log[h]), dt = DTS[(size_t)(m0 + tid) * SH + h];
            const float ac = wave_scan(dt * A, tid), last = __builtin_bit_cast(float, __builtin_amdgcn_readlane(__builtin_bit_cast(int, ac), 63));
            wsh[tid] = __expf(last - ac) * dt; if (tid == 63) CDEC[bc * SH + h] = __expf(last); }
        __syncthreads();
        const int p = tid >> 3, n0 = (tid & 7) * 16;
        float acc[16];
#pragma unroll
        for (int e = 0; e < 16; ++e) acc[e] = 0.f;
        for (int s = 0; s < TC; ++s) {
            const float xw = bf2f(XC[(size_t)(m0 + s) * CONVD + h * HD + p]) * wsh[s];
            float b0[8], b1[8]; ld_bf16x8(XC + (size_t)(m0 + s) * CONVD + DI + g * SN + n0, b0); ld_bf16x8(XC + (size_t)(m0 + s) * CONVD + DI + g * SN + n0 + 8, b1);
#pragma unroll
            for (int e = 0; e < 8; ++e) { acc[e] += xw * b0[e]; acc[8 + e] += xw * b1[e]; }
        }
        float* o = ST + (((size_t)bc * SH + h) * HD + p) * SN + n0;
#pragma unroll
        for (int e = 0; e < 16; e += 4) *(f32x4*)(o + e) = (f32x4){acc[e], acc[e + 1], acc[e + 2], acc[e + 3]};
    }
}
__device__ __forceinline__ void phase_ssd_scan(float* ST, const float* CDEC, int G, int wg) {
    constexpr int PER_B = SH * HD * SN;
    for (int e = wg * NTHR + otid(); e < NB * PER_B; e += G * NTHR) {
        const int b = e / PER_B, r = e % PER_B, h = r / (HD * SN);
        float state = 0.f;
        for (int c = 0; c < NCH; ++c) { const size_t idx = (size_t)(b * NCH + c) * PER_B + r; const float tmp = ST[idx]; ST[idx] = state; state = state * CDEC[(b * NCH + c) * SH + h] + tmp; }
    }
}
__device__ __forceinline__ void phase_ssd_out(const bf16* XC, const float* DTS, const float* a_log, const float* dskip, const float* ST, float* YPRE, LAS unsigned char* lds, int G, int wg) {
    LAS float* Mm = (LAS float*)(lds + RING_OFF);
    LAS float* acs = (LAS float*)(lds + RING_OFF + 20480);
    LAS float* dts = acs + 64;
    const int tid = otid();
    for (int it = wg; it < NB * NCH * SH; it += G) {
        const int h = it % SH, bc = it / SH, m0 = bc * TC, g = h / HPG;
        __syncthreads();
        if (tid < 64) { const float A = -__expf(a_log[h]), dt = DTS[(size_t)(m0 + tid) * SH + h]; acs[tid] = wave_scan(dt * A, tid); dts[tid] = dt; }
        __syncthreads();
        for (int i = 0; i < 8; ++i) { const int e = tid + NTHR * i, t = e >> 6, s = e & 63;
            float v = 0.f;
            if (s <= t) { const bf16* cp = XC + (size_t)(m0 + t) * CONVD + DI + SG * SN + g * SN; const bf16* bp = XC + (size_t)(m0 + s) * CONVD + DI + g * SN;
                float dot = 0.f;
#pragma unroll 4
                for (int n = 0; n < SN; n += 8) { float cv[8], bv[8]; ld_bf16x8(cp + n, cv); ld_bf16x8(bp + n, bv);
#pragma unroll
                    for (int q = 0; q < 8; ++q) dot += cv[q] * bv[q]; }
                v = dot * __expf(acs[t] - acs[s]) * dts[s]; }
            Mm[t * 65 + s] = v; }
        __syncthreads();
        const int t = tid >> 3, p0 = (tid & 7) * 8;
        float y[8];
#pragma unroll
        for (int j = 0; j < 8; ++j) y[j] = 0.f;
        for (int s = 0; s < TC; ++s) { float xv[8]; ld_bf16x8(XC + (size_t)(m0 + s) * CONVD + h * HD + p0, xv); const float mv = Mm[t * 65 + s];
#pragma unroll
            for (int j = 0; j < 8; ++j) y[j] += mv * xv[j]; }
        const float ea = __expf(acs[t]), dk = dskip[h];
        const bf16* cp = XC + (size_t)(m0 + t) * CONVD + DI + SG * SN + g * SN;
        float xt[8]; ld_bf16x8(XC + (size_t)(m0 + t) * CONVD + h * HD + p0, xt);
#pragma unroll
        for (int j = 0; j < 8; ++j) { const float* pp = ST + (((size_t)bc * SH + h) * HD + p0 + j) * SN;
            float dot = 0.f;
#pragma unroll 4
            for (int n = 0; n < SN; n += 8) { float cv[8], pv[8]; ld_bf16x8(cp + n, cv); ld_f32x8(pp + n, pv);
#pragma unroll
                for (int q = 0; q < 8; ++q) dot += cv[q] * pv[q]; }
            y[j] += ea * dot + dk * xt[j]; }
        st_f32x8(YPRE + (size_t)(m0 + t) * DI + h * HD + p0, y);
    }
}

#ifndef CHORE_OVERLAP
#define CHORE_OVERLAP 0
#endif
#ifndef CHORE_ATTN
#define CHORE_ATTN 0
#endif
#ifndef CHORE_CONV
#define CHORE_CONV CHORE_OVERLAP
#endif
#ifndef CHORE_W
#define CHORE_W CHORE_OVERLAP
#endif
#ifndef NCV
#define NCV 8
#endif
#ifndef TIM_WG
#define TIM_WG 0
#endif
#ifndef REP_IN
#define REP_IN 1
#endif
#ifndef REP_RES
#define REP_RES 1
#endif
#ifndef REP_DN
#define REP_DN 1
#endif
#ifndef REP_SCAN
#define REP_SCAN 1
#endif
#ifndef REP_BAR
#define REP_BAR 1
#endif
#ifndef REP_PRO
#define REP_PRO 1
#endif
#ifndef REP_THIN
#define REP_THIN 1
#endif
#ifndef ROT
#define ROT 7
#endif
#ifndef JIT_PHASE
#define JIT_PHASE 3
#endif
#define JIT_AT(p) (JIT_W && JIT_PHASE == (p) && l + 1 < DEPTH && !(G == 256 && DYN_GEMM && CHORE_W) && !(G == 256 && (CHORE_ATTN & 2)))
#ifndef ROT_SH
#define ROT_SH 3
#endif
#define ROT_B(bit) (((ROT) >> (bit)) & 1 && ((wg >> ROT_SH) & 1))
#ifndef ATT_ABL
#define ATT_ABL 0
#endif
#ifndef REP_ATTN
#define REP_ATTN 1
#endif
#ifndef REP_SSD
#define REP_SSD 1
#endif
#ifndef ATTN_REPEAT
#define ATTN_REPEAT 1
#endif
#ifndef SLOW4
#define SLOW4 1
#endif
constexpr int PPL = (FAST_SSD && FAST_ATTN) ? 10 : (FAST_SSD ? 13 : 14), NPH = 1 + DEPTH * PPL;
struct Args { const float* in[26]; float* out; unsigned char* ws; int ph_lo, ph_hi; };
__global__ void __launch_bounds__(NTHR, 2) fwd(Args args) {
    extern __shared__ __attribute__((aligned(16))) unsigned char lds_[];
    LAS unsigned char* lds = (LAS unsigned char*)lds_;
    const int G = gridDim.x, wg = blockIdx.x;
    for (int u = threadIdx.x; u < (LDS_BYTES - LDSCTL_OFF) / 4; u += NTHR) ((LAS unsigned*)(lds + LDSCTL_OFF))[u] = 0u;
    __syncthreads();
    otid_init();
    __syncthreads();
    unsigned char* const ws0 = args.ws;
    unsigned* const ctl0 = (unsigned*)(ws0 + WS_CTL);
    const int lo = args.ph_lo, hi = args.ph_hi;
    XcdBarrier bar; bar.bar = ctl0 + CW_BAR; bar.x = 0; bar.st = (volatile LAS unsigned*)(lds + MISC_OFF) + 8;
    if (hi - lo > 1) bar = xcd_barrier_post(ctl0 + CW_BAR, (volatile LAS unsigned*)(lds + MISC_OFF) + 8);
#define INP(i) (args.in[i])
#define WSP(T, off) ((T*)(ws + (off)))
#define X (args.out)
#define SSQX ((u64*)(ctl + CW_SSQX))
#define SSQC ((u64*)(ctl + CW_SSQC))
#define XB0 WSP(bf16, WS_XB)
#define XB1 WSP(bf16, WS_XB1)
#define XB2 WSP(bf16, WS_XB2)
#define PROJ WSP(bf16, WS_PROJ)
#define U WSP(bf16, WS_U)
#define MISC WSP(float, WS_MISC)
#define QRAW WSP(bf16, WS_QRAW)
#define KVRAW WSP(bf16, WS_KVRAW)
#define KF WSP(bf16, WS_KF)
#define AO WSP(bf16, WS_AO)
#define XC WSP(bf16, WS_XC)
#define DTS WSP(float, WS_DTS)
#define CDEC WSP(float, WS_CDEC)
#define ST WSP(float, WS_ST)
#define YPRE WSP(float, WS_YPRE)
#define Y WSP(bf16, WS_Y)
#define TMPF WSP(float, WS_TMPF)
#define MERGED WSP(bf16, WS_MERGED)
#define PE WSP(bf16, WS_PE)
#define PB WSP(bf16, WS_PB)
#define COS WSP(float, WS_COS)
#define SIN WSP(float, WS_SIN)
    int ph = 0;
#if defined(TIM_KIND)
    unsigned long long tim_acc = 0ull; const unsigned long long clk0 = __builtin_amdgcn_s_memtime();
#define TIM_SEL(kind) (((TIM_KIND) >> ((kind) + 1)) & 1)
#define PHASE(...) do { if (lo <= ph && ph < hi) { const int kind_ = (ph == 0) ? -1 : (ph - 1) % PPL; const unsigned long long tA = __builtin_amdgcn_s_memrealtime(); \
        { unsigned char* ws = ws0; asm volatile("" : "+s"(ws)); unsigned* ctl = (unsigned*)(ws + WS_CTL); __VA_ARGS__; } const unsigned long long tB = __builtin_amdgcn_s_memrealtime(); \
        if (ph + 1 < hi) xcd_barrier(bar); const unsigned long long tC = __builtin_amdgcn_s_memrealtime(); \
        if (TIM_SEL(kind_)) tim_acc += (TIM_PART == 0) ? (tB - tA) : ((TIM_PART == 1) ? (tC - tB) : (tC - tA)); } ++ph; } while (0)
#else
#define PHASE(...) do { if (lo <= ph && ph < hi) { { unsigned char* ws = ws0; asm volatile("" : "+s"(ws)); unsigned* ctl = (unsigned*)(ws + WS_CTL); __VA_ARGS__; } if (ph + 1 < hi) for (int rb = 0; rb < REP_BAR; ++rb) xcd_barrier(bar); } ++ph; } while (0)
#endif

    PHASE({ for (int rr = 0; rr < REP_PRO; ++rr) { prologue_weights(args.in, ws, lds, G, wg, 0, JIT_W ? 1 : DEPTH); prologue_rows(args.in, X, ws, G, wg); } });

#pragma unroll 1
    for (int l = 0; l < DEPTH; ++l) {
#define wl (ws + WS_W + (size_t)l * WL_BYTES)
#define ssq0 (SSQX + (size_t)(l * 3 + 0) * M)
#define ssq1 (SSQX + (size_t)(l * 3 + 1) * M)
#define ssq2 (SSQX + (size_t)(l * 3 + 2) * M)
#define ssqn ((l + 1 < DEPTH) ? SSQX + (size_t)((l + 1) * 3) * M : (u64*)nullptr)
#define ssqc (SSQC + (size_t)l * 2 * M)
#define QH(k) (ctl + CW_Q + ((l * 5 + (k)) * 8) * 64)
#if FAST_SSD && FAST_ATTN
        PHASE({ pg8::Gemm g{XB0, (const bf16*)(wl + WL_IN), M, DINP, DM, DM}; EpiInProj E{ssq0, ssqc, PROJ, MISC}; run_gemm_dyn(lds, g, E, G, wg, QH(0));
                { pg8::Gemm g2{PB + (size_t)l * M * PLE, (const bf16*)(wl + WL_PL), M, DM, PLE, PLE}; EpiScaleBf16 E2{nullptr, 0.f, PE, DM}; run_gemm_dyn(lds, g2, E2, G, wg, QH(3)); } });
        PHASE({ if (G == 256 && DYN_GEMM && CHORE_CONV) { if ((wg >> 3) < NCV) { phase_ssdpre(PROJ, MISC, INP(12) + (size_t)l * CW * CONVD, INP(13) + (size_t)l * CONVD, INP(14) + l * SH, XC, DTS, NCV * 8, (wg & 7) * NCV + (wg >> 3)); __syncthreads(); } }
                { pg8::Gemm g{PROJ + PC_CQ, (const bf16*)(wl + WL_UQ), M, NH * QK, QL, DINP}; EpiScaleBf16 E{ssqc, 1.f / QL, QRAW, NH * QK}; run_gemm_dyn(lds, g, E, G, wg, QH(1)); }
                { pg8::Gemm g{PROJ + PC_CKV, (const bf16*)(wl + WL_UKV), M, NH * 256, KVL, DINP}; EpiScaleBf16 E{ssqc + M, 1.f / KVL, KVRAW, NH * 256}; run_gemm_dyn(lds, g, E, G, wg, QH(2)); }
                if (!(G == 256 && DYN_GEMM && CHORE_CONV)) phase_ssdpre(PROJ, MISC, INP(12) + (size_t)l * CW * CONVD, INP(13) + (size_t)l * CONVD, INP(14) + l * SH, XC, DTS, G, wg); });
        PHASE({ if (!ROT_B(4)) { phase_kfin(KVRAW, MISC, INP(10) + l * QK, COS, SIN, KF, lds, G, wg); __syncthreads(); }
                ssd::phase_states(XC, DTS, INP(15) + l * SH, (bf16*)ST, CDEC, lds, G, wg);
                if (ROT_B(4)) { __syncthreads(); phase_kfin(KVRAW, MISC, INP(10) + l * QK, COS, SIN, KF, lds, G, wg); } });
        PHASE({ if (G == 256 && CHORE_ATTN) {
                    if ((wg >> 3) < NCV) { const int ci = (wg & 7) * NCV + (wg >> 3);
                        if (CHORE_ATTN & 1) ssd::phase_scan((bf16*)ST, CDEC, NCV * 8, ci);
                        if ((CHORE_ATTN & 2) && JIT_W && l + 1 < DEPTH) prologue_weights(args.in, ws, lds, NCV * 8, ci, l + 1, l + 2); }
                    attn::phase_dyn(QRAW, KF, KVRAW, INP(9) + l * QK, COS, SIN, AO, lds, wg, ctl + CW_AQ + (l * 8 + (wg & 7)) * 64);
                    if (!(CHORE_ATTN & 1)) ssd::phase_scan((bf16*)ST, CDEC, G, wg);
                } else {
                    if (ROT_B(0)) { ssd::phase_scan((bf16*)ST, CDEC, G, wg); if (JIT_AT(3)) { __syncthreads(); prologue_weights(args.in, ws, lds, G, wg, l + 1, l + 2); __syncthreads(); } }
                    for (int rr = 0; rr < REP_ATTN - 1; ++rr) attn::phase<ATT_ABL>(QRAW, KF, KVRAW, INP(9) + l * QK, COS, SIN, AO, lds, G, wg);
                    attn::phase<0>(QRAW, KF, KVRAW, INP(9) + l * QK, COS, SIN, AO, lds, G, wg);
                    if (!ROT_B(0)) { for (int rr = 0; rr < REP_SCAN; ++rr) ssd::phase_scan((bf16*)ST, CDEC, G, wg); if (JIT_AT(3)) { __syncthreads(); prologue_weights(args.in, ws, lds, G, wg, l + 1, l + 2); } } } });
        PHASE({ if (!ROT_B(1)) { for (int rr = 0; rr < REP_SSD; ++rr) ssd::phase_out(XC, DTS, INP(15) + l * SH, INP(16) + l * SH, (const bf16*)ST, PROJ, Y, lds, G, wg); __syncthreads(); }
                { pg8::Gemm g{AO, (const bf16*)(wl + WL_OM), M, DM, DM, DM}; EpiGateF32 E{PROJ, (bf16*)TMPF}; run_gemm(lds, g, E, G, wg, GEMM_REPEAT); }
                if (ROT_B(1)) { __syncthreads(); ssd::phase_out(XC, DTS, INP(15) + l * SH, INP(16) + l * SH, (const bf16*)ST, PROJ, Y, lds, G, wg); } });
        PHASE({ pg8::Gemm g{Y, (const bf16*)(wl + WL_OS), M, DM, DI, DI}; EpiMerge E{PROJ, (const bf16*)TMPF, MERGED}; run_gemm(lds, g, E, G, wg, GEMM_REPEAT); });
        PHASE({ pg8::Gemm g{MERGED, (const bf16*)(wl + WL_OUT), M, DM, DM, DM}; EpiResid E{XB0, XB1, ssq1}; run_gemm(lds, g, E, G, wg, SLOW4); for (int rr = 1; rr < REP_RES; ++rr) { EpiResid E2{XB0, XB1, ssq1, 0.f}; run_gemm(lds, g, E2, G, wg, 1); } });
        PHASE({ if (JIT_W && l + 1 < DEPTH && G == 256 && DYN_GEMM && CHORE_W) { if ((wg >> 3) < NCV) { prologue_weights(args.in, ws, lds, NCV * 8, (wg & 7) * NCV + (wg >> 3), l + 1, l + 2); __syncthreads(); } }
                pg8::Gemm g{XB1, (const bf16*)(wl + WL_UP), M, DFF, DM, DM}; EpiUp E{ssq1, U}; run_gemm_dyn(lds, g, E, G, wg, QH(4)); });
        PHASE({ pg8::Gemm g{U, (const bf16*)(wl + WL_DN), M, DM, DFF, DFF}; EpiResid E{XB1, XB2, ssq2}; run_gemm(lds, g, E, G, wg, SLOW4); for (int rr = 1; rr < REP_DN; ++rr) { EpiResid E2{XB1, XB2, ssq2, 0.f}; run_gemm(lds, g, E2, G, wg, 1); } });
        PHASE({ if (ROT_B(2) && JIT_AT(9)) { prologue_weights(args.in, ws, lds, G, wg, l + 1, l + 2); __syncthreads(); }
                pg8::Gemm g{XB2, (const bf16*)(wl + WL_PG), M, DM, DM, DM}; EpiPleGate E{ssq2, PE, XB2, XB0, (l + 1 < DEPTH) ? (float*)nullptr : X, ssqn}; run_gemm(lds, g, E, G, wg, SLOW4); for (int rr = 1; rr < REP_RES; ++rr) { EpiPleGate E2{ssq2, PE, XB2, XB0, (l + 1 < DEPTH) ? (float*)nullptr : X, ssqn, 0.f}; run_gemm(lds, g, E2, G, wg, 1); }
                if (!ROT_B(2) && JIT_AT(9)) { __syncthreads(); prologue_weights(args.in, ws, lds, G, wg, l + 1, l + 2); } });
#else
#error "the simple-loop phase program was retired together with the f32 residual buffer; build with FAST_SSD and FAST_ATTN"
#if 0
        PHASE({ pg8::Gemm g{XB0, (const bf16*)(wl + WL_IN), M, DINP, DM, DM}; EpiInProj E{ssq0, ssqc, PROJ, MISC}; run_gemm(lds, g, E, G, wg, SLOW4); });
        PHASE({ { pg8::Gemm g{PROJ + PC_CQ, (const bf16*)(wl + WL_UQ), M, NH * QK, QL, DINP}; EpiScaleBf16 E{ssqc, 1.f / QL, QRAW, NH * QK}; run_gemm(lds, g, E, G, wg, GEMM_REPEAT); }
                { pg8::Gemm g{PROJ + PC_CKV, (const bf16*)(wl + WL_UKV), M, NH * 256, KVL, DINP}; EpiScaleBf16 E{ssqc + M, 1.f / KVL, KVRAW, NH * 256}; run_gemm(lds, g, E, G, wg, GEMM_REPEAT); }
                { pg8::Gemm g{PB + (size_t)l * M * PLE, (const bf16*)(wl + WL_PL), M, DM, PLE, PLE}; EpiScaleBf16 E{nullptr, 0.f, PE, DM}; run_gemm(lds, g, E, G, wg, GEMM_REPEAT); } });
        PHASE({ for (int rr = 0; rr < REP_THIN; ++rr) { phase_kfin(KVRAW, MISC, INP(10) + l * QK, COS, SIN, KF, lds, G, wg);
                phase_ssdpre(PROJ, MISC, INP(12) + (size_t)l * CW * CONVD, INP(13) + (size_t)l * CONVD, INP(14) + l * SH, XC, DTS, G, wg); } });

#if FAST_ATTN
        PHASE({ for (int rr = 0; rr < REP_ATTN - 1; ++rr) attn::phase<ATT_ABL>(QRAW, KF, KVRAW, INP(9) + l * QK, COS, SIN, AO, lds, G, wg);
                    attn::phase<0>(QRAW, KF, KVRAW, INP(9) + l * QK, COS, SIN, AO, lds, G, wg); });
#else
        PHASE({ phase_attn_simple(QRAW, KF, KVRAW, INP(9) + l * QK, COS, SIN, AO, lds, G, wg); });
#endif

#if FAST_SSD
        PHASE({ for (int rr = 0; rr < REP_SSD; ++rr) ssd::phase_states(XC, DTS, INP(15) + l * SH, (bf16*)ST, CDEC, lds, G, wg); });
        PHASE({ ssd::phase_scan((bf16*)ST, CDEC, G, wg); });
        PHASE({ for (int rr = 0; rr < REP_SSD; ++rr) ssd::phase_out(XC, DTS, INP(15) + l * SH, INP(16) + l * SH, (const bf16*)ST, PROJ, Y, lds, G, wg); });
#else
        PHASE({ phase_ssd_states(XC, DTS, INP(15) + l * SH, ST, CDEC, lds, G, wg); });
        PHASE({ phase_ssd_scan(ST, CDEC, G, wg); });
        PHASE({ phase_ssd_out(XC, DTS, INP(15) + l * SH, INP(16) + l * SH, ST, YPRE, lds, G, wg); });
        PHASE({ phase_ssdnorm(YPRE, PROJ, Y, G, wg); });
#endif
        PHASE({ pg8::Gemm g{AO, (const bf16*)(wl + WL_OM), M, DM, DM, DM}; EpiGateF32 E{PROJ, TMPF}; run_gemm(lds, g, E, G, wg, GEMM_REPEAT); });
        PHASE({ pg8::Gemm g{Y, (const bf16*)(wl + WL_OS), M, DM, DI, DI}; EpiMerge E{PROJ, TMPF, MERGED}; run_gemm(lds, g, E, G, wg, GEMM_REPEAT); });
        PHASE({ pg8::Gemm g{MERGED, (const bf16*)(wl + WL_OUT), M, DM, DM, DM}; EpiResid E{X, XB1, ssq1}; run_gemm(lds, g, E, G, wg, SLOW4); });
        PHASE({ pg8::Gemm g{XB1, (const bf16*)(wl + WL_UP), M, DFF, DM, DM}; EpiUp E{ssq1, U}; run_gemm(lds, g, E, G, wg, GEMM_REPEAT); });
        PHASE({ pg8::Gemm g{U, (const bf16*)(wl + WL_DN), M, DM, DFF, DFF}; EpiResid E{X, XB2, ssq2}; run_gemm(lds, g, E, G, wg, SLOW4); });
        PHASE({ pg8::Gemm g{XB2, (const bf16*)(wl + WL_PG), M, DM, DM, DM};  EpiPleGate E{ssq2, PE, X, XB0, ssqn}; run_gemm(lds, g, E, G, wg, SLOW4); });
#endif
#endif
    }
#undef PHASE
#if defined(TIM_KIND)
#if defined(TIM_CLOCK)
    tim_acc = (__builtin_amdgcn_s_memtime() - clk0) / 160ull;
#endif
    if (wg == TIM_WG) { const unsigned long long t0 = __builtin_amdgcn_s_memrealtime(); while (__builtin_amdgcn_s_memrealtime() - t0 < (unsigned long long)(TIM_AMP) * tim_acc) __builtin_amdgcn_s_sleep(8); }
#endif
}

extern "C" void kernel_launch(void* const* d_in, const int* in_sizes, int n_in, void* d_out, int out_size, void* d_ws, size_t ws_size, hipStream_t stream) {
    static int grid = 0;
    if (grid == 0) {
        if (n_in != 26 || out_size != M * DM || ws_size < WS_END) { fprintf(stderr, "kernel_launch: built for 26 inputs, out %d floats, >= %zu bytes of workspace; got n_in %d out %d ws %zu\n", M * DM, (size_t)WS_END, n_in, out_size, ws_size); grid = -1; return; }
        int dev = 0, cus = 0;
        if (hipGetDevice(&dev) != hipSuccess || hipDeviceGetAttribute(&cus, hipDeviceAttributeMultiprocessorCount, dev) != hipSuccess) { grid = -1; return; }
        if (hipFuncSetAttribute((const void*)fwd, hipFuncAttributeMaxDynamicSharedMemorySize, LDS_BYTES) != hipSuccess) { fprintf(stderr, "kernel_launch: hipFuncSetAttribute failed\n"); grid = -1; return; }
        int per_cu = 0;
        if (hipOccupancyMaxActiveBlocksPerMultiprocessor(&per_cu, (const void*)fwd, NTHR, LDS_BYTES) != hipSuccess || per_cu < 1) fprintf(stderr, "kernel_launch: occupancy query says %d\n", per_cu);
        (void)hipGetLastError();
        grid = cus;
    }
    if (grid < 0) return;
    if (hipMemsetAsync((char*)d_ws + WS_CTL, 0, CTL_ZERO_BYTES, stream) != hipSuccess) return;
    Args a{};
    for (int i = 0; i < 26; ++i) a.in[i] = (const float*)d_in[i];
    a.out = (float*)d_out; a.ws = (unsigned char*)d_ws;
#if MK_ONE_LAUNCH
    a.ph_lo = 0; a.ph_hi = NPH;
    hipLaunchKernelGGL(fwd, dim3(grid), dim3(NTHR), LDS_BYTES, stream, a);
#else
#ifndef STOP_PH
#define STOP_PH NPH
#endif
    for (int ph = 0; ph < STOP_PH; ++ph) {
#ifdef SKIP_LO
        if (ph >= SKIP_LO && ph < SKIP_HI) continue;
#endif
        a.ph_lo = ph; a.ph_hi = ph + 1; hipLaunchKernelGGL(fwd, dim3(grid), dim3(NTHR), LDS_BYTES, stream, a); }
#endif
    const hipError_t le = hipPeekAtLastError();
    if (le != hipSuccess) fprintf(stderr, "kernel_launch: launch failed: %s\n", hipGetErrorName(le));
}
```

```cpp
#include <hip/hip_runtime.h>
#include <cstdio>
#include <cstdint>

#ifndef MK_ONE_LAUNCH
#define MK_ONE_LAUNCH 1
#endif
#ifndef DYN_GEMM
#define DYN_GEMM 1
#endif
#ifndef FAST_SSD
#define FAST_SSD 1
#endif
#ifndef FAST_ATTN
#define FAST_ATTN 1
#endif
#ifndef FAST_GEMM
#define FAST_GEMM 1
#endif
#ifndef GEMM32
#define GEMM32 0
#endif
#ifndef JIT_W
#define JIT_W 1
#endif

constexpr int NB = 2, SEQ = 4096, M = NB * SEQ, DM = 2048, DEPTH = 4, PLE = 256;
constexpr float EPS = 1e-6f;
constexpr int NH = 16, QL = 512, KVL = 512, NOPE = 128, ROPE = 64, VD = 128, QK = 192;
constexpr int DI = 4096, HD = 64, SH = 64, SG = 8, SN = 128, HPG = 8, CW = 4, CONVD = 6144, TC = 64, NCH = SEQ / TC;
constexpr int DFF = 8192;
constexpr int DIN = 15488;
constexpr int DINP = 15616;
constexpr int PC_CQ = 0, PC_CKV = 512, PC_Z = 1024, PC_XBC = 5120, PC_G = 11264, PC_KR = 15360, PC_DT = 15424, PC_PAD = 15488;
constexpr int NWAVES = 8, NTHR = 512;

typedef unsigned short bf16;
typedef unsigned u32x4 __attribute__((ext_vector_type(4)));
typedef unsigned u32x2 __attribute__((ext_vector_type(2)));
typedef float f32x4 __attribute__((ext_vector_type(4)));
typedef float f32x2 __attribute__((ext_vector_type(2)));
typedef short bf16x8 __attribute__((ext_vector_type(8)));
#define GAS __attribute__((address_space(1)))
#define LAS __attribute__((address_space(3)))
typedef GAS unsigned gu32;
#define RLX_AGENT __ATOMIC_RELAXED, __HIP_MEMORY_SCOPE_AGENT
#define LDS_WAIT() asm volatile("s_waitcnt lgkmcnt(0)" ::: "memory")
#define VM_WAIT() asm volatile("s_waitcnt vmcnt(0)" ::: "memory")

constexpr size_t MiB = 1u << 20;
constexpr size_t WS_CTL = 0, CTL_ZERO_BYTES = 2 * MiB;
constexpr int CW_TMO = 0, CW_CODE = 1, CW_BAR = 4096;
typedef unsigned long long u64;
constexpr int CW_SSQX = 16384;
constexpr int CW_SSQC = CW_SSQX + 2 * DEPTH * 3 * M;
static_assert((size_t)(CW_SSQC + 2 * DEPTH * 2 * M) * 4 <= CTL_ZERO_BYTES, "ctl");
constexpr int CW_AQ = 390000;
constexpr int CW_Q = 400000;
static_assert(CW_AQ >= CW_SSQC + 2 * DEPTH * 2 * M && CW_AQ + DEPTH * 8 * 64 <= CW_Q && CW_Q >= CW_SSQC + 2 * DEPTH * 2 * M && (size_t)(CW_Q + DEPTH * 5 * 8 * 64) * 4 <= CTL_ZERO_BYTES, "ctl q");
constexpr size_t WL_IN = 0, WL_UQ = 61 * MiB, WL_UKV = 64 * MiB, WL_OM = 68 * MiB, WL_OS = 76 * MiB, WL_OUT = 92 * MiB, WL_UP = 100 * MiB, WL_DN = 132 * MiB, WL_PG = 164 * MiB, WL_PL = 172 * MiB, WL_BYTES = 173 * MiB;
static_assert((size_t)DINP * DM * 2 == 61 * MiB, "w_in copy");
constexpr size_t WS_W = 2 * MiB;
constexpr size_t WS_ACT = WS_W + DEPTH * WL_BYTES;
constexpr size_t WS_XB = WS_ACT;
constexpr size_t WS_XB1 = WS_XB + 32 * MiB, WS_XB2 = WS_XB1 + 32 * MiB;
constexpr size_t WS_PROJ = WS_XB2 + 32 * MiB;
constexpr size_t WS_U = WS_PROJ;
constexpr size_t WS_MISC = WS_PROJ + 244 * MiB;
constexpr size_t WS_QRAW = WS_MISC + 4 * MiB;
constexpr size_t WS_KVRAW = WS_QRAW + 48 * MiB;
constexpr size_t WS_KF = WS_KVRAW + 64 * MiB;
constexpr size_t WS_AO = WS_KF + 48 * MiB;
constexpr size_t WS_XC = WS_AO + 32 * MiB;
constexpr size_t WS_DTS = WS_XC + 96 * MiB;
constexpr size_t WS_CDEC = WS_DTS + 2 * MiB;
constexpr size_t WS_ST = WS_CDEC + 1 * MiB;
constexpr size_t WS_YPRE = WS_ST + 256 * MiB;
constexpr size_t WS_Y = WS_YPRE + 128 * MiB;
constexpr size_t WS_TMPF = WS_Y + 64 * MiB;
constexpr size_t WS_MERGED = WS_TMPF + 64 * MiB;
constexpr size_t WS_PE = WS_MERGED + 32 * MiB;
constexpr size_t WS_PB = WS_PE + 32 * MiB;
constexpr size_t WS_COS = WS_PB + 16 * MiB;
constexpr size_t WS_SIN = WS_COS + 1 * MiB;
constexpr size_t WS_END = WS_SIN + 1 * MiB;
static_assert(WS_END <= 1936 * MiB, "d_ws budget (4 x the largest input)");

constexpr int RING_OFF = 0, RING_BYTES = 131072;
constexpr int LDSCTL_OFF = RING_BYTES, MISC_OFF = LDSCTL_OFF + 320;
constexpr int QSLOT_OFF = LDSCTL_OFF + 448;
constexpr int EXTRA_OFF = LDSCTL_OFF + 512, LDS_BYTES = 147456, EXTRA_BYTES = LDS_BYTES - EXTRA_OFF;

__device__ __forceinline__ unsigned f2bf(float f) { unsigned u = __builtin_bit_cast(unsigned, f); return (u + 0x7fffu + ((u >> 16) & 1u)) >> 16; }
__device__ __forceinline__ float bf2f(unsigned h) { return __builtin_bit_cast(float, h << 16); }
typedef __bf16 bf16x2_t __attribute__((ext_vector_type(2)));
__device__ __forceinline__ unsigned pk2(float lo, float hi) { const f32x2 v = {lo, hi}; const bf16x2_t b = __builtin_convertvector(v, bf16x2_t); return __builtin_bit_cast(unsigned, b); }
__device__ __forceinline__ u32x4 pack8(const float (&v)[8]) { u32x4 w; w.x = pk2(v[0], v[1]); w.y = pk2(v[2], v[3]); w.z = pk2(v[4], v[5]); w.w = pk2(v[6], v[7]); return w; }
__device__ __forceinline__ void unpack8(u32x4 w, float (&v)[8]) {
    v[0] = bf2f(w.x & 0xffffu); v[1] = bf2f(w.x >> 16); v[2] = bf2f(w.y & 0xffffu); v[3] = bf2f(w.y >> 16);
    v[4] = bf2f(w.z & 0xffffu); v[5] = bf2f(w.z >> 16); v[6] = bf2f(w.w & 0xffffu); v[7] = bf2f(w.w >> 16); }
template <int MASK> __device__ __forceinline__ float swz_xor(float v) { static_assert(MASK > 0 && MASK < 32, "ds_swizzle bit mode"); return __builtin_bit_cast(float, __builtin_amdgcn_ds_swizzle(__builtin_bit_cast(int, v), (MASK << 10) | 0x1f)); }
__device__ __forceinline__ float sum_xor32(float v) { auto rr = __builtin_amdgcn_permlane32_swap(__float_as_uint(v), __float_as_uint(v), false, false); return __uint_as_float(rr[0]) + __uint_as_float(rr[1]); }
__device__ __forceinline__ float max_xor32(float v) { auto rr = __builtin_amdgcn_permlane32_swap(__float_as_uint(v), __float_as_uint(v), false, false); return fmaxf(__uint_as_float(rr[0]), __uint_as_float(rr[1])); }
__device__ __forceinline__ float get_xor32(float v, int lane) { auto rr = __builtin_amdgcn_permlane32_swap(__float_as_uint(v), __float_as_uint(v), false, false); return __uint_as_float(lane < 32 ? rr[1] : rr[0]); }
__device__ __forceinline__ float wave_sum(float v) { v += swz_xor<1>(v); v += swz_xor<2>(v); v += swz_xor<4>(v); v += swz_xor<8>(v); v += swz_xor<16>(v); return sum_xor32(v); }
__device__ __forceinline__ float wave_max(float v) { v = fmaxf(v, swz_xor<1>(v)); v = fmaxf(v, swz_xor<2>(v)); v = fmaxf(v, swz_xor<4>(v)); v = fmaxf(v, swz_xor<8>(v)); v = fmaxf(v, swz_xor<16>(v)); return max_xor32(v); }
__device__ __forceinline__ float lane_up(float v, int o, int lane) { return __builtin_bit_cast(float, __builtin_amdgcn_ds_bpermute((lane - o) << 2, __builtin_bit_cast(int, v))); }
constexpr int WTAB_OFF = 131072;
__device__ __forceinline__ unsigned hw_slot() { return (unsigned)__builtin_amdgcn_s_getreg((5 << 11) | 4) & 63u; }
__device__ __forceinline__ void otid_init() { if ((threadIdx.x & 63) == 0) ((LAS unsigned*)(uintptr_t)WTAB_OFF)[hw_slot()] = threadIdx.x >> 6; }
__device__ __forceinline__ int otid() { const unsigned w = ((volatile LAS unsigned*)(uintptr_t)WTAB_OFF)[hw_slot()];
    int l; asm volatile("v_mbcnt_lo_u32_b32 %0, -1, 0\n\tv_mbcnt_hi_u32_b32 %0, -1, %0" : "=v"(l));
    return (int)(w * 64u) + l; }
__device__ __forceinline__ float sigmoidf_(float x) { return 1.f / (1.f + __expf(-x)); }
__device__ __forceinline__ float siluf_(float x) { return x / (1.f + __expf(-x)); }

#define XB_TMO      128
#define XB_XCNT(j)  (256  + 64 * (j))
#define XB_XSUB(j)  (1280 + 64 * (j))
#define XB_XGEN(j)  (2304 + 64 * (j))
#define XB_TOP      3328
#define XB_TOPGEN   3392
#define XCD_BAR_WORDS 3456
#define XB_SPIN_CAP (1u << 18)
__device__ __forceinline__ unsigned xb_ld(unsigned* p)              { return __hip_atomic_load(p, __ATOMIC_RELAXED, __HIP_MEMORY_SCOPE_AGENT); }
__device__ __forceinline__ unsigned xb_add(unsigned* p, unsigned v) { return __hip_atomic_fetch_add(p, v, __ATOMIC_RELAXED, __HIP_MEMORY_SCOPE_AGENT); }
__device__ __forceinline__ unsigned xb_xcc_id() { return (unsigned)__builtin_amdgcn_s_getreg((3 << 11) | 20) & 0xFu; }
#define XB_SPIN(cond, bar) do { unsigned _sp = 0; while (cond) { __builtin_amdgcn_s_sleep(1); \
    if ((++_sp & 255u) == 0u) { if (xb_ld(&(bar)[XB_TMO])) break; if (_sp > XB_SPIN_CAP) { atomicAdd(&(bar)[XB_TMO], 1u); break; } } } } while (0)
struct XcdBarrier { unsigned* bar; unsigned x; volatile LAS unsigned* st; };
__device__ __forceinline__ XcdBarrier xcd_barrier_post(unsigned* bar, volatile LAS unsigned* st) {
    XcdBarrier b; b.bar = bar; b.x = xb_xcc_id(); b.st = st;
    if (otid() == 0) (void)xb_add(&bar[XB_XCNT(b.x)], 1u);
    return b;
}
__device__ __forceinline__ void xcd_barrier_complete(unsigned* bar, unsigned x, unsigned& nloc, unsigned& nx) {
    const unsigned G = gridDim.x * gridDim.y * gridDim.z;
    unsigned sum, cnt, mine, sp = 0u;
    for (;;) {
        sum = 0u; cnt = 0u; mine = 0u;
#pragma unroll
        for (unsigned j = 0; j < 16; ++j) { const unsigned c = xb_ld(&bar[XB_XCNT(j)]); sum += c; cnt += (c > 0u) ? 1u : 0u; mine = (j == x) ? c : mine; }
        if (sum == G) break;
        __builtin_amdgcn_s_sleep(1);
        if ((++sp & 255u) == 0u) { if (xb_ld(&bar[XB_TMO])) break; if (sp > XB_SPIN_CAP) { atomicAdd(&bar[XB_TMO], 1u); break; } }
    }
    nloc = mine > 0u ? mine : 1u; nx = cnt > 0u ? cnt : 1u;
}
__device__ __forceinline__ void xcd_barrier(const XcdBarrier& b) {
    asm volatile("s_waitcnt vmcnt(0)" ::: "memory");
    __syncthreads();
    if (otid() == 0) {
        unsigned* bar = b.bar;
        __builtin_amdgcn_s_waitcnt(0);
        unsigned nloc = b.st[0], nx = b.st[1];
        if (nloc == 0u) { xcd_barrier_complete(bar, b.x, nloc, nx); b.st[0] = nloc; b.st[1] = nx; }
        const unsigned old = xb_add(&bar[XB_XSUB(b.x)], 1u);
        const unsigned gen = old / nloc;
        if (old + 1u == (gen + 1u) * nloc) {
            __builtin_amdgcn_fence(__ATOMIC_RELEASE, "agent");
            asm volatile("s_waitcnt vmcnt(0)" ::: "memory");
            const unsigned og = xb_add(&bar[XB_TOP], 1u);
            const unsigned tg = og / nx;
            if (og + 1u == (tg + 1u) * nx) xb_add(&bar[XB_TOPGEN], 1u);
            else XB_SPIN(xb_ld(&bar[XB_TOPGEN]) == tg, bar);
            __builtin_amdgcn_fence(__ATOMIC_ACQUIRE, "agent");
            xb_add(&bar[XB_XGEN(b.x)], 1u);
            asm volatile("s_waitcnt vmcnt(0)" ::: "memory");
        } else {
            XB_SPIN(xb_ld(&bar[XB_XGEN(b.x)]) == gen, bar);
            __builtin_amdgcn_fence(__ATOMIC_ACQUIRE, "agent");
            asm volatile("s_waitcnt vmcnt(0)" ::: "memory");
        }
    }
    __syncthreads();
}

namespace pg8 {
typedef unsigned short bf16_t;
constexpr int BM = 256, BK = 64, HALF = 128, HTB = HALF * BK * 2, STAGE_BYTES = 8 * HTB, NXCD = 8, WGM = 8;
#if GEMM32
__host__ __device__ __forceinline__ int lds_byte(int r, int c) { const int st = (r >> 4) * 2 + (c >> 5), rr = r & 15, cc = c & 31, ob = rr * 64 + cc * 2; return st * 1024 + (ob ^ (((ob >> 8) & 3) << 4)); }
__host__ __device__ __forceinline__ void stage_rc(int b, int& R, int& C) { const int st = b / 1024, sb = b % 1024, swz = sb ^ (((sb >> 8) & 3) << 4); R = (st >> 1) * 16 + swz / 64; C = (st & 1) * 32 + (swz % 64) / 2; }
__host__ __device__ __forceinline__ int perm32(int rho) { return 16 * ((rho >> 2) & 1) + (rho & 3) + 4 * (rho >> 3); }
#else
__host__ __device__ __forceinline__ int lds_byte(int r, int c) { const int st = (r >> 4) * 2 + (c >> 5), rr = r & 15, cc = c & 31, ob = rr * 64 + cc * 2; return st * 1024 + (ob ^ (((ob >> 9) & 1) << 5)); }
__host__ __device__ __forceinline__ void stage_rc(int b, int& R, int& C) { const int st = b / 1024, sb = b % 1024, swz = sb ^ (((sb >> 9) & 1) << 5); R = (st >> 1) * 16 + swz / 64; C = (st & 1) * 32 + (swz % 64) / 2; }
__host__ __device__ __forceinline__ int perm32(int rho) { const int n = rho >> 4, i = rho & 15; return 8 * (i >> 2) + 4 * n + (i & 3); }
#endif
__host__ __device__ __forceinline__ int perm32_16(int rho) { const int n = rho >> 4, i = rho & 15; return 8 * (i >> 2) + 4 * n + (i & 3); }
struct Unit { int pm, pn; };
struct Gemm { const bf16_t* A; const bf16_t* Bt; int M, N, K, lda; };
struct StaticOrder {
    static constexpr bool DYN = false;
    int nM, nN, nwg, G, c;
    __host__ __device__ void init(int M_, int N_, int G_, int c_) { nM = M_ / BM; nN = N_ / BM; nwg = nM * nN; G = G_; c = c_; }
    __host__ __device__ bool next(int i, Unit& u) const {
        const long L = (long)i * G + c; if (L >= nwg) return false;
        int wgid = (int)L; { const int q = nwg / NXCD, r = nwg % NXCD, xcd = wgid % NXCD, off = wgid / NXCD; wgid = (xcd < r ? xcd * (q + 1) : r * (q + 1) + (xcd - r) * q) + off; }
        const int nig = WGM * nN, gid = wgid / nig, fm = gid * WGM, gsz = (nM - fm) < WGM ? (nM - fm) : WGM;
        u.pm = fm + ((wgid % nig) % gsz); u.pn = (wgid % nig) / gsz; return true;
    }
    __device__ __forceinline__ void a_ready(const Unit&) const {}
    __device__ __forceinline__ void done(const Unit&) const {}
};

struct DynOrder {
    static constexpr bool DYN = true;
    int nM, nN, q, x; unsigned* head;
    __device__ void init(int M_, int N_, int c_, unsigned* head_base) { nM = M_ / BM; nN = N_ / BM; q = (nM * nN) / NXCD; x = c_ % NXCD; head = head_base + 64 * x; }
    __device__ __forceinline__ int pull() const { return (int)__hip_atomic_fetch_add(head, 1u, __ATOMIC_RELAXED, __HIP_MEMORY_SCOPE_AGENT); }
    __device__ __forceinline__ bool unit_of(int e, Unit& u) const {
        if (e >= q) return false;
        const int wgid = x * q + e, nig = WGM * nN, gid = wgid / nig, fm = gid * WGM, gsz = (nM - fm) < WGM ? (nM - fm) : WGM;
        u.pm = fm + ((wgid % nig) % gsz); u.pn = (wgid % nig) / gsz; return true;
    }
    __device__ __forceinline__ bool next(int, Unit&) const { return false; }
    __device__ __forceinline__ void a_ready(const Unit&) const {}
    __device__ __forceinline__ void done(const Unit&) const {}
};

template <class Epi, class Sched>
__device__ __forceinline__ void gemm_phase(LAS unsigned char* lds, const Gemm g, const Sched& S, const Epi& E) {
    const int tid = otid(), wid = __builtin_amdgcn_readfirstlane(tid >> 6), lane = tid & 63, wr = wid >> 2, wc = wid & 3, fr = lane & 15, fq = lane >> 4;
    const int K = g.K, nt = K / BK, lda = g.lda;
    unsigned voffA[2], voffB[2];
#pragma unroll
    for (int i = 0; i < 2; ++i) { int R, C; stage_rc(tid * 16 + i * 8192, R, C); const int Rb = (R & ~31) + perm32(R & 31);
        voffA[i] = (unsigned)(R * lda + C) * 2u; voffB[i] = (unsigned)(Rb * K + C) * 2u; }
    const size_t kstep = (size_t)(BK * 2);
    const size_t hstepA = (size_t)HALF * lda * 2, hstepB = (size_t)HALF * K * 2;
    const size_t tstepA = 2 * hstepA, tstepB = 2 * hstepB;
    const unsigned ldsw = (unsigned)wid * 1024u;
#if GEMM32
    const int r32 = lane & 31, hi = lane >> 5;
    const int aE = lds_byte(wr * 64 + r32, hi * 8), aO = lds_byte(wr * 64 + r32, 16 + hi * 8), bE = lds_byte(wc * 32 + r32, hi * 8), bO = lds_byte(wc * 32 + r32, 16 + hi * 8);
#else
    const int aoff = lds_byte(wr * 64 + fr, fq * 8), boff = lds_byte(wc * 32 + fr, fq * 8);
#endif
#define PG8_SA(b, h) (((b) * 2 + (h)) * HTB)
#define PG8_SB(b, h) ((4 + (b) * 2 + (h)) * HTB)
#define PG8_STAGE(bufoff, gbase, voff) do { _Pragma("unroll") for (int _i = 0; _i < 2; ++_i) \
        __builtin_amdgcn_global_load_lds((const unsigned*)((const char*)(gbase) + (voff)[_i]), (LAS unsigned*)(lds + (bufoff) + ldsw + _i * 8192), 16, 0, 0); } while (0)
#if GEMM32
#define PG8_LDA(dst, b, h) do { _Pragma("unroll") for (int m = 0; m < 2; ++m) _Pragma("unroll") for (int k = 0; k < 4; ++k) dst[m][k] = *(const LAS bf16x8*)(lds + PG8_SA(b, h) + ((k & 1) ? aO : aE) + m * 4096 + (k >> 1) * 1024); } while (0)
#define PG8_LDB(dst, b, h) do { _Pragma("unroll") for (int k = 0; k < 4; ++k) dst[k] = *(const LAS bf16x8*)(lds + PG8_SB(b, h) + ((k & 1) ? bO : bE) + (k >> 1) * 1024); } while (0)
#define PG8_MMA(ai, bj, At, Bt) do { __builtin_amdgcn_s_setprio(1); _Pragma("unroll") for (int k = 0; k < 4; ++k) _Pragma("unroll") for (int m = 0; m < 2; ++m) \
        acc[ai][bj][m] = __builtin_amdgcn_mfma_f32_32x32x16_bf16(Bt[k], At[m][k], acc[ai][bj][m], 0, 0, 0); __builtin_amdgcn_s_setprio(0); } while (0)
#else
#define PG8_LDA(dst, b, h) do { _Pragma("unroll") for (int m = 0; m < 4; ++m) _Pragma("unroll") for (int k = 0; k < 2; ++k) dst[m][k] = *(const LAS bf16x8*)(lds + PG8_SA(b, h) + aoff + m * 2048 + k * 1024); } while (0)
#define PG8_LDB(dst, b, h) do { _Pragma("unroll") for (int n = 0; n < 2; ++n) _Pragma("unroll") for (int k = 0; k < 2; ++k) dst[n][k] = *(const LAS bf16x8*)(lds + PG8_SB(b, h) + boff + n * 2048 + k * 1024); } while (0)
#define PG8_MMA(ai, bj, At, Bt) do { __builtin_amdgcn_s_setprio(1); _Pragma("unroll") for (int m = 0; m < 4; ++m) _Pragma("unroll") for (int n = 0; n < 2; ++n) _Pragma("unroll") for (int k = 0; k < 2; ++k) \
        acc[ai][bj][m][n] = __builtin_amdgcn_mfma_f32_16x16x32_bf16(Bt[n][k], At[m][k], acc[ai][bj][m][n], 0, 0, 0); __builtin_amdgcn_s_setprio(0); } while (0)
#endif
#define PG8_WAIT_V(n) asm volatile("s_waitcnt vmcnt(" #n ")" ::: "memory")
#define PG8_WAIT_L(n) asm volatile("s_waitcnt lgkmcnt(" #n ")" ::: "memory")
#define PG8_BAR __builtin_amdgcn_s_barrier()
#define PG8_SCHED __builtin_amdgcn_sched_barrier(0)
    Unit cur, nxt; int ui = 0;
    LAS volatile int* qs = (LAS volatile int*)(lds + QSLOT_OFF);
    if constexpr (Sched::DYN) { if (tid == 0) { qs[0] = S.pull(); qs[1] = S.pull(); } __syncthreads(); if (!S.unit_of(qs[0], cur)) return; }
    else { if (!S.next(0, cur)) return; }
#if GEMM32
    typedef float f32x16 __attribute__((ext_vector_type(16)));
    f32x16 acc[2][2][2];
#define PG8_ZERO() do { _Pragma("unroll") for (int a = 0; a < 2; ++a) _Pragma("unroll") for (int b = 0; b < 2; ++b) _Pragma("unroll") for (int m = 0; m < 2; ++m) \
        acc[a][b][m] = (f32x16){0.f, 0.f, 0.f, 0.f, 0.f, 0.f, 0.f, 0.f, 0.f, 0.f, 0.f, 0.f, 0.f, 0.f, 0.f, 0.f}; } while (0)
    PG8_ZERO();
    bf16x8 At[2][4], B0[4], B1[4];
#else
    f32x4 acc[2][2][4][2];
#define PG8_ZERO() do { _Pragma("unroll") for (int a = 0; a < 2; ++a) _Pragma("unroll") for (int b = 0; b < 2; ++b) _Pragma("unroll") for (int m = 0; m < 4; ++m) _Pragma("unroll") for (int n = 0; n < 2; ++n) \
        acc[a][b][m][n] = (f32x4){0.f, 0.f, 0.f, 0.f}; } while (0)
    PG8_ZERO();
    bf16x8 At[4][2], B0[2][2], B1[2][2];
#endif
#define PG8_AP(u) ((const char*)g.A + (size_t)(u).pm * tstepA)
    const char* cA = PG8_AP(cur); const char* cB = (const char*)g.Bt + (size_t)cur.pn * tstepB;
    S.a_ready(cur);
    PG8_STAGE(PG8_SB(0, 0), cB, voffB); PG8_STAGE(PG8_SB(0, 1), cB + hstepB, voffB); PG8_STAGE(PG8_SA(0, 0), cA, voffA); PG8_STAGE(PG8_SA(0, 1), cA + hstepA, voffA);
    if (wr == 1) PG8_BAR;
    PG8_WAIT_V(2); PG8_BAR;
    PG8_STAGE(PG8_SB(1, 0), cB + kstep, voffB); PG8_STAGE(PG8_SA(1, 0), cA + kstep, voffA); PG8_STAGE(PG8_SB(1, 1), cB + hstepB + kstep, voffB);
    PG8_WAIT_V(6); PG8_BAR;
    for (;;) {
        bool has_next = false; const char* nA = cA; const char* nB = cB;
        if constexpr (!Sched::DYN) { has_next = S.next(ui + 1, nxt); if (has_next) { nA = PG8_AP(nxt); nB = (const char*)g.Bt + (size_t)nxt.pn * tstepB; } }
        for (int t = 0; t < nt; t += 2) {
            const bool last = (t == nt - 2);
            if constexpr (Sched::DYN) { if (last) { has_next = S.unit_of(qs[(ui + 1) & 1], nxt); if (has_next) { nA = PG8_AP(nxt); nB = (const char*)g.Bt + (size_t)nxt.pn * tstepB; } } }
            const char* a1 = cA + (size_t)(t + 1) * kstep;
            const char* a2 = last ? nA : cA + (size_t)(t + 2) * kstep; const char* b2 = last ? nB : cB + (size_t)(t + 2) * kstep;
            const char* a3 = a2 + kstep; const char* b3 = b2 + kstep;
            if (last && has_next) S.a_ready(nxt);
            PG8_LDB(B0, 0, 0); PG8_LDB(B1, 0, 1); PG8_SCHED; PG8_LDA(At, 0, 0); PG8_STAGE(PG8_SA(1, 1), a1 + hstepA, voffA);
            PG8_WAIT_V(8); PG8_WAIT_L(0); PG8_BAR; PG8_MMA(0, 0, At, B0); PG8_MMA(0, 1, At, B1); PG8_BAR; PG8_SCHED;
            PG8_LDA(At, 0, 1); PG8_STAGE(PG8_SB(0, 0), b2, voffB); PG8_STAGE(PG8_SB(0, 1), b2 + hstepB, voffB); PG8_STAGE(PG8_SA(0, 0), a2, voffA);
            PG8_WAIT_V(8); PG8_WAIT_L(0); PG8_BAR; PG8_MMA(1, 0, At, B0); PG8_MMA(1, 1, At, B1); PG8_BAR; PG8_SCHED;
            PG8_LDB(B0, 1, 0); PG8_LDB(B1, 1, 1); PG8_SCHED; PG8_LDA(At, 1, 0); PG8_STAGE(PG8_SA(0, 1), a2 + hstepA, voffA);
            PG8_WAIT_V(8); PG8_WAIT_L(0); PG8_BAR; PG8_MMA(0, 0, At, B0); PG8_MMA(0, 1, At, B1); PG8_BAR; PG8_SCHED;
            PG8_LDA(At, 1, 1); PG8_STAGE(PG8_SB(1, 0), b3, voffB); PG8_STAGE(PG8_SB(1, 1), b3 + hstepB, voffB); PG8_STAGE(PG8_SA(1, 0), a3, voffA);
            PG8_WAIT_V(8); PG8_WAIT_L(0); PG8_BAR; PG8_MMA(1, 0, At, B0); PG8_MMA(1, 1, At, B1); PG8_BAR; PG8_SCHED;
        }
        if (wr == 0) PG8_BAR;
        {
#if GEMM32
            const int row0 = cur.pm * BM + wr * 64 + r32, col00 = cur.pn * BM + wc * 32 + 16 * hi;
#define PG8_EROW(cc) (row0 + ((cc) >> 3) * HALF + (((cc) >> 2) & 1) * 32)
#define PG8_ECOL(cc) (col00 + (((cc) >> 1) & 1) * HALF + ((cc) & 1) * 8)
#define PG8_EVAL(cc, j) acc[(cc) >> 3][((cc) >> 1) & 1][((cc) >> 2) & 1][8 * ((cc) & 1) + (j)]
#else
            const int row0 = cur.pm * BM + wr * 64 + fr, col00 = cur.pn * BM + wc * 32 + 8 * fq;
#define PG8_EROW(cc) (row0 + ((cc) >> 3) * HALF + (((cc) >> 1) & 3) * 16)
#define PG8_ECOL(cc) (col00 + ((cc) & 1) * HALF)
#define PG8_EVAL(cc, j) acc[(cc) >> 3][(cc) & 1][((cc) >> 1) & 3][(j) >> 2][(j) & 3]
#endif
            int e2 = 0; if constexpr (Sched::DYN) { if (tid == 0) e2 = S.pull(); }
            constexpr int NBT = sizeof(typename Epi::Regs) <= 8 ? 16 : (sizeof(typename Epi::Regs) <= 32 ? 8 : 4);
#pragma unroll
            for (int c0 = 0; c0 < 16; c0 += NBT) {
                typename Epi::Regs R[NBT];
#pragma unroll
                for (int c = 0; c < NBT; ++c) { const int cc = c0 + c; E.load(PG8_EROW(cc), PG8_ECOL(cc), R[c]); }
                PG8_SCHED;
#pragma unroll
                for (int c = 0; c < NBT; ++c) { const int cc = c0 + c;
                    const float _v[8] = {PG8_EVAL(cc, 0), PG8_EVAL(cc, 1), PG8_EVAL(cc, 2), PG8_EVAL(cc, 3), PG8_EVAL(cc, 4), PG8_EVAL(cc, 5), PG8_EVAL(cc, 6), PG8_EVAL(cc, 7)};
                    E.apply(PG8_EROW(cc), PG8_ECOL(cc), _v, R[c]); }
                PG8_SCHED;
            }
#undef PG8_EROW
#undef PG8_ECOL
#undef PG8_EVAL
            if constexpr (Sched::DYN) { if (tid == 0) qs[ui & 1] = e2; }
        }
        S.done(cur);
        if (!has_next) break;
        PG8_ZERO();
        cur = nxt; cA = nA; cB = nB; ++ui;
        if (wr == 1) PG8_BAR;
    }
    PG8_WAIT_V(0);
    PG8_BAR;
#undef PG8_AP
#undef PG8_ZERO
#undef PG8_SA
#undef PG8_SB
#undef PG8_STAGE
#undef PG8_LDA
#undef PG8_LDB
#undef PG8_MMA
#undef PG8_WAIT_V
#undef PG8_WAIT_L
#undef PG8_BAR
#undef PG8_SCHED
}

template <class Epi>
__device__ __forceinline__ void gemm_simple(const Gemm g, const Epi& E, int G, int wg) {
    const int tid = otid(), wid = tid >> 6, lane = tid & 63, fr = lane & 15, fq = lane >> 4;
    const int nbn = g.N / 32, nblk = (g.M / 16) * nbn;
    for (int it = wg * NWAVES + wid; it < nblk; it += G * NWAVES) {
        const int m0 = (it / nbn) * 16, n0 = (it % nbn) * 32;
        f32x4 acc0 = {0.f, 0.f, 0.f, 0.f}, acc1 = {0.f, 0.f, 0.f, 0.f};
        const bf16_t* ap = g.A + (size_t)(m0 + fr) * g.lda + 8 * fq;
        const bf16_t* bp0 = g.Bt + (size_t)(n0 + perm32_16(fr)) * g.K + 8 * fq;
        const bf16_t* bp1 = g.Bt + (size_t)(n0 + perm32_16(16 + fr)) * g.K + 8 * fq;
        for (int k0 = 0; k0 < g.K; k0 += 32) {
            const bf16x8 a = *(const bf16x8*)(ap + k0), b0 = *(const bf16x8*)(bp0 + k0), b1 = *(const bf16x8*)(bp1 + k0);
            acc0 = __builtin_amdgcn_mfma_f32_16x16x32_bf16(b0, a, acc0, 0, 0, 0);
            acc1 = __builtin_amdgcn_mfma_f32_16x16x32_bf16(b1, a, acc1, 0, 0, 0);
        }
        const float v[8] = {acc0[0], acc0[1], acc0[2], acc0[3], acc1[0], acc1[1], acc1[2], acc1[3]};
        typename Epi::Regs rg; E.load(m0 + fr, n0 + 8 * fq, rg); E.apply(m0 + fr, n0 + 8 * fq, v, rg);
    }
}
}

#ifndef GEMM_REPEAT
#define GEMM_REPEAT 1
#endif
template <class Epi>
__device__ __forceinline__ void run_gemm(LAS unsigned char* lds, const pg8::Gemm g, const Epi& E, int G, int wg, int rep = 1) {
#if FAST_GEMM
    if (rep < 0) { pg8::gemm_simple<Epi>(g, E, G, wg); return; }
    for (int rr = 0; rr < rep; ++rr) { pg8::StaticOrder S; S.init(g.M, g.N, G, wg); pg8::gemm_phase<Epi, pg8::StaticOrder>(lds, g, S, E); }
#else
    pg8::gemm_simple<Epi>(g, E, G, wg);
#endif
}
template <class Epi>
__device__ __forceinline__ void run_gemm_dyn(LAS unsigned char* lds, const pg8::Gemm g, const Epi& E, int G, int wg, unsigned* heads) {
#if FAST_GEMM && DYN_GEMM
    pg8::DynOrder S; S.init(g.M, g.N, wg, heads); pg8::gemm_phase<Epi, pg8::DynOrder>(lds, g, S, E);
#else
    run_gemm(lds, g, E, G, wg, 1);
#endif
}

constexpr float SSQ_SCALE = 16777216.f, SSQ_INV = 1.f / 16777216.f;
__device__ __forceinline__ void ssq_add(u64* dst, int row, const float (&v)[8]) {
    float s = 0.f;
#pragma unroll
    for (int j = 0; j < 8; ++j) s += v[j] * v[j];
#if GEMM32
    s = sum_xor32(s);
    if ((otid() & 63) < 32) atomicAdd(dst + row, (u64)(s * SSQ_SCALE));
#else
    s += swz_xor<16>(s); s = sum_xor32(s);
    if ((otid() & 63) < 16) atomicAdd(dst + row, (u64)(s * SSQ_SCALE));
#endif
}
__device__ __forceinline__ float ld_ssq(const u64* p) { return (float)__hip_atomic_load(p, __ATOMIC_RELAXED, __HIP_MEMORY_SCOPE_AGENT) * SSQ_INV; }
__device__ __forceinline__ void st_f32x8(float* p, const float (&v)[8]) { *(f32x4*)p = (f32x4){v[0], v[1], v[2], v[3]}; *(f32x4*)(p + 4) = (f32x4){v[4], v[5], v[6], v[7]}; }
__device__ __forceinline__ void ld_f32x8(const float* p, float (&v)[8]) { const f32x4 a = *(const f32x4*)p, b = *(const f32x4*)(p + 4); v[0] = a.x; v[1] = a.y; v[2] = a.z; v[3] = a.w; v[4] = b.x; v[5] = b.y; v[6] = b.z; v[7] = b.w; }
__device__ __forceinline__ void ld_bf16x8(const bf16* p, float (&v)[8]) { unpack8(*(const u32x4*)p, v); }

struct EpiInProj {
    const u64* ssq; u64* ssqc; bf16* proj; float* misc; int live = 1;
    struct Regs { float rs; };
    __device__ __forceinline__ void load(int row, int col0, Regs& r) const { r.rs = rsqrtf(ld_ssq(ssq + row) * (1.f / DM) + EPS); }
    __device__ __forceinline__ void apply(int row, int col0, const float (&a)[8], const Regs& r) const {
        float v[8];
#pragma unroll
        for (int j = 0; j < 8; ++j) v[j] = a[j] * r.rs;
        const int tile = col0 >> 8;
        if (tile == 60) { const int c = col0 - PC_KR; if (c < 128) st_f32x8(misc + (size_t)row * 128 + c, v); return; }
        if (tile >= 44) {
#pragma unroll
            for (int j = 0; j < 8; ++j) v[j] = sigmoidf_(v[j]);
        }
        *(u32x4*)(proj + (size_t)row * DINP + col0) = pack8(v);
        if (tile < 4 && live) ssq_add(ssqc + (size_t)(tile >> 1) * M, row, v);
    }
};
struct EpiScaleBf16 {
    const u64* ssq; float inv_n; bf16* O; int ldo;
    struct Regs { float rs; };
    __device__ __forceinline__ void load(int row, int col0, Regs& r) const { r.rs = ssq ? rsqrtf(ld_ssq(ssq + row) * inv_n + EPS) : 1.f; }
    __device__ __forceinline__ void apply(int row, int col0, const float (&a)[8], const Regs& r) const {
        float v[8];
#pragma unroll
        for (int j = 0; j < 8; ++j) v[j] = a[j] * r.rs;
        *(u32x4*)(O + (size_t)row * ldo + col0) = pack8(v);
    }
};
struct EpiQKV {
    const u64* ssqc; bf16* Q; bf16* KV;
    struct Regs { float rs; };
    __device__ __forceinline__ void load(int row, int col0, Regs& r) const { const bool isq = col0 < NH * QK; r.rs = rsqrtf(ld_ssq(ssqc + (isq ? 0 : M) + row) * (1.f / QL) + EPS); }
    __device__ __forceinline__ void apply(int row, int col0, const float (&a)[8], const Regs& r) const {
        float v[8];
#pragma unroll
        for (int j = 0; j < 8; ++j) v[j] = a[j] * r.rs;
        if (col0 < NH * QK) *(u32x4*)(Q + (size_t)row * (NH * QK) + col0) = pack8(v);
        else *(u32x4*)(KV + (size_t)row * (NH * 256) + (col0 - NH * QK)) = pack8(v);
    }
};
struct EpiGateF32 {
    const bf16* proj; bf16* T;
    struct Regs { u32x4 g; };
    __device__ __forceinline__ void load(int row, int col0, Regs& r) const { r.g = *(const u32x4*)(proj + (size_t)row * DINP + PC_G + col0); }
    __device__ __forceinline__ void apply(int row, int col0, const float (&a)[8], const Regs& r) const {
        float g[8], v[8]; unpack8(r.g, g);
#pragma unroll
        for (int j = 0; j < 8; ++j) v[j] = a[j] * g[j];
        *(u32x4*)(T + (size_t)row * DM + col0) = pack8(v);
    }
};
struct EpiMerge {
    const bf16* proj; const bf16* T; bf16* O;
    struct Regs { u32x4 g; u32x4 t; };
    __device__ __forceinline__ void load(int row, int col0, Regs& r) const { r.g = *(const u32x4*)(proj + (size_t)row * DINP + PC_G + DM + col0); r.t = *(const u32x4*)(T + (size_t)row * DM + col0); }
    __device__ __forceinline__ void apply(int row, int col0, const float (&a)[8], const Regs& r) const {
        float g[8], t[8], v[8]; unpack8(r.g, g); unpack8(r.t, t);
#pragma unroll
        for (int j = 0; j < 8; ++j) v[j] = t[j] + a[j] * g[j];
        *(u32x4*)(O + (size_t)row * DM + col0) = pack8(v);
    }
};
struct EpiResid {
    const bf16* XBo; bf16* XBn; u64* ssq_next; float live = 1.f;
    struct Regs { u32x4 x; };
    __device__ __forceinline__ void load(int row, int col0, Regs& r) const { r.x = *(const u32x4*)(XBo + (size_t)row * DM + col0); }
    __device__ __forceinline__ void apply(int row, int col0, const float (&a)[8], const Regs& r) const {
        float x[8]; unpack8(r.x, x);
#pragma unroll
        for (int j = 0; j < 8; ++j) x[j] += a[j] * live;
        *(u32x4*)(XBn + (size_t)row * DM + col0) = pack8(x);
        if (ssq_next && live != 0.f) ssq_add(ssq_next, row, x);
    }
};
struct EpiUp {
    const u64* ssq; bf16* U;
    struct Regs { float rs; };
    __device__ __forceinline__ void load(int row, int col0, Regs& r) const { r.rs = rsqrtf(ld_ssq(ssq + row) * (1.f / DM) + EPS); }
    __device__ __forceinline__ void apply(int row, int col0, const float (&a)[8], const Regs& r) const {
        float v[8];
#pragma unroll
        for (int j = 0; j < 8; ++j) { const float t = fmaxf(a[j] * r.rs, 0.f); v[j] = t * t; }
        *(u32x4*)(U + (size_t)row * DFF + col0) = pack8(v);
    }
};
struct EpiPleGate {
    const u64* ssq; const bf16* PE; const bf16* XBo; bf16* XBn; float* OUT; u64* ssq_next; float live = 1.f;
    struct Regs { float rs; u32x4 x; u32x4 pe; };
    __device__ __forceinline__ void load(int row, int col0, Regs& r) const { r.rs = rsqrtf(ld_ssq(ssq + row) * (1.f / DM) + EPS);
        r.x = *(const u32x4*)(XBo + (size_t)row * DM + col0); r.pe = *(const u32x4*)(PE + (size_t)row * DM + col0); }
    __device__ __forceinline__ void apply(int row, int col0, const float (&a)[8], const Regs& r) const {
        float x[8], pe[8]; unpack8(r.x, x); unpack8(r.pe, pe);
#pragma unroll
        for (int j = 0; j < 8; ++j) x[j] += pe[j] * sigmoidf_(a[j] * r.rs) * live;
        if (OUT) st_f32x8(OUT + (size_t)row * DM + col0, x);
        else *(u32x4*)(XBn + (size_t)row * DM + col0) = pack8(x);
        if (ssq_next && live != 0.f) ssq_add(ssq_next, row, x);
    }
};

__device__ __forceinline__ void transpose_item(const float* W, int K, int Nsrc, int nsrc0, const float* gain, bf16* WT, int ndst0, int k0, LAS float* scr, int lane) {
    f32x4 v[16];
    const int rq = lane >> 4, c4 = (lane & 15) * 4;
    if (nsrc0 >= 0) {
#pragma unroll
        for (int i = 0; i < 16; ++i) v[i] = *(const f32x4*)(W + (size_t)(k0 + 4 * i + rq) * Nsrc + nsrc0 + c4);
        if (gain) {
#pragma unroll
            for (int i = 0; i < 16; ++i) v[i] = v[i] * gain[k0 + 4 * i + rq];
        }
    } else {
#pragma unroll
        for (int i = 0; i < 16; ++i) v[i] = (f32x4){0.f, 0.f, 0.f, 0.f};
    }
#pragma unroll
    for (int hh = 0; hh < 2; ++hh) {
#pragma unroll
        for (int i = 0; i < 8; ++i) { LAS float* d = scr + (4 * i + rq) * 65 + c4; const f32x4 t = v[8 * hh + i]; d[0] = t.x; d[1] = t.y; d[2] = t.z; d[3] = t.w; }
        LDS_WAIT(); asm volatile("" ::: "memory");
        const int c = lane & 3, nq = lane >> 2;
#pragma unroll
        for (int j = 0; j < 4; ++j) { const int n = 16 * j + nq; const LAS float* s = scr + (8 * c) * 65 + n;
            u32x4 o; o.x = pk2(s[0 * 65], s[1 * 65]); o.y = pk2(s[2 * 65], s[3 * 65]); o.z = pk2(s[4 * 65], s[5 * 65]); o.w = pk2(s[6 * 65], s[7 * 65]);
            *(u32x4*)(WT + (size_t)(ndst0 + n) * K + k0 + 32 * hh + 8 * c) = o; }
        LDS_WAIT(); asm volatile("" ::: "memory");
    }
}
__host__ __device__ __forceinline__ int inproj_src_col(int n) {
    if (n < PC_Z) return n;
    if (n < PC_G) return n + 64;
    if (n < PC_KR) return n + 128;
    if (n < PC_DT) return n - PC_KR + 1024;
    if (n < PC_PAD) return n - PC_DT + 11328;
    return -1;
}
constexpr int I_IN = (DM / 64) * (DINP / 64), I_UQ = (QL / 64) * (NH * QK / 64), I_UKV = (KVL / 64) * (NH * 256 / 64), I_OM = (DM / 64) * (DM / 64), I_OS = (DI / 64) * (DM / 64),
              I_OUT = I_OM, I_UP = (DM / 64) * (DFF / 64), I_DN = (DFF / 64) * (DM / 64), I_PG = I_OM, I_PL = (PLE / 64) * (DM / 64),
              I_LAYER = I_IN + I_UQ + I_UKV + I_OM + I_OS + I_OUT + I_UP + I_DN + I_PG + I_PL;
__device__ __forceinline__ void prologue_weights(const float* const (&inp)[26], unsigned char* ws, LAS unsigned char* lds, int G, int wg, int l_lo, int l_hi) {
    const int wave = otid() >> 6, lane = otid() & 63;
    LAS float* scr = (LAS float*)(lds + RING_OFF + wave * 16384);
    for (int it = l_lo * I_LAYER + wg * NWAVES + wave; it < l_hi * I_LAYER; it += G * NWAVES) {
        const int l = it / I_LAYER; int r = it % I_LAYER;
        unsigned char* wl = ws + WS_W + (size_t)l * WL_BYTES;
        if (r < I_IN) { const int nblk = DINP / 64, kb = r / nblk, nb = r % nblk;
            transpose_item(inp[4] + (size_t)l * DM * DIN, DM, DIN, inproj_src_col(64 * nb), inp[3] + l * DM, (bf16*)(wl + WL_IN), 64 * nb, 64 * kb, scr, lane); continue; } r -= I_IN;
        if (r < I_UQ) { const int nblk = NH * QK / 64, kb = r / nblk, nb = r % nblk;
            transpose_item(inp[6] + (size_t)l * QL * NH * QK, QL, NH * QK, 64 * nb, inp[5] + l * QL, (bf16*)(wl + WL_UQ), 64 * nb, 64 * kb, scr, lane); continue; } r -= I_UQ;
        if (r < I_UKV) { const int nblk = NH * 256 / 64, kb = r / nblk, nb = r % nblk;
            transpose_item(inp[8] + (size_t)l * KVL * NH * 256, KVL, NH * 256, 64 * nb, inp[7] + l * KVL, (bf16*)(wl + WL_UKV), 64 * nb, 64 * kb, scr, lane); continue; } r -= I_UKV;
        if (r < I_OM) { const int nblk = DM / 64, kb = r / nblk, nb = r % nblk;
            transpose_item(inp[11] + (size_t)l * DM * DM, DM, DM, 64 * nb, nullptr, (bf16*)(wl + WL_OM), 64 * nb, 64 * kb, scr, lane); continue; } r -= I_OM;
        if (r < I_OS) { const int nblk = DM / 64, kb = r / nblk, nb = r % nblk;
            transpose_item(inp[18] + (size_t)l * DI * DM, DI, DM, 64 * nb, inp[17] + l * DI, (bf16*)(wl + WL_OS), 64 * nb, 64 * kb, scr, lane); continue; } r -= I_OS;
        if (r < I_OUT) { const int nblk = DM / 64, kb = r / nblk, nb = r % nblk;
            transpose_item(inp[19] + (size_t)l * DM * DM, DM, DM, 64 * nb, nullptr, (bf16*)(wl + WL_OUT), 64 * nb, 64 * kb, scr, lane); continue; } r -= I_OUT;
        if (r < I_UP) { const int nblk = DFF / 64, kb = r / nblk, nb = r % nblk;
            transpose_item(inp[21] + (size_t)l * DM * DFF, DM, DFF, 64 * nb, inp[20] + l * DM, (bf16*)(wl + WL_UP), 64 * nb, 64 * kb, scr, lane); continue; } r -= I_UP;
        if (r < I_DN) { const int nblk = DM / 64, kb = r / nblk, nb = r % nblk;
            transpose_item(inp[22] + (size_t)l * DFF * DM, DFF, DM, 64 * nb, nullptr, (bf16*)(wl + WL_DN), 64 * nb, 64 * kb, scr, lane); continue; } r -= I_DN;
        if (r < I_PG) { const int nblk = DM / 64, kb = r / nblk, nb = r % nblk;
            transpose_item(inp[24] + (size_t)l * DM * DM, DM, DM, 64 * nb, inp[23] + l * DM, (bf16*)(wl + WL_PG), 64 * nb, 64 * kb, scr, lane); continue; } r -= I_PG;
        { const int nblk = DM / 64, kb = r / nblk, nb = r % nblk;
            transpose_item(inp[25] + (size_t)l * PLE * DM, PLE, DM, 64 * nb, nullptr, (bf16*)(wl + WL_PL), 64 * nb, 64 * kb, scr, lane); }
    }
}
__device__ __forceinline__ void prologue_rows(const float* const (&inp)[26], float* out, unsigned char* ws, int G, int wg) {
    const int wave = otid() >> 6, lane = otid() & 63, gw = wg * NWAVES + wave, NGW = G * NWAVES;
    const float* x = inp[0]; bf16* XB = (bf16*)(ws + WS_XB); u64* ssq0 = (u64*)((unsigned*)(ws + WS_CTL) + CW_SSQX);
    for (int m = gw; m < M; m += NGW) {
        float s = 0.f;
#pragma unroll
        for (int j = 0; j < 8; ++j) { const f32x4 v = *(const f32x4*)(x + (size_t)m * DM + j * 256 + lane * 4);
            s += v.x * v.x + v.y * v.y + v.z * v.z + v.w * v.w;
            u32x2 o; o.x = pk2(v.x, v.y); o.y = pk2(v.z, v.w); *(u32x2*)(XB + (size_t)m * DM + j * 256 + lane * 4) = o; }
        s = wave_sum(s); if (lane == 0) ssq0[m] = (u64)(s * SSQ_SCALE);
    }
    {
        u64* z0 = (u64*)((unsigned*)(ws + WS_CTL) + CW_SSQX) + M; const int nz = (DEPTH * 3 - 1) * M + DEPTH * 2 * M;
        for (int i = wg * NTHR + otid(); i < nz; i += G * NTHR) z0[i] = 0ull;
    }
    const float* p = inp[1]; bf16* PB = (bf16*)(ws + WS_PB);
    for (size_t i = (size_t)wg * NTHR + otid(); i < (size_t)DEPTH * M * PLE / 8; i += (size_t)G * NTHR) { float v[8]; ld_f32x8(p + i * 8, v); *(u32x4*)(PB + i * 8) = pack8(v); }
    const int* pos = (const int*)inp[2]; float* COS = (float*)(ws + WS_COS); float* SIN = (float*)(ws + WS_SIN);
    for (int i = wg * NTHR + otid(); i < M * 32; i += G * NTHR) { const int m = i >> 5, k = i & 31;
        const float invf = 1.0f / (float)pow(10000.0, (double)k / 32.0);
        const float ang = (float)pos[m] * invf;
        COS[i] = (float)cos((double)ang); SIN[i] = (float)sin((double)ang); }
}

__device__ __forceinline__ void phase_kfin(const bf16* KVRAW, const float* MISC, const float* kw, const float* COS, const float* SIN, bf16* KF, LAS unsigned char* lds, int G, int wg) {
    const int tid = otid(), wave = __builtin_amdgcn_readfirstlane(tid >> 6), lane = tid & 63, hh = lane >> 2, q4 = lane & 3;
    LAS float* krl = (LAS float*)(lds + RING_OFF) + wave * 64;
    float wn[32];
#pragma unroll
    for (int j = 0; j < 32; j += 4) { const f32x4 t = *(const f32x4*)(kw + q4 * 32 + j); wn[j] = t.x; wn[j + 1] = t.y; wn[j + 2] = t.z; wn[j + 3] = t.w; }
    const float wr = kw[128 + lane];
    for (int m = wg * NWAVES + wave; m < M; m += G * NWAVES) {
        u32x4 raw[4];
#pragma unroll
        for (int i = 0; i < 4; ++i) raw[i] = *(const u32x4*)(KVRAW + (size_t)m * 4096 + hh * 256 + q4 * 32 + i * 8);
        const float kr = MISC[(size_t)m * 128 + lane], cs = COS[m * 32 + (lane & 31)], sn = SIN[m * 32 + (lane & 31)];
        float f[32], ss = 0.f;
#pragma unroll
        for (int i = 0; i < 4; ++i) { float t[8]; unpack8(raw[i], t);
#pragma unroll
            for (int j = 0; j < 8; ++j) { f[i * 8 + j] = t[j]; ss += t[j] * t[j]; } }
        ss += swz_xor<1>(ss); ss += swz_xor<2>(ss);
        const float rs = rsqrtf((ss + wave_sum(kr * kr)) * (1.f / QK) + EPS);
        const float t2 = kr * wr, o2 = get_xor32(t2, lane);
        krl[lane] = lane < 32 ? (t2 * cs - o2 * sn) : (o2 * sn + t2 * cs);
        bf16* o = KF + (size_t)m * (NH * QK) + hh * QK;
#pragma unroll
        for (int i = 0; i < 4; ++i) { float t[8];
#pragma unroll
            for (int j = 0; j < 8; ++j) t[j] = f[i * 8 + j] * rs * wn[i * 8 + j];
            *(u32x4*)(o + q4 * 32 + i * 8) = pack8(t); }
        LDS_WAIT();
#pragma unroll
        for (int i = 0; i < 2; ++i) { const f32x4 a0 = *(LAS const f32x4*)(krl + q4 * 16 + i * 8), a1 = *(LAS const f32x4*)(krl + q4 * 16 + i * 8 + 4);
            const float t[8] = {a0.x * rs, a0.y * rs, a0.z * rs, a0.w * rs, a1.x * rs, a1.y * rs, a1.z * rs, a1.w * rs};
            *(u32x4*)(o + 128 + q4 * 16 + i * 8) = pack8(t); }
        LDS_WAIT();
    }
}
__device__ __forceinline__ void phase_ssdpre(const bf16* PROJ, const float* MISC, const float* cw, const float* cb, const float* dtb, bf16* XC, float* DTS, int G, int wg) {
    const int tid = otid();
    for (int gid = wg * NTHR + tid; gid < (CONVD / 8) * (M / TC); gid += G * NTHR) {
        const int c0 = (gid % (CONVD / 8)) * 8, seg = gid / (CONVD / 8), m0 = seg * TC;
        float w0[8], w1[8], w2[8], w3[8], bs[8], xa[8], xb[8], xc[8];
        ld_f32x8(cw + c0, w0); ld_f32x8(cw + CONVD + c0, w1); ld_f32x8(cw + 2 * CONVD + c0, w2); ld_f32x8(cw + 3 * CONVD + c0, w3); ld_f32x8(cb + c0, bs);
        const bf16* src = PROJ + (size_t)m0 * DINP + PC_XBC + c0; bf16* dst = XC + (size_t)m0 * CONVD + c0;
        if (m0 % SEQ != 0) { ld_bf16x8(src - 3 * (size_t)DINP, xa); ld_bf16x8(src - 2 * (size_t)DINP, xb); ld_bf16x8(src - (size_t)DINP, xc); }
        else {
#pragma unroll
            for (int e = 0; e < 8; ++e) { xa[e] = 0.f; xb[e] = 0.f; xc[e] = 0.f; } }
        for (int t0 = 0; t0 < TC; t0 += 8) {
            u32x4 r[8];
#pragma unroll
            for (int i = 0; i < 8; ++i) r[i] = *(const u32x4*)(src + (size_t)(t0 + i) * DINP);
#pragma unroll
            for (int i = 0; i < 8; ++i) { float xd[8], acc[8]; unpack8(r[i], xd);
#pragma unroll
                for (int e = 0; e < 8; ++e) { acc[e] = siluf_(bs[e] + xa[e] * w0[e] + xb[e] * w1[e] + xc[e] * w2[e] + xd[e] * w3[e]); xa[e] = xb[e]; xb[e] = xc[e]; xc[e] = xd[e]; }
                *(u32x4*)(dst + (size_t)(t0 + i) * CONVD) = pack8(acc); }
        }
    }
    for (int i = wg * NTHR + tid; i < M * SH; i += G * NTHR) { const int m = i >> 6, h = i & 63;
        const float x = MISC[(size_t)m * 128 + 64 + h] + dtb[h], e = __expf(-fabsf(x));
        const float lp = e < 0.01f ? e * (1.f - e * (0.5f - e * (1.f / 3.f))) : __logf(1.f + e); DTS[i] = fmaxf(x, 0.f) + lp; }
}
__device__ __forceinline__ void phase_ssdnorm(const float* YPRE, const bf16* PROJ, bf16* Y, int G, int wg) {
    const int wave = otid() >> 6, lane = otid() & 63;
    for (int it = wg * NWAVES + wave; it < M * SG; it += G * NWAVES) {
        const int m = it >> 3, g = it & 7, c0 = g * 512 + lane * 8;
        float y[8], z[8]; ld_f32x8(YPRE + (size_t)m * DI + c0, y); ld_bf16x8(PROJ + (size_t)m * DINP + PC_Z + c0, z);
        float s = 0.f;
#pragma unroll
        for (int e = 0; e < 8; ++e) { y[e] *= siluf_(z[e]); s += y[e] * y[e]; }
        const float rs = rsqrtf(wave_sum(s) * (1.f / 512.f) + EPS);
#pragma unroll
        for (int e = 0; e < 8; ++e) y[e] *= rs;
        *(u32x4*)(Y + (size_t)m * DI + c0) = pack8(y);
    }
}

namespace attn {
typedef float f32x16 __attribute__((ext_vector_type(16)));
typedef short s16x4 __attribute__((ext_vector_type(4)));
constexpr int KB_BYTES = 64 * QK * 2, VB_BYTES = 64 * VD * 2;
constexpr int L_K0 = 0, L_K1 = KB_BYTES, L_V0 = 2 * KB_BYTES, L_V1 = 2 * KB_BYTES + VB_BYTES, L_WS = 2 * KB_BYTES + 2 * VB_BYTES;
constexpr float QSCALE = 0.07216878364870322f * 1.4426950408889634f;
constexpr float THR2 = 8.f;
#define ASBAR() __builtin_amdgcn_sched_barrier(0)
#ifndef ATT_PRIO
#define ATT_PRIO 0
#endif
#if ATT_PRIO
#define AT_PRIO(x) __builtin_amdgcn_s_setprio(x)
#else
#define AT_PRIO(x)
#endif
__device__ __forceinline__ int crow(int r, int hi) { return (r & 3) + 8 * (r >> 2) + 4 * hi; }
__device__ __forceinline__ float sm_moff(float m_reg) { return (m_reg < -1e29f) ? 0.f : m_reg; }
__device__ __forceinline__ bool softSM(f32x16& p0, f32x16& p1, float& m_reg, float& alpha) {
    float pmax = p0[0];
#pragma unroll
    for (int r = 1; r < 16; ++r) pmax = fmaxf(pmax, p0[r]);
#pragma unroll
    for (int r = 0; r < 16; ++r) pmax = fmaxf(pmax, p1[r]);
    { auto rr = __builtin_amdgcn_permlane32_swap(__float_as_uint(pmax), __float_as_uint(pmax), false, false); pmax = fmaxf(__uint_as_float(rr[0]), __uint_as_float(rr[1])); }
    const float moff = sm_moff(m_reg);
    if (__builtin_expect(__all(pmax + moff - m_reg <= THR2), 1)) {
        alpha = 1.f;
#pragma unroll
        for (int r = 0; r < 16; ++r) p0[r] = __builtin_amdgcn_exp2f(p0[r]);
#pragma unroll
        for (int r = 0; r < 16; ++r) p1[r] = __builtin_amdgcn_exp2f(p1[r]);
        return false;
    } else {
        const float mn = fmaxf(m_reg, pmax + moff), sh = mn - moff;
        alpha = __builtin_amdgcn_exp2f(m_reg - mn); m_reg = mn;
#pragma unroll
        for (int r = 0; r < 16; ++r) p0[r] = __builtin_amdgcn_exp2f(p0[r] - sh);
#pragma unroll
        for (int r = 0; r < 16; ++r) p1[r] = __builtin_amdgcn_exp2f(p1[r] - sh);
        return true;
    }
}
__device__ __forceinline__ void finishSM(const f32x16& p0, const f32x16& p1, float alpha, float& l_reg, bf16x8& pa0, bf16x8& pa1, bf16x8& pa2, bf16x8& pa3) {
    typedef float f32x2_ __attribute__((ext_vector_type(2)));
    f32x2_ ps2 = (f32x2_){p0[0], p0[1]} + (f32x2_){p1[0], p1[1]};
#pragma unroll
    for (int r = 2; r < 16; r += 2) { ps2 += (f32x2_){p0[r], p0[r + 1]}; ps2 += (f32x2_){p1[r], p1[r + 1]}; }
    float ps = ps2.x + ps2.y;
    { auto rr = __builtin_amdgcn_permlane32_swap(__float_as_uint(ps), __float_as_uint(ps), false, false); ps = __uint_as_float(rr[0]) + __uint_as_float(rr[1]); }
    l_reg = l_reg * alpha + ps;
#define PK4(P, BASE, OUT) do { unsigned a0 = pk2(P[BASE + 0], P[BASE + 1]), a1 = pk2(P[BASE + 2], P[BASE + 3]);   \
    unsigned b0 = pk2(P[BASE + 4], P[BASE + 5]), b1 = pk2(P[BASE + 6], P[BASE + 7]);                              \
    auto r0 = __builtin_amdgcn_permlane32_swap(a0, b0, false, false); auto r1 = __builtin_amdgcn_permlane32_swap(a1, b1, false, false); \
    u32x4 w = {r0[0], r1[0], r0[1], r1[1]}; OUT = __builtin_bit_cast(bf16x8, w); } while (0)
    PK4(p0, 0, pa0); PK4(p0, 8, pa1); PK4(p1, 0, pa2); PK4(p1, 8, pa3);
#undef PK4
}
#define AT_KRD(dst, addr, OFF) asm volatile("ds_read_b128 %0, %1 offset:%2" : "=&v"(dst) : "v"(addr), "i"(OFF) : "memory")
#define AT_KWAIT(n) do { asm volatile("s_waitcnt lgkmcnt(" #n ")" ::: "memory"); ASBAR(); } while (0)
template <int KOFF> __device__ __forceinline__ void qkt(f32x16& p0, f32x16& p1, const int (&ka)[4], const bf16x8 (&qr)[12], float c0) {
    p0 = (f32x16){c0, c0, c0, c0, c0, c0, c0, c0, c0, c0, c0, c0, c0, c0, c0, c0}; p1 = p0;
    bf16x8 a0, b0, a1, b1, a2, b2, a3, b3;
    constexpr int RB = 32 * QK * 2;
    AT_KWAIT(0);
#define AT_KR(S, A, B) do { AT_KRD(A, ka[(S) & 3], KOFF + ((S) >> 2) * 128); AT_KRD(B, ka[(S) & 3], KOFF + ((S) >> 2) * 128 + RB); } while (0)
#define AT_STEP(S, A, B, AN, BN, W) do { if ((S) + 3 < 12) AT_KR((S) + 3, AN, BN); AT_KWAIT(W); \
        p0 = __builtin_amdgcn_mfma_f32_32x32x16_bf16(A, qr[(S)], p0, 0, 0, 0); p1 = __builtin_amdgcn_mfma_f32_32x32x16_bf16(B, qr[(S)], p1, 0, 0, 0); ASBAR(); } while (0)
    AT_KR(0, a0, b0); AT_KR(1, a1, b1); AT_KR(2, a2, b2);
    AT_PRIO(1);
    AT_STEP(0, a0, b0, a3, b3, 6); AT_STEP(1, a1, b1, a0, b0, 6); AT_STEP(2, a2, b2, a1, b1, 6); AT_STEP(3, a3, b3, a2, b2, 6);
    AT_STEP(4, a0, b0, a3, b3, 6); AT_STEP(5, a1, b1, a0, b0, 6); AT_STEP(6, a2, b2, a1, b1, 6); AT_STEP(7, a3, b3, a2, b2, 6);
    AT_STEP(8, a0, b0, a3, b3, 6); AT_STEP(9, a1, b1, a0, b0, 4); AT_STEP(10, a2, b2, a1, b1, 2); AT_STEP(11, a3, b3, a2, b2, 0);
#undef AT_STEP
#undef AT_KR
    AT_PRIO(0);
}
__device__ __forceinline__ void v_pos_src(int p, int& k, int& c) { const int s = p >> 5, kk = (s >> 2) * 8 + ((p & 31) >> 2); c = (s & 3) * 32 + (p & 3) * 8; k = (kk & ~0xC) | ((kk & 4) << 1) | ((kk & 8) >> 1); }
__device__ __forceinline__ int v_rd_base(int lane) { return ((lane & 3) << 3) | (((lane >> 2) & 3) << 6) | (((lane >> 4) & 1) << 5) | (((lane >> 5) & 1) << 8); }
constexpr int v_rd_off(int d0, int ks, int half) { return d0 * 512 + ks * 4096 + half * 2048; }
template <int OFF> __device__ __forceinline__ s16x4 tr_read(int vb) { s16x4 r; asm volatile("ds_read_b64_tr_b16 %0, %1 offset:%2" : "=&v"(r) : "v"(vb), "i"(OFF) : "memory"); return r; }
struct VFrag { s16x4 l0, h0, l1, h1, l2, h2, l3, h3; };
template <int D0, int VO> __device__ __forceinline__ void v_read(VFrag& f, int vb) {
    f.l0 = tr_read<VO + v_rd_off(D0, 0, 0)>(vb); f.h0 = tr_read<VO + v_rd_off(D0, 0, 1)>(vb); f.l1 = tr_read<VO + v_rd_off(D0, 1, 0)>(vb); f.h1 = tr_read<VO + v_rd_off(D0, 1, 1)>(vb);
    f.l2 = tr_read<VO + v_rd_off(D0, 2, 0)>(vb); f.h2 = tr_read<VO + v_rd_off(D0, 2, 1)>(vb); f.l3 = tr_read<VO + v_rd_off(D0, 3, 0)>(vb); f.h3 = tr_read<VO + v_rd_off(D0, 3, 1)>(vb);
}
#define PKV(L, H) (bf16x8){L[0], L[1], L[2], L[3], H[0], H[1], H[2], H[3]}
__device__ __forceinline__ void v_mma(f32x16& od, const VFrag& f, bf16x8 pa0, bf16x8 pa1, bf16x8 pa2, bf16x8 pa3) {
    od = __builtin_amdgcn_mfma_f32_32x32x16_bf16(pa0, PKV(f.l0, f.h0), od, 0, 0, 0);
    od = __builtin_amdgcn_mfma_f32_32x32x16_bf16(pa1, PKV(f.l1, f.h1), od, 0, 0, 0);
    od = __builtin_amdgcn_mfma_f32_32x32x16_bf16(pa2, PKV(f.l2, f.h2), od, 0, 0, 0);
    od = __builtin_amdgcn_mfma_f32_32x32x16_bf16(pa3, PKV(f.l3, f.h3), od, 0, 0, 0);
}
#undef PKV
template <int VO> __device__ __forceinline__ void pv_main(f32x16 (&o)[4], int vb, VFrag& fa, bf16x8 pa0, bf16x8 pa1, bf16x8 pa2, bf16x8 pa3) {
    VFrag fb, fc;
    AT_PRIO(1);
    v_read<1, VO>(fb, vb); AT_KWAIT(8);
    v_read<2, VO>(fc, vb); ASBAR(); v_mma(o[0], fa, pa0, pa1, pa2, pa3); ASBAR(); AT_KWAIT(8);
    v_read<3, VO>(fa, vb); ASBAR(); v_mma(o[1], fb, pa0, pa1, pa2, pa3); ASBAR(); AT_KWAIT(8);
    v_mma(o[2], fc, pa0, pa1, pa2, pa3); ASBAR(); AT_KWAIT(0);
    v_mma(o[3], fa, pa0, pa1, pa2, pa3);
    AT_PRIO(0);
}

__device__ __forceinline__ void attn_unit(int b, int h, int qb, const bf16* QRAW, const bf16* KF, const bf16* KVRAW, const float* qw, const float* COS, const float* SIN, bf16* AO, LAS unsigned char* lds) {
    const int tid = otid(), wid = __builtin_amdgcn_readfirstlane(tid >> 6), lane = tid & 63, r32 = lane & 31, hi = lane >> 5;
    LAS float* wsf = (LAS float*)(lds + L_WS) + wid * 64; LAS float* li_l = wsf; LAS float* al_l = wsf + 32;
    const int m = b * SEQ + qb * 256 + wid * 32 + r32;
    bf16x8 qr[12];
    {
        const bf16* qp = QRAW + (size_t)m * (NH * QK) + h * QK + hi * 8;
        u32x4 raw[12]; float ss = 0.f;
#pragma unroll
        for (int d0 = 0; d0 < 12; ++d0) { raw[d0] = *(const u32x4*)(qp + d0 * 16); float f[8]; unpack8(raw[d0], f);
#pragma unroll
            for (int j = 0; j < 8; ++j) ss += f[j] * f[j]; }
        ss = sum_xor32(ss);
        const float rs = rsqrtf(ss * (1.f / QK) + EPS) * QSCALE;
#pragma unroll
        for (int d0 = 0; d0 < 8; ++d0) { float f[8], w[8]; unpack8(raw[d0], f); ld_f32x8(qw + d0 * 16 + hi * 8, w);
#pragma unroll
            for (int j = 0; j < 8; ++j) f[j] = f[j] * rs * w[j];
            qr[d0] = __builtin_bit_cast(bf16x8, pack8(f)); }
#pragma unroll
        for (int t = 0; t < 2; ++t) { float x1[8], x2[8], w1[8], w2[8], c[8], s[8], o1[8], o2[8];
            unpack8(raw[8 + t], x1); unpack8(raw[10 + t], x2); ld_f32x8(qw + 128 + t * 16 + hi * 8, w1); ld_f32x8(qw + 160 + t * 16 + hi * 8, w2);
            ld_f32x8(COS + (size_t)m * 32 + t * 16 + hi * 8, c); ld_f32x8(SIN + (size_t)m * 32 + t * 16 + hi * 8, s);
#pragma unroll
            for (int j = 0; j < 8; ++j) { const float a = x1[j] * rs * w1[j], bq = x2[j] * rs * w2[j]; o1[j] = a * c[j] - bq * s[j]; o2[j] = a * s[j] + bq * c[j]; }
            qr[8 + t] = __builtin_bit_cast(bf16x8, pack8(o1)); qr[10 + t] = __builtin_bit_cast(bf16x8, pack8(o2)); }
    }
    const bf16* kbase = KF + (size_t)(b * SEQ) * (NH * QK) + h * QK;
    const bf16* vbase = KVRAW + (size_t)(b * SEQ) * 4096 + h * 256 + 128;
    unsigned koff[3], voff[2];
#pragma unroll
    for (int i = 0; i < 3; ++i) { const int p = i * 512 + tid, row = p / 24, cc = (p % 24) ^ (row & 7); koff[i] = (unsigned)(row * (NH * QK) + cc * 8) * 2u; }
#pragma unroll
    for (int i = 0; i < 2; ++i) { int k, c; v_pos_src(i * 512 + tid, k, c); voff[i] = (unsigned)(k * 4096 + c) * 2u; }
    const unsigned ldsw = (unsigned)wid * 1024u;
#define ATT_ISSUE_K(kb, key0) do { const char* _kg = (const char*)(kbase + (size_t)(key0) * (NH * QK)); \
        _Pragma("unroll") for (int _i = 0; _i < 3; ++_i) __builtin_amdgcn_global_load_lds((const unsigned*)(_kg + koff[_i]), (LAS unsigned*)(lds + (kb) + ldsw + _i * 8192), 16, 0, 0); } while (0)
#define ATT_ISSUE_V(vb_, key0) do { const char* _vg = (const char*)(vbase + (size_t)(key0) * 4096); \
        _Pragma("unroll") for (int _i = 0; _i < 2; ++_i) __builtin_amdgcn_global_load_lds((const unsigned*)(_vg + voff[_i]), (LAS unsigned*)(lds + (vb_) + ldsw + _i * 8192), 16, 0, 0); } while (0)
    float m_reg = -1e30f, l_reg = 0.f;
    f32x16 o[4];
#pragma unroll
    for (int d = 0; d < 4; ++d) o[d] = (f32x16){0.f, 0.f, 0.f, 0.f, 0.f, 0.f, 0.f, 0.f, 0.f, 0.f, 0.f, 0.f, 0.f, 0.f, 0.f, 0.f};
    const int nt = 4 * qb + 4, myc = 4 * qb + (wid >> 1);
    const int vrd = (int)(uintptr_t)(lds + L_V0) + v_rd_base(lane);
    int kad[4];
#pragma unroll
    for (int i = 0; i < 4; ++i) kad[i] = (int)(uintptr_t)lds + r32 * (QK * 2) + ((i * 32 + hi * 16) ^ ((r32 & 7) << 4));
    f32x16 p0, p1;
#define VMW(n) asm volatile("s_waitcnt vmcnt(" #n ")" ::: "memory")
#define HBAR() do { asm volatile("s_waitcnt lgkmcnt(0)" ::: "memory"); ASBAR(); __builtin_amdgcn_s_barrier(); ASBAR(); } while (0)
#define ATT_TILE(kb, vb_, j) do { if ((j) <= myc) { float alpha; bf16x8 pa0, pa1, pa2, pa3; VFrag fa; \
        qkt<(kb)>(p0, p1, kad, qr, -sm_moff(m_reg)); ASBAR(); \
        v_read<0, (vb_) - L_V0>(fa, vrd); ASBAR(); \
        const bool moved_ = softSM(p0, p1, m_reg, alpha); \
        if (moved_) { if (hi == 0) al_l[r32] = alpha; asm volatile("s_waitcnt lgkmcnt(0)" ::: "memory"); \
            _Pragma("unroll") for (int d = 0; d < 4; ++d) _Pragma("unroll") for (int r = 0; r < 16; ++r) o[d][r] *= al_l[crow(r, hi)]; } \
        finishSM(p0, p1, alpha, l_reg, pa0, pa1, pa2, pa3); ASBAR(); \
        pv_main<(vb_) - L_V0>(o, vrd, fa, pa0, pa1, pa2, pa3); } } while (0)
    ATT_ISSUE_K(L_K0, 0); ATT_ISSUE_V(L_V0, 0);
    VMW(0); HBAR();
    for (int j = 0; j < nt; j += 2) {
        ATT_ISSUE_K(L_K1, (j + 1) * 64); ATT_ISSUE_V(L_V1, (j + 1) * 64); ASBAR();
        ATT_TILE(L_K0, L_V0, j); ASBAR(); VMW(0); HBAR();
        if (j + 2 < nt) { ATT_ISSUE_K(L_K0, (j + 2) * 64); ATT_ISSUE_V(L_V0, (j + 2) * 64); } ASBAR();
        ATT_TILE(L_K1, L_V1, j + 1); ASBAR(); VMW(0); HBAR();
    }
#undef ATT_TILE
#undef ATT_ISSUE_K
#undef ATT_ISSUE_V
    if (hi == 0) li_l[r32] = l_reg;
    asm volatile("s_waitcnt lgkmcnt(0)" ::: "memory");
    float rli[16];
#pragma unroll
    for (int r = 0; r < 16; ++r) rli[r] = __builtin_amdgcn_rcpf(li_l[crow(r, hi)]);
    bf16* ob = AO + (size_t)(b * SEQ + qb * 256 + wid * 32) * DM + h * VD;
#pragma unroll
    for (int r = 0; r < 16; ++r) { const int orow = crow(r, hi);
#pragma unroll
        for (int d0 = 0; d0 < 4; ++d0) ob[(size_t)orow * DM + d0 * 32 + r32] = (bf16)f2bf(o[d0][r] * rli[r]); }
    asm volatile("s_waitcnt lgkmcnt(0)" ::: "memory");
}
template <int ABL> __device__ __forceinline__ void phase(const bf16* QRAW, const bf16* KF, const bf16* KVRAW, const float* qw, const float* COS, const float* SIN, bf16* AO, LAS unsigned char* lds, int G, int wg) {
    for (int pr = wg; pr < NB * NH * 8; pr += G) {
        const int x = pr & 7, slot = pr >> 3, bh = x * 4 + (slot >> 3), pi = slot & 7, b = bh / NH, h = bh % NH;
#pragma unroll 1
        for (int u = 0; u < 2; ++u) attn_unit(b, h, u ? pi : 15 - pi, QRAW, KF, KVRAW, qw, COS, SIN, AO, lds);
    }
}
__device__ __forceinline__ void phase_dyn(const bf16* QRAW, const bf16* KF, const bf16* KVRAW, const float* qw, const float* COS, const float* SIN, bf16* AO, LAS unsigned char* lds, int wg, unsigned* head) {
    LAS volatile int* qs = (LAS volatile int*)(lds + QSLOT_OFF);
    for (;;) {
        __syncthreads();
        if (otid() == 0) qs[0] = (int)__hip_atomic_fetch_add(head, 1u, __ATOMIC_RELAXED, __HIP_MEMORY_SCOPE_AGENT);
        __syncthreads();
        const int e = qs[0];
        if (e >= 64) break;
        const int bh = (wg & 7) * 4 + (e & 3), qb = 15 - (e >> 2);
        attn_unit(bh / NH, bh % NH, qb, QRAW, KF, KVRAW, qw, COS, SIN, AO, lds);
    }
}
}

namespace ssd {
using attn::f32x16; using attn::s16x4; using attn::crow; using attn::v_rd_base; using attn::tr_read;
constexpr int L_BT = 0, L_XT = 16384, L_WSH = 16384 + 65536, L_SSQ = L_WSH + 8192, L_END = L_SSQ + 2048;
static_assert(L_END <= RING_BYTES, "ssd lds");
template <int NCS> __device__ __forceinline__ void vimg_src(int p, int& k, int& c) { const int s = p >> 5, kk = (s / NCS) * 8 + ((p & 31) >> 2); c = (s % NCS) * 32 + (p & 3) * 8; k = (kk & ~0xC) | ((kk & 4) << 1) | ((kk & 8) >> 1); }
template <int NCS> constexpr int vimg_off(int d0, int ks, int half) { return ((2 * ks + half) * NCS + d0) * 512; }
#define SSD_PKV(L, H) (bf16x8){L[0], L[1], L[2], L[3], H[0], H[1], H[2], H[3]}
#define SSD_LWAIT() do { asm volatile("s_waitcnt lgkmcnt(0)" ::: "memory"); __builtin_amdgcn_sched_barrier(0); } while (0)
constexpr f32x16 Z16 = {0.f, 0.f, 0.f, 0.f, 0.f, 0.f, 0.f, 0.f, 0.f, 0.f, 0.f, 0.f, 0.f, 0.f, 0.f, 0.f};
__device__ __forceinline__ float wave_scan64(float v, int lane) {
#pragma unroll
    for (int o = 1; o < 64; o <<= 1) { const float n = lane_up(v, o, lane); if (lane >= o) v += n; }
    return v;
}
__device__ __forceinline__ void load_x(const bf16* XC, int m0, int h, int lane, u32x4 (&v)[8]) {
#pragma unroll
    for (int i = 0; i < 8; ++i) { int k, c; vimg_src<2>(i * 64 + lane, k, c); v[i] = *(const u32x4*)(XC + (size_t)(m0 + k) * CONVD + h * HD + c); }
}
__device__ __forceinline__ void store_x(LAS unsigned char* xt, int lane, const u32x4 (&v)[8]) {
#pragma unroll
    for (int i = 0; i < 8; ++i) *(LAS u32x4*)(xt + (i * 64 + lane) * 16) = v[i];
}

__device__ __forceinline__ void phase_states(const bf16* XC, const float* DTS, const float* a_log, bf16* ST16, float* CDEC, LAS unsigned char* lds, int G, int wg) {
    for (int it = wg; it < NB * NCH * SG; it += G) {
        const int tid = otid(), wid = __builtin_amdgcn_readfirstlane(tid >> 6), lane = tid & 63, r32 = lane & 31, hi = lane >> 5;
        LAS unsigned char* xt = lds + L_XT + wid * 8192; LAS float* wsh = (LAS float*)(lds + L_WSH + wid * 1024);
        const int vrd = v_rd_base(lane);
        const int g = it % SG, bc = it / SG, m0 = bc * TC, h = g * HPG + wid;
        __syncthreads();
        {
            u32x4 v[2], xv[8];
#pragma unroll
            for (int i = 0; i < 2; ++i) { int k, c; vimg_src<4>(i * 512 + tid, k, c); v[i] = *(const u32x4*)(XC + (size_t)(m0 + k) * CONVD + DI + g * SN + c); }
            load_x(XC, m0, h, lane, xv);
            const float A = -__expf(a_log[h]), dt = DTS[(size_t)(m0 + lane) * SH + h];
#pragma unroll
            for (int i = 0; i < 2; ++i) *(LAS u32x4*)(lds + L_BT + (i * 512 + tid) * 16) = v[i];
            store_x(xt, lane, xv);
            const float ac = wave_scan64(dt * A, lane), last = __builtin_bit_cast(float, __builtin_amdgcn_readlane(__builtin_bit_cast(int, ac), 63));
            wsh[lane] = __expf(last - ac) * dt; if (lane == 63) CDEC[bc * SH + h] = __expf(last);
        }
        __syncthreads();
        f32x16 acc[2][4];
#pragma unroll
        for (int a = 0; a < 2; ++a)
#pragma unroll
            for (int b = 0; b < 4; ++b) acc[a][b] = Z16;
        const int xb = (int)(uintptr_t)xt + vrd, bb = (int)(uintptr_t)(lds + L_BT) + vrd;
#define SSD_KS(KSI) do { \
            const s16x4 xl0 = tr_read<vimg_off<2>(0, KSI, 0)>(xb), xh0 = tr_read<vimg_off<2>(0, KSI, 1)>(xb), xl1 = tr_read<vimg_off<2>(1, KSI, 0)>(xb), xh1 = tr_read<vimg_off<2>(1, KSI, 1)>(xb); \
            const s16x4 bl0 = tr_read<vimg_off<4>(0, KSI, 0)>(bb), bh0 = tr_read<vimg_off<4>(0, KSI, 1)>(bb), bl1 = tr_read<vimg_off<4>(1, KSI, 0)>(bb), bh1 = tr_read<vimg_off<4>(1, KSI, 1)>(bb); \
            const s16x4 bl2 = tr_read<vimg_off<4>(2, KSI, 0)>(bb), bh2 = tr_read<vimg_off<4>(2, KSI, 1)>(bb), bl3 = tr_read<vimg_off<4>(3, KSI, 0)>(bb), bh3 = tr_read<vimg_off<4>(3, KSI, 1)>(bb); \
            const f32x4 w0 = *(LAS const f32x4*)(wsh + 16 * KSI + 8 * hi), w1 = *(LAS const f32x4*)(wsh + 16 * KSI + 8 * hi + 4); \
            SSD_LWAIT(); \
            bf16x8 xa[2]; { const bf16x8 r0 = SSD_PKV(xl0, xh0), r1 = SSD_PKV(xl1, xh1); float f[8]; \
                unpack8(__builtin_bit_cast(u32x4, r0), f); f[0] *= w0.x; f[1] *= w0.y; f[2] *= w0.z; f[3] *= w0.w; f[4] *= w1.x; f[5] *= w1.y; f[6] *= w1.z; f[7] *= w1.w; xa[0] = __builtin_bit_cast(bf16x8, pack8(f)); \
                unpack8(__builtin_bit_cast(u32x4, r1), f); f[0] *= w0.x; f[1] *= w0.y; f[2] *= w0.z; f[3] *= w0.w; f[4] *= w1.x; f[5] *= w1.y; f[6] *= w1.z; f[7] *= w1.w; xa[1] = __builtin_bit_cast(bf16x8, pack8(f)); } \
            const bf16x8 bf0 = SSD_PKV(bl0, bh0), bf1 = SSD_PKV(bl1, bh1), bf2 = SSD_PKV(bl2, bh2), bf3 = SSD_PKV(bl3, bh3); \
            _Pragma("unroll") for (int a = 0; a < 2; ++a) { \
                acc[a][0] = __builtin_amdgcn_mfma_f32_32x32x16_bf16(xa[a], bf0, acc[a][0], 0, 0, 0); acc[a][1] = __builtin_amdgcn_mfma_f32_32x32x16_bf16(xa[a], bf1, acc[a][1], 0, 0, 0); \
                acc[a][2] = __builtin_amdgcn_mfma_f32_32x32x16_bf16(xa[a], bf2, acc[a][2], 0, 0, 0); acc[a][3] = __builtin_amdgcn_mfma_f32_32x32x16_bf16(xa[a], bf3, acc[a][3], 0, 0, 0); } } while (0)
        SSD_KS(0); SSD_KS(1); SSD_KS(2); SSD_KS(3);
#undef SSD_KS
        bf16* o = ST16 + ((size_t)bc * SH + h) * (HD * SN);
#pragma unroll
        for (int a = 0; a < 2; ++a)
#pragma unroll
            for (int r = 0; r < 16; ++r) { const int p = 32 * a + crow(r, hi);
#pragma unroll
                for (int b = 0; b < 4; ++b) o[p * SN + 32 * b + r32] = (bf16)f2bf(acc[a][b][r]); }
    }
}

__device__ __forceinline__ void phase_scan(bf16* ST16, const float* CDEC, int G, int wg) {
    constexpr int PER_B8 = SH * HD * SN / 8;
    for (int e = wg * NTHR + otid(); e < NB * PER_B8; e += G * NTHR) {
        const int b = e / PER_B8, r8 = e % PER_B8, h = r8 / (HD * SN / 8);
        float st[8];
#pragma unroll
        for (int j = 0; j < 8; ++j) st[j] = 0.f;
        bf16* base = ST16 + (size_t)b * NCH * (SH * HD * SN) + (size_t)r8 * 8;
        for (int c0 = 0; c0 < NCH; c0 += 8) {
            u32x4 raw[8]; float cd[8];
#pragma unroll
            for (int i = 0; i < 8; ++i) { raw[i] = *(const u32x4*)(base + (size_t)(c0 + i) * (SH * HD * SN)); cd[i] = CDEC[(b * NCH + c0 + i) * SH + h]; }
#pragma unroll
            for (int i = 0; i < 8; ++i) { float v[8]; unpack8(raw[i], v); *(u32x4*)(base + (size_t)(c0 + i) * (SH * HD * SN)) = pack8(st);
#pragma unroll
                for (int j = 0; j < 8; ++j) st[j] = st[j] * cd[i] + v[j]; }
        }
    }
}

constexpr int O_CT = 0, O_BT = 17408, O_XT = 34816, O_WSH = O_XT + 65536, O_SSQ = O_WSH + 8192, O_END = O_SSQ + 2048, O_ROW = 272;
static_assert(O_END <= RING_BYTES, "ssd out lds");
__device__ __forceinline__ void phase_out(const bf16* XC, const float* DTS, const float* a_log, const float* dskip, const bf16* ST16, const bf16* PROJ, bf16* Y, LAS unsigned char* lds, int G, int wg) {
    for (int it = wg; it < NB * NCH * SG; it += G) {
        const int tid = otid(), wid = __builtin_amdgcn_readfirstlane(tid >> 6), lane = tid & 63, r32 = lane & 31, hi = lane >> 5;
        LAS unsigned char* xt = lds + O_XT + wid * 8192; LAS float* acs = (LAS float*)(lds + O_WSH + wid * 1024); LAS float* dts = acs + 64; LAS float* rsl = acs + 128;
        LAS float* ssqx = (LAS float*)(lds + O_SSQ);
        const int vrd = v_rd_base(lane);
        LAS const unsigned char* cl = lds + O_CT + r32 * O_ROW + hi * 16;
        LAS const unsigned char* bl = lds + O_BT + r32 * O_ROW + hi * 16;
        const int g = it % SG, bc = it / SG, m0 = bc * TC, h = g * HPG + wid;
        __syncthreads();
        u32x4 cv[2], bv[2], xv[8];
#pragma unroll
        for (int i = 0; i < 2; ++i) { const int q = i * 512 + tid, row = q >> 4, c16 = q & 15;
            cv[i] = *(const u32x4*)(XC + (size_t)(m0 + row) * CONVD + DI + SG * SN + g * SN + c16 * 8); bv[i] = *(const u32x4*)(XC + (size_t)(m0 + row) * CONVD + DI + g * SN + c16 * 8); }
        const bf16* pg = ST16 + (((size_t)bc * SH + h) * HD + r32) * SN + 8 * hi;
        bf16x8 pf[2][8];
#pragma unroll
        for (int kn = 0; kn < 8; ++kn) { pf[0][kn] = *(const bf16x8*)(pg + kn * 16); pf[1][kn] = *(const bf16x8*)(pg + 32 * SN + kn * 16); }
        load_x(XC, m0, h, lane, xv);
        const float A_ = -__expf(a_log[h]), dt_ = DTS[(size_t)(m0 + lane) * SH + h];
        __builtin_amdgcn_sched_barrier(0);
#pragma unroll
        for (int i = 0; i < 2; ++i) { const int q = i * 512 + tid, row = q >> 4, c16 = q & 15;
            *(LAS u32x4*)(lds + O_CT + row * O_ROW + c16 * 16) = cv[i]; *(LAS u32x4*)(lds + O_BT + row * O_ROW + c16 * 16) = bv[i]; }
        store_x(xt, lane, xv);
        { acs[lane] = wave_scan64(dt_ * A_, lane); dts[lane] = dt_; }
        __builtin_amdgcn_sched_barrier(0);
        const float dk = dskip[h];
        __syncthreads();
        f32x16 acc[2][2];
#pragma unroll
        for (int a = 0; a < 2; ++a)
#pragma unroll
            for (int b = 0; b < 2; ++b) acc[a][b] = Z16;
#pragma unroll
        for (int kn = 0; kn < 8; ++kn) {
            const bf16x8 c0 = *(LAS const bf16x8*)(cl + kn * 32), c1 = *(LAS const bf16x8*)(cl + 32 * O_ROW + kn * 32);
            acc[0][0] = __builtin_amdgcn_mfma_f32_32x32x16_bf16(c0, pf[0][kn], acc[0][0], 0, 0, 0); acc[0][1] = __builtin_amdgcn_mfma_f32_32x32x16_bf16(c0, pf[1][kn], acc[0][1], 0, 0, 0);
            acc[1][0] = __builtin_amdgcn_mfma_f32_32x32x16_bf16(c1, pf[0][kn], acc[1][0], 0, 0, 0); acc[1][1] = __builtin_amdgcn_mfma_f32_32x32x16_bf16(c1, pf[1][kn], acc[1][1], 0, 0, 0);
        }
        u32x4 zv[8];
#pragma unroll
        for (int i = 0; i < 8; ++i) zv[i] = *(const u32x4*)(PROJ + (size_t)(m0 + i * 8 + (lane >> 3)) * DINP + PC_Z + h * HD + (lane & 7) * 8);
        LDS_WAIT();
#pragma unroll
        for (int a = 0; a < 2; ++a)
#pragma unroll
            for (int r = 0; r < 16; ++r) { const float ea = __expf(acs[32 * a + crow(r, hi)]); acc[a][0][r] *= ea; acc[a][1][r] *= ea; }
        const int xb = (int)(uintptr_t)xt + vrd;
#define SSD_TB(TB) do { f32x16 p0 = Z16, p1 = Z16; \
            _Pragma("unroll") for (int kn = 0; kn < 8; ++kn) { const bf16x8 cf = *(LAS const bf16x8*)(cl + (32 * TB) * O_ROW + kn * 32), b0 = *(LAS const bf16x8*)(bl + kn * 32); \
                p0 = __builtin_amdgcn_mfma_f32_32x32x16_bf16(b0, cf, p0, 0, 0, 0); \
                if (TB == 1) { const bf16x8 b1 = *(LAS const bf16x8*)(bl + 32 * O_ROW + kn * 32); p1 = __builtin_amdgcn_mfma_f32_32x32x16_bf16(b1, cf, p1, 0, 0, 0); } } \
            const int t = 32 * TB + r32; const float at = acs[t]; \
            _Pragma("unroll") for (int r = 0; r < 16; ++r) { const int s0 = crow(r, hi); \
                { const float w = (s0 <= t) ? __expf(fminf(at - acs[s0], 0.f)) * dts[s0] : 0.f; p0[r] = p0[r] * w + ((s0 == t) ? dk : 0.f); } \
                if (TB == 1) { const int s1 = 32 + s0; const float w = (s1 <= t) ? __expf(fminf(at - acs[s1], 0.f)) * dts[s1] : 0.f; p1[r] = p1[r] * w + ((s1 == t) ? dk : 0.f); } } \
            bf16x8 pa0, pa1, pa2, pa3; \
            { PK4_(p0, 0, pa0); PK4_(p0, 8, pa1); if (TB == 1) { PK4_(p1, 0, pa2); PK4_(p1, 8, pa3); } } \
            _Pragma("unroll") for (int pb = 0; pb < 2; ++pb) { \
                const s16x4 l0 = pb ? tr_read<vimg_off<2>(1, 0, 0)>(xb) : tr_read<vimg_off<2>(0, 0, 0)>(xb), h0 = pb ? tr_read<vimg_off<2>(1, 0, 1)>(xb) : tr_read<vimg_off<2>(0, 0, 1)>(xb); \
                const s16x4 l1 = pb ? tr_read<vimg_off<2>(1, 1, 0)>(xb) : tr_read<vimg_off<2>(0, 1, 0)>(xb), h1 = pb ? tr_read<vimg_off<2>(1, 1, 1)>(xb) : tr_read<vimg_off<2>(0, 1, 1)>(xb); \
                s16x4 l2 = l0, h2 = h0, l3 = l1, h3 = h1; \
                if (TB == 1) { l2 = pb ? tr_read<vimg_off<2>(1, 2, 0)>(xb) : tr_read<vimg_off<2>(0, 2, 0)>(xb); h2 = pb ? tr_read<vimg_off<2>(1, 2, 1)>(xb) : tr_read<vimg_off<2>(0, 2, 1)>(xb); \
                               l3 = pb ? tr_read<vimg_off<2>(1, 3, 0)>(xb) : tr_read<vimg_off<2>(0, 3, 0)>(xb); h3 = pb ? tr_read<vimg_off<2>(1, 3, 1)>(xb) : tr_read<vimg_off<2>(0, 3, 1)>(xb); } \
                SSD_LWAIT(); \
                acc[TB][pb] = __builtin_amdgcn_mfma_f32_32x32x16_bf16(pa0, SSD_PKV(l0, h0), acc[TB][pb], 0, 0, 0); acc[TB][pb] = __builtin_amdgcn_mfma_f32_32x32x16_bf16(pa1, SSD_PKV(l1, h1), acc[TB][pb], 0, 0, 0); \
                if (TB == 1) { acc[TB][pb] = __builtin_amdgcn_mfma_f32_32x32x16_bf16(pa2, SSD_PKV(l2, h2), acc[TB][pb], 0, 0, 0); acc[TB][pb] = __builtin_amdgcn_mfma_f32_32x32x16_bf16(pa3, SSD_PKV(l3, h3), acc[TB][pb], 0, 0, 0); } } } while (0)
#define PK4_(P, BASE, OUT) do { unsigned a0_ = pk2(P[BASE + 0], P[BASE + 1]), a1_ = pk2(P[BASE + 2], P[BASE + 3]); unsigned b0_ = pk2(P[BASE + 4], P[BASE + 5]), b1_ = pk2(P[BASE + 6], P[BASE + 7]); \
    auto r0_ = __builtin_amdgcn_permlane32_swap(a0_, b0_, false, false); auto r1_ = __builtin_amdgcn_permlane32_swap(a1_, b1_, false, false); \
    u32x4 w_ = {r0_[0], r1_[0], r0_[1], r1_[1]}; OUT = __builtin_bit_cast(bf16x8, w_); } while (0)
        SSD_TB(0); SSD_TB(1);
#undef SSD_TB
#undef PK4_
        LAS unsigned short* zt = (LAS unsigned short*)xt;
        {
            LDS_WAIT();
#pragma unroll
            for (int i = 0; i < 8; ++i) *(LAS u32x4*)(xt + (i * 64 + lane) * 16) = zv[i];
        }
        LDS_WAIT();
#pragma unroll
        for (int a = 0; a < 2; ++a)
#pragma unroll
            for (int r = 0; r < 16; ++r) { const int t = 32 * a + crow(r, hi);
                acc[a][0][r] *= siluf_(bf2f(zt[t * 64 + r32])); acc[a][1][r] *= siluf_(bf2f(zt[t * 64 + 32 + r32])); }
        LDS_WAIT();
        LAS float* red = (LAS float*)xt;
#pragma unroll
        for (int a = 0; a < 2; ++a)
#pragma unroll
            for (int r = 0; r < 16; ++r) red[(32 * a + crow(r, hi)) * 32 + r32] = acc[a][0][r] * acc[a][0][r] + acc[a][1][r] * acc[a][1][r];
        LDS_WAIT();
        { float sm = 0.f;
#pragma unroll
          for (int q = 0; q < 8; ++q) { const f32x4 v = *(LAS const f32x4*)(red + lane * 32 + q * 4); sm += (v.x + v.y) + (v.z + v.w); }
          ssqx[wid * 64 + lane] = sm; }
        __syncthreads();
        { float sm = 0.f;
#pragma unroll
          for (int w = 0; w < 8; ++w) sm += ssqx[w * 64 + lane];
          rsl[lane] = rsqrtf(sm * (1.f / 512.f) + EPS); }
        LDS_WAIT();
#pragma unroll
        for (int a = 0; a < 2; ++a)
#pragma unroll
            for (int r = 0; r < 16; ++r) { const int t = 32 * a + crow(r, hi); const float rs = rsl[t];
                zt[t * 64 + r32] = (unsigned short)f2bf(acc[a][0][r] * rs); zt[t * 64 + 32 + r32] = (unsigned short)f2bf(acc[a][1][r] * rs); }
        LDS_WAIT();
#pragma unroll
        for (int i = 0; i < 8; ++i) *(u32x4*)(Y + (size_t)(m0 + i * 8 + (lane >> 3)) * DI + h * HD + (lane & 7) * 8) = *(LAS const u32x4*)(xt + (i * 64 + lane) * 16);
    }
}
}

__device__ __forceinline__ void phase_attn_simple(const bf16* QRAW, const bf16* KF, const bf16* KVRAW, const float* qw, const float* COS, const float* SIN, bf16* AO, LAS unsigned char* lds, int G, int wg) {
    const int wave = otid() >> 6, lane = otid() & 63;
    LAS float* sc = (LAS float*)(lds + RING_OFF + wave * 16384);
    LAS float* qs = (LAS float*)(lds + EXTRA_OFF + wave * 768);
    const float w0 = qw[lane], w1 = qw[64 + lane], w2 = qw[128 + lane];
    for (int it = wg * NWAVES + wave; it < NB * NH * SEQ; it += G * NWAVES) {
        const int t = it % SEQ, bh = it / SEQ, h = bh % NH, b = bh / NH, m = b * SEQ + t;
        const bf16* qp = QRAW + (size_t)m * (NH * QK) + h * QK;
        const float a0 = bf2f(qp[lane]), a1 = bf2f(qp[64 + lane]), a2 = bf2f(qp[128 + lane]);
        const float ss = wave_sum(a0 * a0 + a1 * a1 + a2 * a2), rs = rsqrtf(ss * (1.f / QK) + EPS);
        const float t2 = a2 * rs * w2, o2 = get_xor32(t2, lane);
        const float c = COS[m * 32 + (lane & 31)], s = SIN[m * 32 + (lane & 31)];
        const float r2 = lane < 32 ? (t2 * c - o2 * s) : (o2 * s + t2 * c);
        const float scale = 0.07216878364870322f;
        qs[lane] = a0 * rs * w0 * scale; qs[64 + lane] = a1 * rs * w1 * scale; qs[128 + lane] = r2 * scale;
        LDS_WAIT();
        const int nk = (t / TC + 1) * TC;
        float mx = -3.0e38f;
        for (int j = lane; j < nk; j += 64) {
            const bf16* kp = KF + (size_t)(b * SEQ + j) * (NH * QK) + h * QK;
            float acc = 0.f;
#pragma unroll 4
            for (int d = 0; d < QK; d += 8) { float kv[8]; ld_bf16x8(kp + d, kv);
#pragma unroll
                for (int e = 0; e < 8; ++e) acc += qs[d + e] * kv[e]; }
            sc[j] = acc; mx = fmaxf(mx, acc);
        }
        mx = wave_max(mx);
        LDS_WAIT();
        float l = 0.f;
        for (int j = lane; j < nk; j += 64) { const float p = __expf(sc[j] - mx); sc[j] = p; l += p; }
        l = wave_sum(l);
        LDS_WAIT();
        float o0 = 0.f, o1 = 0.f;
        const bf16* vp = KVRAW + (size_t)(b * SEQ) * 4096 + h * 256 + 128;
#pragma unroll 8
        for (int j = 0; j < nk; ++j) { const float p = sc[j]; o0 += p * bf2f(vp[(size_t)j * 4096 + lane]); o1 += p * bf2f(vp[(size_t)j * 4096 + 64 + lane]); }
        const float il = 1.f / l;
        AO[(size_t)m * DM + h * VD + lane] = (bf16)f2bf(o0 * il); AO[(size_t)m * DM + h * VD + 64 + lane] = (bf16)f2bf(o1 * il);
        LDS_WAIT();
    }
}
__device__ __forceinline__ float wave_scan(float v, int lane) {
#pragma unroll
    for (int o = 1; o < 64; o <<= 1) { const float n = lane_up(v, o, lane); if (lane >= o) v += n; }
    return v;
}
__device__ __forceinline__ void phase_ssd_states(const bf16* XC, const float* DTS, const float* a_log, float* ST, float* CDEC, LAS unsigned char* lds, int G, int wg) {
    LAS float* wsh = (LAS float*)(lds + RING_OFF);
    const int tid = otid();
    for (int it = wg; it < NB * NCH * SH; it += G) {
        const int h = it % SH, bc = it / SH, m0 = bc * TC, g = h / HPG;
        __syncthreads();
        if (tid < 64) { const float A = -__expf(a_log[h]), dt = DTS[(size_t)(m0 + tid) * SH + h];
            const float ac = wave_scan(dt * A, tid), last = __builtin_bit_cast(float, __builtin_amdgcn_readlane(__builtin_bit_cast(int, ac), 63));
            wsh[tid] = __expf(last - ac) * dt; if (tid == 63) CDEC[bc * SH + h] = __expf(last); }
        __syncthreads();
        const int p = tid >> 3, n0 = (tid & 7) * 16;
        float acc[16];
#pragma unroll
        for (int e = 0; e < 16; ++e) acc[e] = 0.f;
        for (int s = 0; s < TC; ++s) {
            const float xw = bf2f(XC[(size_t)(m0 + s) * CONVD + h * HD + p]) * wsh[s];
            float b0[8], b1[8]; ld_bf16x8(XC + (size_t)(m0 + s) * CONVD + DI + g * SN + n0, b0); ld_bf16x8(XC + (size_t)(m0 + s) * CONVD + DI + g * SN + n0 + 8, b1);
#pragma unroll
            for (int e = 0; e < 8; ++e) { acc[e] += xw * b0[e]; acc[8 + e] += xw * b1[e]; }
        }
        float* o = ST + (((size_t)bc * SH + h) * HD + p) * SN + n0;
#pragma unroll
        for (int e = 0; e < 16; e += 4) *(f32x4*)(o + e) = (f32x4){acc[e], acc[e + 1], acc[e + 2], acc[e + 3]};
    }
}
__device__ __forceinline__ void phase_ssd_scan(float* ST, const float* CDEC, int G, int wg) {
    constexpr int PER_B = SH * HD * SN;
    for (int e = wg * NTHR + otid(); e < NB * PER_B; e += G * NTHR) {
        const int b = e / PER_B, r = e % PER_B, h = r / (HD * SN);
        float state = 0.f;
        for (int c = 0; c < NCH; ++c) { const size_t idx = (size_t)(b * NCH + c) * PER_B + r; const float tmp = ST[idx]; ST[idx] = state; state = state * CDEC[(b * NCH + c) * SH + h] + tmp; }
    }
}
__device__ __forceinline__ void phase_ssd_out(const bf16* XC, const float* DTS, const float* a_log, const float* dskip, const float* ST, float* YPRE, LAS unsigned char* lds, int G, int wg) {
    LAS float* Mm = (LAS float*)(lds + RING_OFF);
    LAS float* acs = (LAS float*)(lds + RING_OFF + 20480);
    LAS float* dts = acs + 64;
    const int tid = otid();
    for (int it = wg; it < NB * NCH * SH; it += G) {
        const int h = it % SH, bc = it / SH, m0 = bc * TC, g = h / HPG;
        __syncthreads();
        if (tid < 64) { const float A = -__expf(a_log[h]), dt = DTS[(size_t)(m0 + tid) * SH + h]; acs[tid] = wave_scan(dt * A, tid); dts[tid] = dt; }
        __syncthreads();
        for (int i = 0; i < 8; ++i) { const int e = tid + NTHR * i, t = e >> 6, s = e & 63;
            float v = 0.f;
            if (s <= t) { const bf16* cp = XC + (size_t)(m0 + t) * CONVD + DI + SG * SN + g * SN; const bf16* bp = XC + (size_t)(m0 + s) * CONVD + DI + g * SN;
                float dot = 0.f;
#pragma unroll 4
                for (int n = 0; n < SN; n += 8) { float cv[8], bv[8]; ld_bf16x8(cp + n, cv); ld_bf16x8(bp + n, bv);
#pragma unroll
                    for (int q = 0; q < 8; ++q) dot += cv[q] * bv[q]; }
                v = dot * __expf(acs[t] - acs[s]) * dts[s]; }
            Mm[t * 65 + s] = v; }
        __syncthreads();
        const int t = tid >> 3, p0 = (tid & 7) * 8;
        float y[8];
#pragma unroll
        for (int j = 0; j < 8; ++j) y[j] = 0.f;
        for (int s = 0; s < TC; ++s) { float xv[8]; ld_bf16x8(XC + (size_t)(m0 + s) * CONVD + h * HD + p0, xv); const float mv = Mm[t * 65 + s];
#pragma unroll
            for (int j = 0; j < 8; ++j) y[j] += mv * xv[j]; }
        const float ea = __expf(acs[t]), dk = dskip[h];
        const bf16* cp = XC + (size_t)(m0 + t) * CONVD + DI + SG * SN + g * SN;
        float xt[8]; ld_bf16x8(XC + (size_t)(m0 + t) * CONVD + h * HD + p0, xt);
#pragma unroll
        for (int j = 0; j < 8; ++j) { const float* pp = ST + (((size_t)bc * SH + h) * HD + p0 + j) * SN;
            float dot = 0.f;
#pragma unroll 4
            for (int n = 0; n < SN; n += 8) { float cv[8], pv[8]; ld_bf16x8(cp + n, cv); ld_f32x8(pp + n, pv);
#pragma unroll
                for (int q = 0; q < 8; ++q) dot += cv[q] * pv[q]; }
            y[j] += ea * dot + dk * xt[j]; }
        st_f32x8(YPRE + (size_t)(m0 + t) * DI + h * HD + p0, y);
    }
}

#ifndef CHORE_OVERLAP
#define CHORE_OVERLAP 0
#endif
#ifndef CHORE_ATTN
#define CHORE_ATTN 0
#endif
#ifndef CHORE_CONV
#define CHORE_CONV CHORE_OVERLAP
#endif
#ifndef CHORE_W
#define CHORE_W CHORE_OVERLAP
#endif
#ifndef NCV
#define NCV 8
#endif
#ifndef TIM_WG
#define TIM_WG 0
#endif
#ifndef REP_IN
#define REP_IN 1
#endif
#ifndef REP_RES
#define REP_RES 1
#endif
#ifndef REP_DN
#define REP_DN 1
#endif
#ifndef REP_SCAN
#define REP_SCAN 1
#endif
#ifndef REP_BAR
#define REP_BAR 1
#endif
#ifndef REP_PRO
#define REP_PRO 1
#endif
#ifndef REP_THIN
#define REP_THIN 1
#endif
#ifndef ROT
#define ROT 7
#endif
#ifndef JIT_PHASE
#define JIT_PHASE 3
#endif
#define JIT_AT(p) (JIT_W && JIT_PHASE == (p) && l + 1 < DEPTH && !(G == 256 && DYN_GEMM && CHORE_W) && !(G == 256 && (CHORE_ATTN & 2)))
#ifndef ROT_SH
#define ROT_SH 3
#endif
#define ROT_B(bit) (((ROT) >> (bit)) & 1 && ((wg >> ROT_SH) & 1))
#ifndef ATT_ABL
#define ATT_ABL 0
#endif
#ifndef REP_ATTN
#define REP_ATTN 1
#endif
#ifndef REP_SSD
#define REP_SSD 1
#endif
#ifndef ATTN_REPEAT
#define ATTN_REPEAT 1
#endif
#ifndef SLOW4
#define SLOW4 1
#endif
constexpr int PPL = (FAST_SSD && FAST_ATTN) ? 10 : (FAST_SSD ? 13 : 14), NPH = 1 + DEPTH * PPL;
struct Args { const float* in[26]; float* out; unsigned char* ws; int ph_lo, ph_hi; };
__global__ void __launch_bounds__(NTHR, 2) fwd(Args args) {
    extern __shared__ __attribute__((aligned(16))) unsigned char lds_[];
    LAS unsigned char* lds = (LAS unsigned char*)lds_;
    const int G = gridDim.x, wg = blockIdx.x;
    for (int u = threadIdx.x; u < (LDS_BYTES - LDSCTL_OFF) / 4; u += NTHR) ((LAS unsigned*)(lds + LDSCTL_OFF))[u] = 0u;
    __syncthreads();
    otid_init();
    __syncthreads();
    unsigned char* const ws0 = args.ws;
    unsigned* const ctl0 = (unsigned*)(ws0 + WS_CTL);
    const int lo = args.ph_lo, hi = args.ph_hi;
    XcdBarrier bar; bar.bar = ctl0 + CW_BAR; bar.x = 0; bar.st = (volatile LAS unsigned*)(lds + MISC_OFF) + 8;
    if (hi - lo > 1) bar = xcd_barrier_post(ctl0 + CW_BAR, (volatile LAS unsigned*)(lds + MISC_OFF) + 8);
#define INP(i) (args.in[i])
#define WSP(T, off) ((T*)(ws + (off)))
#define X (args.out)
#define SSQX ((u64*)(ctl + CW_SSQX))
#define SSQC ((u64*)(ctl + CW_SSQC))
#define XB0 WSP(bf16, WS_XB)
#define XB1 WSP(bf16, WS_XB1)
#define XB2 WSP(bf16, WS_XB2)
#define PROJ WSP(bf16, WS_PROJ)
#define U WSP(bf16, WS_U)
#define MISC WSP(float, WS_MISC)
#define QRAW WSP(bf16, WS_QRAW)
#define KVRAW WSP(bf16, WS_KVRAW)
#define KF WSP(bf16, WS_KF)
#define AO WSP(bf16, WS_AO)
#define XC WSP(bf16, WS_XC)
#define DTS WSP(float, WS_DTS)
#define CDEC WSP(float, WS_CDEC)
#define ST WSP(float, WS_ST)
#define YPRE WSP(float, WS_YPRE)
#define Y WSP(bf16, WS_Y)
#define TMPF WSP(float, WS_TMPF)
#define MERGED WSP(bf16, WS_MERGED)
#define PE WSP(bf16, WS_PE)
#define PB WSP(bf16, WS_PB)
#define COS WSP(float, WS_COS)
#define SIN WSP(float, WS_SIN)
    int ph = 0;
#if defined(TIM_KIND)
    unsigned long long tim_acc = 0ull; const unsigned long long clk0 = __builtin_amdgcn_s_memtime();
#define TIM_SEL(kind) (((TIM_KIND) >> ((kind) + 1)) & 1)
#define PHASE(...) do { if (lo <= ph && ph < hi) { const int kind_ = (ph == 0) ? -1 : (ph - 1) % PPL; const unsigned long long tA = __builtin_amdgcn_s_memrealtime(); \
        { unsigned char* ws = ws0; asm volatile("" : "+s"(ws)); unsigned* ctl = (unsigned*)(ws + WS_CTL); __VA_ARGS__; } const unsigned long long tB = __builtin_amdgcn_s_memrealtime(); \
        if (ph + 1 < hi) xcd_barrier(bar); const unsigned long long tC = __builtin_amdgcn_s_memrealtime(); \
        if (TIM_SEL(kind_)) tim_acc += (TIM_PART == 0) ? (tB - tA) : ((TIM_PART == 1) ? (tC - tB) : (tC - tA)); } ++ph; } while (0)
#else
#define PHASE(...) do { if (lo <= ph && ph < hi) { { unsigned char* ws = ws0; asm volatile("" : "+s"(ws)); unsigned* ctl = (unsigned*)(ws + WS_CTL); __VA_ARGS__; } if (ph + 1 < hi) for (int rb = 0; rb < REP_BAR; ++rb) xcd_barrier(bar); } ++ph; } while (0)
#endif

    PHASE({ for (int rr = 0; rr < REP_PRO; ++rr) { prologue_weights(args.in, ws, lds, G, wg, 0, JIT_W ? 1 : DEPTH); prologue_rows(args.in, X, ws, G, wg); } });

#pragma unroll 1
    for (int l = 0; l < DEPTH; ++l) {
#define wl (ws + WS_W + (size_t)l * WL_BYTES)
#define ssq0 (SSQX + (size_t)(l * 3 + 0) * M)
#define ssq1 (SSQX + (size_t)(l * 3 + 1) * M)
#define ssq2 (SSQX + (size_t)(l * 3 + 2) * M)
#define ssqn ((l + 1 < DEPTH) ? SSQX + (size_t)((l + 1) * 3) * M : (u64*)nullptr)
#define ssqc (SSQC + (size_t)l * 2 * M)
#define QH(k) (ctl + CW_Q + ((l * 5 + (k)) * 8) * 64)
#if FAST_SSD && FAST_ATTN
        PHASE({ pg8::Gemm g{XB0, (const bf16*)(wl + WL_IN), M, DINP, DM, DM}; EpiInProj E{ssq0, ssqc, PROJ, MISC}; run_gemm_dyn(lds, g, E, G, wg, QH(0));
                { pg8::Gemm g2{PB + (size_t)l * M * PLE, (const bf16*)(wl + WL_PL), M, DM, PLE, PLE}; EpiScaleBf16 E2{nullptr, 0.f, PE, DM}; run_gemm_dyn(lds, g2, E2, G, wg, QH(3)); } });
        PHASE({ if (G == 256 && DYN_GEMM && CHORE_CONV) { if ((wg >> 3) < NCV) { phase_ssdpre(PROJ, MISC, INP(12) + (size_t)l * CW * CONVD, INP(13) + (size_t)l * CONVD, INP(14) + l * SH, XC, DTS, NCV * 8, (wg & 7) * NCV + (wg >> 3)); __syncthreads(); } }
                { pg8::Gemm g{PROJ + PC_CQ, (const bf16*)(wl + WL_UQ), M, NH * QK, QL, DINP}; EpiScaleBf16 E{ssqc, 1.f / QL, QRAW, NH * QK}; run_gemm_dyn(lds, g, E, G, wg, QH(1)); }
                { pg8::Gemm g{PROJ + PC_CKV, (const bf16*)(wl + WL_UKV), M, NH * 256, KVL, DINP}; EpiScaleBf16 E{ssqc + M, 1.f / KVL, KVRAW, NH * 256}; run_gemm_dyn(lds, g, E, G, wg, QH(2)); }
                if (!(G == 256 && DYN_GEMM && CHORE_CONV)) phase_ssdpre(PROJ, MISC, INP(12) + (size_t)l * CW * CONVD, INP(13) + (size_t)l * CONVD, INP(14) + l * SH, XC, DTS, G, wg); });
        PHASE({ if (!ROT_B(4)) { phase_kfin(KVRAW, MISC, INP(10) + l * QK, COS, SIN, KF, lds, G, wg); __syncthreads(); }
                ssd::phase_states(XC, DTS, INP(15) + l * SH, (bf16*)ST, CDEC, lds, G, wg);
                if (ROT_B(4)) { __syncthreads(); phase_kfin(KVRAW, MISC, INP(10) + l * QK, COS, SIN, KF, lds, G, wg); } });
        PHASE({ if (G == 256 && CHORE_ATTN) {
                    if ((wg >> 3) < NCV) { const int ci = (wg & 7) * NCV + (wg >> 3);
                        if (CHORE_ATTN & 1) ssd::phase_scan((bf16*)ST, CDEC, NCV * 8, ci);
                        if ((CHORE_ATTN & 2) && JIT_W && l + 1 < DEPTH) prologue_weights(args.in, ws, lds, NCV * 8, ci, l + 1, l + 2); }
                    attn::phase_dyn(QRAW, KF, KVRAW, INP(9) + l * QK, COS, SIN, AO, lds, wg, ctl + CW_AQ + (l * 8 + (wg & 7)) * 64);
                    if (!(CHORE_ATTN & 1)) ssd::phase_scan((bf16*)ST, CDEC, G, wg);
                } else {
                    if (ROT_B(0)) { ssd::phase_scan((bf16*)ST, CDEC, G, wg); if (JIT_AT(3)) { __syncthreads(); prologue_weights(args.in, ws, lds, G, wg, l + 1, l + 2); __syncthreads(); } }
                    for (int rr = 0; rr < REP_ATTN - 1; ++rr) attn::phase<ATT_ABL>(QRAW, KF, KVRAW, INP(9) + l * QK, COS, SIN, AO, lds, G, wg);
                    attn::phase<0>(QRAW, KF, KVRAW, INP(9) + l * QK, COS, SIN, AO, lds, G, wg);
                    if (!ROT_B(0)) { for (int rr = 0; rr < REP_SCAN; ++rr) ssd::phase_scan((bf16*)ST, CDEC, G, wg); if (JIT_AT(3)) { __syncthreads(); prologue_weights(args.in, ws, lds, G, wg, l + 1, l + 2); } } } });
        PHASE({ if (!ROT_B(1)) { for (int rr = 0; rr < REP_SSD; ++rr) ssd::phase_out(XC, DTS, INP(15) + l * SH, INP(16) + l * SH, (const bf16*)ST, PROJ, Y, lds, G, wg); __syncthreads(); }
                { pg8::Gemm g{AO, (const bf16*)(wl + WL_OM), M, DM, DM, DM}; EpiGateF32 E{PROJ, (bf16*)TMPF}; run_gemm(lds, g, E, G, wg, GEMM_REPEAT); }
                if (ROT_B(1)) { __syncthreads(); ssd::phase_out(XC, DTS, INP(15) + l * SH, INP(16) + l * SH, (const bf16*)ST, PROJ, Y, lds, G, wg); } });
        PHASE({ pg8::Gemm g{Y, (const bf16*)(wl + WL_OS), M, DM, DI, DI}; EpiMerge E{PROJ, (const bf16*)TMPF, MERGED}; run_gemm(lds, g, E, G, wg, GEMM_REPEAT); });
        PHASE({ pg8::Gemm g{MERGED, (const bf16*)(wl + WL_OUT), M, DM, DM, DM}; EpiResid E{XB0, XB1, ssq1}; run_gemm(lds, g, E, G, wg, SLOW4); for (int rr = 1; rr < REP_RES; ++rr) { EpiResid E2{XB0, XB1, ssq1, 0.f}; run_gemm(lds, g, E2, G, wg, 1); } });
        PHASE({ if (JIT_W && l + 1 < DEPTH && G == 256 && DYN_GEMM && CHORE_W) { if ((wg >> 3) < NCV) { prologue_weights(args.in, ws, lds, NCV * 8, (wg & 7) * NCV + (wg >> 3), l + 1, l + 2); __syncthreads(); } }
                pg8::Gemm g{XB1, (const bf16*)(wl + WL_UP), M, DFF, DM, DM}; EpiUp E{ssq1, U}; run_gemm_dyn(lds, g, E, G, wg, QH(4)); });
        PHASE({ pg8::Gemm g{U, (const bf16*)(wl + WL_DN), M, DM, DFF, DFF}; EpiResid E{XB1, XB2, ssq2}; run_gemm(lds, g, E, G, wg, SLOW4); for (int rr = 1; rr < REP_DN; ++rr) { EpiResid E2{XB1, XB2, ssq2, 0.f}; run_gemm(lds, g, E2, G, wg, 1); } });
        PHASE({ if (ROT_B(2) && JIT_AT(9)) { prologue_weights(args.in, ws, lds, G, wg, l + 1, l + 2); __syncthreads(); }
                pg8::Gemm g{XB2, (const bf16*)(wl + WL_PG), M, DM, DM, DM}; EpiPleGate E{ssq2, PE, XB2, XB0, (l + 1 < DEPTH) ? (float*)nullptr : X, ssqn}; run_gemm(lds, g, E, G, wg, SLOW4); for (int rr = 1; rr < REP_RES; ++rr) { EpiPleGate E2{ssq2, PE, XB2, XB0, (l + 1 < DEPTH) ? (float*)nullptr : X, ssqn, 0.f}; run_gemm(lds, g, E2, G, wg, 1); }
                if (!ROT_B(2) && JIT_AT(9)) { __syncthreads(); prologue_weights(args.in, ws, lds, G, wg, l + 1, l + 2); } });
#else
#error "the simple-loop phase program was retired together with the f32 residual buffer; build with FAST_SSD and FAST_ATTN"
#if 0
        PHASE({ pg8::Gemm g{XB0, (const bf16*)(wl + WL_IN), M, DINP, DM, DM}; EpiInProj E{ssq0, ssqc, PROJ, MISC}; run_gemm(lds, g, E, G, wg, SLOW4); });
        PHASE({ { pg8::Gemm g{PROJ + PC_CQ, (const bf16*)(wl + WL_UQ), M, NH * QK, QL, DINP}; EpiScaleBf16 E{ssqc, 1.f / QL, QRAW, NH * QK}; run_gemm(lds, g, E, G, wg, GEMM_REPEAT); }
                { pg8::Gemm g{PROJ + PC_CKV, (const bf16*)(wl + WL_UKV), M, NH * 256, KVL, DINP}; EpiScaleBf16 E{ssqc + M, 1.f / KVL, KVRAW, NH * 256}; run_gemm(lds, g, E, G, wg, GEMM_REPEAT); }
                { pg8::Gemm g{PB + (size_t)l * M * PLE, (const bf16*)(wl + WL_PL), M, DM, PLE, PLE}; EpiScaleBf16 E{nullptr, 0.f, PE, DM}; run_gemm(lds, g, E, G, wg, GEMM_REPEAT); } });
        PHASE({ for (int rr = 0; rr < REP_THIN; ++rr) { phase_kfin(KVRAW, MISC, INP(10) + l * QK, COS, SIN, KF, lds, G, wg);
                phase_ssdpre(PROJ, MISC, INP(12) + (size_t)l * CW * CONVD, INP(13) + (size_t)l * CONVD, INP(14) + l * SH, XC, DTS, G, wg); } });

#if FAST_ATTN
        PHASE({ for (int rr = 0; rr < REP_ATTN - 1; ++rr) attn::phase<ATT_ABL>(QRAW, KF, KVRAW, INP(9) + l * QK, COS, SIN, AO, lds, G, wg);
                    attn::phase<0>(QRAW, KF, KVRAW, INP(9) + l * QK, COS, SIN, AO, lds, G, wg); });
#else
        PHASE({ phase_attn_simple(QRAW, KF, KVRAW, INP(9) + l * QK, COS, SIN, AO, lds, G, wg); });
#endif

#if FAST_SSD
        PHASE({ for (int rr = 0; rr < REP_SSD; ++rr) ssd::phase_states(XC, DTS, INP(15) + l * SH, (bf16*)ST, CDEC, lds, G, wg); });
        PHASE({ ssd::phase_scan((bf16*)ST, CDEC, G, wg); });
        PHASE({ for (int rr = 0; rr < REP_SSD; ++rr) ssd::phase_out(XC, DTS, INP(15) + l * SH, INP(16) + l * SH, (const bf16*)ST, PROJ, Y, lds, G, wg); });
#else
        PHASE({ phase_ssd_states(XC, DTS, INP(15) + l * SH, ST, CDEC, lds, G, wg); });
        PHASE({ phase_ssd_scan(ST, CDEC, G, wg); });
        PHASE({ phase_ssd_out(XC, DTS, INP(15) + l * SH, INP(16) + l * SH, ST, YPRE, lds, G, wg); });
        PHASE({ phase_ssdnorm(YPRE, PROJ, Y, G, wg); });
#endif
        PHASE({ pg8::Gemm g{AO, (const bf16*)(wl + WL_OM), M, DM, DM, DM}; EpiGateF32 E{PROJ, TMPF}; run_gemm(lds, g, E, G, wg, GEMM_REPEAT); });
        PHASE({ pg8::Gemm g{Y, (const bf16*)(wl + WL_OS), M, DM, DI, DI}; EpiMerge E{PROJ, TMPF, MERGED}; run_gemm(lds, g, E, G, wg, GEMM_REPEAT); });
        PHASE({ pg8::Gemm g{MERGED, (const bf16*)(wl + WL_OUT), M, DM, DM, DM}; EpiResid E{X, XB1, ssq1}; run_gemm(lds, g, E, G, wg, SLOW4); });
        PHASE({ pg8::Gemm g{XB1, (const bf16*)(wl + WL_UP), M, DFF, DM, DM}; EpiUp E{ssq1, U}; run_gemm(lds, g, E, G, wg, GEMM_REPEAT); });
        PHASE({ pg8::Gemm g{U, (const bf16*)(wl + WL_DN), M, DM, DFF, DFF}; EpiResid E{X, XB2, ssq2}; run_gemm(lds, g, E, G, wg, SLOW4); });
        PHASE({ pg8::Gemm g{XB2, (const bf16*)(wl + WL_PG), M, DM, DM, DM};  EpiPleGate E{ssq2, PE, X, XB0, ssqn}; run_gemm(lds, g, E, G, wg, SLOW4); });
#endif
#endif
    }
#undef PHASE
#if defined(TIM_KIND)
#if defined(TIM_CLOCK)
    tim_acc = (__builtin_amdgcn_s_memtime() - clk0) / 160ull;
#endif
    if (wg == TIM_WG) { const unsigned long long t0 = __builtin_amdgcn_s_memrealtime(); while (__builtin_amdgcn_s_memrealtime() - t0 < (unsigned long long)(TIM_AMP) * tim_acc) __builtin_amdgcn_s_sleep(8); }
#endif
}

extern "C" void kernel_launch(void* const* d_in, const int* in_sizes, int n_in, void* d_out, int out_size, void* d_ws, size_t ws_size, hipStream_t stream) {
    static int grid = 0;
    if (grid == 0) {
        if (n_in != 26 || out_size != M * DM || ws_size < WS_END) { fprintf(stderr, "kernel_launch: built for 26 inputs, out %d floats, >= %zu bytes of workspace; got n_in %d out %d ws %zu\n", M * DM, (size_t)WS_END, n_in, out_size, ws_size); grid = -1; return; }
        int dev = 0, cus = 0;
        if (hipGetDevice(&dev) != hipSuccess || hipDeviceGetAttribute(&cus, hipDeviceAttributeMultiprocessorCount, dev) != hipSuccess) { grid = -1; return; }
        if (hipFuncSetAttribute((const void*)fwd, hipFuncAttributeMaxDynamicSharedMemorySize, LDS_BYTES) != hipSuccess) { fprintf(stderr, "kernel_launch: hipFuncSetAttribute failed\n"); grid = -1; return; }
        int per_cu = 0;
        if (hipOccupancyMaxActiveBlocksPerMultiprocessor(&per_cu, (const void*)fwd, NTHR, LDS_BYTES) != hipSuccess || per_cu < 1) fprintf(stderr, "kernel_launch: occupancy query says %d\n", per_cu);
        (void)hipGetLastError();
        grid = cus;
    }
    if (grid < 0) return;
    if (hipMemsetAsync((char*)d_ws + WS_CTL, 0, CTL_ZERO_BYTES, stream) != hipSuccess) return;
    Args a{};
    for (int i = 0; i < 26; ++i) a.in[i] = (const float*)d_in[i];
    a.out = (float*)d_out; a.ws = (unsigned char*)d_ws;
#if MK_ONE_LAUNCH
    a.ph_lo = 0; a.ph_hi = NPH;
    hipLaunchKernelGGL(fwd, dim3(grid), dim3(NTHR), LDS_BYTES, stream, a);
#else
#ifndef STOP_PH
#define STOP_PH NPH
#endif
    for (int ph = 0; ph < STOP_PH; ++ph) {
#ifdef SKIP_LO
        if (ph >= SKIP_LO && ph < SKIP_HI) continue;
#endif
        a.ph_lo = ph; a.ph_hi = ph + 1; hipLaunchKernelGGL(fwd, dim3(grid), dim3(NTHR), LDS_BYTES, stream, a); }
#endif
    const hipError_t le = hipPeekAtLastError();
    if (le != hipSuccess) fprintf(stderr, "kernel_launch: launch failed: %s\n", hipGetErrorName(le));
}
```

```cpp
#include <hip/hip_runtime.h>
#include <cstdio>
#include <cstdint>

#ifndef MK_ONE_LAUNCH
#define MK_ONE_LAUNCH 1
#endif
#ifndef DYN_GEMM
#define DYN_GEMM 1
#endif
#ifndef FAST_SSD
#define FAST_SSD 1
#endif
#ifndef FAST_ATTN
#define FAST_ATTN 1
#endif
#ifndef FAST_GEMM
#define FAST_GEMM 1
#endif
#ifndef GEMM32
#define GEMM32 0
#endif
#ifndef JIT_W
#define JIT_W 1
#endif

constexpr int NB = 2, SEQ = 4096, M = NB * SEQ, DM = 2048, DEPTH = 4, PLE = 256;
constexpr float EPS = 1e-6f;
constexpr int NH = 16, QL = 512, KVL = 512, NOPE = 128, ROPE = 64, VD = 128, QK = 192;
constexpr int DI = 4096, HD = 64, SH = 64, SG = 8, SN = 128, HPG = 8, CW = 4, CONVD = 6144, TC = 64, NCH = SEQ / TC;
constexpr int DFF = 8192;
constexpr int DIN = 15488;
constexpr int DINP = 15616;
constexpr int PC_CQ = 0, PC_CKV = 512, PC_Z = 1024, PC_XBC = 5120, PC_G = 11264, PC_KR = 15360, PC_DT = 15424, PC_PAD = 15488;
constexpr int NWAVES = 8, NTHR = 512;

typedef unsigned short bf16;
typedef unsigned u32x4 __attribute__((ext_vector_type(4)));
typedef unsigned u32x2 __attribute__((ext_vector_type(2)));
typedef float f32x4 __attribute__((ext_vector_type(4)));
typedef float f32x2 __attribute__((ext_vector_type(2)));
typedef short bf16x8 __attribute__((ext_vector_type(8)));
#define GAS __attribute__((address_space(1)))
#define LAS __attribute__((address_space(3)))
typedef GAS unsigned gu32;
#define RLX_AGENT __ATOMIC_RELAXED, __HIP_MEMORY_SCOPE_AGENT
#define LDS_WAIT() asm volatile("s_waitcnt lgkmcnt(0)" ::: "memory")
#define VM_WAIT() asm volatile("s_waitcnt vmcnt(0)" ::: "memory")

constexpr size_t MiB = 1u << 20;
constexpr size_t WS_CTL = 0, CTL_ZERO_BYTES = 2 * MiB;
constexpr int CW_TMO = 0, CW_CODE = 1, CW_BAR = 4096;
typedef unsigned long long u64;
constexpr int CW_SSQX = 16384;
constexpr int CW_SSQC = CW_SSQX + 2 * DEPTH * 3 * M;
static_assert((size_t)(CW_SSQC + 2 * DEPTH * 2 * M) * 4 <= CTL_ZERO_BYTES, "ctl");
constexpr int CW_AQ = 390000;
constexpr int CW_Q = 400000;
static_assert(CW_AQ >= CW_SSQC + 2 * DEPTH * 2 * M && CW_AQ + DEPTH * 8 * 64 <= CW_Q && CW_Q >= CW_SSQC + 2 * DEPTH * 2 * M && (size_t)(CW_Q + DEPTH * 5 * 8 * 64) * 4 <= CTL_ZERO_BYTES, "ctl q");
constexpr size_t WL_IN = 0, WL_UQ = 61 * MiB, WL_UKV = 64 * MiB, WL_OM = 68 * MiB, WL_OS = 76 * MiB, WL_OUT = 92 * MiB, WL_UP = 100 * MiB, WL_DN = 132 * MiB, WL_PG = 164 * MiB, WL_PL = 172 * MiB, WL_BYTES = 173 * MiB;
static_assert((size_t)DINP * DM * 2 == 61 * MiB, "w_in copy");
constexpr size_t WS_W = 2 * MiB;
constexpr size_t WS_ACT = WS_W + DEPTH * WL_BYTES;
constexpr size_t WS_XB = WS_ACT;
constexpr size_t WS_XB1 = WS_XB + 32 * MiB, WS_XB2 = WS_XB1 + 32 * MiB;
constexpr size_t WS_PROJ = WS_XB2 + 32 * MiB;
constexpr size_t WS_U = WS_PROJ;
constexpr size_t WS_MISC = WS_PROJ + 244 * MiB;
constexpr size_t WS_QRAW = WS_MISC + 4 * MiB;
constexpr size_t WS_KVRAW = WS_QRAW + 48 * MiB;
constexpr size_t WS_KF = WS_KVRAW + 64 * MiB;
constexpr size_t WS_AO = WS_KF + 48 * MiB;
constexpr size_t WS_XC = WS_AO + 32 * MiB;
constexpr size_t WS_DTS = WS_XC + 96 * MiB;
constexpr size_t WS_CDEC = WS_DTS + 2 * MiB;
constexpr size_t WS_ST = WS_CDEC + 1 * MiB;
constexpr size_t WS_YPRE = WS_ST + 256 * MiB;
constexpr size_t WS_Y = WS_YPRE + 128 * MiB;
constexpr size_t WS_TMPF = WS_Y + 64 * MiB;
constexpr size_t WS_MERGED = WS_TMPF + 64 * MiB;
constexpr size_t WS_PE = WS_MERGED + 32 * MiB;
constexpr size_t WS_PB = WS_PE + 32 * MiB;
constexpr size_t WS_COS = WS_PB + 16 * MiB;
constexpr size_t WS_SIN = WS_COS + 1 * MiB;
constexpr size_t WS_END = WS_SIN + 1 * MiB;
static_assert(WS_END <= 1936 * MiB, "d_ws budget (4 x the largest input)");

constexpr int RING_OFF = 0, RING_BYTES = 131072;
constexpr int LDSCTL_OFF = RING_BYTES, MISC_OFF = LDSCTL_OFF + 320;
constexpr int QSLOT_OFF = LDSCTL_OFF + 448;
constexpr int EXTRA_OFF = LDSCTL_OFF + 512, LDS_BYTES = 147456, EXTRA_BYTES = LDS_BYTES - EXTRA_OFF;

__device__ __forceinline__ unsigned f2bf(float f) { unsigned u = __builtin_bit_cast(unsigned, f); return (u + 0x7fffu + ((u >> 16) & 1u)) >> 16; }
__device__ __forceinline__ float bf2f(unsigned h) { return __builtin_bit_cast(float, h << 16); }
typedef __bf16 bf16x2_t __attribute__((ext_vector_type(2)));
__device__ __forceinline__ unsigned pk2(float lo, float hi) { const f32x2 v = {lo, hi}; const bf16x2_t b = __builtin_convertvector(v, bf16x2_t); return __builtin_bit_cast(unsigned, b); }
__device__ __forceinline__ u32x4 pack8(const float (&v)[8]) { u32x4 w; w.x = pk2(v[0], v[1]); w.y = pk2(v[2], v[3]); w.z = pk2(v[4], v[5]); w.w = pk2(v[6], v[7]); return w; }
__device__ __forceinline__ void unpack8(u32x4 w, float (&v)[8]) {
    v[0] = bf2f(w.x & 0xffffu); v[1] = bf2f(w.x >> 16); v[2] = bf2f(w.y & 0xffffu); v[3] = bf2f(w.y >> 16);
    v[4] = bf2f(w.z & 0xffffu); v[5] = bf2f(w.z >> 16); v[6] = bf2f(w.w & 0xffffu); v[7] = bf2f(w.w >> 16); }
template <int MASK> __device__ __forceinline__ float swz_xor(float v) { static_assert(MASK > 0 && MASK < 32, "ds_swizzle bit mode"); return __builtin_bit_cast(float, __builtin_amdgcn_ds_swizzle(__builtin_bit_cast(int, v), (MASK << 10) | 0x1f)); }
__device__ __forceinline__ float sum_xor32(float v) { auto rr = __builtin_amdgcn_permlane32_swap(__float_as_uint(v), __float_as_uint(v), false, false); return __uint_as_float(rr[0]) + __uint_as_float(rr[1]); }
__device__ __forceinline__ float max_xor32(float v) { auto rr = __builtin_amdgcn_permlane32_swap(__float_as_uint(v), __float_as_uint(v), false, false); return fmaxf(__uint_as_float(rr[0]), __uint_as_float(rr[1])); }
__device__ __forceinline__ float get_xor32(float v, int lane) { auto rr = __builtin_amdgcn_permlane32_swap(__float_as_uint(v), __float_as_uint(v), false, false); return __uint_as_float(lane < 32 ? rr[1] : rr[0]); }
__device__ __forceinline__ float wave_sum(float v) { v += swz_xor<1>(v); v += swz_xor<2>(v); v += swz_xor<4>(v); v += swz_xor<8>(v); v += swz_xor<16>(v); return sum_xor32(v); }
__device__ __forceinline__ float wave_max(float v) { v = fmaxf(v, swz_xor<1>(v)); v = fmaxf(v, swz_xor<2>(v)); v = fmaxf(v, swz_xor<4>(v)); v = fmaxf(v, swz_xor<8>(v)); v = fmaxf(v, swz_xor<16>(v)); return max_xor32(v); }
__device__ __forceinline__ float lane_up(float v, int o, int lane) { return __builtin_bit_cast(float, __builtin_amdgcn_ds_bpermute((lane - o) << 2, __builtin_bit_cast(int, v))); }
constexpr int WTAB_OFF = 131072;
__device__ __forceinline__ unsigned hw_slot() { return (unsigned)__builtin_amdgcn_s_getreg((5 << 11) | 4) & 63u; }
__device__ __forceinline__ void otid_init() { if ((threadIdx.x & 63) == 0) ((LAS unsigned*)(uintptr_t)WTAB_OFF)[hw_slot()] = threadIdx.x >> 6; }
__device__ __forceinline__ int otid() { const unsigned w = ((volatile LAS unsigned*)(uintptr_t)WTAB_OFF)[hw_slot()];
    int l; asm volatile("v_mbcnt_lo_u32_b32 %0, -1, 0\n\tv_mbcnt_hi_u32_b32 %0, -1, %0" : "=v"(l));
    return (int)(w * 64u) + l; }
__device__ __forceinline__ float sigmoidf_(float x) { return 1.f / (1.f + __expf(-x)); }
__device__ __forceinline__ float siluf_(float x) { return x / (1.f + __expf(-x)); }

#define XB_TMO      128
#define XB_XCNT(j)  (256  + 64 * (j))
#define XB_XSUB(j)  (1280 + 64 * (j))
#define XB_XGEN(j)  (2304 + 64 * (j))
#define XB_TOP      3328
#define XB_TOPGEN   3392
#define XCD_BAR_WORDS 3456
#define XB_SPIN_CAP (1u << 18)
__device__ __forceinline__ unsigned xb_ld(unsigned* p)              { return __hip_atomic_load(p, __ATOMIC_RELAXED, __HIP_MEMORY_SCOPE_AGENT); }
__device__ __forceinline__ unsigned xb_add(unsigned* p, unsigned v) { return __hip_atomic_fetch_add(p, v, __ATOMIC_RELAXED, __HIP_MEMORY_SCOPE_AGENT); }
__device__ __forceinline__ unsigned xb_xcc_id() { return (unsigned)__builtin_amdgcn_s_getreg((3 << 11) | 20) & 0xFu; }
#define XB_SPIN(cond, bar) do { unsigned _sp = 0; while (cond) { __builtin_amdgcn_s_sleep(1); \
    if ((++_sp & 255u) == 0u) { if (xb_ld(&(bar)[XB_TMO])) break; if (_sp > XB_SPIN_CAP) { atomicAdd(&(bar)[XB_TMO], 1u); break; } } } } while (0)
struct XcdBarrier { unsigned* bar; unsigned x; volatile LAS unsigned* st; };
__device__ __forceinline__ XcdBarrier xcd_barrier_post(unsigned* bar, volatile LAS unsigned* st) {
    XcdBarrier b; b.bar = bar; b.x = xb_xcc_id(); b.st = st;
    if (otid() == 0) (void)xb_add(&bar[XB_XCNT(b.x)], 1u);
    return b;
}
__device__ __forceinline__ void xcd_barrier_complete(unsigned* bar, unsigned x, unsigned& nloc, unsigned& nx) {
    const unsigned G = gridDim.x * gridDim.y * gridDim.z;
    unsigned sum, cnt, mine, sp = 0u;
    for (;;) {
        sum = 0u; cnt = 0u; mine = 0u;
#pragma unroll
        for (unsigned j = 0; j < 16; ++j) { const unsigned c = xb_ld(&bar[XB_XCNT(j)]); sum += c; cnt += (c > 0u) ? 1u : 0u; mine = (j == x) ? c : mine; }
        if (sum == G) break;
        __builtin_amdgcn_s_sleep(1);
        if ((++sp & 255u) == 0u) { if (xb_ld(&bar[XB_TMO])) break; if (sp > XB_SPIN_CAP) { atomicAdd(&bar[XB_TMO], 1u); break; } }
    }
    nloc = mine > 0u ? mine : 1u; nx = cnt > 0u ? cnt : 1u;
}
__device__ __forceinline__ void xcd_barrier(const XcdBarrier& b) {
    asm volatile("s_waitcnt vmcnt(0)" ::: "memory");
    __syncthreads();
    if (otid() == 0) {
        unsigned* bar = b.bar;
        __builtin_amdgcn_s_waitcnt(0);
        unsigned nloc = b.st[0], nx = b.st[1];
        if (nloc == 0u) { xcd_barrier_complete(bar, b.x, nloc, nx); b.st[0] = nloc; b.st[1] = nx; }
        const unsigned old = xb_add(&bar[XB_XSUB(b.x)], 1u);
        const unsigned gen = old / nloc;
        if (old + 1u == (gen + 1u) * nloc) {
            __builtin_amdgcn_fence(__ATOMIC_RELEASE, "agent");
            asm volatile("s_waitcnt vmcnt(0)" ::: "memory");
            const unsigned og = xb_add(&bar[XB_TOP], 1u);
            const unsigned tg = og / nx;
            if (og + 1u == (tg + 1u) * nx) xb_add(&bar[XB_TOPGEN], 1u);
            else XB_SPIN(xb_ld(&bar[XB_TOPGEN]) == tg, bar);
            __builtin_amdgcn_fence(__ATOMIC_ACQUIRE, "agent");
            xb_add(&bar[XB_XGEN(b.x)], 1u);
            asm volatile("s_waitcnt vmcnt(0)" ::: "memory");
        } else {
            XB_SPIN(xb_ld(&bar[XB_XGEN(b.x)]) == gen, bar);
            __builtin_amdgcn_fence(__ATOMIC_ACQUIRE, "agent");
            asm volatile("s_waitcnt vmcnt(0)" ::: "memory");
        }
    }
    __syncthreads();
}

namespace pg8 {
typedef unsigned short bf16_t;
constexpr int BM = 256, BK = 64, HALF = 128, HTB = HALF * BK * 2, STAGE_BYTES = 8 * HTB, NXCD = 8;
#ifndef PG8_WGM
#define PG8_WGM 4
#endif
constexpr int WGM = PG8_WGM;
#if GEMM32
__host__ __device__ __forceinline__ int lds_byte(int r, int c) { const int st = (r >> 4) * 2 + (c >> 5), rr = r & 15, cc = c & 31, ob = rr * 64 + cc * 2; return st * 1024 + (ob ^ (((ob >> 8) & 3) << 4)); }
__host__ __device__ __forceinline__ void stage_rc(int b, int& R, int& C) { const int st = b / 1024, sb = b % 1024, swz = sb ^ (((sb >> 8) & 3) << 4); R = (st >> 1) * 16 + swz / 64; C = (st & 1) * 32 + (swz % 64) / 2; }
__host__ __device__ __forceinline__ int perm32(int rho) { return 16 * ((rho >> 2) & 1) + (rho & 3) + 4 * (rho >> 3); }
#else
__host__ __device__ __forceinline__ int lds_byte(int r, int c) { const int st = (r >> 4) * 2 + (c >> 5), rr = r & 15, cc = c & 31, ob = rr * 64 + cc * 2; return st * 1024 + (ob ^ (((ob >> 9) & 1) << 5)); }
__host__ __device__ __forceinline__ void stage_rc(int b, int& R, int& C) { const int st = b / 1024, sb = b % 1024, swz = sb ^ (((sb >> 9) & 1) << 5); R = (st >> 1) * 16 + swz / 64; C = (st & 1) * 32 + (swz % 64) / 2; }
__host__ __device__ __forceinline__ int perm32(int rho) { const int n = rho >> 4, i = rho & 15; return 8 * (i >> 2) + 4 * n + (i & 3); }
#endif
__host__ __device__ __forceinline__ int perm32_16(int rho) { const int n = rho >> 4, i = rho & 15; return 8 * (i >> 2) + 4 * n + (i & 3); }
struct Unit { int pm, pn; };
struct Gemm { const bf16_t* A; const bf16_t* Bt; int M, N, K, lda; };
struct StaticOrder {
    static constexpr bool DYN = false;
    int nM, nN, nwg, G, c;
    __host__ __device__ void init(int M_, int N_, int G_, int c_) { nM = M_ / BM; nN = N_ / BM; nwg = nM * nN; G = G_; c = c_; }
    __host__ __device__ bool next(int i, Unit& u) const {
        const long L = (long)i * G + c; if (L >= nwg) return false;
        int wgid = (int)L; { const int q = nwg / NXCD, r = nwg % NXCD, xcd = wgid % NXCD, off = wgid / NXCD; wgid = (xcd < r ? xcd * (q + 1) : r * (q + 1) + (xcd - r) * q) + off; }
        const int nig = WGM * nN, gid = wgid / nig, fm = gid * WGM, gsz = (nM - fm) < WGM ? (nM - fm) : WGM;
        u.pm = fm + ((wgid % nig) % gsz); u.pn = (wgid % nig) / gsz; return true;
    }
    __device__ __forceinline__ void a_ready(const Unit&) const {}
    __device__ __forceinline__ void done(const Unit&) const {}
};

struct DynOrder {
    static constexpr bool DYN = true;
    int nM, nN, q, x; unsigned* head;
    __device__ void init(int M_, int N_, int c_, unsigned* head_base) { nM = M_ / BM; nN = N_ / BM; q = (nM * nN) / NXCD; x = c_ % NXCD; head = head_base + 64 * x; }
    __device__ __forceinline__ int pull() const { return (int)__hip_atomic_fetch_add(head, 1u, __ATOMIC_RELAXED, __HIP_MEMORY_SCOPE_AGENT); }
    __device__ __forceinline__ bool unit_of(int e, Unit& u) const {
        if (e >= q) return false;
        const int wgid = x * q + e, nig = WGM * nN, gid = wgid / nig, fm = gid * WGM, gsz = (nM - fm) < WGM ? (nM - fm) : WGM;
        u.pm = fm + ((wgid % nig) % gsz); u.pn = (wgid % nig) / gsz; return true;
    }
    __device__ __forceinline__ bool next(int, Unit&) const { return false; }
    __device__ __forceinline__ void a_ready(const Unit&) const {}
    __device__ __forceinline__ void done(const Unit&) const {}
};

template <class Epi, class Sched>
__device__ __forceinline__ void gemm_phase(LAS unsigned char* lds, const Gemm g, const Sched& S, const Epi& E) {
    const int tid = otid(), wid = __builtin_amdgcn_readfirstlane(tid >> 6), lane = tid & 63, wr = wid >> 2, wc = wid & 3, fr = lane & 15, fq = lane >> 4;
    const int K = g.K, nt = K / BK, lda = g.lda;
    unsigned voffA[2], voffB[2];
#pragma unroll
    for (int i = 0; i < 2; ++i) { int R, C; stage_rc(tid * 16 + i * 8192, R, C); const int Rb = (R & ~31) + perm32(R & 31);
        voffA[i] = (unsigned)(R * lda + C) * 2u; voffB[i] = (unsigned)(Rb * K + C) * 2u; }
    const size_t kstep = (size_t)(BK * 2);
    const size_t hstepA = (size_t)HALF * lda * 2, hstepB = (size_t)HALF * K * 2;
    const size_t tstepA = 2 * hstepA, tstepB = 2 * hstepB;
    const unsigned ldsw = (unsigned)wid * 1024u;
#if GEMM32
    const int r32 = lane & 31, hi = lane >> 5;
    const int aE = lds_byte(wr * 64 + r32, hi * 8), aO = lds_byte(wr * 64 + r32, 16 + hi * 8), bE = lds_byte(wc * 32 + r32, hi * 8), bO = lds_byte(wc * 32 + r32, 16 + hi * 8);
#else
    const int aoff = lds_byte(wr * 64 + fr, fq * 8), boff = lds_byte(wc * 32 + fr, fq * 8);
#endif
#define PG8_SA(b, h) (((b) * 2 + (h)) * HTB)
#define PG8_SB(b, h) ((4 + (b) * 2 + (h)) * HTB)
#define PG8_STAGE(bufoff, gbase, voff) do { _Pragma("unroll") for (int _i = 0; _i < 2; ++_i) \
        __builtin_amdgcn_global_load_lds((const unsigned*)((const char*)(gbase) + (voff)[_i]), (LAS unsigned*)(lds + (bufoff) + ldsw + _i * 8192), 16, 0, 0); } while (0)
#if GEMM32
#define PG8_LDA(dst, b, h) do { _Pragma("unroll") for (int m = 0; m < 2; ++m) _Pragma("unroll") for (int k = 0; k < 4; ++k) dst[m][k] = *(const LAS bf16x8*)(lds + PG8_SA(b, h) + ((k & 1) ? aO : aE) + m * 4096 + (k >> 1) * 1024); } while (0)
#define PG8_LDB(dst, b, h) do { _Pragma("unroll") for (int k = 0; k < 4; ++k) dst[k] = *(const LAS bf16x8*)(lds + PG8_SB(b, h) + ((k & 1) ? bO : bE) + (k >> 1) * 1024); } while (0)
#define PG8_MMA(ai, bj, At, Bt) do { __builtin_amdgcn_s_setprio(1); _Pragma("unroll") for (int k = 0; k < 4; ++k) _Pragma("unroll") for (int m = 0; m < 2; ++m) \
        acc[ai][bj][m] = __builtin_amdgcn_mfma_f32_32x32x16_bf16(Bt[k], At[m][k], acc[ai][bj][m], 0, 0, 0); __builtin_amdgcn_s_setprio(0); } while (0)
#else
#define PG8_LDA(dst, b, h) do { _Pragma("unroll") for (int m = 0; m < 4; ++m) _Pragma("unroll") for (int k = 0; k < 2; ++k) dst[m][k] = *(const LAS bf16x8*)(lds + PG8_SA(b, h) + aoff + m * 2048 + k * 1024); } while (0)
#define PG8_LDB(dst, b, h) do { _Pragma("unroll") for (int n = 0; n < 2; ++n) _Pragma("unroll") for (int k = 0; k < 2; ++k) dst[n][k] = *(const LAS bf16x8*)(lds + PG8_SB(b, h) + boff + n * 2048 + k * 1024); } while (0)
#define PG8_MMA(ai, bj, At, Bt) do { __builtin_amdgcn_s_setprio(1); _Pragma("unroll") for (int m = 0; m < 4; ++m) _Pragma("unroll") for (int n = 0; n < 2; ++n) _Pragma("unroll") for (int k = 0; k < 2; ++k) \
        acc[ai][bj][m][n] = __builtin_amdgcn_mfma_f32_16x16x32_bf16(Bt[n][k], At[m][k], acc[ai][bj][m][n], 0, 0, 0); __builtin_amdgcn_s_setprio(0); } while (0)
#endif
#define PG8_WAIT_V(n) asm volatile("s_waitcnt vmcnt(" #n ")" ::: "memory")
#define PG8_WAIT_L(n) asm volatile("s_waitcnt lgkmcnt(" #n ")" ::: "memory")
#define PG8_BAR __builtin_amdgcn_s_barrier()
#define PG8_SCHED __builtin_amdgcn_sched_barrier(0)
    Unit cur, nxt; int ui = 0;
    LAS volatile int* qs = (LAS volatile int*)(lds + QSLOT_OFF);
    if constexpr (Sched::DYN) { if (tid == 0) { qs[0] = S.pull(); qs[1] = S.pull(); } __syncthreads(); if (!S.unit_of(qs[0], cur)) return; }
    else { if (!S.next(0, cur)) return; }
#if GEMM32
    typedef float f32x16 __attribute__((ext_vector_type(16)));
    f32x16 acc[2][2][2];
#define PG8_ZERO() do { _Pragma("unroll") for (int a = 0; a < 2; ++a) _Pragma("unroll") for (int b = 0; b < 2; ++b) _Pragma("unroll") for (int m = 0; m < 2; ++m) \
        acc[a][b][m] = (f32x16){0.f, 0.f, 0.f, 0.f, 0.f, 0.f, 0.f, 0.f, 0.f, 0.f, 0.f, 0.f, 0.f, 0.f, 0.f, 0.f}; } while (0)
    PG8_ZERO();
    bf16x8 At[2][4], B0[4], B1[4];
#else
    f32x4 acc[2][2][4][2];
#define PG8_ZERO() do { _Pragma("unroll") for (int a = 0; a < 2; ++a) _Pragma("unroll") for (int b = 0; b < 2; ++b) _Pragma("unroll") for (int m = 0; m < 4; ++m) _Pragma("unroll") for (int n = 0; n < 2; ++n) \
        acc[a][b][m][n] = (f32x4){0.f, 0.f, 0.f, 0.f}; } while (0)
    PG8_ZERO();
    bf16x8 At[4][2], B0[2][2], B1[2][2];
#endif
#define PG8_AP(u) ((const char*)g.A + (size_t)(u).pm * tstepA)
    const char* cA = PG8_AP(cur); const char* cB = (const char*)g.Bt + (size_t)cur.pn * tstepB;
    S.a_ready(cur);
    PG8_STAGE(PG8_SB(0, 0), cB, voffB); PG8_STAGE(PG8_SB(0, 1), cB + hstepB, voffB); PG8_STAGE(PG8_SA(0, 0), cA, voffA); PG8_STAGE(PG8_SA(0, 1), cA + hstepA, voffA);
    if (wr == 1) PG8_BAR;
    PG8_WAIT_V(2); PG8_BAR;
    PG8_STAGE(PG8_SB(1, 0), cB + kstep, voffB); PG8_STAGE(PG8_SA(1, 0), cA + kstep, voffA); PG8_STAGE(PG8_SB(1, 1), cB + hstepB + kstep, voffB);
    PG8_WAIT_V(6); PG8_BAR;
    for (;;) {
        bool has_next = false; const char* nA = cA; const char* nB = cB;
        if constexpr (!Sched::DYN) { has_next = S.next(ui + 1, nxt); if (has_next) { nA = PG8_AP(nxt); nB = (const char*)g.Bt + (size_t)nxt.pn * tstepB; } }
        for (int t = 0; t < nt; t += 2) {
            const bool last = (t == nt - 2);
            if constexpr (Sched::DYN) { if (last) { has_next = S.unit_of(qs[(ui + 1) & 1], nxt); if (has_next) { nA = PG8_AP(nxt); nB = (const char*)g.Bt + (size_t)nxt.pn * tstepB; } } }
            const char* a1 = cA + (size_t)(t + 1) * kstep;
            const char* a2 = last ? nA : cA + (size_t)(t + 2) * kstep; const char* b2 = last ? nB : cB + (size_t)(t + 2) * kstep;
            const char* a3 = a2 + kstep; const char* b3 = b2 + kstep;
            if (last && has_next) S.a_ready(nxt);
            PG8_LDB(B0, 0, 0); PG8_LDB(B1, 0, 1); PG8_SCHED; PG8_LDA(At, 0, 0); PG8_STAGE(PG8_SA(1, 1), a1 + hstepA, voffA);
            PG8_WAIT_V(8); PG8_WAIT_L(0); PG8_BAR; PG8_MMA(0, 0, At, B0); PG8_MMA(0, 1, At, B1); PG8_BAR; PG8_SCHED;
            PG8_LDA(At, 0, 1); PG8_STAGE(PG8_SB(0, 0), b2, voffB); PG8_STAGE(PG8_SB(0, 1), b2 + hstepB, voffB); PG8_STAGE(PG8_SA(0, 0), a2, voffA);
            PG8_WAIT_V(8); PG8_WAIT_L(0); PG8_BAR; PG8_MMA(1, 0, At, B0); PG8_MMA(1, 1, At, B1); PG8_BAR; PG8_SCHED;
            PG8_LDB(B0, 1, 0); PG8_LDB(B1, 1, 1); PG8_SCHED; PG8_LDA(At, 1, 0); PG8_STAGE(PG8_SA(0, 1), a2 + hstepA, voffA);
            PG8_WAIT_V(8); PG8_WAIT_L(0); PG8_BAR; PG8_MMA(0, 0, At, B0); PG8_MMA(0, 1, At, B1); PG8_BAR; PG8_SCHED;
            PG8_LDA(At, 1, 1); PG8_STAGE(PG8_SB(1, 0), b3, voffB); PG8_STAGE(PG8_SB(1, 1), b3 + hstepB, voffB); PG8_STAGE(PG8_SA(1, 0), a3, voffA);
            PG8_WAIT_V(8); PG8_WAIT_L(0); PG8_BAR; PG8_MMA(1, 0, At, B0); PG8_MMA(1, 1, At, B1); PG8_BAR; PG8_SCHED;
        }
        if (wr == 0) PG8_BAR;
        {
#if GEMM32
            const int row0 = cur.pm * BM + wr * 64 + r32, col00 = cur.pn * BM + wc * 32 + 16 * hi;
#define PG8_EROW(cc) (row0 + ((cc) >> 3) * HALF + (((cc) >> 2) & 1) * 32)
#define PG8_ECOL(cc) (col00 + (((cc) >> 1) & 1) * HALF + ((cc) & 1) * 8)
#define PG8_EVAL(cc, j) acc[(cc) >> 3][((cc) >> 1) & 1][((cc) >> 2) & 1][8 * ((cc) & 1) + (j)]
#else
            const int row0 = cur.pm * BM + wr * 64 + fr, col00 = cur.pn * BM + wc * 32 + 8 * fq;
#define PG8_EROW(cc) (row0 + ((cc) >> 3) * HALF + (((cc) >> 1) & 3) * 16)
#define PG8_ECOL(cc) (col00 + ((cc) & 1) * HALF)
#define PG8_EVAL(cc, j) acc[(cc) >> 3][(cc) & 1][((cc) >> 1) & 3][(j) >> 2][(j) & 3]
#endif
            int e2 = 0; if constexpr (Sched::DYN) { if (tid == 0) e2 = S.pull(); }
            constexpr int NBT = sizeof(typename Epi::Regs) <= 8 ? 16 : (sizeof(typename Epi::Regs) <= 32 ? 8 : 4);
#pragma unroll
            for (int c0 = 0; c0 < 16; c0 += NBT) {
                typename Epi::Regs R[NBT];
#pragma unroll
                for (int c = 0; c < NBT; ++c) { const int cc = c0 + c; E.load(PG8_EROW(cc), PG8_ECOL(cc), R[c]); }
                PG8_SCHED;
#pragma unroll
                for (int c = 0; c < NBT; ++c) { const int cc = c0 + c;
                    const float _v[8] = {PG8_EVAL(cc, 0), PG8_EVAL(cc, 1), PG8_EVAL(cc, 2), PG8_EVAL(cc, 3), PG8_EVAL(cc, 4), PG8_EVAL(cc, 5), PG8_EVAL(cc, 6), PG8_EVAL(cc, 7)};
                    E.apply(PG8_EROW(cc), PG8_ECOL(cc), _v, R[c]); }
                PG8_SCHED;
            }
#undef PG8_EROW
#undef PG8_ECOL
#undef PG8_EVAL
            if constexpr (Sched::DYN) { if (tid == 0) qs[ui & 1] = e2; }
        }
        S.done(cur);
        if (!has_next) break;
        PG8_ZERO();
        cur = nxt; cA = nA; cB = nB; ++ui;
        if (wr == 1) PG8_BAR;
    }
    PG8_WAIT_V(0);
    PG8_BAR;
#undef PG8_AP
#undef PG8_ZERO
#undef PG8_SA
#undef PG8_SB
#undef PG8_STAGE
#undef PG8_LDA
#undef PG8_LDB
#undef PG8_MMA
#undef PG8_WAIT_V
#undef PG8_WAIT_L
#undef PG8_BAR
#undef PG8_SCHED
}

template <class Epi>
__device__ __forceinline__ void gemm_simple(const Gemm g, const Epi& E, int G, int wg) {
    const int tid = otid(), wid = tid >> 6, lane = tid & 63, fr = lane & 15, fq = lane >> 4;
    const int nbn = g.N / 32, nblk = (g.M / 16) * nbn;
    for (int it = wg * NWAVES + wid; it < nblk; it += G * NWAVES) {
        const int m0 = (it / nbn) * 16, n0 = (it % nbn) * 32;
        f32x4 acc0 = {0.f, 0.f, 0.f, 0.f}, acc1 = {0.f, 0.f, 0.f, 0.f};
        const bf16_t* ap = g.A + (size_t)(m0 + fr) * g.lda + 8 * fq;
        const bf16_t* bp0 = g.Bt + (size_t)(n0 + perm32_16(fr)) * g.K + 8 * fq;
        const bf16_t* bp1 = g.Bt + (size_t)(n0 + perm32_16(16 + fr)) * g.K + 8 * fq;
        for (int k0 = 0; k0 < g.K; k0 += 32) {
            const bf16x8 a = *(const bf16x8*)(ap + k0), b0 = *(const bf16x8*)(bp0 + k0), b1 = *(const bf16x8*)(bp1 + k0);
            acc0 = __builtin_amdgcn_mfma_f32_16x16x32_bf16(b0, a, acc0, 0, 0, 0);
            acc1 = __builtin_amdgcn_mfma_f32_16x16x32_bf16(b1, a, acc1, 0, 0, 0);
        }
        const float v[8] = {acc0[0], acc0[1], acc0[2], acc0[3], acc1[0], acc1[1], acc1[2], acc1[3]};
        typename Epi::Regs rg; E.load(m0 + fr, n0 + 8 * fq, rg); E.apply(m0 + fr, n0 + 8 * fq, v, rg);
    }
}
}

#ifndef GEMM_REPEAT
#define GEMM_REPEAT 1
#endif
template <class Epi>
__device__ __forceinline__ void run_gemm(LAS unsigned char* lds, const pg8::Gemm g, const Epi& E, int G, int wg, int rep = 1) {
#if FAST_GEMM
    if (rep < 0) { pg8::gemm_simple<Epi>(g, E, G, wg); return; }
    for (int rr = 0; rr < rep; ++rr) { pg8::StaticOrder S; S.init(g.M, g.N, G, wg); pg8::gemm_phase<Epi, pg8::StaticOrder>(lds, g, S, E); }
#else
    pg8::gemm_simple<Epi>(g, E, G, wg);
#endif
}
template <class Epi>
__device__ __forceinline__ void run_gemm_dyn(LAS unsigned char* lds, const pg8::Gemm g, const Epi& E, int G, int wg, unsigned* heads) {
#if FAST_GEMM && DYN_GEMM
    pg8::DynOrder S; S.init(g.M, g.N, wg, heads); pg8::gemm_phase<Epi, pg8::DynOrder>(lds, g, S, E);
#else
    run_gemm(lds, g, E, G, wg, 1);
#endif
}

constexpr float SSQ_SCALE = 16777216.f, SSQ_INV = 1.f / 16777216.f;
__device__ __forceinline__ void ssq_add(u64* dst, int row, const float (&v)[8]) {
    float s = 0.f;
#pragma unroll
    for (int j = 0; j < 8; ++j) s += v[j] * v[j];
#if GEMM32
    s = sum_xor32(s);
    if ((otid() & 63) < 32) atomicAdd(dst + row, (u64)(s * SSQ_SCALE));
#else
    s += swz_xor<16>(s); s = sum_xor32(s);
    if ((otid() & 63) < 16) atomicAdd(dst + row, (u64)(s * SSQ_SCALE));
#endif
}
__device__ __forceinline__ float ld_ssq(const u64* p) { return (float)__hip_atomic_load(p, __ATOMIC_RELAXED, __HIP_MEMORY_SCOPE_AGENT) * SSQ_INV; }
__device__ __forceinline__ void st_f32x8(float* p, const float (&v)[8]) { *(f32x4*)p = (f32x4){v[0], v[1], v[2], v[3]}; *(f32x4*)(p + 4) = (f32x4){v[4], v[5], v[6], v[7]}; }
__device__ __forceinline__ void ld_f32x8(const float* p, float (&v)[8]) { const f32x4 a = *(const f32x4*)p, b = *(const f32x4*)(p + 4); v[0] = a.x; v[1] = a.y; v[2] = a.z; v[3] = a.w; v[4] = b.x; v[5] = b.y; v[6] = b.z; v[7] = b.w; }
__device__ __forceinline__ void ld_bf16x8(const bf16* p, float (&v)[8]) { unpack8(*(const u32x4*)p, v); }

struct EpiInProj {
    const u64* ssq; u64* ssqc; bf16* proj; float* misc; int live = 1;
    struct Regs { float rs; };
    __device__ __forceinline__ void load(int row, int col0, Regs& r) const { r.rs = rsqrtf(ld_ssq(ssq + row) * (1.f / DM) + EPS); }
    __device__ __forceinline__ void apply(int row, int col0, const float (&a)[8], const Regs& r) const {
        float v[8];
#pragma unroll
        for (int j = 0; j < 8; ++j) v[j] = a[j] * r.rs;
        const int tile = col0 >> 8;
        if (tile == 60) { const int c = col0 - PC_KR; if (c < 128) st_f32x8(misc + (size_t)row * 128 + c, v); return; }
        if (tile >= 44) {
#pragma unroll
            for (int j = 0; j < 8; ++j) v[j] = sigmoidf_(v[j]);
        }
        *(u32x4*)(proj + (size_t)row * DINP + col0) = pack8(v);
        if (tile < 4 && live) ssq_add(ssqc + (size_t)(tile >> 1) * M, row, v);
    }
};
struct EpiScaleBf16 {
    const u64* ssq; float inv_n; bf16* O; int ldo;
    struct Regs { float rs; };
    __device__ __forceinline__ void load(int row, int col0, Regs& r) const { r.rs = ssq ? rsqrtf(ld_ssq(ssq + row) * inv_n + EPS) : 1.f; }
    __device__ __forceinline__ void apply(int row, int col0, const float (&a)[8], const Regs& r) const {
        float v[8];
#pragma unroll
        for (int j = 0; j < 8; ++j) v[j] = a[j] * r.rs;
        *(u32x4*)(O + (size_t)row * ldo + col0) = pack8(v);
    }
};
struct EpiQKV {
    const u64* ssqc; bf16* Q; bf16* KV;
    struct Regs { float rs; };
    __device__ __forceinline__ void load(int row, int col0, Regs& r) const { const bool isq = col0 < NH * QK; r.rs = rsqrtf(ld_ssq(ssqc + (isq ? 0 : M) + row) * (1.f / QL) + EPS); }
    __device__ __forceinline__ void apply(int row, int col0, const float (&a)[8], const Regs& r) const {
        float v[8];
#pragma unroll
        for (int j = 0; j < 8; ++j) v[j] = a[j] * r.rs;
        if (col0 < NH * QK) *(u32x4*)(Q + (size_t)row * (NH * QK) + col0) = pack8(v);
        else *(u32x4*)(KV + (size_t)row * (NH * 256) + (col0 - NH * QK)) = pack8(v);
    }
};
struct EpiGateF32 {
    const bf16* proj; bf16* T;
    struct Regs { u32x4 g; };
    __device__ __forceinline__ void load(int row, int col0, Regs& r) const { r.g = *(const u32x4*)(proj + (size_t)row * DINP + PC_G + col0); }
    __device__ __forceinline__ void apply(int row, int col0, const float (&a)[8], const Regs& r) const {
        float g[8], v[8]; unpack8(r.g, g);
#pragma unroll
        for (int j = 0; j < 8; ++j) v[j] = a[j] * g[j];
        *(u32x4*)(T + (size_t)row * DM + col0) = pack8(v);
    }
};
struct EpiMerge {
    const bf16* proj; const bf16* T; bf16* O;
    struct Regs { u32x4 g; u32x4 t; };
    __device__ __forceinline__ void load(int row, int col0, Regs& r) const { r.g = *(const u32x4*)(proj + (size_t)row * DINP + PC_G + DM + col0); r.t = *(const u32x4*)(T + (size_t)row * DM + col0); }
    __device__ __forceinline__ void apply(int row, int col0, const float (&a)[8], const Regs& r) const {
        float g[8], t[8], v[8]; unpack8(r.g, g); unpack8(r.t, t);
#pragma unroll
        for (int j = 0; j < 8; ++j) v[j] = t[j] + a[j] * g[j];
        *(u32x4*)(O + (size_t)row * DM + col0) = pack8(v);
    }
};
struct EpiResid {
    const bf16* XBo; bf16* XBn; u64* ssq_next; float live = 1.f;
    struct Regs { u32x4 x; };
    __device__ __forceinline__ void load(int row, int col0, Regs& r) const { r.x = *(const u32x4*)(XBo + (size_t)row * DM + col0); }
    __device__ __forceinline__ void apply(int row, int col0, const float (&a)[8], const Regs& r) const {
        float x[8]; unpack8(r.x, x);
#pragma unroll
        for (int j = 0; j < 8; ++j) x[j] += a[j] * live;
        *(u32x4*)(XBn + (size_t)row * DM + col0) = pack8(x);
        if (ssq_next && live != 0.f) ssq_add(ssq_next, row, x);
    }
};
struct EpiUp {
    const u64* ssq; bf16* U;
    struct Regs { float rs; };
    __device__ __forceinline__ void load(int row, int col0, Regs& r) const { r.rs = rsqrtf(ld_ssq(ssq + row) * (1.f / DM) + EPS); }
    __device__ __forceinline__ void apply(int row, int col0, const float (&a)[8], const Regs& r) const {
        float v[8];
#pragma unroll
        for (int j = 0; j < 8; ++j) { const float t = fmaxf(a[j] * r.rs, 0.f); v[j] = t * t; }
        *(u32x4*)(U + (size_t)row * DFF + col0) = pack8(v);
    }
};
struct EpiPleGate {
    const u64* ssq; const bf16* PE; const bf16* XBo; bf16* XBn; float* OUT; u64* ssq_next; float live = 1.f;
    struct Regs { float rs; u32x4 x; u32x4 pe; };
    __device__ __forceinline__ void load(int row, int col0, Regs& r) const { r.rs = rsqrtf(ld_ssq(ssq + row) * (1.f / DM) + EPS);
        r.x = *(const u32x4*)(XBo + (size_t)row * DM + col0); r.pe = *(const u32x4*)(PE + (size_t)row * DM + col0); }
    __device__ __forceinline__ void apply(int row, int col0, const float (&a)[8], const Regs& r) const {
        float x[8], pe[8]; unpack8(r.x, x); unpack8(r.pe, pe);
#pragma unroll
        for (int j = 0; j < 8; ++j) x[j] += pe[j] * sigmoidf_(a[j] * r.rs) * live;
        if (OUT) st_f32x8(OUT + (size_t)row * DM + col0, x);
        else *(u32x4*)(XBn + (size_t)row * DM + col0) = pack8(x);
        if (ssq_next && live != 0.f) ssq_add(ssq_next, row, x);
    }
};

__device__ __forceinline__ void transpose_item(const float* W, int K, int Nsrc, int nsrc0, const float* gain, bf16* WT, int ndst0, int k0, LAS float* scr, int lane) {
    f32x4 v[16];
    const int rq = lane >> 4, c4 = (lane & 15) * 4;
    if (nsrc0 >= 0) {
#pragma unroll
        for (int i = 0; i < 16; ++i) v[i] = *(const f32x4*)(W + (size_t)(k0 + 4 * i + rq) * Nsrc + nsrc0 + c4);
        if (gain) {
#pragma unroll
            for (int i = 0; i < 16; ++i) v[i] = v[i] * gain[k0 + 4 * i + rq];
        }
    } else {
#pragma unroll
        for (int i = 0; i < 16; ++i) v[i] = (f32x4){0.f, 0.f, 0.f, 0.f};
    }
#pragma unroll
    for (int hh = 0; hh < 2; ++hh) {
#pragma unroll
        for (int i = 0; i < 8; ++i) { LAS float* d = scr + (4 * i + rq) * 65 + c4; const f32x4 t = v[8 * hh + i]; d[0] = t.x; d[1] = t.y; d[2] = t.z; d[3] = t.w; }
        LDS_WAIT(); asm volatile("" ::: "memory");
        const int c = lane & 3, nq = lane >> 2;
#pragma unroll
        for (int j = 0; j < 4; ++j) { const int n = 16 * j + nq; const LAS float* s = scr + (8 * c) * 65 + n;
            u32x4 o; o.x = pk2(s[0 * 65], s[1 * 65]); o.y = pk2(s[2 * 65], s[3 * 65]); o.z = pk2(s[4 * 65], s[5 * 65]); o.w = pk2(s[6 * 65], s[7 * 65]);
            *(u32x4*)(WT + (size_t)(ndst0 + n) * K + k0 + 32 * hh + 8 * c) = o; }
        LDS_WAIT(); asm volatile("" ::: "memory");
    }
}
__host__ __device__ __forceinline__ int inproj_src_col(int n) {
    if (n < PC_Z) return n;
    if (n < PC_G) return n + 64;
    if (n < PC_KR) return n + 128;
    if (n < PC_DT) return n - PC_KR + 1024;
    if (n < PC_PAD) return n - PC_DT + 11328;
    return -1;
}
constexpr int I_IN = (DM / 64) * (DINP / 64), I_UQ = (QL / 64) * (NH * QK / 64), I_UKV = (KVL / 64) * (NH * 256 / 64), I_OM = (DM / 64) * (DM / 64), I_OS = (DI / 64) * (DM / 64),
              I_OUT = I_OM, I_UP = (DM / 64) * (DFF / 64), I_DN = (DFF / 64) * (DM / 64), I_PG = I_OM, I_PL = (PLE / 64) * (DM / 64),
              I_LAYER = I_IN + I_UQ + I_UKV + I_OM + I_OS + I_OUT + I_UP + I_DN + I_PG + I_PL;
__device__ __forceinline__ void prologue_weights(const float* const (&inp)[26], unsigned char* ws, LAS unsigned char* lds, int G, int wg, int l_lo, int l_hi) {
    const int wave = otid() >> 6, lane = otid() & 63;
    LAS float* scr = (LAS float*)(lds + RING_OFF + wave * 16384);
    for (int it = l_lo * I_LAYER + wg * NWAVES + wave; it < l_hi * I_LAYER; it += G * NWAVES) {
        const int l = it / I_LAYER; int r = it % I_LAYER;
        unsigned char* wl = ws + WS_W + (size_t)l * WL_BYTES;
        if (r < I_IN) { const int nblk = DINP / 64, kb = r / nblk, nb = r % nblk;
            transpose_item(inp[4] + (size_t)l * DM * DIN, DM, DIN, inproj_src_col(64 * nb), inp[3] + l * DM, (bf16*)(wl + WL_IN), 64 * nb, 64 * kb, scr, lane); continue; } r -= I_IN;
        if (r < I_UQ) { const int nblk = NH * QK / 64, kb = r / nblk, nb = r % nblk;
            transpose_item(inp[6] + (size_t)l * QL * NH * QK, QL, NH * QK, 64 * nb, inp[5] + l * QL, (bf16*)(wl + WL_UQ), 64 * nb, 64 * kb, scr, lane); continue; } r -= I_UQ;
        if (r < I_UKV) { const int nblk = NH * 256 / 64, kb = r / nblk, nb = r % nblk;
            transpose_item(inp[8] + (size_t)l * KVL * NH * 256, KVL, NH * 256, 64 * nb, inp[7] + l * KVL, (bf16*)(wl + WL_UKV), 64 * nb, 64 * kb, scr, lane); continue; } r -= I_UKV;
        if (r < I_OM) { const int nblk = DM / 64, kb = r / nblk, nb = r % nblk;
            transpose_item(inp[11] + (size_t)l * DM * DM, DM, DM, 64 * nb, nullptr, (bf16*)(wl + WL_OM), 64 * nb, 64 * kb, scr, lane); continue; } r -= I_OM;
        if (r < I_OS) { const int nblk = DM / 64, kb = r / nblk, nb = r % nblk;
            transpose_item(inp[18] + (size_t)l * DI * DM, DI, DM, 64 * nb, inp[17] + l * DI, (bf16*)(wl + WL_OS), 64 * nb, 64 * kb, scr, lane); continue; } r -= I_OS;
        if (r < I_OUT) { const int nblk = DM / 64, kb = r / nblk, nb = r % nblk;
            transpose_item(inp[19] + (size_t)l * DM * DM, DM, DM, 64 * nb, nullptr, (bf16*)(wl + WL_OUT), 64 * nb, 64 * kb, scr, lane); continue; } r -= I_OUT;
        if (r < I_UP) { const int nblk = DFF / 64, kb = r / nblk, nb = r % nblk;
            transpose_item(inp[21] + (size_t)l * DM * DFF, DM, DFF, 64 * nb, inp[20] + l * DM, (bf16*)(wl + WL_UP), 64 * nb, 64 * kb, scr, lane); continue; } r -= I_UP;
        if (r < I_DN) { const int nblk = DM / 64, kb = r / nblk, nb = r % nblk;
            transpose_item(inp[22] + (size_t)l * DFF * DM, DFF, DM, 64 * nb, nullptr, (bf16*)(wl + WL_DN), 64 * nb, 64 * kb, scr, lane); continue; } r -= I_DN;
        if (r < I_PG) { const int nblk = DM / 64, kb = r / nblk, nb = r % nblk;
            transpose_item(inp[24] + (size_t)l * DM * DM, DM, DM, 64 * nb, inp[23] + l * DM, (bf16*)(wl + WL_PG), 64 * nb, 64 * kb, scr, lane); continue; } r -= I_PG;
        { const int nblk = DM / 64, kb = r / nblk, nb = r % nblk;
            transpose_item(inp[25] + (size_t)l * PLE * DM, PLE, DM, 64 * nb, nullptr, (bf16*)(wl + WL_PL), 64 * nb, 64 * kb, scr, lane); }
    }
}
__device__ __forceinline__ void prologue_rows(const float* const (&inp)[26], float* out, unsigned char* ws, int G, int wg) {
    const int wave = otid() >> 6, lane = otid() & 63, gw = wg * NWAVES + wave, NGW = G * NWAVES;
    const float* x = inp[0]; bf16* XB = (bf16*)(ws + WS_XB); u64* ssq0 = (u64*)((unsigned*)(ws + WS_CTL) + CW_SSQX);
    for (int m = gw; m < M; m += NGW) {
        float s = 0.f;
#pragma unroll
        for (int j = 0; j < 8; ++j) { const f32x4 v = *(const f32x4*)(x + (size_t)m * DM + j * 256 + lane * 4);
            s += v.x * v.x + v.y * v.y + v.z * v.z + v.w * v.w;
            u32x2 o; o.x = pk2(v.x, v.y); o.y = pk2(v.z, v.w); *(u32x2*)(XB + (size_t)m * DM + j * 256 + lane * 4) = o; }
        s = wave_sum(s); if (lane == 0) ssq0[m] = (u64)(s * SSQ_SCALE);
    }
    {
        u64* z0 = (u64*)((unsigned*)(ws + WS_CTL) + CW_SSQX) + M; const int nz = (DEPTH * 3 - 1) * M + DEPTH * 2 * M;
        for (int i = wg * NTHR + otid(); i < nz; i += G * NTHR) z0[i] = 0ull;
    }
    const float* p = inp[1]; bf16* PB = (bf16*)(ws + WS_PB);
    for (size_t i = (size_t)wg * NTHR + otid(); i < (size_t)DEPTH * M * PLE / 8; i += (size_t)G * NTHR) { float v[8]; ld_f32x8(p + i * 8, v); *(u32x4*)(PB + i * 8) = pack8(v); }
    const int* pos = (const int*)inp[2]; float* COS = (float*)(ws + WS_COS); float* SIN = (float*)(ws + WS_SIN);
    for (int i = wg * NTHR + otid(); i < M * 32; i += G * NTHR) { const int m = i >> 5, k = i & 31;
        const float invf = 1.0f / (float)pow(10000.0, (double)k / 32.0);
        const float ang = (float)pos[m] * invf;
        COS[i] = (float)cos((double)ang); SIN[i] = (float)sin((double)ang); }
}

__device__ __forceinline__ void phase_kfin(const bf16* KVRAW, const float* MISC, const float* kw, const float* COS, const float* SIN, bf16* KF, LAS unsigned char* lds, int G, int wg) {
    const int tid = otid(), wave = __builtin_amdgcn_readfirstlane(tid >> 6), lane = tid & 63, hh = lane >> 2, q4 = lane & 3;
    LAS float* krl = (LAS float*)(lds + RING_OFF) + wave * 64;
    float wn[32];
#pragma unroll
    for (int j = 0; j < 32; j += 4) { const f32x4 t = *(const f32x4*)(kw + q4 * 32 + j); wn[j] = t.x; wn[j + 1] = t.y; wn[j + 2] = t.z; wn[j + 3] = t.w; }
    const float wr = kw[128 + lane];
    for (int m = wg * NWAVES + wave; m < M; m += G * NWAVES) {
        u32x4 raw[4];
#pragma unroll
        for (int i = 0; i < 4; ++i) raw[i] = *(const u32x4*)(KVRAW + (size_t)m * 4096 + hh * 256 + q4 * 32 + i * 8);
        const float kr = MISC[(size_t)m * 128 + lane], cs = COS[m * 32 + (lane & 31)], sn = SIN[m * 32 + (lane & 31)];
        float f[32], ss = 0.f;
#pragma unroll
        for (int i = 0; i < 4; ++i) { float t[8]; unpack8(raw[i], t);
#pragma unroll
            for (int j = 0; j < 8; ++j) { f[i * 8 + j] = t[j]; ss += t[j] * t[j]; } }
        ss += swz_xor<1>(ss); ss += swz_xor<2>(ss);
        const float rs = rsqrtf((ss + wave_sum(kr * kr)) * (1.f / QK) + EPS);
        const float t2 = kr * wr, o2 = get_xor32(t2, lane);
        krl[lane] = lane < 32 ? (t2 * cs - o2 * sn) : (o2 * sn + t2 * cs);
        bf16* o = KF + (size_t)m * (NH * QK) + hh * QK;
#pragma unroll
        for (int i = 0; i < 4; ++i) { float t[8];
#pragma unroll
            for (int j = 0; j < 8; ++j) t[j] = f[i * 8 + j] * rs * wn[i * 8 + j];
            *(u32x4*)(o + q4 * 32 + i * 8) = pack8(t); }
        LDS_WAIT();
#pragma unroll
        for (int i = 0; i < 2; ++i) { const f32x4 a0 = *(LAS const f32x4*)(krl + q4 * 16 + i * 8), a1 = *(LAS const f32x4*)(krl + q4 * 16 + i * 8 + 4);
            const float t[8] = {a0.x * rs, a0.y * rs, a0.z * rs, a0.w * rs, a1.x * rs, a1.y * rs, a1.z * rs, a1.w * rs};
            *(u32x4*)(o + 128 + q4 * 16 + i * 8) = pack8(t); }
        LDS_WAIT();
    }
}
__device__ __forceinline__ void phase_ssdpre(const bf16* PROJ, const float* MISC, const float* cw, const float* cb, const float* dtb, bf16* XC, float* DTS, int G, int wg) {
    const int tid = otid();
    for (int gid = wg * NTHR + tid; gid < (CONVD / 8) * (M / TC); gid += G * NTHR) {
        const int c0 = (gid % (CONVD / 8)) * 8, seg = gid / (CONVD / 8), m0 = seg * TC;
        float w0[8], w1[8], w2[8], w3[8], bs[8], xa[8], xb[8], xc[8];
        ld_f32x8(cw + c0, w0); ld_f32x8(cw + CONVD + c0, w1); ld_f32x8(cw + 2 * CONVD + c0, w2); ld_f32x8(cw + 3 * CONVD + c0, w3); ld_f32x8(cb + c0, bs);
        const bf16* src = PROJ + (size_t)m0 * DINP + PC_XBC + c0; bf16* dst = XC + (size_t)m0 * CONVD + c0;
        if (m0 % SEQ != 0) { ld_bf16x8(src - 3 * (size_t)DINP, xa); ld_bf16x8(src - 2 * (size_t)DINP, xb); ld_bf16x8(src - (size_t)DINP, xc); }
        else {
#pragma unroll
            for (int e = 0; e < 8; ++e) { xa[e] = 0.f; xb[e] = 0.f; xc[e] = 0.f; } }
        for (int t0 = 0; t0 < TC; t0 += 8) {
            u32x4 r[8];
#pragma unroll
            for (int i = 0; i < 8; ++i) r[i] = *(const u32x4*)(src + (size_t)(t0 + i) * DINP);
#pragma unroll
            for (int i = 0; i < 8; ++i) { float xd[8], acc[8]; unpack8(r[i], xd);
#pragma unroll
                for (int e = 0; e < 8; ++e) { acc[e] = siluf_(bs[e] + xa[e] * w0[e] + xb[e] * w1[e] + xc[e] * w2[e] + xd[e] * w3[e]); xa[e] = xb[e]; xb[e] = xc[e]; xc[e] = xd[e]; }
                *(u32x4*)(dst + (size_t)(t0 + i) * CONVD) = pack8(acc); }
        }
    }
    for (int i = wg * NTHR + tid; i < M * SH; i += G * NTHR) { const int m = i >> 6, h = i & 63;
        const float x = MISC[(size_t)m * 128 + 64 + h] + dtb[h], e = __expf(-fabsf(x));
        const float lp = e < 0.01f ? e * (1.f - e * (0.5f - e * (1.f / 3.f))) : __logf(1.f + e); DTS[i] = fmaxf(x, 0.f) + lp; }
}
__device__ __forceinline__ void phase_ssdnorm(const float* YPRE, const bf16* PROJ, bf16* Y, int G, int wg) {
    const int wave = otid() >> 6, lane = otid() & 63;
    for (int it = wg * NWAVES + wave; it < M * SG; it += G * NWAVES) {
        const int m = it >> 3, g = it & 7, c0 = g * 512 + lane * 8;
        float y[8], z[8]; ld_f32x8(YPRE + (size_t)m * DI + c0, y); ld_bf16x8(PROJ + (size_t)m * DINP + PC_Z + c0, z);
        float s = 0.f;
#pragma unroll
        for (int e = 0; e < 8; ++e) { y[e] *= siluf_(z[e]); s += y[e] * y[e]; }
        const float rs = rsqrtf(wave_sum(s) * (1.f / 512.f) + EPS);
#pragma unroll
        for (int e = 0; e < 8; ++e) y[e] *= rs;
        *(u32x4*)(Y + (size_t)m * DI + c0) = pack8(y);
    }
}

namespace attn {
typedef float f32x16 __attribute__((ext_vector_type(16)));
typedef short s16x4 __attribute__((ext_vector_type(4)));
constexpr int KB_BYTES = 64 * QK * 2, VB_BYTES = 64 * VD * 2;
constexpr int L_K0 = 0, L_K1 = KB_BYTES, L_V0 = 2 * KB_BYTES, L_V1 = 2 * KB_BYTES + VB_BYTES, L_WS = 2 * KB_BYTES + 2 * VB_BYTES;
constexpr float QSCALE = 0.07216878364870322f * 1.4426950408889634f;
constexpr float THR2 = 8.f;
#define ASBAR() __builtin_amdgcn_sched_barrier(0)
#ifndef ATT_PRIO
#define ATT_PRIO 0
#endif
#if ATT_PRIO
#define AT_PRIO(x) __builtin_amdgcn_s_setprio(x)
#else
#define AT_PRIO(x)
#endif
__device__ __forceinline__ int crow(int r, int hi) { return (r & 3) + 8 * (r >> 2) + 4 * hi; }
__device__ __forceinline__ float sm_moff(float m_reg) { return (m_reg < -1e29f) ? 0.f : m_reg; }
__device__ __forceinline__ void softSM(f32x16& p0, f32x16& p1, float& m_reg, float& alpha) {
    float pmax = p0[0];
#pragma unroll
    for (int r = 1; r < 16; ++r) pmax = fmaxf(pmax, p0[r]);
#pragma unroll
    for (int r = 0; r < 16; ++r) pmax = fmaxf(pmax, p1[r]);
    { auto rr = __builtin_amdgcn_permlane32_swap(__float_as_uint(pmax), __float_as_uint(pmax), false, false); pmax = fmaxf(__uint_as_float(rr[0]), __uint_as_float(rr[1])); }
    const float moff = sm_moff(m_reg);
    if (__builtin_expect(__all(pmax + moff - m_reg <= THR2), 1)) {
        alpha = 1.f;
#pragma unroll
        for (int r = 0; r < 16; ++r) p0[r] = __builtin_amdgcn_exp2f(p0[r]);
#pragma unroll
        for (int r = 0; r < 16; ++r) p1[r] = __builtin_amdgcn_exp2f(p1[r]);
    } else {
        const float mn = fmaxf(m_reg, pmax + moff), sh = mn - moff;
        alpha = __builtin_amdgcn_exp2f(m_reg - mn); m_reg = mn;
#pragma unroll
        for (int r = 0; r < 16; ++r) p0[r] = __builtin_amdgcn_exp2f(p0[r] - sh);
#pragma unroll
        for (int r = 0; r < 16; ++r) p1[r] = __builtin_amdgcn_exp2f(p1[r] - sh);
    }
}
__device__ __forceinline__ void finishSM(const f32x16& p0, const f32x16& p1, float alpha, float& l_reg, bf16x8& pa0, bf16x8& pa1, bf16x8& pa2, bf16x8& pa3) {
    typedef float f32x2_ __attribute__((ext_vector_type(2)));
    f32x2_ ps2 = (f32x2_){p0[0], p0[1]} + (f32x2_){p1[0], p1[1]};
#pragma unroll
    for (int r = 2; r < 16; r += 2) { ps2 += (f32x2_){p0[r], p0[r + 1]}; ps2 += (f32x2_){p1[r], p1[r + 1]}; }
    float ps = ps2.x + ps2.y;
    { auto rr = __builtin_amdgcn_permlane32_swap(__float_as_uint(ps), __float_as_uint(ps), false, false); ps = __uint_as_float(rr[0]) + __uint_as_float(rr[1]); }
    l_reg = l_reg * alpha + ps;
#define PK4(P, BASE, OUT) do { unsigned a0 = pk2(P[BASE + 0], P[BASE + 1]), a1 = pk2(P[BASE + 2], P[BASE + 3]);   \
    unsigned b0 = pk2(P[BASE + 4], P[BASE + 5]), b1 = pk2(P[BASE + 6], P[BASE + 7]);                              \
    u32x4 w = {a0, a1, b0, b1}; OUT = __builtin_bit_cast(bf16x8, w); } while (0)
    PK4(p0, 0, pa0); PK4(p0, 8, pa1); PK4(p1, 0, pa2); PK4(p1, 8, pa3);
#undef PK4
}
#define AT_KRD(dst, addr, OFF) asm volatile("ds_read_b128 %0, %1 offset:%2" : "=&v"(dst) : "v"(addr), "i"(OFF) : "memory")
#define AT_KWAIT(n) do { asm volatile("s_waitcnt lgkmcnt(" #n ")" ::: "memory"); ASBAR(); } while (0)
template <int KOFF> __device__ __forceinline__ void qkt(f32x16& p0, f32x16& p1, const int (&ka)[4], const bf16x8 (&qr)[12], float c0) {
    p0 = (f32x16){c0, c0, c0, c0, c0, c0, c0, c0, c0, c0, c0, c0, c0, c0, c0, c0}; p1 = p0;
    bf16x8 a0, b0, a1, b1, a2, b2, a3, b3;
    constexpr int RB = 32 * QK * 2;
    AT_KWAIT(0);
#define AT_KR(S, A, B) do { AT_KRD(A, ka[(S) & 3], KOFF + ((S) >> 2) * 128); AT_KRD(B, ka[(S) & 3], KOFF + ((S) >> 2) * 128 + RB); } while (0)
#define AT_STEP(S, A, B, AN, BN, W) do { if ((S) + 3 < 12) AT_KR((S) + 3, AN, BN); AT_KWAIT(W); \
        p0 = __builtin_amdgcn_mfma_f32_32x32x16_bf16(A, qr[(S)], p0, 0, 0, 0); p1 = __builtin_amdgcn_mfma_f32_32x32x16_bf16(B, qr[(S)], p1, 0, 0, 0); ASBAR(); } while (0)
    AT_KR(0, a0, b0); AT_KR(1, a1, b1); AT_KR(2, a2, b2);
    AT_PRIO(1);
    AT_STEP(0, a0, b0, a3, b3, 6); AT_STEP(1, a1, b1, a0, b0, 6); AT_STEP(2, a2, b2, a1, b1, 6); AT_STEP(3, a3, b3, a2, b2, 6);
    AT_STEP(4, a0, b0, a3, b3, 6); AT_STEP(5, a1, b1, a0, b0, 6); AT_STEP(6, a2, b2, a1, b1, 6); AT_STEP(7, a3, b3, a2, b2, 6);
    AT_STEP(8, a0, b0, a3, b3, 6); AT_STEP(9, a1, b1, a0, b0, 4); AT_STEP(10, a2, b2, a1, b1, 2); AT_STEP(11, a3, b3, a2, b2, 0);
#undef AT_STEP
#undef AT_KR
    AT_PRIO(0);
}
__device__ __forceinline__ void v_pos_src(int p, int& k, int& c) { const int s = p >> 5, kk = (s >> 2) * 8 + ((p & 31) >> 2); c = (s & 3) * 32 + (p & 3) * 8; k = kk; }
__device__ __forceinline__ int v_rd_base(int lane) { return ((lane & 3) << 3) | (((lane >> 2) & 3) << 6) | (((lane >> 4) & 1) << 5) | (((lane >> 5) & 1) << 8); }
constexpr int v_rd_off(int d0, int ks, int half) { return d0 * 512 + ks * 4096 + half * 2048; }
template <int OFF> __device__ __forceinline__ s16x4 tr_read(int vb) { s16x4 r; asm volatile("ds_read_b64_tr_b16 %0, %1 offset:%2" : "=&v"(r) : "v"(vb), "i"(OFF) : "memory"); return r; }
struct VFrag { s16x4 l0, h0, l1, h1, l2, h2, l3, h3; };
template <int D0, int VO> __device__ __forceinline__ void v_read(VFrag& f, int vb) {
    f.l0 = tr_read<VO + v_rd_off(D0, 0, 0)>(vb); f.h0 = tr_read<VO + v_rd_off(D0, 0, 1)>(vb); f.l1 = tr_read<VO + v_rd_off(D0, 1, 0)>(vb); f.h1 = tr_read<VO + v_rd_off(D0, 1, 1)>(vb);
    f.l2 = tr_read<VO + v_rd_off(D0, 2, 0)>(vb); f.h2 = tr_read<VO + v_rd_off(D0, 2, 1)>(vb); f.l3 = tr_read<VO + v_rd_off(D0, 3, 0)>(vb); f.h3 = tr_read<VO + v_rd_off(D0, 3, 1)>(vb);
}
#define PKV(L, H) (bf16x8){L[0], L[1], L[2], L[3], H[0], H[1], H[2], H[3]}
__device__ __forceinline__ void v_mma(f32x16& od, const VFrag& f, bf16x8 pa0, bf16x8 pa1, bf16x8 pa2, bf16x8 pa3) {
    od = __builtin_amdgcn_mfma_f32_32x32x16_bf16(pa0, PKV(f.l0, f.h0), od, 0, 0, 0);
    od = __builtin_amdgcn_mfma_f32_32x32x16_bf16(pa1, PKV(f.l1, f.h1), od, 0, 0, 0);
    od = __builtin_amdgcn_mfma_f32_32x32x16_bf16(pa2, PKV(f.l2, f.h2), od, 0, 0, 0);
    od = __builtin_amdgcn_mfma_f32_32x32x16_bf16(pa3, PKV(f.l3, f.h3), od, 0, 0, 0);
}
#undef PKV
template <int VO> __device__ __forceinline__ void pv_main(f32x16 (&o)[4], int vb, VFrag& fa, bf16x8 pa0, bf16x8 pa1, bf16x8 pa2, bf16x8 pa3) {
    VFrag fb, fc;
    AT_PRIO(1);
    v_read<1, VO>(fb, vb); AT_KWAIT(8);
    v_read<2, VO>(fc, vb); ASBAR(); v_mma(o[0], fa, pa0, pa1, pa2, pa3); ASBAR(); AT_KWAIT(8);
    v_read<3, VO>(fa, vb); ASBAR(); v_mma(o[1], fb, pa0, pa1, pa2, pa3); ASBAR(); AT_KWAIT(8);
    v_mma(o[2], fc, pa0, pa1, pa2, pa3); ASBAR(); AT_KWAIT(0);
    v_mma(o[3], fa, pa0, pa1, pa2, pa3);
    AT_PRIO(0);
}

__device__ __forceinline__ void attn_unit(int b, int h, int qb, const bf16* QRAW, const bf16* KF, const bf16* KVRAW, const float* qw, const float* COS, const float* SIN, bf16* AO, LAS unsigned char* lds) {
    const int tid = otid(), wid = __builtin_amdgcn_readfirstlane(tid >> 6), lane = tid & 63, r32 = lane & 31, hi = lane >> 5;
    LAS float* wsf = (LAS float*)(lds + L_WS) + wid * 64; LAS float* li_l = wsf; LAS float* al_l = wsf + 32;
    const int m = b * SEQ + qb * 256 + wid * 32 + r32;
    bf16x8 qr[12];
    {
        const bf16* qp = QRAW + (size_t)m * (NH * QK) + h * QK + hi * 8;
        u32x4 raw[12]; float ss = 0.f;
#pragma unroll
        for (int d0 = 0; d0 < 12; ++d0) { raw[d0] = *(const u32x4*)(qp + d0 * 16); float f[8]; unpack8(raw[d0], f);
#pragma unroll
            for (int j = 0; j < 8; ++j) ss += f[j] * f[j]; }
        ss = sum_xor32(ss);
        const float rs = rsqrtf(ss * (1.f / QK) + EPS) * QSCALE;
#pragma unroll
        for (int d0 = 0; d0 < 8; ++d0) { float f[8], w[8]; unpack8(raw[d0], f); ld_f32x8(qw + d0 * 16 + hi * 8, w);
#pragma unroll
            for (int j = 0; j < 8; ++j) f[j] = f[j] * rs * w[j];
            qr[d0] = __builtin_bit_cast(bf16x8, pack8(f)); }
#pragma unroll
        for (int t = 0; t < 2; ++t) { float x1[8], x2[8], w1[8], w2[8], c[8], s[8], o1[8], o2[8];
            unpack8(raw[8 + t], x1); unpack8(raw[10 + t], x2); ld_f32x8(qw + 128 + t * 16 + hi * 8, w1); ld_f32x8(qw + 160 + t * 16 + hi * 8, w2);
            ld_f32x8(COS + (size_t)m * 32 + t * 16 + hi * 8, c); ld_f32x8(SIN + (size_t)m * 32 + t * 16 + hi * 8, s);
#pragma unroll
            for (int j = 0; j < 8; ++j) { const float a = x1[j] * rs * w1[j], bq = x2[j] * rs * w2[j]; o1[j] = a * c[j] - bq * s[j]; o2[j] = a * s[j] + bq * c[j]; }
            qr[8 + t] = __builtin_bit_cast(bf16x8, pack8(o1)); qr[10 + t] = __builtin_bit_cast(bf16x8, pack8(o2)); }
    }
    const bf16* kbase = KF + (size_t)(b * SEQ) * (NH * QK) + h * QK;
    const bf16* vbase = KVRAW + (size_t)(b * SEQ) * 4096 + h * 256 + 128;
    unsigned koff[3], voff[2];
#pragma unroll
    for (int i = 0; i < 3; ++i) { const int p = i * 512 + tid, row = p / 24, cc = (p % 24) ^ (row & 7); koff[i] = (unsigned)(row * (NH * QK) + cc * 8) * 2u; }
#pragma unroll
    for (int i = 0; i < 2; ++i) { int k, c; v_pos_src(i * 512 + tid, k, c); voff[i] = (unsigned)(k * 4096 + c) * 2u; }
    const unsigned ldsw = (unsigned)wid * 1024u;
#define ATT_ISSUE_K(kb, key0) do { const char* _kg = (const char*)(kbase + (size_t)(key0) * (NH * QK)); \
        _Pragma("unroll") for (int _i = 0; _i < 3; ++_i) __builtin_amdgcn_global_load_lds((const unsigned*)(_kg + koff[_i]), (LAS unsigned*)(lds + (kb) + ldsw + _i * 8192), 16, 0, 0); } while (0)
#define ATT_ISSUE_V(vb_, key0) do { const char* _vg = (const char*)(vbase + (size_t)(key0) * 4096); \
        _Pragma("unroll") for (int _i = 0; _i < 2; ++_i) __builtin_amdgcn_global_load_lds((const unsigned*)(_vg + voff[_i]), (LAS unsigned*)(lds + (vb_) + ldsw + _i * 8192), 16, 0, 0); } while (0)
    float m_reg = -1e30f, l_reg = 0.f;
    f32x16 o[4];
#pragma unroll
    for (int d = 0; d < 4; ++d) o[d] = (f32x16){0.f, 0.f, 0.f, 0.f, 0.f, 0.f, 0.f, 0.f, 0.f, 0.f, 0.f, 0.f, 0.f, 0.f, 0.f, 0.f};
    const int nt = 4 * qb + 4, myc = 4 * qb + (wid >> 1);
    const int vrd = (int)(uintptr_t)(lds + L_V0) + v_rd_base(lane);
    int kad[4];
#pragma unroll
    for (int i = 0; i < 4; ++i) kad[i] = (int)(uintptr_t)lds + r32 * (QK * 2) + ((i * 32 + hi * 16) ^ ((r32 & 7) << 4));
    f32x16 p0, p1;
#define VMW(n) asm volatile("s_waitcnt vmcnt(" #n ")" ::: "memory")
#define HBAR() do { asm volatile("s_waitcnt lgkmcnt(0)" ::: "memory"); ASBAR(); __builtin_amdgcn_s_barrier(); ASBAR(); } while (0)
#define ATT_TILE(kb, vb_, j) do { if ((j) <= myc) { float alpha; bf16x8 pa0, pa1, pa2, pa3; VFrag fa; \
        qkt<(kb)>(p0, p1, kad, qr, -sm_moff(m_reg)); ASBAR(); \
        v_read<0, (vb_) - L_V0>(fa, vrd); ASBAR(); \
        softSM(p0, p1, m_reg, alpha); \
        if (__any(alpha < 1.f)) { if (hi == 0) al_l[r32] = alpha; asm volatile("s_waitcnt lgkmcnt(0)" ::: "memory"); \
            _Pragma("unroll") for (int d = 0; d < 4; ++d) _Pragma("unroll") for (int r = 0; r < 16; ++r) o[d][r] *= al_l[crow(r, hi)]; } \
        finishSM(p0, p1, alpha, l_reg, pa0, pa1, pa2, pa3); ASBAR(); \
        pv_main<(vb_) - L_V0>(o, vrd, fa, pa0, pa1, pa2, pa3); } } while (0)
    ATT_ISSUE_K(L_K0, 0); ATT_ISSUE_V(L_V0, 0);
    VMW(0); HBAR();
    for (int j = 0; j < nt; j += 2) {
        ATT_ISSUE_K(L_K1, (j + 1) * 64); ATT_ISSUE_V(L_V1, (j + 1) * 64); ASBAR();
        ATT_TILE(L_K0, L_V0, j); ASBAR(); VMW(0); HBAR();
        if (j + 2 < nt) { ATT_ISSUE_K(L_K0, (j + 2) * 64); ATT_ISSUE_V(L_V0, (j + 2) * 64); } ASBAR();
        ATT_TILE(L_K1, L_V1, j + 1); ASBAR(); VMW(0); HBAR();
    }
#undef ATT_TILE
#undef ATT_ISSUE_K
#undef ATT_ISSUE_V
    if (hi == 0) li_l[r32] = l_reg;
    asm volatile("s_waitcnt lgkmcnt(0)" ::: "memory");
    float rli[16];
#pragma unroll
    for (int r = 0; r < 16; ++r) rli[r] = __builtin_amdgcn_rcpf(li_l[crow(r, hi)]);
    bf16* ob = AO + (size_t)(b * SEQ + qb * 256 + wid * 32) * DM + h * VD;
#pragma unroll
    for (int r = 0; r < 16; ++r) { const int orow = crow(r, hi);
#pragma unroll
        for (int d0 = 0; d0 < 4; ++d0) ob[(size_t)orow * DM + d0 * 32 + r32] = (bf16)f2bf(o[d0][r] * rli[r]); }
    asm volatile("s_waitcnt lgkmcnt(0)" ::: "memory");
}
template <int ABL> __device__ __forceinline__ void phase(const bf16* QRAW, const bf16* KF, const bf16* KVRAW, const float* qw, const float* COS, const float* SIN, bf16* AO, LAS unsigned char* lds, int G, int wg) {
    for (int pr = wg; pr < NB * NH * 8; pr += G) {
        const int x = pr & 7, slot = pr >> 3, bh = x * 4 + (slot >> 3), pi = slot & 7, b = bh / NH, h = bh % NH;
#pragma unroll 1
        for (int u = 0; u < 2; ++u) attn_unit(b, h, u ? pi : 15 - pi, QRAW, KF, KVRAW, qw, COS, SIN, AO, lds);
    }
}
__device__ __forceinline__ void phase_dyn(const bf16* QRAW, const bf16* KF, const bf16* KVRAW, const float* qw, const float* COS, const float* SIN, bf16* AO, LAS unsigned char* lds, int wg, unsigned* head) {
    LAS volatile int* qs = (LAS volatile int*)(lds + QSLOT_OFF);
    for (;;) {
        __syncthreads();
        if (otid() == 0) qs[0] = (int)__hip_atomic_fetch_add(head, 1u, __ATOMIC_RELAXED, __HIP_MEMORY_SCOPE_AGENT);
        __syncthreads();
        const int e = qs[0];
        if (e >= 64) break;
        const int bh = (wg & 7) * 4 + (e & 3), qb = 15 - (e >> 2);
        attn_unit(bh / NH, bh % NH, qb, QRAW, KF, KVRAW, qw, COS, SIN, AO, lds);
    }
}
}

namespace ssd {
using attn::f32x16; using attn::s16x4; using attn::crow; using attn::v_rd_base; using attn::tr_read;
constexpr int L_BT = 0, L_XT = 16384, L_WSH = 16384 + 65536, L_SSQ = L_WSH + 8192, L_END = L_SSQ + 2048;
static_assert(L_END <= RING_BYTES, "ssd lds");
template <int NCS> __device__ __forceinline__ void vimg_src(int p, int& k, int& c) { const int s = p >> 5, kk = (s / NCS) * 8 + ((p & 31) >> 2); c = (s % NCS) * 32 + (p & 3) * 8; k = (kk & ~0xC) | ((kk & 4) << 1) | ((kk & 8) >> 1); }
template <int NCS> constexpr int vimg_off(int d0, int ks, int half) { return ((2 * ks + half) * NCS + d0) * 512; }
#define SSD_PKV(L, H) (bf16x8){L[0], L[1], L[2], L[3], H[0], H[1], H[2], H[3]}
#define SSD_LWAIT() do { asm volatile("s_waitcnt lgkmcnt(0)" ::: "memory"); __builtin_amdgcn_sched_barrier(0); } while (0)
constexpr f32x16 Z16 = {0.f, 0.f, 0.f, 0.f, 0.f, 0.f, 0.f, 0.f, 0.f, 0.f, 0.f, 0.f, 0.f, 0.f, 0.f, 0.f};
__device__ __forceinline__ float wave_scan64(float v, int lane) {
#pragma unroll
    for (int o = 1; o < 64; o <<= 1) { const float n = lane_up(v, o, lane); if (lane >= o) v += n; }
    return v;
}
__device__ __forceinline__ void load_x(const bf16* XC, int m0, int h, int lane, u32x4 (&v)[8]) {
#pragma unroll
    for (int i = 0; i < 8; ++i) { int k, c; vimg_src<2>(i * 64 + lane, k, c); v[i] = *(const u32x4*)(XC + (size_t)(m0 + k) * CONVD + h * HD + c); }
}
__device__ __forceinline__ void store_x(LAS unsigned char* xt, int lane, const u32x4 (&v)[8]) {
#pragma unroll
    for (int i = 0; i < 8; ++i) *(LAS u32x4*)(xt + (i * 64 + lane) * 16) = v[i];
}

__device__ __forceinline__ void phase_states(const bf16* XC, const float* DTS, const float* a_log, bf16* ST16, float* CDEC, LAS unsigned char* lds, int G, int wg) {
    for (int it = wg; it < NB * NCH * SG; it += G) {
        const int tid = otid(), wid = __builtin_amdgcn_readfirstlane(tid >> 6), lane = tid & 63, r32 = lane & 31, hi = lane >> 5;
        LAS unsigned char* xt = lds + L_XT + wid * 8192; LAS float* wsh = (LAS float*)(lds + L_WSH + wid * 1024);
        const int vrd = v_rd_base(lane);
        const int g = it % SG, bc = it / SG, m0 = bc * TC, h = g * HPG + wid;
        __syncthreads();
        {
            u32x4 v[2], xv[8];
#pragma unroll
            for (int i = 0; i < 2; ++i) { int k, c; vimg_src<4>(i * 512 + tid, k, c); v[i] = *(const u32x4*)(XC + (size_t)(m0 + k) * CONVD + DI + g * SN + c); }
            load_x(XC, m0, h, lane, xv);
            const float A = -__expf(a_log[h]), dt = DTS[(size_t)(m0 + lane) * SH + h];
#pragma unroll
            for (int i = 0; i < 2; ++i) *(LAS u32x4*)(lds + L_BT + (i * 512 + tid) * 16) = v[i];
            store_x(xt, lane, xv);
            const float ac = wave_scan64(dt * A, lane), last = __builtin_bit_cast(float, __builtin_amdgcn_readlane(__builtin_bit_cast(int, ac), 63));
            wsh[lane] = __expf(last - ac) * dt; if (lane == 63) CDEC[bc * SH + h] = __expf(last);
        }
        __syncthreads();
        f32x16 acc[2][4];
#pragma unroll
        for (int a = 0; a < 2; ++a)
#pragma unroll
            for (int b = 0; b < 4; ++b) acc[a][b] = Z16;
        const int xb = (int)(uintptr_t)xt + vrd, bb = (int)(uintptr_t)(lds + L_BT) + vrd;
#define SSD_KS(KSI) do { \
            const s16x4 xl0 = tr_read<vimg_off<2>(0, KSI, 0)>(xb), xh0 = tr_read<vimg_off<2>(0, KSI, 1)>(xb), xl1 = tr_read<vimg_off<2>(1, KSI, 0)>(xb), xh1 = tr_read<vimg_off<2>(1, KSI, 1)>(xb); \
            const s16x4 bl0 = tr_read<vimg_off<4>(0, KSI, 0)>(bb), bh0 = tr_read<vimg_off<4>(0, KSI, 1)>(bb), bl1 = tr_read<vimg_off<4>(1, KSI, 0)>(bb), bh1 = tr_read<vimg_off<4>(1, KSI, 1)>(bb); \
            const s16x4 bl2 = tr_read<vimg_off<4>(2, KSI, 0)>(bb), bh2 = tr_read<vimg_off<4>(2, KSI, 1)>(bb), bl3 = tr_read<vimg_off<4>(3, KSI, 0)>(bb), bh3 = tr_read<vimg_off<4>(3, KSI, 1)>(bb); \
            const f32x4 w0 = *(LAS const f32x4*)(wsh + 16 * KSI + 8 * hi), w1 = *(LAS const f32x4*)(wsh + 16 * KSI + 8 * hi + 4); \
            SSD_LWAIT(); \
            bf16x8 xa[2]; { const bf16x8 r0 = SSD_PKV(xl0, xh0), r1 = SSD_PKV(xl1, xh1); float f[8]; \
                unpack8(__builtin_bit_cast(u32x4, r0), f); f[0] *= w0.x; f[1] *= w0.y; f[2] *= w0.z; f[3] *= w0.w; f[4] *= w1.x; f[5] *= w1.y; f[6] *= w1.z; f[7] *= w1.w; xa[0] = __builtin_bit_cast(bf16x8, pack8(f)); \
                unpack8(__builtin_bit_cast(u32x4, r1), f); f[0] *= w0.x; f[1] *= w0.y; f[2] *= w0.z; f[3] *= w0.w; f[4] *= w1.x; f[5] *= w1.y; f[6] *= w1.z; f[7] *= w1.w; xa[1] = __builtin_bit_cast(bf16x8, pack8(f)); } \
            const bf16x8 bf0 = SSD_PKV(bl0, bh0), bf1 = SSD_PKV(bl1, bh1), bf2 = SSD_PKV(bl2, bh2), bf3 = SSD_PKV(bl3, bh3); \
            _Pragma("unroll") for (int a = 0; a < 2; ++a) { \
                acc[a][0] = __builtin_amdgcn_mfma_f32_32x32x16_bf16(xa[a], bf0, acc[a][0], 0, 0, 0); acc[a][1] = __builtin_amdgcn_mfma_f32_32x32x16_bf16(xa[a], bf1, acc[a][1], 0, 0, 0); \
                acc[a][2] = __builtin_amdgcn_mfma_f32_32x32x16_bf16(xa[a], bf2, acc[a][2], 0, 0, 0); acc[a][3] = __builtin_amdgcn_mfma_f32_32x32x16_bf16(xa[a], bf3, acc[a][3], 0, 0, 0); } } while (0)
        SSD_KS(0); SSD_KS(1); SSD_KS(2); SSD_KS(3);
#undef SSD_KS
        bf16* o = ST16 + ((size_t)bc * SH + h) * (HD * SN);
#pragma unroll
        for (int a = 0; a < 2; ++a)
#pragma unroll
            for (int r = 0; r < 16; ++r) { const int p = 32 * a + crow(r, hi);
#pragma unroll
                for (int b = 0; b < 4; ++b) o[p * SN + 32 * b + r32] = (bf16)f2bf(acc[a][b][r]); }
    }
}

__device__ __forceinline__ void phase_scan(bf16* ST16, const float* CDEC, int G, int wg) {
    constexpr int PER_B8 = SH * HD * SN / 8;
    for (int e = wg * NTHR + otid(); e < NB * PER_B8; e += G * NTHR) {
        const int b = e / PER_B8, r8 = e % PER_B8, h = r8 / (HD * SN / 8);
        float st[8];
#pragma unroll
        for (int j = 0; j < 8; ++j) st[j] = 0.f;
        bf16* base = ST16 + (size_t)b * NCH * (SH * HD * SN) + (size_t)r8 * 8;
        for (int c0 = 0; c0 < NCH; c0 += 8) {
            u32x4 raw[8]; float cd[8];
#pragma unroll
            for (int i = 0; i < 8; ++i) { raw[i] = *(const u32x4*)(base + (size_t)(c0 + i) * (SH * HD * SN)); cd[i] = CDEC[(b * NCH + c0 + i) * SH + h]; }
#pragma unroll
            for (int i = 0; i < 8; ++i) { float v[8]; unpack8(raw[i], v); *(u32x4*)(base + (size_t)(c0 + i) * (SH * HD * SN)) = pack8(st);
#pragma unroll
                for (int j = 0; j < 8; ++j) st[j] = st[j] * cd[i] + v[j]; }
        }
    }
}

constexpr int O_CT = 0, O_BT = 17408, O_XT = 34816, O_WSH = O_XT + 65536, O_SSQ = O_WSH + 8192, O_END = O_SSQ + 2048, O_ROW = 272;
static_assert(O_END <= RING_BYTES, "ssd out lds");
__device__ __forceinline__ void phase_out(const bf16* XC, const float* DTS, const float* a_log, const float* dskip, const bf16* ST16, const bf16* PROJ, bf16* Y, LAS unsigned char* lds, int G, int wg) {
    for (int it = wg; it < NB * NCH * SG; it += G) {
        const int tid = otid(), wid = __builtin_amdgcn_readfirstlane(tid >> 6), lane = tid & 63, r32 = lane & 31, hi = lane >> 5;
        LAS unsigned char* xt = lds + O_XT + wid * 8192; LAS float* acs = (LAS float*)(lds + O_WSH + wid * 1024); LAS float* dts = acs + 64; LAS float* rsl = acs + 128;
        LAS float* ssqx = (LAS float*)(lds + O_SSQ);
        const int vrd = v_rd_base(lane);
        LAS const unsigned char* cl = lds + O_CT + r32 * O_ROW + hi * 16;
        LAS const unsigned char* bl = lds + O_BT + r32 * O_ROW + hi * 16;
        const int g = it % SG, bc = it / SG, m0 = bc * TC, h = g * HPG + wid;
        __syncthreads();
        u32x4 cv[2], bv[2], xv[8];
#pragma unroll
        for (int i = 0; i < 2; ++i) { const int q = i * 512 + tid, row = q >> 4, c16 = q & 15;
            cv[i] = *(const u32x4*)(XC + (size_t)(m0 + row) * CONVD + DI + SG * SN + g * SN + c16 * 8); bv[i] = *(const u32x4*)(XC + (size_t)(m0 + row) * CONVD + DI + g * SN + c16 * 8); }
        const bf16* pg = ST16 + (((size_t)bc * SH + h) * HD + r32) * SN + 8 * hi;
        bf16x8 pf[2][8];
#pragma unroll
        for (int kn = 0; kn < 8; ++kn) { pf[0][kn] = *(const bf16x8*)(pg + kn * 16); pf[1][kn] = *(const bf16x8*)(pg + 32 * SN + kn * 16); }
        load_x(XC, m0, h, lane, xv);
        const float A_ = -__expf(a_log[h]), dt_ = DTS[(size_t)(m0 + lane) * SH + h];
        __builtin_amdgcn_sched_barrier(0);
#pragma unroll
        for (int i = 0; i < 2; ++i) { const int q = i * 512 + tid, row = q >> 4, c16 = q & 15;
            *(LAS u32x4*)(lds + O_CT + row * O_ROW + c16 * 16) = cv[i]; *(LAS u32x4*)(lds + O_BT + row * O_ROW + c16 * 16) = bv[i]; }
        store_x(xt, lane, xv);
        { acs[lane] = wave_scan64(dt_ * A_, lane); dts[lane] = dt_; }
        __builtin_amdgcn_sched_barrier(0);
        const float dk = dskip[h];
        __syncthreads();
        f32x16 acc[2][2];
#pragma unroll
        for (int a = 0; a < 2; ++a)
#pragma unroll
            for (int b = 0; b < 2; ++b) acc[a][b] = Z16;
#pragma unroll
        for (int kn = 0; kn < 8; ++kn) {
            const bf16x8 c0 = *(LAS const bf16x8*)(cl + kn * 32), c1 = *(LAS const bf16x8*)(cl + 32 * O_ROW + kn * 32);
            acc[0][0] = __builtin_amdgcn_mfma_f32_32x32x16_bf16(c0, pf[0][kn], acc[0][0], 0, 0, 0); acc[0][1] = __builtin_amdgcn_mfma_f32_32x32x16_bf16(c0, pf[1][kn], acc[0][1], 0, 0, 0);
            acc[1][0] = __builtin_amdgcn_mfma_f32_32x32x16_bf16(c1, pf[0][kn], acc[1][0], 0, 0, 0); acc[1][1] = __builtin_amdgcn_mfma_f32_32x32x16_bf16(c1, pf[1][kn], acc[1][1], 0, 0, 0);
        }
        u32x4 zv[8];
#pragma unroll
        for (int i = 0; i < 8; ++i) zv[i] = *(const u32x4*)(PROJ + (size_t)(m0 + i * 8 + (lane >> 3)) * DINP + PC_Z + h * HD + (lane & 7) * 8);
        LDS_WAIT();
#pragma unroll
        for (int a = 0; a < 2; ++a)
#pragma unroll
            for (int r = 0; r < 16; ++r) { const float ea = __expf(acs[32 * a + crow(r, hi)]); acc[a][0][r] *= ea; acc[a][1][r] *= ea; }
        const int xb = (int)(uintptr_t)xt + vrd;
#define SSD_TB(TB) do { f32x16 p0 = Z16, p1 = Z16; \
            _Pragma("unroll") for (int kn = 0; kn < 8; ++kn) { const bf16x8 cf = *(LAS const bf16x8*)(cl + (32 * TB) * O_ROW + kn * 32), b0 = *(LAS const bf16x8*)(bl + kn * 32); \
                p0 = __builtin_amdgcn_mfma_f32_32x32x16_bf16(b0, cf, p0, 0, 0, 0); \
                if (TB == 1) { const bf16x8 b1 = *(LAS const bf16x8*)(bl + 32 * O_ROW + kn * 32); p1 = __builtin_amdgcn_mfma_f32_32x32x16_bf16(b1, cf, p1, 0, 0, 0); } } \
            const int t = 32 * TB + r32; const float at = acs[t]; \
            _Pragma("unroll") for (int r = 0; r < 16; ++r) { const int s0 = crow(r, hi); \
                { const float w = (s0 <= t) ? __expf(fminf(at - acs[s0], 0.f)) * dts[s0] : 0.f; p0[r] = p0[r] * w + ((s0 == t) ? dk : 0.f); } \
                if (TB == 1) { const int s1 = 32 + s0; const float w = (s1 <= t) ? __expf(fminf(at - acs[s1], 0.f)) * dts[s1] : 0.f; p1[r] = p1[r] * w + ((s1 == t) ? dk : 0.f); } } \
            bf16x8 pa0, pa1, pa2, pa3; \
            { PK4_(p0, 0, pa0); PK4_(p0, 8, pa1); if (TB == 1) { PK4_(p1, 0, pa2); PK4_(p1, 8, pa3); } } \
            _Pragma("unroll") for (int pb = 0; pb < 2; ++pb) { \
                const s16x4 l0 = pb ? tr_read<vimg_off<2>(1, 0, 0)>(xb) : tr_read<vimg_off<2>(0, 0, 0)>(xb), h0 = pb ? tr_read<vimg_off<2>(1, 0, 1)>(xb) : tr_read<vimg_off<2>(0, 0, 1)>(xb); \
                const s16x4 l1 = pb ? tr_read<vimg_off<2>(1, 1, 0)>(xb) : tr_read<vimg_off<2>(0, 1, 0)>(xb), h1 = pb ? tr_read<vimg_off<2>(1, 1, 1)>(xb) : tr_read<vimg_off<2>(0, 1, 1)>(xb); \
                s16x4 l2 = l0, h2 = h0, l3 = l1, h3 = h1; \
                if (TB == 1) { l2 = pb ? tr_read<vimg_off<2>(1, 2, 0)>(xb) : tr_read<vimg_off<2>(0, 2, 0)>(xb); h2 = pb ? tr_read<vimg_off<2>(1, 2, 1)>(xb) : tr_read<vimg_off<2>(0, 2, 1)>(xb); \
                               l3 = pb ? tr_read<vimg_off<2>(1, 3, 0)>(xb) : tr_read<vimg_off<2>(0, 3, 0)>(xb); h3 = pb ? tr_read<vimg_off<2>(1, 3, 1)>(xb) : tr_read<vimg_off<2>(0, 3, 1)>(xb); } \
                SSD_LWAIT(); \
                acc[TB][pb] = __builtin_amdgcn_mfma_f32_32x32x16_bf16(pa0, SSD_PKV(l0, h0), acc[TB][pb], 0, 0, 0); acc[TB][pb] = __builtin_amdgcn_mfma_f32_32x32x16_bf16(pa1, SSD_PKV(l1, h1), acc[TB][pb], 0, 0, 0); \
                if (TB == 1) { acc[TB][pb] = __builtin_amdgcn_mfma_f32_32x32x16_bf16(pa2, SSD_PKV(l2, h2), acc[TB][pb], 0, 0, 0); acc[TB][pb] = __builtin_amdgcn_mfma_f32_32x32x16_bf16(pa3, SSD_PKV(l3, h3), acc[TB][pb], 0, 0, 0); } } } while (0)
#define PK4_(P, BASE, OUT) do { unsigned a0_ = pk2(P[BASE + 0], P[BASE + 1]), a1_ = pk2(P[BASE + 2], P[BASE + 3]); unsigned b0_ = pk2(P[BASE + 4], P[BASE + 5]), b1_ = pk2(P[BASE + 6], P[BASE + 7]); \
    auto r0_ = __builtin_amdgcn_permlane32_swap(a0_, b0_, false, false); auto r1_ = __builtin_amdgcn_permlane32_swap(a1_, b1_, false, false); \
    u32x4 w_ = {r0_[0], r1_[0], r0_[1], r1_[1]}; OUT = __builtin_bit_cast(bf16x8, w_); } while (0)
        SSD_TB(0); SSD_TB(1);
#undef SSD_TB
#undef PK4_
        LAS unsigned short* zt = (LAS unsigned short*)xt;
        {
            LDS_WAIT();
#pragma unroll
            for (int i = 0; i < 8; ++i) *(LAS u32x4*)(xt + (i * 64 + lane) * 16) = zv[i];
        }
        LDS_WAIT();
#pragma unroll
        for (int a = 0; a < 2; ++a)
#pragma unroll
            for (int r = 0; r < 16; ++r) { const int t = 32 * a + crow(r, hi);
                acc[a][0][r] *= siluf_(bf2f(zt[t * 64 + r32])); acc[a][1][r] *= siluf_(bf2f(zt[t * 64 + 32 + r32])); }
        LDS_WAIT();
        LAS float* red = (LAS float*)xt;
#pragma unroll
        for (int a = 0; a < 2; ++a)
#pragma unroll
            for (int r = 0; r < 16; ++r) red[(32 * a + crow(r, hi)) * 32 + r32] = acc[a][0][r] * acc[a][0][r] + acc[a][1][r] * acc[a][1][r];
        LDS_WAIT();
        { float sm = 0.f;
#pragma unroll
          for (int q = 0; q < 8; ++q) { const f32x4 v = *(LAS const f32x4*)(red + lane * 32 + q * 4); sm += (v.x + v.y) + (v.z + v.w); }
          ssqx[wid * 64 + lane] = sm; }
        __syncthreads();
        { float sm = 0.f;
#pragma unroll
          for (int w = 0; w < 8; ++w) sm += ssqx[w * 64 + lane];
          rsl[lane] = rsqrtf(sm * (1.f / 512.f) + EPS); }
        LDS_WAIT();
#pragma unroll
        for (int a = 0; a < 2; ++a)
#pragma unroll
            for (int r = 0; r < 16; ++r) { const int t = 32 * a + crow(r, hi); const float rs = rsl[t];
                zt[t * 64 + r32] = (unsigned short)f2bf(acc[a][0][r] * rs); zt[t * 64 + 32 + r32] = (unsigned short)f2bf(acc[a][1][r] * rs); }
        LDS_WAIT();
#pragma unroll
        for (int i = 0; i < 8; ++i) *(u32x4*)(Y + (size_t)(m0 + i * 8 + (lane >> 3)) * DI + h * HD + (lane & 7) * 8) = *(LAS const u32x4*)(xt + (i * 64 + lane) * 16);
    }
}
}

__device__ __forceinline__ void phase_attn_simple(const bf16* QRAW, const bf16* KF, const bf16* KVRAW, const float* qw, const float* COS, const float* SIN, bf16* AO, LAS unsigned char* lds, int G, int wg) {
    const int wave = otid() >> 6, lane = otid() & 63;
    LAS float* sc = (LAS float*)(lds + RING_OFF + wave * 16384);
    LAS float* qs = (LAS float*)(lds + EXTRA_OFF + wave * 768);
    const float w0 = qw[lane], w1 = qw[64 + lane], w2 = qw[128 + lane];
    for (int it = wg * NWAVES + wave; it < NB * NH * SEQ; it += G * NWAVES) {
        const int t = it % SEQ, bh = it / SEQ, h = bh % NH, b = bh / NH, m = b * SEQ + t;
        const bf16* qp = QRAW + (size_t)m * (NH * QK) + h * QK;
        const float a0 = bf2f(qp[lane]), a1 = bf2f(qp[64 + lane]), a2 = bf2f(qp[128 + lane]);
        const float ss = wave_sum(a0 * a0 + a1 * a1 + a2 * a2), rs = rsqrtf(ss * (1.f / QK) + EPS);
        const float t2 = a2 * rs * w2, o2 = get_xor32(t2, lane);
        const float c = COS[m * 32 + (lane & 31)], s = SIN[m * 32 + (lane & 31)];
        const float r2 = lane < 32 ? (t2 * c - o2 * s) : (o2 * s + t2 * c);
        const float scale = 0.07216878364870322f;
        qs[lane] = a0 * rs * w0 * scale; qs[64 + lane] = a1 * rs * w1 * scale; qs[128 + lane] = r2 * scale;
        LDS_WAIT();
        const int nk = (t / TC + 1) * TC;
        float mx = -3.0e38f;
        for (int j = lane; j < nk; j += 64) {
            const bf16* kp = KF + (size_t)(b * SEQ + j) * (NH * QK) + h * QK;
            float acc = 0.f;
#pragma unroll 4
            for (int d = 0; d < QK; d += 8) { float kv[8]; ld_bf16x8(kp + d, kv);
#pragma unroll
                for (int e = 0; e < 8; ++e) acc += qs[d + e] * kv[e]; }
            sc[j] = acc; mx = fmaxf(mx, acc);
        }
        mx = wave_max(mx);
        LDS_WAIT();
        float l = 0.f;
        for (int j = lane; j < nk; j += 64) { const float p = __expf(sc[j] - mx); sc[j] = p; l += p; }
        l = wave_sum(l);
        LDS_WAIT();
        float o0 = 0.f, o1 = 0.f;
        const bf16* vp = KVRAW + (size_t)(b * SEQ) * 4096 + h * 256 + 128;
#pragma unroll 8
        for (int j = 0; j < nk; ++j) { const float p = sc[j]; o0 += p * bf2f(vp[(size_t)j * 4096 + lane]); o1 += p * bf2f(vp[(size_t)j * 4096 + 64 + lane]); }
        const float il = 1.f / l;
        AO[(size_t)m * DM + h * VD + lane] = (bf16)f2bf(o0 * il); AO[(size_t)m * DM + h * VD + 64 + lane] = (bf16)f2bf(o1 * il);
        LDS_WAIT();
    }
}
__device__ __forceinline__ float wave_scan(float v, int lane) {
#pragma unroll
    for (int o = 1; o < 64; o <<= 1) { const float n = lane_up(v, o, lane); if (lane >= o) v += n; }
    return v;
}
__device__ __forceinline__ void phase_ssd_states(const bf16* XC, const float* DTS, const float* a_log, float* ST, float* CDEC, LAS unsigned char* lds, int G, int wg) {
    LAS float* wsh = (LAS float*)(lds + RING_OFF);
    const int tid = otid();
    for (int it = wg; it < NB * NCH * SH; it += G) {
        const int h = it % SH, bc = it / SH, m0 = bc * TC, g = h / HPG;
        __syncthreads();
        if (tid < 64) { const float A = -__expf(a_log[h]), dt = DTS[(size_t)(m0 + tid) * SH + h];
            const float ac = wave_scan(dt * A, tid), last = __builtin_bit_cast(float, __builtin_amdgcn_readlane(__builtin_bit_cast(int, ac), 63));
            wsh[tid] = __expf(last - ac) * dt; if (tid == 63) CDEC[bc * SH + h] = __expf(last); }
        __syncthreads();
        const int p = tid >> 3, n0 = (tid & 7) * 16;
        float acc[16];
#pragma unroll
        for (int e = 0; e < 16; ++e) acc[e] = 0.f;
        for (int s = 0; s < TC; ++s) {
            const float xw = bf2f(XC[(size_t)(m0 + s) * CONVD + h * HD + p]) * wsh[s];
            float b0[8], b1[8]; ld_bf16x8(XC + (size_t)(m0 + s) * CONVD + DI + g * SN + n0, b0); ld_bf16x8(XC + (size_t)(m0 + s) * CONVD + DI + g * SN + n0 + 8, b1);
#pragma unroll
            for (int e = 0; e < 8; ++e) { acc[e] += xw * b0[e]; acc[8 + e] += xw * b1[e]; }
        }
        float* o = ST + (((size_t)bc * SH + h) * HD + p) * SN + n0;
#pragma unroll
        for (int e = 0; e < 16; e += 4) *(f32x4*)(o + e) = (f32x4){acc[e], acc[e + 1], acc[e + 2], acc[e + 3]};
    }
}
__device__ __forceinline__ void phase_ssd_scan(float* ST, const float* CDEC, int G, int wg) {
    constexpr int PER_B = SH * HD * SN;
    for (int e = wg * NTHR + otid(); e < NB * PER_B; e += G * NTHR) {
        const int b = e / PER_B, r = e % PER_B, h = r / (HD * SN);
        float state = 0.f;
        for (int c = 0; c < NCH; ++c) { const size_t idx = (size_t)(b * NCH + c) * PER_B + r; const float tmp = ST[idx]; ST[idx] = state; state = state * CDEC[(b * NCH + c) * SH + h] + tmp; }
    }
}
__device__ __forceinline__ void phase_ssd_out(const bf16* XC, const float* DTS, const float* a_log, const float* dskip, const float* ST, float* YPRE, LAS unsigned char* lds, int G, int wg) {
    LAS float* Mm = (LAS float*)(lds + RING_OFF);
    LAS float* acs = (LAS float*)(lds + RING_OFF + 20480);
    LAS float* dts = acs + 64;
    const int tid = otid();
    for (int it = wg; it < NB * NCH * SH; it += G) {
        const int h = it % SH, bc = it / SH, m0 = bc * TC, g = h / HPG;
        __syncthreads();
        if (tid < 64) { const float A = -__expf(a_log[h]), dt = DTS[(size_t)(m0 + tid) * SH + h]; acs[tid] = wave_scan(dt * A, tid); dts[tid] = dt; }
        __syncthreads();
        for (int i = 0; i < 8; ++i) { const int e = tid + NTHR * i, t = e >> 6, s = e & 63;
            float v = 0.f;
            if (s <= t) { const bf16* cp = XC + (size_t)(m0 + t) * CONVD + DI + SG * SN + g * SN; const bf16* bp = XC + (size_t)(m0 + s) * CONVD + DI + g * SN;
                float dot = 0.f;
#pragma unroll 4
                for (int n = 0; n < SN; n += 8) { float cv[8], bv[8]; ld_bf16x8(cp + n, cv); ld_bf16x8(bp + n, bv);
#pragma unroll
                    for (int q = 0; q < 8; ++q) dot += cv[q] * bv[q]; }
                v = dot * __expf(acs[t] - acs[s]) * dts[s]; }
            Mm[t * 65 + s] = v; }
        __syncthreads();
        const int t = tid >> 3, p0 = (tid & 7) * 8;
        float y[8];
#pragma unroll
        for (int j = 0; j < 8; ++j) y[j] = 0.f;
        for (int s = 0; s < TC; ++s) { float xv[8]; ld_bf16x8(XC + (size_t)(m0 + s) * CONVD + h * HD + p0, xv); const float mv = Mm[t * 65 + s];
#pragma unroll
            for (int j = 0; j < 8; ++j) y[j] += mv * xv[j]; }
        const float ea = __expf(acs[t]), dk = dskip[h];
        const bf16* cp = XC + (size_t)(m0 + t) * CONVD + DI + SG * SN + g * SN;
        float xt[8]; ld_bf16x8(XC + (size_t)(m0 + t) * CONVD + h * HD + p0, xt);
#pragma unroll
        for (int j = 0; j < 8; ++j) { const float* pp = ST + (((size_t)bc * SH + h) * HD + p0 + j) * SN;
            float dot = 0.f;
#pragma unroll 4
            for (int n = 0; n < SN; n += 8) { float cv[8], pv[8]; ld_bf16x8(cp + n, cv); ld_f32x8(pp + n, pv);
#pragma unroll
                for (int q = 0; q < 8; ++q) dot += cv[q] * pv[q]; }
            y[j] += ea * dot + dk * xt[j]; }
        st_f32x8(YPRE + (size_t)(m0 + t) * DI + h * HD + p0, y);
    }
}

#ifndef CHORE_OVERLAP
#define CHORE_OVERLAP 0
#endif
#ifndef CHORE_ATTN
#define CHORE_ATTN 0
#endif
#ifndef CHORE_CONV
#define CHORE_CONV CHORE_OVERLAP
#endif
#ifndef CHORE_W
#define CHORE_W CHORE_OVERLAP
#endif
#ifndef NCV
#define NCV 8
#endif
#ifndef TIM_WG
#define TIM_WG 0
#endif
#ifndef REP_IN
#define REP_IN 1
#endif
#ifndef REP_RES
#define REP_RES 1
#endif
#ifndef REP_DN
#define REP_DN 1
#endif
#ifndef REP_SCAN
#define REP_SCAN 1
#endif
#ifndef REP_BAR
#define REP_BAR 1
#endif
#ifndef REP_PRO
#define REP_PRO 1
#endif
#ifndef REP_THIN
#define REP_THIN 1
#endif
#ifndef ROT
#define ROT 7
#endif
#ifndef JIT_PHASE
#define JIT_PHASE 3
#endif
#define JIT_AT(p) (JIT_W && JIT_PHASE == (p) && l + 1 < DEPTH && !(G == 256 && DYN_GEMM && CHORE_W) && !(G == 256 && (CHORE_ATTN & 2)))
#ifndef ROT_SH
#define ROT_SH 3
#endif
#define ROT_B(bit) (((ROT) >> (bit)) & 1 && ((wg >> ROT_SH) & 1))
#ifndef ATT_ABL
#define ATT_ABL 0
#endif
#ifndef REP_ATTN
#define REP_ATTN 1
#endif
#ifndef REP_SSD
#define REP_SSD 1
#endif
#ifndef ATTN_REPEAT
#define ATTN_REPEAT 1
#endif
#ifndef SLOW4
#define SLOW4 1
#endif
constexpr int PPL = (FAST_SSD && FAST_ATTN) ? 10 : (FAST_SSD ? 13 : 14), NPH = 1 + DEPTH * PPL;
struct Args { const float* in[26]; float* out; unsigned char* ws; int ph_lo, ph_hi; };
__global__ void __launch_bounds__(NTHR, 2) fwd(Args args) {
    extern __shared__ __attribute__((aligned(16))) unsigned char lds_[];
    LAS unsigned char* lds = (LAS unsigned char*)lds_;
    const int G = gridDim.x, wg = blockIdx.x;
    for (int u = threadIdx.x; u < (LDS_BYTES - LDSCTL_OFF) / 4; u += NTHR) ((LAS unsigned*)(lds + LDSCTL_OFF))[u] = 0u;
    __syncthreads();
    otid_init();
    __syncthreads();
    unsigned char* const ws0 = args.ws;
    unsigned* const ctl0 = (unsigned*)(ws0 + WS_CTL);
    const int lo = args.ph_lo, hi = args.ph_hi;
    XcdBarrier bar; bar.bar = ctl0 + CW_BAR; bar.x = 0; bar.st = (volatile LAS unsigned*)(lds + MISC_OFF) + 8;
    if (hi - lo > 1) bar = xcd_barrier_post(ctl0 + CW_BAR, (volatile LAS unsigned*)(lds + MISC_OFF) + 8);
#define INP(i) (args.in[i])
#define WSP(T, off) ((T*)(ws + (off)))
#define X (args.out)
#define SSQX ((u64*)(ctl + CW_SSQX))
#define SSQC ((u64*)(ctl + CW_SSQC))
#define XB0 WSP(bf16, WS_XB)
#define XB1 WSP(bf16, WS_XB1)
#define XB2 WSP(bf16, WS_XB2)
#define PROJ WSP(bf16, WS_PROJ)
#define U WSP(bf16, WS_U)
#define MISC WSP(float, WS_MISC)
#define QRAW WSP(bf16, WS_QRAW)
#define KVRAW WSP(bf16, WS_KVRAW)
#define KF WSP(bf16, WS_KF)
#define AO WSP(bf16, WS_AO)
#define XC WSP(bf16, WS_XC)
#define DTS WSP(float, WS_DTS)
#define CDEC WSP(float, WS_CDEC)
#define ST WSP(float, WS_ST)
#define YPRE WSP(float, WS_YPRE)
#define Y WSP(bf16, WS_Y)
#define TMPF WSP(float, WS_TMPF)
#define MERGED WSP(bf16, WS_MERGED)
#define PE WSP(bf16, WS_PE)
#define PB WSP(bf16, WS_PB)
#define COS WSP(float, WS_COS)
#define SIN WSP(float, WS_SIN)
    int ph = 0;
#if defined(TIM_KIND)
    unsigned long long tim_acc = 0ull; const unsigned long long clk0 = __builtin_amdgcn_s_memtime();
#define TIM_SEL(kind) (((TIM_KIND) >> ((kind) + 1)) & 1)
#define PHASE(...) do { if (lo <= ph && ph < hi) { const int kind_ = (ph == 0) ? -1 : (ph - 1) % PPL; const unsigned long long tA = __builtin_amdgcn_s_memrealtime(); \
        { unsigned char* ws = ws0; asm volatile("" : "+s"(ws)); unsigned* ctl = (unsigned*)(ws + WS_CTL); __VA_ARGS__; } const unsigned long long tB = __builtin_amdgcn_s_memrealtime(); \
        if (ph + 1 < hi) xcd_barrier(bar); const unsigned long long tC = __builtin_amdgcn_s_memrealtime(); \
        if (TIM_SEL(kind_)) tim_acc += (TIM_PART == 0) ? (tB - tA) : ((TIM_PART == 1) ? (tC - tB) : (tC - tA)); } ++ph; } while (0)
#else
#define PHASE(...) do { if (lo <= ph && ph < hi) { { unsigned char* ws = ws0; asm volatile("" : "+s"(ws)); unsigned* ctl = (unsigned*)(ws + WS_CTL); __VA_ARGS__; } if (ph + 1 < hi) for (int rb = 0; rb < REP_BAR; ++rb) xcd_barrier(bar); } ++ph; } while (0)
#endif
#ifndef LABEL_BAR
#define LABEL_BAR 1
#endif
    unsigned lb_done = 0u;
#define LBAR() do { if (LABEL_BAR && G == 256 && hi - lo > 1) { asm volatile("s_waitcnt vmcnt(0)" ::: "memory"); __syncthreads(); \
            if (otid() == 0) { unsigned* w_ = ctl0 + 8192 + 64 * (wg & 7); __builtin_amdgcn_fence(__ATOMIC_RELEASE, "agent"); asm volatile("s_waitcnt vmcnt(0)" ::: "memory"); \
                (void)__hip_atomic_fetch_add(w_, 1u, __ATOMIC_RELAXED, __HIP_MEMORY_SCOPE_AGENT); const unsigned tgt_ = 32u * (lb_done + 1u); unsigned sp_ = 0u; \
                while (__hip_atomic_load(w_, __ATOMIC_RELAXED, __HIP_MEMORY_SCOPE_AGENT) < tgt_ && ++sp_ < (1u << 20)) __builtin_amdgcn_s_sleep(1); \
                __builtin_amdgcn_fence(__ATOMIC_ACQUIRE, "agent"); asm volatile("s_waitcnt vmcnt(0)" ::: "memory"); } \
            __syncthreads(); ++lb_done; } else xcd_barrier(bar); } while (0)
#define PHASE_L(...) do { if (lo <= ph && ph < hi) { { unsigned char* ws = ws0; asm volatile("" : "+s"(ws)); unsigned* ctl = (unsigned*)(ws + WS_CTL); __VA_ARGS__; } if (ph + 1 < hi) LBAR(); } ++ph; } while (0)

    PHASE({ for (int rr = 0; rr < REP_PRO; ++rr) { prologue_weights(args.in, ws, lds, G, wg, 0, JIT_W ? 1 : DEPTH); prologue_rows(args.in, X, ws, G, wg); } });

#pragma unroll 1
    for (int l = 0; l < DEPTH; ++l) {
#define wl (ws + WS_W + (size_t)l * WL_BYTES)
#define ssq0 (SSQX + (size_t)(l * 3 + 0) * M)
#define ssq1 (SSQX + (size_t)(l * 3 + 1) * M)
#define ssq2 (SSQX + (size_t)(l * 3 + 2) * M)
#define ssqn ((l + 1 < DEPTH) ? SSQX + (size_t)((l + 1) * 3) * M : (u64*)nullptr)
#define ssqc (SSQC + (size_t)l * 2 * M)
#define QH(k) (ctl + CW_Q + ((l * 5 + (k)) * 8) * 64)
#if FAST_SSD && FAST_ATTN
        PHASE({ pg8::Gemm g{XB0, (const bf16*)(wl + WL_IN), M, DINP, DM, DM}; EpiInProj E{ssq0, ssqc, PROJ, MISC}; run_gemm_dyn(lds, g, E, G, wg, QH(0));
                { pg8::Gemm g2{PB + (size_t)l * M * PLE, (const bf16*)(wl + WL_PL), M, DM, PLE, PLE}; EpiScaleBf16 E2{nullptr, 0.f, PE, DM}; run_gemm_dyn(lds, g2, E2, G, wg, QH(3)); } });
        PHASE({ if (G == 256 && DYN_GEMM && CHORE_CONV) { if ((wg >> 3) < NCV) { phase_ssdpre(PROJ, MISC, INP(12) + (size_t)l * CW * CONVD, INP(13) + (size_t)l * CONVD, INP(14) + l * SH, XC, DTS, NCV * 8, (wg & 7) * NCV + (wg >> 3)); __syncthreads(); } }
                { pg8::Gemm g{PROJ + PC_CQ, (const bf16*)(wl + WL_UQ), M, NH * QK, QL, DINP}; EpiScaleBf16 E{ssqc, 1.f / QL, QRAW, NH * QK}; run_gemm_dyn(lds, g, E, G, wg, QH(1)); }
                { pg8::Gemm g{PROJ + PC_CKV, (const bf16*)(wl + WL_UKV), M, NH * 256, KVL, DINP}; EpiScaleBf16 E{ssqc + M, 1.f / KVL, KVRAW, NH * 256}; run_gemm_dyn(lds, g, E, G, wg, QH(2)); }
                if (!(G == 256 && DYN_GEMM && CHORE_CONV)) phase_ssdpre(PROJ, MISC, INP(12) + (size_t)l * CW * CONVD, INP(13) + (size_t)l * CONVD, INP(14) + l * SH, XC, DTS, G, wg); });
        PHASE({ if (!ROT_B(4)) { phase_kfin(KVRAW, MISC, INP(10) + l * QK, COS, SIN, KF, lds, G, wg); __syncthreads(); }
                ssd::phase_states(XC, DTS, INP(15) + l * SH, (bf16*)ST, CDEC, lds, G, wg);
                if (ROT_B(4)) { __syncthreads(); phase_kfin(KVRAW, MISC, INP(10) + l * QK, COS, SIN, KF, lds, G, wg); } });
        PHASE({ if (G == 256 && CHORE_ATTN) {
                    if ((wg >> 3) < NCV) { const int ci = (wg & 7) * NCV + (wg >> 3);
                        if (CHORE_ATTN & 1) ssd::phase_scan((bf16*)ST, CDEC, NCV * 8, ci);
                        if ((CHORE_ATTN & 2) && JIT_W && l + 1 < DEPTH) prologue_weights(args.in, ws, lds, NCV * 8, ci, l + 1, l + 2); }
                    attn::phase_dyn(QRAW, KF, KVRAW, INP(9) + l * QK, COS, SIN, AO, lds, wg, ctl + CW_AQ + (l * 8 + (wg & 7)) * 64);
                    if (!(CHORE_ATTN & 1)) ssd::phase_scan((bf16*)ST, CDEC, G, wg);
                } else {
                    if (ROT_B(0)) { ssd::phase_scan((bf16*)ST, CDEC, G, wg); if (JIT_AT(3)) { __syncthreads(); prologue_weights(args.in, ws, lds, G, wg, l + 1, l + 2); __syncthreads(); } }
                    for (int rr = 0; rr < REP_ATTN - 1; ++rr) attn::phase<ATT_ABL>(QRAW, KF, KVRAW, INP(9) + l * QK, COS, SIN, AO, lds, G, wg);
                    attn::phase<0>(QRAW, KF, KVRAW, INP(9) + l * QK, COS, SIN, AO, lds, G, wg);
                    if (!ROT_B(0)) { for (int rr = 0; rr < REP_SCAN; ++rr) ssd::phase_scan((bf16*)ST, CDEC, G, wg); if (JIT_AT(3)) { __syncthreads(); prologue_weights(args.in, ws, lds, G, wg, l + 1, l + 2); } } } });
        PHASE({ if (!ROT_B(1)) { for (int rr = 0; rr < REP_SSD; ++rr) ssd::phase_out(XC, DTS, INP(15) + l * SH, INP(16) + l * SH, (const bf16*)ST, PROJ, Y, lds, G, wg); __syncthreads(); }
                { pg8::Gemm g{AO, (const bf16*)(wl + WL_OM), M, DM, DM, DM}; EpiGateF32 E{PROJ, (bf16*)TMPF}; run_gemm(lds, g, E, G, wg, GEMM_REPEAT); }
                if (ROT_B(1)) { __syncthreads(); ssd::phase_out(XC, DTS, INP(15) + l * SH, INP(16) + l * SH, (const bf16*)ST, PROJ, Y, lds, G, wg); } });
        PHASE_L({ pg8::Gemm g{Y, (const bf16*)(wl + WL_OS), M, DM, DI, DI}; EpiMerge E{PROJ, (const bf16*)TMPF, MERGED}; run_gemm(lds, g, E, G, wg, GEMM_REPEAT); });
        PHASE_L({ pg8::Gemm g{MERGED, (const bf16*)(wl + WL_OUT), M, DM, DM, DM}; EpiResid E{XB0, XB1, ssq1}; run_gemm(lds, g, E, G, wg, SLOW4); for (int rr = 1; rr < REP_RES; ++rr) { EpiResid E2{XB0, XB1, ssq1, 0.f}; run_gemm(lds, g, E2, G, wg, 1); } });
        PHASE_L({ if (JIT_W && l + 1 < DEPTH && G == 256 && DYN_GEMM && CHORE_W) { if ((wg >> 3) < NCV) { prologue_weights(args.in, ws, lds, NCV * 8, (wg & 7) * NCV + (wg >> 3), l + 1, l + 2); __syncthreads(); } }
                pg8::Gemm g{XB1, (const bf16*)(wl + WL_UP), M, DFF, DM, DM}; EpiUp E{ssq1, U}; run_gemm_dyn(lds, g, E, G, wg, QH(4)); });
        PHASE_L({ pg8::Gemm g{U, (const bf16*)(wl + WL_DN), M, DM, DFF, DFF}; EpiResid E{XB1, XB2, ssq2}; run_gemm(lds, g, E, G, wg, SLOW4); for (int rr = 1; rr < REP_DN; ++rr) { EpiResid E2{XB1, XB2, ssq2, 0.f}; run_gemm(lds, g, E2, G, wg, 1); } });
        PHASE_L({ if (ROT_B(2) && JIT_AT(9)) { prologue_weights(args.in, ws, lds, G, wg, l + 1, l + 2); __syncthreads(); }
                pg8::Gemm g{XB2, (const bf16*)(wl + WL_PG), M, DM, DM, DM}; EpiPleGate E{ssq2, PE, XB2, XB0, (l + 1 < DEPTH) ? (float*)nullptr : X, ssqn}; run_gemm(lds, g, E, G, wg, SLOW4); for (int rr = 1; rr < REP_RES; ++rr) { EpiPleGate E2{ssq2, PE, XB2, XB0, (l + 1 < DEPTH) ? (float*)nullptr : X, ssqn, 0.f}; run_gemm(lds, g, E2, G, wg, 1); }
                if (!ROT_B(2) && JIT_AT(9)) { __syncthreads(); prologue_weights(args.in, ws, lds, G, wg, l + 1, l + 2); } });
#else
#error "the simple-loop phase program was retired together with the f32 residual buffer; build with FAST_SSD and FAST_ATTN"
#if 0
        PHASE({ pg8::Gemm g{XB0, (const bf16*)(wl + WL_IN), M, DINP, DM, DM}; EpiInProj E{ssq0, ssqc, PROJ, MISC}; run_gemm(lds, g, E, G, wg, SLOW4); });
        PHASE({ { pg8::Gemm g{PROJ + PC_CQ, (const bf16*)(wl + WL_UQ), M, NH * QK, QL, DINP}; EpiScaleBf16 E{ssqc, 1.f / QL, QRAW, NH * QK}; run_gemm(lds, g, E, G, wg, GEMM_REPEAT); }
                { pg8::Gemm g{PROJ + PC_CKV, (const bf16*)(wl + WL_UKV), M, NH * 256, KVL, DINP}; EpiScaleBf16 E{ssqc + M, 1.f / KVL, KVRAW, NH * 256}; run_gemm(lds, g, E, G, wg, GEMM_REPEAT); }
                { pg8::Gemm g{PB + (size_t)l * M * PLE, (const bf16*)(wl + WL_PL), M, DM, PLE, PLE}; EpiScaleBf16 E{nullptr, 0.f, PE, DM}; run_gemm(lds, g, E, G, wg, GEMM_REPEAT); } });
        PHASE({ for (int rr = 0; rr < REP_THIN; ++rr) { phase_kfin(KVRAW, MISC, INP(10) + l * QK, COS, SIN, KF, lds, G, wg);
                phase_ssdpre(PROJ, MISC, INP(12) + (size_t)l * CW * CONVD, INP(13) + (size_t)l * CONVD, INP(14) + l * SH, XC, DTS, G, wg); } });

#if FAST_ATTN
        PHASE({ for (int rr = 0; rr < REP_ATTN - 1; ++rr) attn::phase<ATT_ABL>(QRAW, KF, KVRAW, INP(9) + l * QK, COS, SIN, AO, lds, G, wg);
                    attn::phase<0>(QRAW, KF, KVRAW, INP(9) + l * QK, COS, SIN, AO, lds, G, wg); });
#else
        PHASE({ phase_attn_simple(QRAW, KF, KVRAW, INP(9) + l * QK, COS, SIN, AO, lds, G, wg); });
#endif

#if FAST_SSD
        PHASE({ for (int rr = 0; rr < REP_SSD; ++rr) ssd::phase_states(XC, DTS, INP(15) + l * SH, (bf16*)ST, CDEC, lds, G, wg); });
        PHASE({ ssd::phase_scan((bf16*)ST, CDEC, G, wg); });
        PHASE({ for (int rr = 0; rr < REP_SSD; ++rr) ssd::phase_out(XC, DTS, INP(15) + l * SH, INP(16) + l * SH, (const bf16*)ST, PROJ, Y, lds, G, wg); });
#else
        PHASE({ phase_ssd_states(XC, DTS, INP(15) + l * SH, ST, CDEC, lds, G, wg); });
        PHASE({ phase_ssd_scan(ST, CDEC, G, wg); });
        PHASE({ phase_ssd_out(XC, DTS, INP(15) + l * SH, INP(16) + l * SH, ST, YPRE, lds, G, wg); });
        PHASE({ phase_ssdnorm(YPRE, PROJ, Y, G, wg); });
#endif
        PHASE({ pg8::Gemm g{AO, (const bf16*)(wl + WL_OM), M, DM, DM, DM}; EpiGateF32 E{PROJ, TMPF}; run_gemm(lds, g, E, G, wg, GEMM_REPEAT); });
        PHASE({ pg8::Gemm g{Y, (const bf16*)(wl + WL_OS), M, DM, DI, DI}; EpiMerge E{PROJ, TMPF, MERGED}; run_gemm(lds, g, E, G, wg, GEMM_REPEAT); });
        PHASE({ pg8::Gemm g{MERGED, (const bf16*)(wl + WL_OUT), M, DM, DM, DM}; EpiResid E{X, XB1, ssq1}; run_gemm(lds, g, E, G, wg, SLOW4); });
        PHASE({ pg8::Gemm g{XB1, (const bf16*)(wl + WL_UP), M, DFF, DM, DM}; EpiUp E{ssq1, U}; run_gemm(lds, g, E, G, wg, GEMM_REPEAT); });
        PHASE({ pg8::Gemm g{U, (const bf16*)(wl + WL_DN), M, DM, DFF, DFF}; EpiResid E{X, XB2, ssq2}; run_gemm(lds, g, E, G, wg, SLOW4); });
        PHASE({ pg8::Gemm g{XB2, (const bf16*)(wl + WL_PG), M, DM, DM, DM};  EpiPleGate E{ssq2, PE, X, XB0, ssqn}; run_gemm(lds, g, E, G, wg, SLOW4); });
#endif
#endif
    }
#undef PHASE
#if defined(TIM_KIND)
#if defined(TIM_CLOCK)
    tim_acc = (__builtin_amdgcn_s_memtime() - clk0) / 160ull;
#endif
    if (wg == TIM_WG) { const unsigned long long t0 = __builtin_amdgcn_s_memrealtime(); while (__builtin_amdgcn_s_memrealtime() - t0 < (unsigned long long)(TIM_AMP) * tim_acc) __builtin_amdgcn_s_sleep(8); }
#endif
}

extern "C" void kernel_launch(void* const* d_in, const int* in_sizes, int n_in, void* d_out, int out_size, void* d_ws, size_t ws_size, hipStream_t stream) {
    static int grid = 0;
    if (grid == 0) {
        if (n_in != 26 || out_size != M * DM || ws_size < WS_END) { fprintf(stderr, "kernel_launch: built for 26 inputs, out %d floats, >= %zu bytes of workspace; got n_in %d out %d ws %zu\n", M * DM, (size_t)WS_END, n_in, out_size, ws_size); grid = -1; return; }
        int dev = 0, cus = 0;
        if (hipGetDevice(&dev) != hipSuccess || hipDeviceGetAttribute(&cus, hipDeviceAttributeMultiprocessorCount, dev) != hipSuccess) { grid = -1; return; }
        if (hipFuncSetAttribute((const void*)fwd, hipFuncAttributeMaxDynamicSharedMemorySize, LDS_BYTES) != hipSuccess) { fprintf(stderr, "kernel_launch: hipFuncSetAttribute failed\n"); grid = -1; return; }
        int per_cu = 0;
        if (hipOccupancyMaxActiveBlocksPerMultiprocessor(&per_cu, (const void*)fwd, NTHR, LDS_BYTES) != hipSuccess || per_cu < 1) fprintf(stderr, "kernel_launch: occupancy query says %d\n", per_cu);
        (void)hipGetLastError();
        grid = cus;
    }
    if (grid < 0) return;
    if (hipMemsetAsync((char*)d_ws + WS_CTL, 0, CTL_ZERO_BYTES, stream) != hipSuccess) return;
    Args a{};
    for (int i = 0; i < 26; ++i) a.in[i] = (const float*)d_in[i];
    a.out = (float*)d_out; a.ws = (unsigned char*)d_ws;
#if MK_ONE_LAUNCH
    a.ph_lo = 0; a.ph_hi = NPH;
    hipLaunchKernelGGL(fwd, dim3(grid), dim3(NTHR), LDS_BYTES, stream, a);
#else
#ifndef STOP_PH
#define STOP_PH NPH
#endif
    for (int ph = 0; ph < STOP_PH; ++ph) {
#ifdef SKIP_LO
        if (ph >= SKIP_LO && ph < SKIP_HI) continue;
#endif
        a.ph_lo = ph; a.ph_hi = ph + 1; hipLaunchKernelGGL(fwd, dim3(grid), dim3(NTHR), LDS_BYTES, stream, a); }
#endif
    const hipError_t le = hipPeekAtLastError();
    if (le != hipSuccess) fprintf(stderr, "kernel_launch: launch failed: %s\n", hipGetErrorName(le));
}
```
